# Optimizing an MI355X kernel written in HIP

```python
import math
import jax, jax.numpy as jnp
from jax import lax
import numpy as np

D_MODEL = 1024
BATCH = 8
SEQ = 4096
DEPTH = 4

GRID_W = 64
HEAD_DIM = 64
NA_HEADS = 4
NA_KH_MAX = 8
NA_KW = 16
WIN_HEADS = 4
WIN_KV_HEADS = 2
WINDOW = 128
WIN_BLOCK = 128
MLA_HEADS = 4
MLA_Q_RANK = 192
MLA_KV_RANK = 256
MLA_NOPE = 64
MLA_ROPE = 32
MLA_V = 64
AX_HEADS = 4
AX_KV_HEADS = 2
Q_BLOCK = 128
ROPE_THETA = 10000.0
N_BRANCH = 4
BRANCH_W = 256
N_GROUPS = 4
EXPERTS_PER_GROUP = 8
N_EXPERTS = N_GROUPS * EXPERTS_PER_GROUP
TOP_K = 2
D_EXPERT = 256
N_MOD = 6
EPS = 1e-6
NEG_INF = -1e30

IN_SIZES = (
    NA_HEADS * HEAD_DIM, NA_HEADS * HEAD_DIM, NA_HEADS * HEAD_DIM,
    WIN_HEADS * HEAD_DIM, WIN_KV_HEADS * HEAD_DIM, WIN_KV_HEADS * HEAD_DIM,
    MLA_Q_RANK, MLA_KV_RANK, MLA_ROPE,
    AX_HEADS * HEAD_DIM, AX_KV_HEADS * HEAD_DIM, AX_KV_HEADS * HEAD_DIM,
    N_BRANCH * D_MODEL,
)
D_IN = sum(IN_SIZES)

kernel_name = 'hybrid_gated_multimixer_hmoe_encoder'


def rmsnorm(x, g):
    xf = x.astype(jnp.float32)
    y = xf * lax.rsqrt(jnp.mean(xf * xf, axis=-1, keepdims=True) + EPS)
    return (y * g.astype(jnp.float32)).astype(x.dtype)


def to_heads(t, n):
    B, S, _ = t.shape
    return t.reshape(B, S, n, -1).transpose(0, 2, 1, 3)


def from_heads(t):
    B, H, S, d = t.shape
    return t.transpose(0, 2, 1, 3).reshape(B, S, H * d)


def rope_angles(pos, dim):
    inv = ROPE_THETA ** (-jnp.arange(0, dim, 2, dtype=jnp.float32) / dim)
    ang = pos.astype(jnp.float32)[:, None] * inv[None, :]
    return jnp.cos(ang), jnp.sin(ang)


def apply_rope(x, cos, sin):
    x1, x2 = jnp.split(x, 2, axis=-1)
    c = cos.astype(x.dtype)
    s = sin.astype(x.dtype)
    return jnp.concatenate([x1 * c - x2 * s, x1 * s + x2 * c], axis=-1)


def axial_rope(x, cos_r, sin_r, cos_c, sin_c):
    xr, xc = jnp.split(x, 2, axis=-1)
    return jnp.concatenate([apply_rope(xr, cos_r, sin_r), apply_rope(xc, cos_c, sin_c)], axis=-1)


def neighbourhood_attention(q, k, v, rel_bias, scale):
    B, H, S, dh = q.shape
    rows = S // GRID_W
    kh = min(NA_KH_MAX, rows)
    qg = q.reshape(B, H, rows, GRID_W, dh)
    kg = k.reshape(B, H, rows, GRID_W, dh)
    vg = v.reshape(B, H, rows, GRID_W, dh)
    r = jnp.arange(rows)
    row_start = jnp.clip(r - kh // 2, 0, rows - kh)
    key_rows = row_start[:, None] + jnp.arange(kh)[None, :]
    k_blk = kg[:, :, key_rows]
    v_blk = vg[:, :, key_rows]
    col = jnp.arange(GRID_W)
    col_start = jnp.clip(col - NA_KW // 2, 0, GRID_W - NA_KW)
    col_off = col[None, :] - col_start[:, None]
    col_in = (col_off >= 0) & (col_off < NA_KW)
    dr = key_rows - r[:, None]
    dc_idx = jnp.clip(col[None, :] - col[:, None], -(NA_KW - 1), NA_KW - 1) + NA_KW - 1
    bias = rel_bias.astype(jnp.float32)[:, dr + NA_KH_MAX - 1]
    bias = bias[..., dc_idx].transpose(0, 1, 3, 2, 4)
    s = jnp.einsum('bhrqd,bhrikd->bhrqik', qg, k_blk, preferred_element_type=jnp.float32) * scale
    s = jnp.where(col_in[:, None, :], s + bias[None], NEG_INF)
    p = jax.nn.softmax(s.reshape(B, H, rows, GRID_W, kh * GRID_W), axis=-1)
    p = p.reshape(B, H, rows, GRID_W, kh, GRID_W).astype(v.dtype)
    out = jnp.einsum('bhrqik,bhrikd->bhrqd', p, v_blk)
    return out.reshape(B, H, S, dh)


def window_attention(q, k, v, sink, scale):
    B, Hq, S, dh = q.shape
    Hkv = k.shape[1]
    G = Hq // Hkv
    nb = S // WIN_BLOCK
    qb = q.reshape(B, Hkv, G, nb, WIN_BLOCK, dh)
    pad = ((0, 0), (0, 0), (WIN_BLOCK, WIN_BLOCK), (0, 0))
    kp = jnp.pad(k, pad).reshape(B, Hkv, nb + 2, WIN_BLOCK, dh)
    vp = jnp.pad(v, pad).reshape(B, Hkv, nb + 2, WIN_BLOCK, dh)
    kw = jnp.concatenate([kp[:, :, :-2], kp[:, :, 1:-1], kp[:, :, 2:]], axis=3)
    vw = jnp.concatenate([vp[:, :, :-2], vp[:, :, 1:-1], vp[:, :, 2:]], axis=3)
    i = jnp.arange(WIN_BLOCK)
    m = jnp.arange(3 * WIN_BLOCK)
    rel = m[None, :] - WIN_BLOCK - i[:, None]
    s_abs = (jnp.arange(nb)[:, None] - 1) * WIN_BLOCK + m[None, :]
    valid = (jnp.abs(rel) <= WINDOW)[None] & ((s_abs >= 0) & (s_abs < S))[:, None, :]
    slopes = 2.0 ** (-8.0 * (jnp.arange(Hq, dtype=jnp.float32) + 1.0) / Hq)
    alibi = -slopes.reshape(Hkv, G)[:, :, None, None, None] * jnp.abs(rel).astype(jnp.float32)
    s = jnp.einsum('bkgnid,bknmd->bkgnim', qb, kw, preferred_element_type=jnp.float32) * scale
    s = jnp.where(valid, s + alibi, NEG_INF)
    sink_col = jnp.broadcast_to(sink.astype(jnp.float32).reshape(1, Hkv, G, 1, 1, 1), s.shape[:-1] + (1,))
    p = jax.nn.softmax(jnp.concatenate([s, sink_col], axis=-1), axis=-1)[..., :-1]
    out = jnp.einsum('bkgnim,bknmd->bkgnid', p.astype(v.dtype), vw)
    return out.reshape(B, Hq, S, dh)


def dense_attention(q, k, v, scale):
    B, Hq, S, dq = q.shape
    Hkv = k.shape[1]
    G = Hq // Hkv
    dv = v.shape[-1]
    nb = S // Q_BLOCK
    qb = q.reshape(B, Hkv, G, nb, Q_BLOCK, dq).transpose(3, 0, 1, 2, 4, 5)

    def block(qi):
        s = jnp.einsum('bkgid,bksd->bkgis', qi, k, preferred_element_type=jnp.float32) * scale
        p = jax.nn.softmax(s, axis=-1)
        return jnp.einsum('bkgis,bksd->bkgid', p.astype(v.dtype), v)

    out = lax.map(block, qb)
    return out.transpose(1, 2, 3, 0, 4, 5).reshape(B, Hq, S, dv)


def hybrid_mixer(h, rope_tabs, w_in, na_rel_bias, win_sink, mla_q_norm_g, mla_kv_norm_g, w_uq, w_ukv,
                 ax_q_norm_g, ax_k_norm_g, w_branch, w_out):
    B, S, _ = h.shape
    cos_t, sin_t, cos_r, sin_r, cos_c, sin_c = rope_tabs
    proj = h @ w_in
    (na_q, na_k, na_v, win_q, win_k, win_v, c_q, c_kv, k_rope,
     ax_q, ax_k, ax_v, gate_logits) = jnp.split(proj, np.cumsum(IN_SIZES)[:-1].tolist(), axis=-1)
    scale = HEAD_DIM ** -0.5
    y_a = neighbourhood_attention(to_heads(na_q, NA_HEADS), to_heads(na_k, NA_HEADS),
                                  to_heads(na_v, NA_HEADS), na_rel_bias, scale)
    y_b = window_attention(to_heads(win_q, WIN_HEADS), to_heads(win_k, WIN_KV_HEADS),
                           to_heads(win_v, WIN_KV_HEADS), win_sink, scale)
    q_c = to_heads(rmsnorm(c_q, mla_q_norm_g) @ w_uq, MLA_HEADS)
    q_nope, q_pe = jnp.split(q_c, [MLA_NOPE], axis=-1)
    kv_c = to_heads(rmsnorm(c_kv, mla_kv_norm_g) @ w_ukv, MLA_HEADS)
    k_nope, v_c = jnp.split(kv_c, [MLA_NOPE], axis=-1)
    k_pe = apply_rope(k_rope[:, None], cos_t, sin_t)
    q_full = jnp.concatenate([q_nope, apply_rope(q_pe, cos_t, sin_t)], axis=-1)
    k_full = jnp.concatenate([k_nope, jnp.broadcast_to(k_pe, (B, MLA_HEADS, S, MLA_ROPE))], axis=-1)
    y_c = dense_attention(q_full, k_full, v_c, (MLA_NOPE + MLA_ROPE) ** -0.5)
    q_d = axial_rope(rmsnorm(to_heads(ax_q, AX_HEADS), ax_q_norm_g), cos_r, sin_r, cos_c, sin_c)
    k_d = axial_rope(rmsnorm(to_heads(ax_k, AX_KV_HEADS), ax_k_norm_g), cos_r, sin_r, cos_c, sin_c)
    y_d = dense_attention(q_d, k_d, to_heads(ax_v, AX_KV_HEADS), scale)
    gates = jax.nn.sigmoid(gate_logits.reshape(B, S, N_BRANCH, D_MODEL))
    branches = (y_a, y_b, y_c, y_d)
    merged = gates[:, :, 0] * (from_heads(branches[0]) @ w_branch[0])
    for n in range(1, N_BRANCH):
        merged = merged + gates[:, :, n] * (from_heads(branches[n]) @ w_branch[n])
    return merged @ w_out


def hierarchical_moe(h, w_group, b_group, w_router, b_router, w_exp1, w_exp3, w_exp2):
    B, S, D = h.shape
    t = h.reshape(-1, D)
    N = t.shape[0]
    g_logits = (t @ w_group).astype(jnp.float32) + b_group.astype(jnp.float32)
    g_prob = jax.nn.softmax(g_logits, axis=-1)
    g_sel = jnp.argmax(g_logits, axis=-1)
    g_w = jnp.take_along_axis(g_prob, g_sel[:, None], axis=-1)
    e_logits = ((t @ w_router).astype(jnp.float32) + b_router.astype(jnp.float32)).reshape(N, N_GROUPS, EXPERTS_PER_GROUP)
    e_logits = jnp.take_along_axis(e_logits, g_sel[:, None, None], axis=1)[:, 0]
    e_prob = jax.nn.softmax(e_logits, axis=-1)
    top_p, top_i = lax.top_k(e_prob, TOP_K)
    weights = g_w * top_p / jnp.sum(top_p, axis=-1, keepdims=True)
    expert_id = g_sel[:, None] * EXPERTS_PER_GROUP + top_i
    combine = jnp.sum(jax.nn.one_hot(expert_id, N_EXPERTS, dtype=jnp.float32) * weights[..., None], axis=1)

    def expert_step(acc, params):
        w1e, w3e, w2e, ce = params
        hid = jax.nn.silu(t @ w1e) * (t @ w3e)
        return acc + ce[:, None].astype(t.dtype) * (hid @ w2e), None

    out, _ = lax.scan(expert_step, jnp.zeros_like(t), (w_exp1, w_exp3, w_exp2, combine.T))
    return out.reshape(B, S, D)


def setup_inputs(seed: int = 0) -> dict:
    key = jax.random.key(seed)
    ks = jax.random.split(key, 25)
    L, D = DEPTH, D_MODEL

    def nrm(k, shape, scale):
        return jax.random.normal(k, shape, jnp.float32) * scale

    return {
        'x': nrm(ks[0], (BATCH, SEQ, D), 1.0),
        'c': nrm(ks[1], (BATCH, D), 1.0),
        'w_ada': nrm(ks[2], (L, D, N_MOD * D), 0.5 * D ** -0.5),
        'b_ada': nrm(ks[3], (L, N_MOD * D), 0.01),
        'norm1_g': 1.0 + nrm(ks[4], (L, D), 0.01),
        'norm2_g': 1.0 + nrm(ks[5], (L, D), 0.01),
        'w_in': nrm(ks[6], (L, D, D_IN), D ** -0.5),
        'na_rel_bias': nrm(ks[7], (L, NA_HEADS, 2 * NA_KH_MAX - 1, 2 * NA_KW - 1), 0.1),
        'win_sink': nrm(ks[8], (L, WIN_HEADS), 0.5),
        'mla_q_norm_g': 1.0 + nrm(ks[9], (L, MLA_Q_RANK), 0.01),
        'mla_kv_norm_g': 1.0 + nrm(ks[10], (L, MLA_KV_RANK), 0.01),
        'w_uq': nrm(ks[11], (L, MLA_Q_RANK, MLA_HEADS * (MLA_NOPE + MLA_ROPE)), MLA_Q_RANK ** -0.5),
        'w_ukv': nrm(ks[12], (L, MLA_KV_RANK, MLA_HEADS * (MLA_NOPE + MLA_V)), MLA_KV_RANK ** -0.5),
        'ax_q_norm_g': 1.0 + nrm(ks[13], (L, HEAD_DIM), 0.01),
        'ax_k_norm_g': 1.0 + nrm(ks[14], (L, HEAD_DIM), 0.01),
        'w_branch': nrm(ks[15], (L, N_BRANCH, BRANCH_W, D), BRANCH_W ** -0.5),
        'w_out': nrm(ks[16], (L, D, D), D ** -0.5),
        'w_group': nrm(ks[17], (L, D, N_GROUPS), D ** -0.5),
        'b_group': nrm(ks[18], (L, N_GROUPS), 0.01),
        'w_router': nrm(ks[19], (L, D, N_EXPERTS), D ** -0.5),
        'b_router': nrm(ks[20], (L, N_EXPERTS), 0.01),
        'w_exp1': nrm(ks[21], (L, N_EXPERTS, D, D_EXPERT), D ** -0.5),
        'w_exp3': nrm(ks[22], (L, N_EXPERTS, D, D_EXPERT), D ** -0.5),
        'w_exp2': nrm(ks[23], (L, N_EXPERTS, D_EXPERT, D), D_EXPERT ** -0.5),
        'final_norm_g': 1.0 + nrm(ks[24], (D,), 0.01),
    }


def reference(x, c, w_ada, b_ada, norm1_g, norm2_g, w_in, na_rel_bias, win_sink, mla_q_norm_g,
              mla_kv_norm_g, w_uq, w_ukv, ax_q_norm_g, ax_k_norm_g, w_branch, w_out, w_group, b_group,
              w_router, b_router, w_exp1, w_exp3, w_exp2, final_norm_g):
    S = x.shape[1]
    pos = jnp.arange(S)
    cos_t, sin_t = rope_angles(pos, MLA_ROPE)
    cos_r, sin_r = rope_angles(pos // GRID_W, HEAD_DIM // 2)
    cos_c, sin_c = rope_angles(pos % GRID_W, HEAD_DIM // 2)
    rope_tabs = (cos_t, sin_t, cos_r, sin_r, cos_c, sin_c)
    c_act = jax.nn.silu(c)
    for l in range(DEPTH):
        mod = c_act @ w_ada[l] + b_ada[l]
        sh1, sc1, g1, sh2, sc2, g2 = jnp.split(mod[:, None, :], N_MOD, axis=-1)
        h = rmsnorm(x, norm1_g[l]) * (1.0 + sc1) + sh1
        x = x + g1 * hybrid_mixer(h, rope_tabs, w_in[l], na_rel_bias[l], win_sink[l], mla_q_norm_g[l],
                                  mla_kv_norm_g[l], w_uq[l], w_ukv[l], ax_q_norm_g[l], ax_k_norm_g[l],
                                  w_branch[l], w_out[l])
        h = rmsnorm(x, norm2_g[l]) * (1.0 + sc2) + sh2
        x = x + g2 * hierarchical_moe(h, w_group[l], b_group[l], w_router[l], b_router[l],
                                      w_exp1[l], w_exp3[l], w_exp2[l])
    return rmsnorm(x, final_norm_g)
```

```cpp
#include <hip/hip_runtime.h>
#include <hip/hip_bf16.h>
#include <cstdio>
#include <cstdint>

#define GAS __attribute__((address_space(1)))
#define LAS __attribute__((address_space(3)))
typedef unsigned short bf16_t;
typedef short bf16x8 __attribute__((ext_vector_type(8)));
typedef short s16x4 __attribute__((ext_vector_type(4)));
typedef float f32x2 __attribute__((ext_vector_type(2)));
typedef float f32x4 __attribute__((ext_vector_type(4)));
typedef float f32x16 __attribute__((ext_vector_type(16)));
typedef unsigned u32x2 __attribute__((ext_vector_type(2)));
typedef unsigned u32x4 __attribute__((ext_vector_type(4)));
typedef __bf16 bf16x2_t __attribute__((ext_vector_type(2)));

constexpr int NB = 8, SEQ = 4096, DM = 1024, DEPTH = 4, MTOK = NB * SEQ;
constexpr int NPROJ = 6400;
constexpr int LDP = 2304;
constexpr size_t GATE_BASE = (size_t)NB * SEQ * LDP * 2;
__device__ __forceinline__ size_t gate_off(int pm, int g, int wid, int ai, int lane) { return GATE_BASE + ((((size_t)(pm * 16 + g) * 8 + wid) * 2 + ai) * 64 + lane) * 64; }
constexpr int PC_NAQ = 0, PC_NAK = 256, PC_NAV = 512, PC_WQ = 768, PC_WK = 1024, PC_WV = 1152, PC_AXQ = 1280, PC_AXK = 1536, PC_AXV = 1664,
              PC_CQ = 1792, PC_CKV = 1984, PC_KR = 2240, PC_GATE = 2304, PC_YC = 1792;
constexpr int NEXP = 32, LISTCAP = 32768, SORTROWS = 2 * MTOK + NEXP * 256;
constexpr float LOG2E = 1.4426950408889634f;
constexpr float EPS = 1e-6f;

__device__ __forceinline__ unsigned cvt_pk_bf16(float lo, float hi) { f32x2 v = {lo, hi}; bf16x2_t b = __builtin_convertvector(v, bf16x2_t); return __builtin_bit_cast(unsigned, b); }
__device__ __forceinline__ float bf2f(unsigned short b) { return __uint_as_float(((unsigned)b) << 16); }
__device__ __forceinline__ float bflo(unsigned w) { return __uint_as_float(w << 16); }
__device__ __forceinline__ float bfhi(unsigned w) { return __uint_as_float(w & 0xffff0000u); }
__device__ __forceinline__ unsigned short f2bf(float f) { return (unsigned short)(cvt_pk_bf16(f, 0.f) & 0xffffu); }
__device__ __forceinline__ int lane_now() { int l; asm volatile("v_mbcnt_lo_u32_b32 %0, -1, 0\n\tv_mbcnt_hi_u32_b32 %0, -1, %0" : "=v"(l)); return l; }
template <int MASK> __device__ __forceinline__ float xshfl(float v) {
    if constexpr (MASK == 32) { auto rr = __builtin_amdgcn_permlane32_swap(__float_as_uint(v), __float_as_uint(v), false, false); return __uint_as_float((lane_now() & 32) ? rr[0] : rr[1]); }
    else return __uint_as_float((unsigned)__builtin_amdgcn_ds_swizzle((int)__float_as_uint(v), (MASK << 10) | 0x1f));
}
__device__ __forceinline__ unsigned pk_fp8x4(float a, float b, float c, float d) { unsigned w = 0u; w = __builtin_amdgcn_cvt_pk_fp8_f32(a, b, w, false); w = __builtin_amdgcn_cvt_pk_fp8_f32(c, d, w, true); return w; }
__device__ __forceinline__ float fast_sigmoid(float x) { return __builtin_amdgcn_rcpf(1.0f + __builtin_amdgcn_exp2f(-x * LOG2E)); }

namespace pg8 {
constexpr int BM = 256, BK = 64, HALF = 128, HTB = HALF * BK * 2, STAGE_BYTES = 8 * HTB, NXCD = 8, WGM = 8;

__host__ __device__ __forceinline__ int lds_byte(int r, int c) { const int st = (r >> 4) * 2 + (c >> 5), rr = r & 15, cc = c & 31, ob = rr * 64 + cc * 2; return st * 1024 + (ob ^ (((ob >> 9) & 1) << 5)); }
__host__ __device__ __forceinline__ void stage_rc(int b, int& R, int& C) { const int st = b / 1024, sb = b % 1024, swz = sb ^ (((sb >> 9) & 1) << 5); R = (st >> 1) * 16 + swz / 64; C = (st & 1) * 32 + (swz % 64) / 2; }
__host__ __device__ __forceinline__ int perm32(int rho) { const int n = rho >> 4, i = rho & 15; return 8 * (i >> 2) + 4 * n + (i & 3); }

typedef int i32x4 __attribute__((ext_vector_type(4)));
typedef int i32x8 __attribute__((ext_vector_type(8)));
struct Unit { int pm, pn, e, acol, lbase, nv; };
struct Gemm { const bf16_t* A; const bf16_t* Bt; const int* list; };

struct StaticOrder {
    int nM, nN, nwg, G, c, skew;
    __device__ __forceinline__ void init(int M, int N, int G_, int c_, int skew_ = 0) { nM = M / BM; nN = N / BM; nwg = nM * nN; G = G_; c = c_; skew = (skew_ && nwg % G_ == 0 && G_ % 16 == 0 && nwg >= 2 * G_) ? 1 : 0; }
    __device__ __forceinline__ bool next(int i, Unit& u) const {
        long L = (long)i * G + c;
        if (skew) { const int R = nwg / G; if (i >= R - 1) { const int k = i - (R - 1); if (c < G / 2 || k >= 2) return false; L = (long)(R - 1) * G + k * (G / 2) + (c - G / 2); } }
        if (L >= nwg) return false;
        int wgid = (int)L; { const int q = nwg / NXCD, r = nwg % NXCD, xcd = wgid % NXCD, off = wgid / NXCD; wgid = (xcd < r ? xcd * (q + 1) : r * (q + 1) + (xcd - r) * q) + off; }
        const int nig = WGM * nN, gid = wgid / nig, fm = gid * WGM, gsz = (nM - fm) < WGM ? (nM - fm) : WGM;
        u.pm = fm + ((wgid % nig) % gsz); u.pn = (wgid % nig) / gsz; u.e = 0; u.acol = 0; u.lbase = 0; u.nv = 256; return true;
    }
};

template <bool GATHER, int LDA>
__device__ __forceinline__ void a_offsets(const Gemm& g, const Unit& u, const int (&Rr)[2], const unsigned (&Cb)[2], unsigned (&vo)[2][2]) {
#pragma unroll
    for (int h = 0; h < 2; ++h)
#pragma unroll
        for (int i = 0; i < 2; ++i) {
            if constexpr (GATHER) {
                int idx = h * HALF + Rr[i]; idx = idx < u.nv ? idx : (u.nv - 1);
                const int row = g.list[u.lbase + idx];
                vo[h][i] = (unsigned)row * (unsigned)(LDA * 2) + Cb[i];
            } else {
                vo[h][i] = (unsigned)(h * HALF + Rr[i]) * (unsigned)(LDA * 2) + Cb[i];
            }
        }
}

template <class Epi, class Sched, bool GATHER, bool ALIGN_EPI, int LDA, int LDB, int KK, int NBE, bool F8 = false>
__device__ __forceinline__ void gemm_phase(LAS unsigned char* lds, const Gemm g, const Sched& S, const Epi& E, int tid) {
    asm volatile("" : "+v"(tid));
    const int wid = __builtin_amdgcn_readfirstlane(tid >> 6), lane = tid & 63, wr = wid >> 2, wc = wid & 3, fr = lane & 15, fq = lane >> 4;
    constexpr int nt = KK / BK;
    int Rr[2]; unsigned Cb[2]; unsigned voffB[2];
#pragma unroll
    for (int i = 0; i < 2; ++i) { int R, C; stage_rc(tid * 16 + i * 8192, R, C); const int Rb = Epi::PERM ? ((R & ~31) + perm32(R & 31)) : R;
        Rr[i] = R; Cb[i] = (unsigned)C * 2u; voffB[i] = (unsigned)(Rb * LDB + C) * 2u; }
    const size_t kstep = (size_t)(BK * 2);
    constexpr size_t hstepB = (size_t)HALF * LDB * 2, hstepA = (size_t)HALF * LDA * 2;
    const unsigned ldsw = (unsigned)wid * 1024u;
    const int aoff = lds_byte(wr * 64 + fr, fq * 8), boff = lds_byte(wc * 32 + fr, fq * 8);
#define PG8_SA(b, h) (((b) * 2 + (h)) * HTB)
#define PG8_SB(b, h) ((4 + (b) * 2 + (h)) * HTB)
#define PG8_STAGE(bufoff, gbase, voff) do { _Pragma("unroll") for (int _i = 0; _i < 2; ++_i) \
        __builtin_amdgcn_global_load_lds((const unsigned*)((const char*)(gbase) + (voff)[_i]), (LAS unsigned*)(lds + (bufoff) + ldsw + _i * 8192), 16, 0, 0); } while (0)
#define PG8_LDA(dst, b, h) do { _Pragma("unroll") for (int m = 0; m < 4; ++m) { if constexpr (F8) { dst##8[m].lo = *(const LAS i32x4*)(lds + PG8_SA(b, h) + aoff + m * 2048); dst##8[m].hi = *(const LAS i32x4*)(lds + PG8_SA(b, h) + aoff + m * 2048 + 1024); } \
        else { _Pragma("unroll") for (int k = 0; k < 2; ++k) dst[m][k] = *(const LAS bf16x8*)(lds + PG8_SA(b, h) + aoff + m * 2048 + k * 1024); } } } while (0)
#define PG8_LDB(dst, b, h) do { _Pragma("unroll") for (int n = 0; n < 2; ++n) { if constexpr (F8) { dst##8[n].lo = *(const LAS i32x4*)(lds + PG8_SB(b, h) + boff + n * 2048); dst##8[n].hi = *(const LAS i32x4*)(lds + PG8_SB(b, h) + boff + n * 2048 + 1024); } \
        else { _Pragma("unroll") for (int k = 0; k < 2; ++k) dst[n][k] = *(const LAS bf16x8*)(lds + PG8_SB(b, h) + boff + n * 2048 + k * 1024); } } } while (0)
#define PG8_MMA(ai, bj, At, Bt) do { __builtin_amdgcn_s_setprio(1); _Pragma("unroll") for (int m = 0; m < 4; ++m) _Pragma("unroll") for (int n = 0; n < 2; ++n) { \
        if constexpr (F8) { asm volatile("v_mfma_scale_f32_16x16x128_f8f6f4 %0, %1, %2, %0, %3, %3 op_sel_hi:[0,0,0]" : "+v"(acc[ai][bj][m][n]) : "v"(Bt##8[n]), "v"(At##8[m]), "v"(sc127)); }   \
        else { _Pragma("unroll") for (int k = 0; k < 2; ++k) acc[ai][bj][m][n] = __builtin_amdgcn_mfma_f32_16x16x32_bf16(Bt[n][k], At[m][k], acc[ai][bj][m][n], 0, 0, 0); } } \
        __builtin_amdgcn_s_setprio(0); } while (0)
#define PG8_WAIT_V(n) asm volatile("s_waitcnt vmcnt(" #n ")" ::: "memory")
#define PG8_WAIT_L(n) asm volatile("s_waitcnt lgkmcnt(" #n ")" ::: "memory")
#define PG8_BAR __builtin_amdgcn_s_barrier()
#define PG8_SCHED __builtin_amdgcn_sched_barrier(0)
#define PG8_STAGE_A(bufoff, gbase, vo, h) do { if constexpr (GATHER) { PG8_STAGE(bufoff, gbase, (vo)[h]); } else { PG8_STAGE(bufoff, (gbase) + (h) * hstepA, (vo)[0]); } } while (0)
#define PG8_ABASE(u) (GATHER ? (size_t)0 : ((size_t)(u).pm * BM * LDA + (size_t)(u).acol) * 2)
#define PG8_BBASE(u) (((size_t)(u).e * NBE + (size_t)(u).pn * BM) * LDB * 2)
    Unit cur, nxt; int ui = 0;
    if (!S.next(0, cur)) return;
    f32x4 acc[2][2][4][2];
#pragma unroll
    for (int a = 0; a < 2; ++a)
#pragma unroll
        for (int b = 0; b < 2; ++b)
#pragma unroll
            for (int m = 0; m < 4; ++m)
#pragma unroll
                for (int n = 0; n < 2; ++n) acc[a][b][m][n] = (f32x4){0.f, 0.f, 0.f, 0.f};
    bf16x8 At[4][2], B0[2][2], B1[2][2];
    i32x8 At8[4], B08[2], B18[2];
    int sc127 = 127; asm volatile("" : "+v"(sc127)); (void)sc127;
    (void)At; (void)B0; (void)B1; (void)At8; (void)B08; (void)B18;
    unsigned voA[2][2];
    a_offsets<GATHER, LDA>(g, cur, Rr, Cb, voA);
    if constexpr (GATHER) { asm volatile("s_waitcnt vmcnt(0)" ::: "memory"); }
    const char* Ab = (const char*)g.A; const char* Bb = (const char*)g.Bt; asm volatile("" : "+s"(Ab), "+s"(Bb)); Ab = (const char*)(const GAS char*)Ab; Bb = (const char*)(const GAS char*)Bb;
    const char* cA = Ab + PG8_ABASE(cur); const char* cB = Bb + PG8_BBASE(cur);
    PG8_STAGE(PG8_SB(0, 0), cB, voffB); PG8_STAGE(PG8_SB(0, 1), cB + hstepB, voffB); PG8_STAGE_A(PG8_SA(0, 0), cA, voA, 0); PG8_STAGE_A(PG8_SA(0, 1), cA, voA, 1);
    if (wr == 1) PG8_BAR;
    PG8_WAIT_V(2); PG8_BAR;
    PG8_STAGE(PG8_SB(1, 0), cB + kstep, voffB); PG8_STAGE_A(PG8_SA(1, 0), cA + kstep, voA, 0); PG8_STAGE(PG8_SB(1, 1), cB + hstepB + kstep, voffB);
    PG8_WAIT_V(6); PG8_BAR;
    for (;;) {
        const bool has_next = S.next(ui + 1, nxt);
        const char* nA = has_next ? Ab + PG8_ABASE(nxt) : cA; const char* nB = has_next ? Bb + PG8_BBASE(nxt) : cB;
#pragma unroll 1
        for (int t = 0; t < nt; t += 2) {
            const bool last = (t == nt - 2);
            const char* a1 = cA + (size_t)(t + 1) * kstep;
            const char* a2 = last ? nA : cA + (size_t)(t + 2) * kstep; const char* b2 = last ? nB : cB + (size_t)(t + 2) * kstep;
            const char* a3 = a2 + kstep; const char* b3 = b2 + kstep;
            PG8_LDB(B0, 0, 0); PG8_LDB(B1, 0, 1); PG8_SCHED; PG8_LDA(At, 0, 0); PG8_STAGE_A(PG8_SA(1, 1), a1, voA, 1);
            if constexpr (GATHER) { if (last && has_next) { a_offsets<GATHER, LDA>(g, nxt, Rr, Cb, voA); asm volatile("s_waitcnt vmcnt(0)" ::: "memory"); } }
            PG8_WAIT_V(8); PG8_WAIT_L(0); PG8_BAR; PG8_MMA(0, 0, At, B0); PG8_MMA(0, 1, At, B1); PG8_BAR; PG8_SCHED;
            PG8_LDA(At, 0, 1); PG8_STAGE(PG8_SB(0, 0), b2, voffB); PG8_STAGE(PG8_SB(0, 1), b2 + hstepB, voffB); PG8_STAGE_A(PG8_SA(0, 0), a2, voA, 0);
            PG8_WAIT_V(8); PG8_WAIT_L(0); PG8_BAR; PG8_MMA(1, 0, At, B0); PG8_MMA(1, 1, At, B1); PG8_BAR; PG8_SCHED;
            PG8_LDB(B0, 1, 0); PG8_LDB(B1, 1, 1); PG8_SCHED; PG8_LDA(At, 1, 0); PG8_STAGE_A(PG8_SA(0, 1), a2, voA, 1);
            PG8_WAIT_V(8); PG8_WAIT_L(0); PG8_BAR; PG8_MMA(0, 0, At, B0); PG8_MMA(0, 1, At, B1); PG8_BAR; PG8_SCHED;
            PG8_LDA(At, 1, 1); PG8_STAGE(PG8_SB(1, 0), b3, voffB); PG8_STAGE(PG8_SB(1, 1), b3 + hstepB, voffB); PG8_STAGE_A(PG8_SA(1, 0), a3, voA, 0);
            PG8_WAIT_V(8); PG8_WAIT_L(0); PG8_BAR; PG8_MMA(1, 0, At, B0); PG8_MMA(1, 1, At, B1); PG8_BAR; PG8_SCHED;
        }
        if constexpr (F8) { asm volatile("s_nop 15\n\ts_nop 15\n\ts_nop 15" ::: "memory"); }
        if constexpr (ALIGN_EPI) { if (wr == 0) PG8_BAR; }
        if constexpr (!Epi::AFTER_DRAIN) { E(acc, cur, wr, wc, fr, fq); }
        if (!has_next) break;
#pragma unroll
        for (int a = 0; a < 2; ++a)
#pragma unroll
            for (int b = 0; b < 2; ++b)
#pragma unroll
                for (int m = 0; m < 4; ++m)
#pragma unroll
                    for (int n = 0; n < 2; ++n) acc[a][b][m][n] = (f32x4){0.f, 0.f, 0.f, 0.f};
        cur = nxt; cA = nA; cB = nB; ++ui;
        if constexpr (ALIGN_EPI) { if (wr == 1) PG8_BAR; }
    }
    PG8_WAIT_V(0);
    if constexpr (!ALIGN_EPI) { if (wr == 0) PG8_BAR; }
    PG8_BAR;
    if constexpr (Epi::AFTER_DRAIN) { E.fused(acc, cur, wr, wc, fr, fq, lds, wid, lane); }
#undef PG8_SA
#undef PG8_SB
#undef PG8_STAGE
#undef PG8_LDA
#undef PG8_LDB
#undef PG8_MMA
#undef PG8_WAIT_V
#undef PG8_WAIT_L
#undef PG8_BAR
#undef PG8_SCHED
#undef PG8_STAGE_A
#undef PG8_ABASE
#undef PG8_BBASE
}
}
namespace pg8 {
typedef f32x4 AccT[2][2][4][2];

__device__ __forceinline__ u32x4 pack8(const f32x4 v0, const f32x4 v1) {
    u32x4 w; w.x = cvt_pk_bf16(v0[0], v0[1]); w.y = cvt_pk_bf16(v0[2], v0[3]); w.z = cvt_pk_bf16(v1[0], v1[1]); w.w = cvt_pk_bf16(v1[2], v1[3]); return w;
}
__device__ __forceinline__ void unpack8(const u32x4 w, f32x4& v0, f32x4& v1) {
    v0 = (f32x4){bflo(w.x), bfhi(w.x), bflo(w.y), bfhi(w.y)}; v1 = (f32x4){bflo(w.z), bfhi(w.z), bflo(w.w), bfhi(w.w)};
}

constexpr float MERGE_WSCALE = 16.0f;
constexpr float GATE_WSCALE = 64.0f, GATE_WINV = 1.0f / 64.0f;
struct EpiProj {
    static constexpr bool PERM = true, AFTER_DRAIN = false;
    bf16_t* O; LAS float* xch; float* ssq; const float* cs; bf16_t* KC; const float* gaq; const float* gak; int pn0;
    __device__ __forceinline__ void operator()(const AccT& acc, const Unit& u_, int wr, int wc, int fr, int fq) const {
        Unit u = u_; u.pn += pn0;
        const bool gate = u.pn >= 9;
        const float qs = (u.pn == 0 || u.pn == 3) ? 0.125f * LOG2E : 1.0f;
        const int row0 = u.pm * BM + wr * 64 + fr, col0 = u.pn * BM + wc * 32 + 8 * fq;
        if (gate) {
            int lx = fq * 16 + fr; asm volatile("" : "+v"(lx));
            unsigned char* gt = (unsigned char*)O + gate_off(u.pm, u.pn - 9, wr * 4 + wc, 0, lx);
#pragma unroll
            for (int ai = 0; ai < 2; ++ai)
#pragma unroll
                for (int m = 0; m < 4; ++m) { u32x4 w4;
#pragma unroll
                    for (int bj = 0; bj < 2; ++bj) { const f32x4 v0 = acc[ai][bj][m][0], v1 = acc[ai][bj][m][1]; unsigned q[8];
#pragma unroll
                        for (int j = 0; j < 4; ++j) {
                            q[j] = (unsigned)fmaxf(__builtin_amdgcn_rcpf(1.0f + __builtin_amdgcn_exp2f(v0[j] * GATE_WINV)) * 255.0f + 0.5f, 1.0f); q[4 + j] = (unsigned)fmaxf(__builtin_amdgcn_rcpf(1.0f + __builtin_amdgcn_exp2f(v1[j] * GATE_WINV)) * 255.0f + 0.5f, 1.0f); }
                        const unsigned lo = q[0] | (q[1] << 8) | (q[2] << 16) | (q[3] << 24), hi = q[4] | (q[5] << 8) | (q[6] << 16) | (q[7] << 24);
                        if (bj == 0) { w4.x = lo; w4.y = hi; } else { w4.z = lo; w4.w = hi; } }
                    *(GAS u32x4*)(gt + ai * 4096 + m * 16) = w4; }
        } else if (u.pn == 5 || u.pn == 6) {
            const bool isq = u.pn == 5;
            int frx = fr; asm volatile("" : "+v"(frx));
#pragma unroll
            for (int ai = 0; ai < 2; ++ai)
#pragma unroll
                for (int m = 0; m < 4; ++m)
#pragma unroll
                    for (int bj = 0; bj < 2; ++bj) { const f32x4 v0 = acc[ai][bj][m][0], v1 = acc[ai][bj][m][1];
                        float p = (v0[0] * v0[0] + v0[1] * v0[1]) + (v0[2] * v0[2] + v0[3] * v0[3]) + (v1[0] * v1[0] + v1[1] * v1[1]) + (v1[2] * v1[2] + v1[3] * v1[3]);
                        p += xshfl<16>(p); p += xshfl<32>(p);
                        if (fq == 0 && (isq || bj == 0)) xch[(ai * HALF + wr * 64 + m * 16 + frx) * 8 + 4 * bj + wc] = p; }
            asm volatile("s_waitcnt lgkmcnt(0)\n\ts_barrier" ::: "memory");
#pragma unroll
            for (int ai = 0; ai < 2; ++ai)
#pragma unroll
                for (int m = 0; m < 4; ++m) { const int rl = ai * HALF + wr * 64 + m * 16 + frx, row = u.pm * BM + rl; const int pos = row & (SEQ - 1);
                    bf16_t* rowp = O + (size_t)row * LDP + col0;
#pragma unroll
                    for (int bj = 0; bj < 2; ++bj) { f32x4 v0 = acc[ai][bj][m][0], v1 = acc[ai][bj][m][1];
                        if (isq || bj == 0) {
                            const f32x2 pr_ = *(const LAS f32x2*)(xch + rl * 8 + ((4 * bj + wc) & ~1)); const float tot = pr_.x + pr_.y;
                            const float rstd = rsqrtf(tot * (1.0f / 64.0f) + EPS) * (isq ? 0.125f * LOG2E : 1.0f);
                            const int hf = wc & 1;
                            const float* G = (isq ? gaq : gak) + 32 * hf + 4 * fq;
                            { const f32x4 g0 = *(const GAS f32x4*)G; v0 = v0 * rstd * g0; }
                            { const f32x4 g1 = *(const GAS f32x4*)(G + 16); v1 = v1 * rstd * g1; }
                            const int idx = hf ? (pos & 63) : (pos >> 6);
                            const f32x4 c4 = *(const GAS f32x4*)(cs + idx * 16 + 4 * fq), s4 = *(const GAS f32x4*)(cs + SEQ * 16 + idx * 16 + 4 * fq);
                            const f32x4 o0 = v0 * c4 - v1 * s4, o1 = v0 * s4 + v1 * c4; v0 = o0; v1 = o1; }
                        *(GAS u32x4*)(rowp + bj * HALF) = pack8(v0, v1);
                        asm volatile("" ::: "memory"); }
                    asm volatile("" ::: "memory"); }
        } else if (u.pn == 7 || u.pn == 8) {
#pragma unroll
            for (int ai = 0; ai < 2; ++ai)
#pragma unroll
                for (int m = 0; m < 4; ++m) { const int row = row0 + ai * HALF + m * 16; bf16_t* rowp = O + (size_t)row * LDP + col0;
#pragma unroll
                    for (int bj = 0; bj < 2; ++bj) { const f32x4 v0 = acc[ai][bj][m][0], v1 = acc[ai][bj][m][1];
                        *(GAS u32x4*)(rowp + bj * HALF) = pack8(v0, v1);
                        const int lc = 128 * bj + 32 * wc;
                        const int grp = lc >> 5;
                        const int slot = (u.pn == 7) ? (grp < 6 ? grp : 8 + (grp - 6)) : (grp < 6 ? 10 + grp : -1);
                        if (slot >= 0) {
                            float p = (v0[0] * v0[0] + v0[1] * v0[1]) + (v0[2] * v0[2] + v0[3] * v0[3]) + (v1[0] * v1[0] + v1[1] * v1[1]) + (v1[2] * v1[2] + v1[3] * v1[3]);
                            p += xshfl<16>(p); p += xshfl<32>(p);
                            if (fq == 0) ssq[(size_t)row * 16 + slot] = p;
                        } else if (lc == 192) {
                            const int pos = row & (SEQ - 1);
                            const f32x4 c4 = *(const GAS f32x4*)(cs + pos * 16 + 4 * fq), s4 = *(const GAS f32x4*)(cs + SEQ * 16 + pos * 16 + 4 * fq);
                            const u32x4 w = pack8(v0 * c4 - v1 * s4, v0 * s4 + v1 * c4);
                            bf16_t* kr = KC + (size_t)row * 384 + 64 + 8 * fq;
#pragma unroll
                            for (int h = 0; h < 4; ++h) *(GAS u32x4*)(kr + 96 * h) = w;
                        } } }
        } else {
#pragma unroll
            for (int ai = 0; ai < 2; ++ai)
#pragma unroll
                for (int m = 0; m < 4; ++m) { bf16_t* rowp = O + (size_t)(row0 + ai * HALF + m * 16) * LDP + col0;
#pragma unroll
                    for (int bj = 0; bj < 2; ++bj) *(GAS u32x4*)(rowp + bj * HALF) = pack8(acc[ai][bj][m][0] * qs, acc[ai][bj][m][1] * qs); }
        }
    }
};

struct EpiNone {
    static constexpr bool PERM = true, AFTER_DRAIN = false;
    float* sink;
    __device__ __forceinline__ void operator()(const AccT& acc, const Unit& u, int wr, int wc, int fr, int fq) const {
        float s = 0.f;
#pragma unroll
        for (int ai = 0; ai < 2; ++ai)
#pragma unroll
            for (int bj = 0; bj < 2; ++bj)
#pragma unroll
                for (int m = 0; m < 4; ++m) s += acc[ai][bj][m][0][0] + acc[ai][bj][m][1][3];
        if (s == 1.2345e30f) sink[0] = s;
    }
};

struct EpiQup {
    static constexpr bool PERM = true, AFTER_DRAIN = false;
    bf16_t* QC; const float* cs; const float* ssq;
    __device__ __forceinline__ void operator()(const AccT& acc, const Unit& u, int wr, int wc, int fr, int fq) const {
        const int row0 = u.pm * BM + wr * 64 + fr;
#pragma unroll
        for (int bj = 0; bj < 2; ++bj) {
            const int gi = 8 * u.pn + 4 * bj + wc;
            if (gi >= 12) continue;
            const bool rope = (gi % 3) == 2;
            const int col = 32 * gi + 8 * fq;
#pragma unroll
            for (int ai = 0; ai < 2; ++ai)
#pragma unroll
                for (int m = 0; m < 4; ++m) { const int row = row0 + ai * HALF + m * 16; const f32x4 sa_ = *(const GAS f32x4*)(ssq + (size_t)row * 16); const f32x2 sb_ = *(const GAS f32x2*)(ssq + (size_t)row * 16 + 4);
                    const float rs_ = rsqrtf((((sa_[0] + sa_[1]) + (sa_[2] + sa_[3])) + (sb_[0] + sb_[1])) * (1.0f / 192.0f) + EPS) * (0.10206207261596575f * LOG2E);
                    f32x4 v0 = acc[ai][bj][m][0] * rs_, v1 = acc[ai][bj][m][1] * rs_;
                    if (rope) { const int pos = row & (SEQ - 1);
                        const f32x4 c4 = *(const GAS f32x4*)(cs + pos * 16 + 4 * fq), s4 = *(const GAS f32x4*)(cs + SEQ * 16 + pos * 16 + 4 * fq);
                        const f32x4 o1 = v0 * c4 - v1 * s4, o2 = v0 * s4 + v1 * c4; v0 = o1; v1 = o2; }
                    *(GAS u32x4*)(QC + (size_t)row * 384 + col) = pack8(v0, v1); asm volatile("" ::: "memory"); }
        }
    }
};

struct EpiKVup {
    static constexpr bool PERM = true, AFTER_DRAIN = false;
    bf16_t* KC; bf16_t* VC; const float* ssq;
    __device__ __forceinline__ void operator()(const AccT& acc, const Unit& u, int wr, int wc, int fr, int fq) const {
        const int row0 = u.pm * BM + wr * 64 + fr;
#pragma unroll
        for (int bj = 0; bj < 2; ++bj) {
            const int col = 128 * bj + 32 * wc + 8 * fq;
            bf16_t* base = (u.pn == 0) ? KC : VC; const int ld = (u.pn == 0) ? 384 : 256; const int coff = (u.pn == 0) ? (96 * (col >> 6) + (col & 63)) : col;
#pragma unroll
            for (int ai = 0; ai < 2; ++ai)
#pragma unroll
                for (int m = 0; m < 4; ++m) { const int row = row0 + ai * HALF + m * 16;
                    const f32x4 sa_ = *(const GAS f32x4*)(ssq + (size_t)row * 16 + 8), sb_ = *(const GAS f32x4*)(ssq + (size_t)row * 16 + 12);
                    const float rs_ = rsqrtf((((sa_[0] + sa_[1]) + (sa_[2] + sa_[3])) + ((sb_[0] + sb_[1]) + (sb_[2] + sb_[3]))) * (1.0f / 256.0f) + EPS);
                    *(GAS u32x4*)(base + (size_t)row * ld + coff) = pack8(acc[ai][bj][m][0] * rs_, acc[ai][bj][m][1] * rs_); }
        }
    }
};

struct EpiMerge {
    static constexpr bool PERM = true, AFTER_DRAIN = false;
    const bf16_t* P; bf16_t* HB;
    __device__ __forceinline__ void operator()(const AccT& acc, const Unit& u, int wr, int wc, int fr, int fq) const {
        const int row0 = u.pm * BM + wr * 64 + fr, col0 = u.pn * BM + wc * 32 + 8 * fq, n = u.e;
#pragma unroll
        for (int ai = 0; ai < 2; ++ai) {
            u32x2 gw[4][2]; u32x4 ow[4][2];
#pragma unroll
            for (int m = 0; m < 4; ++m)
#pragma unroll
                for (int bj = 0; bj < 2; ++bj) { const int row = row0 + ai * HALF + m * 16, col = col0 + bj * HALF;
                    gw[m][bj] = *(const GAS u32x2*)((const unsigned char*)(P + (size_t)row * LDP + PC_GATE) + 1024 * n + col);
                    if (n > 0) ow[m][bj] = *(const GAS u32x4*)(HB + (size_t)row * DM + col); else ow[m][bj] = (u32x4){0u, 0u, 0u, 0u}; }
#pragma unroll
            for (int m = 0; m < 4; ++m)
#pragma unroll
                for (int bj = 0; bj < 2; ++bj) { const int row = row0 + ai * HALF + m * 16, col = col0 + bj * HALF;
                    const unsigned ga = gw[m][bj].x, gb = gw[m][bj].y; constexpr float K = 1.0f / 255.0f;
                    const f32x4 g0 = (f32x4){(float)(ga & 0xffu), (float)((ga >> 8) & 0xffu), (float)((ga >> 16) & 0xffu), (float)(ga >> 24)} * K;
                    const f32x4 g1 = (f32x4){(float)(gb & 0xffu), (float)((gb >> 8) & 0xffu), (float)((gb >> 16) & 0xffu), (float)(gb >> 24)} * K;
                    f32x4 o0, o1; unpack8(ow[m][bj], o0, o1);
                    const f32x4 v0 = g0 * acc[ai][bj][m][0] + o0, v1 = g1 * acc[ai][bj][m][1] + o1;
                    *(GAS u32x4*)(HB + (size_t)row * DM + col) = pack8(v0, v1); }
            asm volatile("" ::: "memory");
        }
    }
};

struct EpiOut {
    static constexpr bool PERM = false, AFTER_DRAIN = false;
    const float* base; float* out; const float* gvec;
    __device__ __forceinline__ void operator()(const AccT& acc, const Unit& u, int wr, int wc, int fr, int fq) const {
        const int b = u.pm >> 4;
        const int row0 = u.pm * BM + wr * 64 + fr, col0 = u.pn * BM + wc * 32 + 4 * fq;
#pragma unroll
        for (int bj = 0; bj < 2; ++bj)
#pragma unroll
            for (int n = 0; n < 2; ++n) {
                const int col = col0 + bj * HALF + n * 16; const f32x4 gv = *(const GAS f32x4*)(gvec + b * 6144 + col);
                f32x4 bs[2][4];
#pragma unroll
                for (int ai = 0; ai < 2; ++ai)
#pragma unroll
                    for (int m = 0; m < 4; ++m) bs[ai][m] = *(const GAS f32x4*)(base + (size_t)(row0 + ai * HALF + m * 16) * DM + col);
#pragma unroll
                for (int ai = 0; ai < 2; ++ai)
#pragma unroll
                    for (int m = 0; m < 4; ++m) *(GAS f32x4*)(out + (size_t)(row0 + ai * HALF + m * 16) * DM + col) = bs[ai][m] + gv * acc[ai][bj][m][n];
                asm volatile("" ::: "memory");
            }
    }
};

struct EpiResid {
    static constexpr bool PERM = true, AFTER_DRAIN = false;
    const float* xf; bf16_t* XBo; const float* gvec;
    __device__ __forceinline__ void operator()(const AccT& acc, const Unit& u, int wr, int wc, int fr, int fq) const {
        const int b = u.pm >> 4;
        const int row0 = u.pm * BM + wr * 64 + fr, col0 = u.pn * BM + wc * 32 + 8 * fq;
#pragma unroll
        for (int bj = 0; bj < 2; ++bj) { const int col = col0 + bj * HALF;
            const f32x4 g0 = *(const GAS f32x4*)(gvec + b * 6144 + col), g1 = *(const GAS f32x4*)(gvec + b * 6144 + col + 4);
#pragma unroll
            for (int ai = 0; ai < 2; ++ai) {
                f32x4 x0[4], x1[4];
                if (xf) {
#pragma unroll
                    for (int m = 0; m < 4; ++m) { const size_t off = (size_t)(row0 + ai * HALF + m * 16) * DM + col; x0[m] = *(const GAS f32x4*)(xf + off); x1[m] = *(const GAS f32x4*)(xf + off + 4); }
                } else {
                    u32x4 xw[4];
#pragma unroll
                    for (int m = 0; m < 4; ++m) xw[m] = *(const GAS u32x4*)(XBo + (size_t)(row0 + ai * HALF + m * 16) * DM + col);
#pragma unroll
                    for (int m = 0; m < 4; ++m) unpack8(xw[m], x0[m], x1[m]);
                }
#pragma unroll
                for (int m = 0; m < 4; ++m) *(GAS u32x4*)(XBo + (size_t)(row0 + ai * HALF + m * 16) * DM + col) = pack8(x0[m] + acc[ai][bj][m][0] * g0, x1[m] + acc[ai][bj][m][1] * g1);
                asm volatile("" ::: "memory"); } }
    }
};

struct EpiRoute {
    static constexpr bool PERM = true, AFTER_DRAIN = true;
    const float* bg; const float* br; unsigned* ecnt; int* list; int* tok_es; float* tok_w;
    __device__ __forceinline__ void fused(const AccT& acc, const Unit& u, int wr, int wc, int fr, int fq, LAS unsigned char* lds, int wid, int lane) const {
        LAS float* LG = (LAS float*)lds;
        LAS unsigned* lcnt = (LAS unsigned*)(lds + 256 * 40 * 4);
        LAS unsigned* lbase = lcnt + 32;
        int tid = wid * 64 + lane; asm volatile("" : "+v"(tid));
        if (wc < 2) {
#pragma unroll
            for (int ai = 0; ai < 2; ++ai)
#pragma unroll
                for (int m = 0; m < 4; ++m) { const int rl = ai * HALF + wr * 64 + m * 16 + fr; const f32x4 v0 = acc[ai][0][m][0], v1 = acc[ai][0][m][1];
                    if (wc == 0) { *(LAS f32x4*)(LG + rl * 40 + 8 * fq) = v0; *(LAS f32x4*)(LG + rl * 40 + 8 * fq + 4) = v1; }
                    else if (fq == 0) { *(LAS f32x4*)(LG + rl * 40 + 32) = v0; } }
        }
        if (tid < 32) lcnt[tid] = 0u;
        __syncthreads();
        int e1 = 0, e2 = 0; unsigned r1 = 0, r2 = 0; float w1 = 0.f, w2 = 0.f;
        if (tid < 256) {
            const LAS float* lg = LG + tid * 40;
            float g[4];
#pragma unroll
            for (int j = 0; j < 4; ++j) g[j] = lg[j] + bg[j];
            int gs = 0; float gm = g[0];
#pragma unroll
            for (int j = 1; j < 4; ++j) if (g[j] > gm) { gm = g[j]; gs = j; }
            float gsum = 0.f;
#pragma unroll
            for (int j = 0; j < 4; ++j) gsum += __expf(g[j] - gm);
            const float gw = 1.0f / gsum;
            float el[8];
#pragma unroll
            for (int j = 0; j < 8; ++j) el[j] = lg[4 + 8 * gs + j] + br[8 * gs + j];
            int i1 = 0; float m1 = el[0];
#pragma unroll
            for (int j = 1; j < 8; ++j) if (el[j] > m1) { m1 = el[j]; i1 = j; }
            int i2 = -1; float m2 = 0.f;
#pragma unroll
            for (int j = 0; j < 8; ++j) if (j != i1 && (i2 < 0 || el[j] > m2)) { m2 = el[j]; i2 = j; }
            const float t = __expf(m2 - m1);
            w1 = gw / (1.0f + t); w2 = gw * t / (1.0f + t);
            e1 = 8 * gs + i1; e2 = 8 * gs + i2;
            r1 = atomicAdd((unsigned*)(lcnt + e1), 1u); r2 = atomicAdd((unsigned*)(lcnt + e2), 1u);
        }
        __syncthreads();
        if (tid < 32) lbase[tid] = __hip_atomic_fetch_add(ecnt + tid, lcnt[tid], __ATOMIC_RELAXED, __HIP_MEMORY_SCOPE_AGENT);
        __syncthreads();
        if (tid < 256) {
            const int token = u.pm * BM + tid;
            const int s1 = (int)(lbase[e1] + r1), s2 = (int)(lbase[e2] + r2);
            list[e1 * LISTCAP + s1] = token; list[e2 * LISTCAP + s2] = token;
            tok_es[2 * token] = (e1 << 16) | s1; tok_es[2 * token + 1] = (e2 << 16) | s2;
            tok_w[2 * token] = w1; tok_w[2 * token + 1] = w2;
        }
    }
};

struct EpiExp1 {
    static constexpr bool PERM = true, AFTER_DRAIN = false;
    bf16_t* HS;
    __device__ __forceinline__ void operator()(const AccT& acc, const Unit& u, int wr, int wc, int fr, int fq) const {
        const int row0 = u.pm * BM + wr * 64 + fr;
#pragma unroll
        for (int ai = 0; ai < 2; ++ai)
#pragma unroll
            for (int m = 0; m < 4; ++m) { bf16_t* rowp = HS + (size_t)(row0 + ai * HALF + m * 16) * 256;
#pragma unroll
                for (int bj = 0; bj < 2; ++bj) { const f32x4 a = acc[ai][bj][m][0], b = acc[ai][bj][m][1]; float h[4];
#pragma unroll
                    for (int j = 0; j < 4; ++j) h[j] = a[j] * fast_sigmoid(a[j]) * b[j];
                    u32x2 w; w.x = cvt_pk_bf16(h[0], h[1]); w.y = cvt_pk_bf16(h[2], h[3]);
                    *(GAS u32x2*)(rowp + u.pn * 128 + 64 * bj + 16 * wc + 4 * fq) = w; } }
    }
};

struct EpiStore {
    static constexpr bool PERM = true, AFTER_DRAIN = false;
    bf16_t* O; int ldc;
    __device__ __forceinline__ void operator()(const AccT& acc, const Unit& u, int wr, int wc, int fr, int fq) const {
        const int row0 = u.pm * BM + wr * 64 + fr, col0 = u.pn * BM + wc * 32 + 8 * fq;
#pragma unroll
        for (int ai = 0; ai < 2; ++ai)
#pragma unroll
            for (int m = 0; m < 4; ++m) { bf16_t* rowp = O + (size_t)(row0 + ai * HALF + m * 16) * ldc + col0;
#pragma unroll
                for (int bj = 0; bj < 2; ++bj) *(GAS u32x4*)(rowp + bj * HALF) = pack8(acc[ai][bj][m][0], acc[ai][bj][m][1]); }
    }
};

struct MergeOrder {
    int G, vc;
    __device__ bool next(int i, Unit& u) const {
        const int tile = vc + G * (i >> 2); if (tile >= (MTOK / BM) * (DM / BM)) return false;
        u.pm = tile >> 2; u.pn = tile & 3; u.e = i & 3; u.lbase = 0; u.nv = 256;
        u.acol = (u.e == 0) ? PC_NAQ : (u.e == 1) ? PC_WQ : (u.e == 2) ? PC_YC : PC_AXQ;
        return true;
    }
};

struct MoeOrder {
    int G, c, sh; const LAS int* tend; const LAS int* cnt;
    __device__ bool next(int i, Unit& u) const {
        const int L = i * G + c, tau = L >> sh;
        const int total = __builtin_amdgcn_readfirstlane(tend[NEXP - 1]);
        if (tau >= total) return false;
        int e = 0;
        while (e < NEXP - 1 && __builtin_amdgcn_readfirstlane(tend[e]) <= tau) ++e;
        const int ts = e ? __builtin_amdgcn_readfirstlane(tend[e - 1]) : 0, lt = tau - ts;
        int nv = __builtin_amdgcn_readfirstlane(cnt[e]) - 256 * lt; nv = nv > 256 ? 256 : nv;
        u.pm = tau; u.pn = L & ((1 << sh) - 1); u.e = e; u.acol = 0; u.lbase = e * LISTCAP + 256 * lt; u.nv = nv;
        return true;
    }
};
}
namespace pg8 {
struct MUnit { int pm, pn; };
__device__ __forceinline__ void merge_phase(LAS unsigned char* lds, const bf16_t* Pp, const bf16_t* Wbt, bf16_t* HBo, int G, int vc, int tid) {
    asm volatile("" : "+v"(tid));
    const int wid = __builtin_amdgcn_readfirstlane(tid >> 6), lane = tid & 63, wr = wid >> 2, wc = wid & 3, fr = lane & 15, fq = lane >> 4;
    constexpr int nt = 16, NU = (MTOK / 128) * (DM / 256);
    unsigned voffA[2], voffB[2];
#pragma unroll
    for (int i = 0; i < 2; ++i) { int R, C; stage_rc(tid * 16 + i * 8192, R, C); const int Rb = (R & ~31) + perm32(R & 31);
        voffA[i] = (unsigned)(R * LDP + C) * 2u; voffB[i] = (unsigned)(Rb * 256 + C) * 2u; }
    const unsigned ldsw = (unsigned)wid * 1024u;
    const int aoff = lds_byte(wr * 64 + fr, fq * 8), boff = lds_byte(wc * 32 + fr, fq * 8);
#define MG_SA(b) (((b) * 2) * HTB)
#define MG_SB(b, h) ((4 + (b) * 2 + (h)) * HTB)
#define MG_STAGE(bufoff, gbase, voff) do { _Pragma("unroll") for (int _i = 0; _i < 2; ++_i) \
        __builtin_amdgcn_global_load_lds((const unsigned*)((const char*)(gbase) + (voff)[_i]), (LAS unsigned*)(lds + (bufoff) + ldsw + _i * 8192), 16, 0, 0); } while (0)
#define MG_LDA(dst, b) do { _Pragma("unroll") for (int m = 0; m < 4; ++m) _Pragma("unroll") for (int k = 0; k < 2; ++k) dst[m][k] = *(const LAS bf16x8*)(lds + MG_SA(b) + aoff + m * 2048 + k * 1024); } while (0)
#define MG_LDB(dst, b, h) do { _Pragma("unroll") for (int n = 0; n < 2; ++n) _Pragma("unroll") for (int k = 0; k < 2; ++k) dst[n][k] = *(const LAS bf16x8*)(lds + MG_SB(b, h) + boff + n * 2048 + k * 1024); } while (0)
#define MG_MMA(bj, At, Bt) do { __builtin_amdgcn_s_setprio(1); _Pragma("unroll") for (int m = 0; m < 4; ++m) _Pragma("unroll") for (int n = 0; n < 2; ++n) _Pragma("unroll") for (int k = 0; k < 2; ++k) \
        acc[bj][m][n] = __builtin_amdgcn_mfma_f32_16x16x32_bf16(Bt[n][k], At[m][k], acc[bj][m][n], 0, 0, 0); __builtin_amdgcn_s_setprio(0); } while (0)
#define MG_WAIT_V(n) asm volatile("s_waitcnt vmcnt(" #n ")" ::: "memory")
#define MG_WAIT_L(n) asm volatile("s_waitcnt lgkmcnt(" #n ")" ::: "memory")
#define MG_BAR __builtin_amdgcn_s_barrier()
#define MG_SCHED __builtin_amdgcn_sched_barrier(0)
    const char* Ab = (const char*)Pp; const char* Bb = (const char*)Wbt; asm volatile("" : "+s"(Ab), "+s"(Bb)); Ab = (const char*)(const GAS char*)Ab; Bb = (const char*)(const GAS char*)Bb;
#define MG_ACOL(n) ((n) == 0 ? PC_NAQ : (n) == 1 ? PC_WQ : (n) == 2 ? PC_YC : PC_AXQ)
#define MG_A(u, kt) (Ab + ((size_t)(u).pm * 128 * LDP + MG_ACOL((kt) >> 2) + ((kt) & 3) * 64) * 2)
#define MG_B(u, kt) (Bb + ((size_t)(((kt) >> 2) * DM + (u).pn * 256) * 256 + ((kt) & 3) * 64) * 2)
    constexpr size_t hstepB = (size_t)HALF * 256 * 2, kstep = 128;
    MUnit cur, nxt; int ui = 0;
    { const int idx = vc; if (idx >= NU) return; cur.pm = idx >> 2; cur.pn = idx & 3; }
    f32x4 acc[2][4][2], sum[2][4][2];
#pragma unroll
    for (int b = 0; b < 2; ++b)
#pragma unroll
        for (int m = 0; m < 4; ++m)
#pragma unroll
            for (int n = 0; n < 2; ++n) { acc[b][m][n] = (f32x4){0.f, 0.f, 0.f, 0.f}; sum[b][m][n] = (f32x4){0.f, 0.f, 0.f, 0.f}; }
    bf16x8 At[4][2], B0[2][2], B1[2][2];
    u32x2 gw[4][2];
#pragma unroll
    for (int m = 0; m < 4; ++m) { gw[m][0] = (u32x2){0u, 0u}; gw[m][1] = (u32x2){0u, 0u}; }
    { const char* b0_ = MG_B(cur, 0); MG_STAGE(MG_SB(0, 0), b0_, voffB); MG_STAGE(MG_SB(0, 1), b0_ + hstepB, voffB); MG_STAGE(MG_SA(0), MG_A(cur, 0), voffA); }
    if (wr == 1) MG_BAR;
    MG_WAIT_V(0); MG_BAR;
    { const char* b1_ = MG_B(cur, 1); MG_STAGE(MG_SB(1, 0), b1_, voffB); MG_STAGE(MG_SA(1), MG_A(cur, 1), voffA); MG_STAGE(MG_SB(1, 1), b1_ + hstepB, voffB); }
    MG_WAIT_V(6); MG_BAR;
    for (;;) {
        bool has_next; { const int idx = vc + G * (ui + 1); has_next = idx < NU; nxt.pm = idx >> 2; nxt.pn = idx & 3; }
#pragma unroll 1
        for (int t = 0; t < nt; t += 2) {
            const bool last = (t == nt - 2);
            const char* a2 = last ? (has_next ? MG_A(nxt, 0) : MG_A(cur, 0)) : MG_A(cur, t + 2);
            const char* b2 = last ? (has_next ? MG_B(nxt, 0) : MG_B(cur, 0)) : MG_B(cur, t + 2);
            const char* a3 = a2 + kstep; const char* b3 = b2 + kstep;
            if ((t & 3) == 0) {
                const int n = t >> 2; int lx = lane; asm volatile("" : "+v"(lx));
                const unsigned char* gp = (const unsigned char*)Pp + gate_off(cur.pm >> 1, 4 * n + cur.pn, wid, cur.pm & 1, lx);
#pragma unroll
                for (int m = 0; m < 4; ++m) { const u32x4 w4 = *(const GAS u32x4*)(gp + m * 16); gw[m][0] = (u32x2){w4.x, w4.y}; gw[m][1] = (u32x2){w4.z, w4.w}; }
            }
            MG_LDB(B0, 0, 0); MG_LDB(B1, 0, 1); MG_SCHED; MG_LDA(At, 0);
            MG_WAIT_L(0); MG_BAR; MG_MMA(0, At, B0); MG_MMA(1, At, B1); MG_BAR; MG_SCHED;
            MG_STAGE(MG_SB(0, 0), b2, voffB); MG_STAGE(MG_SB(0, 1), b2 + hstepB, voffB); MG_STAGE(MG_SA(0), a2, voffA);
            if ((t & 3) == 0) MG_WAIT_V(10); else MG_WAIT_V(6);
            MG_WAIT_L(0); MG_BAR; MG_BAR; MG_SCHED;
            MG_LDB(B0, 1, 0); MG_LDB(B1, 1, 1); MG_SCHED; MG_LDA(At, 1);
            MG_WAIT_L(0); MG_BAR; MG_MMA(0, At, B0); MG_MMA(1, At, B1); MG_BAR; MG_SCHED;
            if ((t & 3) == 2) {
#pragma unroll
                for (int m = 0; m < 4; ++m)
#pragma unroll
                    for (int bj = 0; bj < 2; ++bj) { const unsigned ga = gw[m][bj].x, gb = gw[m][bj].y; constexpr float Kq = 1.0f / 255.0f;
                        const f32x4 g0 = (f32x4){(float)(ga & 0xffu), (float)((ga >> 8) & 0xffu), (float)((ga >> 16) & 0xffu), (float)(ga >> 24)} * Kq;
                        const f32x4 g1 = (f32x4){(float)(gb & 0xffu), (float)((gb >> 8) & 0xffu), (float)((gb >> 16) & 0xffu), (float)(gb >> 24)} * Kq;
                        sum[bj][m][0] += g0 * acc[bj][m][0]; sum[bj][m][1] += g1 * acc[bj][m][1];
                        acc[bj][m][0] = (f32x4){0.f, 0.f, 0.f, 0.f}; acc[bj][m][1] = (f32x4){0.f, 0.f, 0.f, 0.f}; }
                asm volatile("" ::: "memory");
            }
            MG_STAGE(MG_SB(1, 0), b3, voffB); MG_STAGE(MG_SB(1, 1), b3 + hstepB, voffB); MG_STAGE(MG_SA(1), a3, voffA);
            MG_WAIT_V(6); MG_WAIT_L(0); MG_BAR; MG_BAR; MG_SCHED;
        }
        if (wr == 0) MG_BAR;
        { const int row0 = cur.pm * 128 + wr * 64 + fr, col0 = cur.pn * 256 + wc * 32 + 8 * fq;
#pragma unroll
          for (int m = 0; m < 4; ++m)
#pragma unroll
              for (int bj = 0; bj < 2; ++bj) { *(GAS u32x4*)(HBo + (size_t)(row0 + m * 16) * DM + col0 + bj * HALF) = pack8(sum[bj][m][0], sum[bj][m][1]);
                  sum[bj][m][0] = (f32x4){0.f, 0.f, 0.f, 0.f}; sum[bj][m][1] = (f32x4){0.f, 0.f, 0.f, 0.f}; } }
        if (!has_next) break;
        cur = nxt; ++ui;
        if (wr == 1) MG_BAR;
    }
    MG_WAIT_V(0);
    MG_BAR;
#undef MG_SA
#undef MG_SB
#undef MG_STAGE
#undef MG_LDA
#undef MG_LDB
#undef MG_MMA
#undef MG_WAIT_V
#undef MG_WAIT_L
#undef MG_BAR
#undef MG_SCHED
#undef MG_ACOL
#undef MG_A
#undef MG_B
}
}

namespace pg8 {
__device__ __forceinline__ f32x4 gate_q4(unsigned w) {
    f32x4 q = (f32x4){(float)(w & 0xffu), (float)((w >> 8) & 0xffu), (float)((w >> 16) & 0xffu), (float)(w >> 24)};
    return q;
}
__device__ __forceinline__ f32x4 rcp4(f32x4 v) { return (f32x4){__builtin_amdgcn_rcpf(v[0]), __builtin_amdgcn_rcpf(v[1]), __builtin_amdgcn_rcpf(v[2]), __builtin_amdgcn_rcpf(v[3])}; }
__device__ __forceinline__ void merge_phase2(LAS unsigned char* lds, const bf16_t* Pp, const bf16_t* Wbt, bf16_t* HBo, int G, int vc, int tid) {
    asm volatile("" : "+v"(tid));
    const int wid = __builtin_amdgcn_readfirstlane(tid >> 6), lane = tid & 63, wr = wid >> 2, wc = wid & 3, fr = lane & 15, fq = lane >> 4;
    constexpr int nt = 16, NU = (MTOK / 256) * (DM / 256);
    unsigned voffA[2], voffB[2];
#pragma unroll
    for (int i = 0; i < 2; ++i) { int R, C; stage_rc(tid * 16 + i * 8192, R, C); const int Rb = (R & ~31) + perm32(R & 31);
        voffA[i] = (unsigned)(R * LDP + C) * 2u; voffB[i] = (unsigned)(Rb * 256 + C) * 2u; }
    const unsigned ldsw = (unsigned)wid * 1024u;
    const int aoff = lds_byte(wr * 64 + fr, fq * 8), boff = lds_byte(wc * 32 + fr, fq * 8);
#define M2_SA(b, h) (((b) * 2 + (h)) * HTB)
#define M2_SB(b, h) ((4 + (b) * 2 + (h)) * HTB)
#define M2_STAGE(bufoff, gbase, voff) do { _Pragma("unroll") for (int _i = 0; _i < 2; ++_i) \
        __builtin_amdgcn_global_load_lds((const unsigned*)((const char*)(gbase) + (voff)[_i]), (LAS unsigned*)(lds + (bufoff) + ldsw + _i * 8192), 16, 0, 0); } while (0)
#define M2_LDA(dst, b, h) do { _Pragma("unroll") for (int m = 0; m < 4; ++m) _Pragma("unroll") for (int k = 0; k < 2; ++k) dst[m][k] = *(const LAS bf16x8*)(lds + M2_SA(b, h) + aoff + m * 2048 + k * 1024); } while (0)
#define M2_LDB(dst, b, h) do { _Pragma("unroll") for (int n = 0; n < 2; ++n) _Pragma("unroll") for (int k = 0; k < 2; ++k) dst[n][k] = *(const LAS bf16x8*)(lds + M2_SB(b, h) + boff + n * 2048 + k * 1024); } while (0)
#define M2_MMA(ai, bj, At, Bt) do { __builtin_amdgcn_s_setprio(1); _Pragma("unroll") for (int m = 0; m < 4; ++m) _Pragma("unroll") for (int n = 0; n < 2; ++n) _Pragma("unroll") for (int k = 0; k < 2; ++k) \
        acc[ai][bj][m][n] = __builtin_amdgcn_mfma_f32_16x16x32_bf16(Bt[n][k], At[m][k], acc[ai][bj][m][n], 0, 0, 0); __builtin_amdgcn_s_setprio(0); } while (0)
#define M2_WAIT_V(n) asm volatile("s_waitcnt vmcnt(" #n ")" ::: "memory")
#define M2_WAIT_L(n) asm volatile("s_waitcnt lgkmcnt(" #n ")" ::: "memory")
#define M2_BAR __builtin_amdgcn_s_barrier()
#define M2_SCHED __builtin_amdgcn_sched_barrier(0)
    const char* Ab = (const char*)Pp; const char* Bb = (const char*)Wbt; asm volatile("" : "+s"(Ab), "+s"(Bb)); Ab = (const char*)(const GAS char*)Ab; Bb = (const char*)(const GAS char*)Bb;
#define M2_ACOL(n) ((n) == 0 ? PC_NAQ : (n) == 1 ? PC_WQ : (n) == 2 ? PC_YC : PC_AXQ)
#define M2_A(u, kt) (Ab + ((size_t)(u).pm * 256 * LDP + M2_ACOL((kt) >> 2) + ((kt) & 3) * 64) * 2)
#define M2_B(u, kt) (Bb + ((size_t)(((kt) >> 2) * DM + (u).pn * 256) * 256 + ((kt) & 3) * 64) * 2)
    constexpr size_t hstepB = (size_t)HALF * 256 * 2, hstepA = (size_t)HALF * LDP * 2, kstep = 128;
    MUnit cur, nxt; int ui = 0;
    { const int idx = vc; if (idx >= NU) return; cur.pm = idx >> 2; cur.pn = idx & 3; }
    f32x4 acc[2][2][4][2];
#pragma unroll
    for (int a = 0; a < 2; ++a)
#pragma unroll
        for (int b = 0; b < 2; ++b)
#pragma unroll
            for (int m = 0; m < 4; ++m)
#pragma unroll
                for (int n = 0; n < 2; ++n) acc[a][b][m][n] = (f32x4){0.f, 0.f, 0.f, 0.f};
    bf16x8 At[4][2], B0[2][2], B1[2][2];
    u32x2 ga[4][2], gb[4][2];
#pragma unroll
    for (int m = 0; m < 4; ++m) { ga[m][0] = (u32x2){0u, 0u}; ga[m][1] = ga[m][0]; gb[m][0] = ga[m][0]; gb[m][1] = ga[m][0]; }
#define M2_GLOAD(ai, n) do { int lx = lane; asm volatile("" : "+v"(lx)); const unsigned char* gp = (const unsigned char*)Pp + gate_off(cur.pm, 4 * (n) + cur.pn, wid, (ai), lx); \
        _Pragma("unroll") for (int m = 0; m < 4; ++m) { const u32x4 wa = *(const GAS u32x4*)(gp + m * 16), wb_ = *(const GAS u32x4*)(gp + 4 * 65536 + m * 16); \
            ga[m][0] = (u32x2){wa.x, wa.y}; ga[m][1] = (u32x2){wa.z, wa.w}; gb[m][0] = (u32x2){wb_.x, wb_.y}; gb[m][1] = (u32x2){wb_.z, wb_.w}; } } while (0)
#define M2_GSCALE(ai) do { _Pragma("unroll") for (int m = 0; m < 4; ++m) _Pragma("unroll") for (int bj = 0; bj < 2; ++bj) { \
            acc[ai][bj][m][0] = acc[ai][bj][m][0] * (gate_q4(ga[m][bj].x) * rcp4(gate_q4(gb[m][bj].x))); \
            acc[ai][bj][m][1] = acc[ai][bj][m][1] * (gate_q4(ga[m][bj].y) * rcp4(gate_q4(gb[m][bj].y))); } } while (0)
    { const char* cA = M2_A(cur, 0); const char* cB = M2_B(cur, 0);
      M2_STAGE(M2_SB(0, 0), cB, voffB); M2_STAGE(M2_SB(0, 1), cB + hstepB, voffB); M2_STAGE(M2_SA(0, 0), cA, voffA); M2_STAGE(M2_SA(0, 1), cA + hstepA, voffA);
      if (wr == 1) M2_BAR;
      M2_WAIT_V(2); M2_BAR;
      M2_STAGE(M2_SB(1, 0), cB + kstep, voffB); M2_STAGE(M2_SA(1, 0), cA + kstep, voffA); M2_STAGE(M2_SB(1, 1), cB + hstepB + kstep, voffB);
      M2_WAIT_V(6); M2_BAR; }
    for (;;) {
        bool has_next; { const int idx = vc + G * (ui + 1); has_next = idx < NU; nxt.pm = idx >> 2; nxt.pn = idx & 3; }
#pragma unroll 1
        for (int t = 0; t < nt; t += 2) {
            const bool last = (t == nt - 2);
            const bool bnd = ((t & 3) == 2) && !last;
            const bool pend = ((t & 3) == 0) && t != 0;
            const char* a1 = M2_A(cur, t) + kstep;
            const char* a2 = last ? (has_next ? M2_A(nxt, 0) : M2_A(cur, 0)) : M2_A(cur, t + 2);
            const char* b2 = last ? (has_next ? M2_B(nxt, 0) : M2_B(cur, 0)) : M2_B(cur, t + 2);
            const char* a3 = a2 + kstep; const char* b3 = b2 + kstep;
            M2_LDB(B0, 0, 0); M2_LDB(B1, 0, 1); M2_SCHED; M2_LDA(At, 0, 0); M2_STAGE(M2_SA(1, 1), a1 + hstepA, voffA);
            if (pend) M2_WAIT_V(16); else M2_WAIT_V(8);
            M2_WAIT_L(0); M2_BAR; M2_MMA(0, 0, At, B0); M2_MMA(0, 1, At, B1); M2_BAR; M2_SCHED;
            if (pend) { M2_WAIT_V(2); M2_GSCALE(1); M2_SCHED; }
            M2_LDA(At, 0, 1); M2_STAGE(M2_SB(0, 0), b2, voffB); M2_STAGE(M2_SB(0, 1), b2 + hstepB, voffB); M2_STAGE(M2_SA(0, 0), a2, voffA);
            M2_WAIT_V(8); M2_WAIT_L(0); M2_BAR; M2_MMA(1, 0, At, B0); M2_MMA(1, 1, At, B1); M2_BAR; M2_SCHED;
            if (bnd) { M2_GLOAD(0, t >> 2); }
            M2_LDB(B0, 1, 0); M2_LDB(B1, 1, 1); M2_SCHED; M2_LDA(At, 1, 0); M2_STAGE(M2_SA(0, 1), a2 + hstepA, voffA);
            if (bnd) M2_WAIT_V(16); else M2_WAIT_V(8);
            M2_WAIT_L(0); M2_BAR; M2_MMA(0, 0, At, B0); M2_MMA(0, 1, At, B1); M2_BAR; M2_SCHED;
            M2_LDA(At, 1, 1); M2_STAGE(M2_SB(1, 0), b3, voffB); M2_STAGE(M2_SB(1, 1), b3 + hstepB, voffB); M2_STAGE(M2_SA(1, 0), a3, voffA);
            M2_WAIT_V(8); M2_WAIT_L(0); M2_BAR; M2_MMA(1, 0, At, B0); M2_MMA(1, 1, At, B1); if (bnd) { M2_SCHED; M2_GSCALE(0); } M2_BAR;
            if (bnd) { M2_GLOAD(1, t >> 2); }
            M2_SCHED;
        }
        if (wr == 0) M2_BAR;
        { int frx = fr; asm volatile("" : "+v"(frx)); const int row0 = cur.pm * 256 + wr * 64 + frx, col0 = cur.pn * 256 + wc * 32 + 8 * fq;
#pragma unroll
          for (int ai = 0; ai < 2; ++ai) {
              u32x2 g3[4][2];
              { const unsigned char* gp = (const unsigned char*)Pp + gate_off(cur.pm, 12 + cur.pn, wid, ai, frx + 16 * fq);
#pragma unroll
                for (int m = 0; m < 4; ++m) { const u32x4 w4 = *(const GAS u32x4*)(gp + m * 16); g3[m][0] = (u32x2){w4.x, w4.y}; g3[m][1] = (u32x2){w4.z, w4.w}; } }
#pragma unroll
              for (int m = 0; m < 4; ++m)
#pragma unroll
                  for (int bj = 0; bj < 2; ++bj) { constexpr float Kq = 1.0f / 255.0f;
                      *(GAS u32x4*)(HBo + (size_t)(row0 + ai * HALF + m * 16) * DM + col0 + bj * HALF) = pack8(acc[ai][bj][m][0] * (gate_q4(g3[m][bj].x) * Kq), acc[ai][bj][m][1] * (gate_q4(g3[m][bj].y) * Kq));
                      acc[ai][bj][m][0] = (f32x4){0.f, 0.f, 0.f, 0.f}; acc[ai][bj][m][1] = (f32x4){0.f, 0.f, 0.f, 0.f}; }
              asm volatile("" ::: "memory"); } }
        if (!has_next) break;
        cur = nxt; ++ui;
        if (wr == 1) M2_BAR;
    }
    M2_WAIT_V(0);
    M2_BAR;
#undef M2_SA
#undef M2_SB
#undef M2_STAGE
#undef M2_LDA
#undef M2_LDB
#undef M2_MMA
#undef M2_WAIT_V
#undef M2_WAIT_L
#undef M2_BAR
#undef M2_SCHED
#undef M2_GLOAD
#undef M2_GSCALE
#undef M2_ACOL
#undef M2_A
#undef M2_B
}
__device__ __forceinline__ void merge_phase3(LAS unsigned char* lds, const bf16_t* Pp, const unsigned char* Y8, const unsigned char* Wb8, bf16_t* HBo, int G, int vc, int tid) {
    asm volatile("" : "+v"(tid));
    const int wid = __builtin_amdgcn_readfirstlane(tid >> 6), lane = tid & 63, wr = wid >> 2, wc = wid & 3, fr = lane & 15, fq = lane >> 4;
    constexpr int nt = 8, NU = (MTOK / 256) * (DM / 256);
    unsigned voffA[2], voffB[2];
#pragma unroll
    for (int i = 0; i < 2; ++i) { int R, C; stage_rc(tid * 16 + i * 8192, R, C); const int Rb = (R & ~31) + perm32(R & 31);
        voffA[i] = (unsigned)(R * 1024 + C * 2); voffB[i] = (unsigned)(Rb * 256 + C * 2); }
    const unsigned ldsw = (unsigned)wid * 1024u;
    const int aoff = lds_byte(wr * 64 + fr, fq * 8), boff = lds_byte(wc * 32 + fr, fq * 8);
#define M2_SA(b, h) (((b) * 2 + (h)) * HTB)
#define M2_SB(b, h) ((4 + (b) * 2 + (h)) * HTB)
#define M2_STAGE(bufoff, gbase, voff) do { _Pragma("unroll") for (int _i = 0; _i < 2; ++_i) \
        __builtin_amdgcn_global_load_lds((const unsigned*)((const char*)(gbase) + (voff)[_i]), (LAS unsigned*)(lds + (bufoff) + ldsw + _i * 8192), 16, 0, 0); } while (0)
#define M2_LDA(dst, b, h) do { _Pragma("unroll") for (int m = 0; m < 4; ++m) { dst[m].lo = *(const LAS i32x4*)(lds + M2_SA(b, h) + aoff + m * 2048); dst[m].hi = *(const LAS i32x4*)(lds + M2_SA(b, h) + aoff + m * 2048 + 1024); } } while (0)
#define M2_LDB(dst, b, h) do { _Pragma("unroll") for (int n = 0; n < 2; ++n) { dst[n].lo = *(const LAS i32x4*)(lds + M2_SB(b, h) + boff + n * 2048); dst[n].hi = *(const LAS i32x4*)(lds + M2_SB(b, h) + boff + n * 2048 + 1024); } } while (0)
#define M2_MMA(ai, bj, At, Bt) do { __builtin_amdgcn_s_setprio(1); _Pragma("unroll") for (int m = 0; m < 4; ++m) _Pragma("unroll") for (int n = 0; n < 2; ++n) \
        asm volatile("v_mfma_scale_f32_16x16x128_f8f6f4 %0, %1, %2, %0, %3, %3 op_sel_hi:[0,0,0]" : "+v"(acc[ai][bj][m][n]) : "v"(Bt[n]), "v"(At[m]), "v"(sc127)); __builtin_amdgcn_s_setprio(0); } while (0)
#define M2_WAIT_V(n) asm volatile("s_waitcnt vmcnt(" #n ")" ::: "memory")
#define M2_WAIT_L(n) asm volatile("s_waitcnt lgkmcnt(" #n ")" ::: "memory")
#define M2_BAR __builtin_amdgcn_s_barrier()
#define M2_SCHED __builtin_amdgcn_sched_barrier(0)
    const char* Ab = (const char*)Y8; const char* Bb = (const char*)Wb8; asm volatile("" : "+s"(Ab), "+s"(Bb)); Ab = (const char*)(const GAS char*)Ab; Bb = (const char*)(const GAS char*)Bb;
#define M2_A(u, kt) (Ab + ((size_t)(u).pm * 256 * 1024 + ((kt) >> 1) * 256 + ((kt) & 1) * 128))
#define M2_B(u, kt) (Bb + ((size_t)(((kt) >> 1) * DM + (u).pn * 256) * 256 + ((kt) & 1) * 128))
    constexpr size_t hstepB = (size_t)HALF * 256, hstepA = (size_t)HALF * 1024, kstep = 128;
    MUnit cur, nxt; int ui = 0;
    { const int idx = vc; if (idx >= NU) return; cur.pm = idx >> 2; cur.pn = idx & 3; }
    f32x4 acc[2][2][4][2];
    i32x8 At[4], B0[2], B1[2];
    int sc127 = 127; asm volatile("" : "+v"(sc127));
    u32x4 ga4[4], gb4[4];
#define M2_GLOAD(ai, n) do { const int lx = lane_now(); const unsigned char* gp = (const unsigned char*)Pp + gate_off(cur.pm, 4 * (n) + cur.pn, wid, (ai), lx); \
        _Pragma("unroll") for (int m = 0; m < 4; ++m) { ga4[m] = *(const GAS u32x4*)(gp + m * 16); gb4[m] = *(const GAS u32x4*)(gp + 4 * 65536 + m * 16); } } while (0)
#define M2_GSCALE(ai) do { _Pragma("unroll") for (int m = 0; m < 4; ++m) { \
            acc[ai][0][m][0] = acc[ai][0][m][0] * (gate_q4(ga4[m].x) * rcp4(gate_q4(gb4[m].x))); acc[ai][0][m][1] = acc[ai][0][m][1] * (gate_q4(ga4[m].y) * rcp4(gate_q4(gb4[m].y))); \
            acc[ai][1][m][0] = acc[ai][1][m][0] * (gate_q4(ga4[m].z) * rcp4(gate_q4(gb4[m].z))); acc[ai][1][m][1] = acc[ai][1][m][1] * (gate_q4(ga4[m].w) * rcp4(gate_q4(gb4[m].w))); } } while (0)
    { const char* cA = M2_A(cur, 0); const char* cB = M2_B(cur, 0);
      M2_STAGE(M2_SB(0, 0), cB, voffB); M2_SCHED; M2_STAGE(M2_SB(0, 1), cB + hstepB, voffB); M2_SCHED; M2_STAGE(M2_SA(0, 0), cA, voffA); M2_SCHED; M2_STAGE(M2_SA(0, 1), cA + hstepA, voffA); M2_SCHED;
      if (wr == 1) M2_BAR;
      M2_WAIT_V(2); M2_BAR;
      M2_STAGE(M2_SB(1, 0), cB + kstep, voffB); M2_SCHED; M2_STAGE(M2_SA(1, 0), cA + kstep, voffA); M2_SCHED; M2_STAGE(M2_SB(1, 1), cB + hstepB + kstep, voffB); M2_SCHED;
      M2_WAIT_V(6); M2_BAR; }
    M2_SCHED;
#pragma unroll
    for (int a = 0; a < 2; ++a)
#pragma unroll
        for (int b = 0; b < 2; ++b)
#pragma unroll
            for (int m = 0; m < 4; ++m)
#pragma unroll
                for (int n = 0; n < 2; ++n) acc[a][b][m][n] = (f32x4){0.f, 0.f, 0.f, 0.f};
    for (;;) {
        asm volatile("" : "+s"(Ab), "+s"(Bb));
        bool has_next; { const int idx = vc + G * (ui + 1); has_next = idx < NU; nxt.pm = idx >> 2; nxt.pn = idx & 3; }
#pragma unroll 1
        for (int t = 0; t < nt; t += 2) {
            const bool last = (t == nt - 2);
            asm volatile("" : "+v"(voffA[0]), "+v"(voffA[1]), "+v"(voffB[0]), "+v"(voffB[1]));
            const bool bnd = !last;
            const bool pend = t != 0;
            const char* a1 = M2_A(cur, t) + kstep;
            const char* a2 = last ? (has_next ? M2_A(nxt, 0) : M2_A(cur, 0)) : M2_A(cur, t + 2);
            const char* b2 = last ? (has_next ? M2_B(nxt, 0) : M2_B(cur, 0)) : M2_B(cur, t + 2);
            const char* a3 = a2 + kstep; const char* b3 = b2 + kstep;
            M2_LDB(B0, 0, 0); M2_LDB(B1, 0, 1); M2_SCHED; M2_LDA(At, 0, 0); M2_STAGE(M2_SA(1, 1), a1 + hstepA, voffA);
            if (pend) M2_WAIT_V(16); else M2_WAIT_V(8);
            M2_WAIT_L(0); M2_BAR; M2_MMA(0, 0, At, B0); M2_MMA(0, 1, At, B1); M2_BAR; M2_SCHED;
            if (pend) { M2_WAIT_V(2); M2_GSCALE(1); M2_SCHED; }
            M2_LDA(At, 0, 1); M2_STAGE(M2_SB(0, 0), b2, voffB); M2_STAGE(M2_SB(0, 1), b2 + hstepB, voffB); M2_STAGE(M2_SA(0, 0), a2, voffA);
            M2_WAIT_V(8); M2_WAIT_L(0); M2_BAR; M2_MMA(1, 0, At, B0); M2_MMA(1, 1, At, B1); M2_BAR; M2_SCHED;
            if (bnd) { M2_GLOAD(0, t >> 1); }
            M2_LDB(B0, 1, 0); M2_LDB(B1, 1, 1); M2_SCHED; M2_LDA(At, 1, 0); M2_STAGE(M2_SA(0, 1), a2 + hstepA, voffA);
            if (bnd) M2_WAIT_V(16); else M2_WAIT_V(8);
            M2_WAIT_L(0); M2_BAR; M2_MMA(0, 0, At, B0); M2_MMA(0, 1, At, B1); M2_BAR; M2_SCHED;
            M2_LDA(At, 1, 1); M2_STAGE(M2_SB(1, 0), b3, voffB); M2_STAGE(M2_SB(1, 1), b3 + hstepB, voffB); M2_STAGE(M2_SA(1, 0), a3, voffA);
            M2_WAIT_V(8); M2_WAIT_L(0); M2_BAR; M2_MMA(1, 0, At, B0); M2_MMA(1, 1, At, B1); if (bnd) { M2_SCHED; M2_GSCALE(0); } M2_BAR;
            if (bnd) { M2_GLOAD(1, t >> 1); }
            M2_SCHED;
        }
        asm volatile("s_nop 15\n\ts_nop 15\n\ts_nop 15" ::: "memory");
        if (wr == 0) M2_BAR;
        { const int lnx = lane_now(), frx = lnx & 15, fqx = lnx >> 4; const int row0 = cur.pm * 256 + wr * 64 + frx, col0 = cur.pn * 256 + wc * 32 + 8 * fqx;
#pragma unroll
          for (int ai = 0; ai < 2; ++ai) {
              u32x2 g3[4][2];
              { const unsigned char* gp = (const unsigned char*)Pp + gate_off(cur.pm, 12 + cur.pn, wid, ai, lnx);
#pragma unroll
                for (int m = 0; m < 4; ++m) { const u32x4 w4 = *(const GAS u32x4*)(gp + m * 16); g3[m][0] = (u32x2){w4.x, w4.y}; g3[m][1] = (u32x2){w4.z, w4.w}; } }
#pragma unroll
              for (int m = 0; m < 4; ++m)
#pragma unroll
                  for (int bj = 0; bj < 2; ++bj) { constexpr float Kq = 1.0f / (255.0f * 256.0f);
                      *(GAS u32x4*)(HBo + (size_t)(row0 + ai * HALF + m * 16) * DM + col0 + bj * HALF) = pack8(acc[ai][bj][m][0] * (gate_q4(g3[m][bj].x) * Kq), acc[ai][bj][m][1] * (gate_q4(g3[m][bj].y) * Kq));
                      acc[ai][bj][m][0] = (f32x4){0.f, 0.f, 0.f, 0.f}; acc[ai][bj][m][1] = (f32x4){0.f, 0.f, 0.f, 0.f}; }
              asm volatile("" ::: "memory"); } }
        if (!has_next) break;
        cur = nxt; ++ui;
        if (wr == 1) M2_BAR;
    }
    M2_WAIT_V(0);
    M2_BAR;
#undef M2_SA
#undef M2_SB
#undef M2_STAGE
#undef M2_LDA
#undef M2_LDB
#undef M2_MMA
#undef M2_WAIT_V
#undef M2_WAIT_L
#undef M2_BAR
#undef M2_SCHED
#undef M2_GLOAD
#undef M2_GSCALE
#undef M2_A
#undef M2_B
}
}
namespace att {
constexpr int STG = 20480, VOFF = 12288;
constexpr int LDS_WSF = 3 * STG;
constexpr int LDS_OST = LDS_WSF + 8 * 512;
constexpr int LDS_BIAS = LDS_OST + 8 * 4096;
constexpr int LDS_BYTES = LDS_BIAS + 2048;
typedef short v4i16_t __attribute__((ext_vector_type(4)));

__device__ __forceinline__ int crow(int r, int hi) { return (r & 3) + 8 * (r >> 2) + 4 * hi; }
__device__ __forceinline__ s16x4 vtr(const LAS unsigned char* p) { return __builtin_bit_cast(s16x4, __builtin_amdgcn_ds_read_tr16_b64_v4i16((LAS v4i16_t*)p)); }
__device__ __forceinline__ void glds16(const void* gsrc, unsigned lds_dst) { unsigned keep;
    asm volatile("s_mov_b32 %0, m0\n\ts_mov_b32 m0, %2\n\ts_nop 0\n\tglobal_load_lds_dwordx4 %1, off\n\ts_mov_b32 m0, %0" : "=&s"(keep) : "v"(gsrc), "s"(lds_dst) : "memory"); }
__device__ __forceinline__ int clampi(int v, int lo, int hi) { return v < lo ? lo : (v > hi ? hi : v); }

__device__ __forceinline__ u32x2 bf8_to_fp8x8(const u32x4 v) { u32x2 w;
    w.x = pk_fp8x4(bflo(v.x) * 16.0f, bfhi(v.x) * 16.0f, bflo(v.y) * 16.0f, bfhi(v.y) * 16.0f); w.y = pk_fp8x4(bflo(v.z) * 16.0f, bfhi(v.z) * 16.0f, bflo(v.w) * 16.0f, bfhi(v.w) * 16.0f); return w; }
template <int DQ, int MODE, int VAR = 0, bool O8 = false>
__device__ __forceinline__ void attn_unit(const bf16_t* Qp, const bf16_t* Kp, const bf16_t* Vp, bf16_t* Op, int ldq, int ldk, int ldv, int ldo,
                                          int q0, float sc2, float par0, float par1, const float* biasp, LAS unsigned char* lds, int tid) {
    asm volatile("" : "+v"(tid));
    const int lane = tid & 63, r32 = lane & 31, hi = lane >> 5; const int wid = __builtin_amdgcn_readfirstlane(tid >> 6);
    constexpr int ND = DQ / 16;
    int t0 = 0, t1 = SEQ / 64 - 1;
    const int wq0 = q0 + wid * 32;
    int wt0 = 0, wt1 = SEQ / 64 - 1;
    if (MODE == 1) { t0 = (q0 >> 6) - 2; t0 = t0 < 0 ? 0 : t0; t1 = (q0 >> 6) + 5; t1 = t1 > 63 ? 63 : t1;
        int klo = wq0 - 128; klo = klo < 0 ? 0 : klo; int khi = wq0 + 31 + 128; khi = khi > SEQ - 1 ? SEQ - 1 : khi; wt0 = klo >> 6; wt1 = khi >> 6; }
    if (MODE == 2) { const int R0 = q0 >> 6; t0 = clampi(R0 - 4, 0, 56); t1 = clampi(R0 + 3 - 4, 0, 56) + 7; const int R = wq0 >> 6; wt0 = clampi(R - 4, 0, 56); wt1 = wt0 + 7; }
    LAS float* wsf = (LAS float*)(lds + LDS_WSF) + wid * 128;
    LAS float* bt = (LAS float*)(lds + LDS_BIAS);
    bf16x8 qr[ND];
    { const bf16_t* Qw = Qp + (size_t)(wq0 + r32) * ldq + hi * 8;
#pragma unroll
      for (int d0 = 0; d0 < ND; ++d0) qr[d0] = *(const GAS bf16x8*)(Qw + d0 * 16); }
    const bf16_t* ksrc = Kp + (size_t)lane * ldk + wid * 8;
    const bf16_t* ksrc2 = Kp + (size_t)lane * ldk + (8 + (wid & 3)) * 8;
    const bf16_t* vsrc = Vp + (size_t)(16 * (wid & 3) + (lane >> 2)) * ldv + (wid >> 2) * 32 + (lane & 3) * 8;
    const int kdst = wid * 1024 + lane * 16, kdst2 = (8 + (wid & 3)) * 1024 + lane * 16, vdst = VOFF + wid * 1024 + lane * 16;
    u32x4 kreg, kreg2, vreg; kreg2 = (u32x4){0u, 0u, 0u, 0u};
    u32x4 kregB, kreg2B, vregB; kreg2B = (u32x4){0u, 0u, 0u, 0u};
#define ATT_LOAD(t) do { if (VAR == 5) break; const size_t ro_ = (size_t)(t) * 64; kreg = *(const GAS u32x4*)(ksrc + ro_ * ldk); if (DQ == 96) kreg2 = *(const GAS u32x4*)(ksrc2 + ro_ * ldk); vreg = *(const GAS u32x4*)(vsrc + ro_ * ldv); } while (0)
#define ATT_STORE(s) do { if (VAR == 5) break; LAS unsigned char* sb_ = lds + (s) * STG; *(LAS u32x4*)(sb_ + kdst) = kreg; if (DQ == 96) *(LAS u32x4*)(sb_ + kdst2) = kreg2; *(LAS u32x4*)(sb_ + vdst) = vreg; } while (0)
#define ATT_LOADB(t) do { if (VAR == 5) break; const size_t ro_ = (size_t)(t) * 64; kregB = *(const GAS u32x4*)(ksrc + ro_ * ldk); if (DQ == 96) kreg2B = *(const GAS u32x4*)(ksrc2 + ro_ * ldk); vregB = *(const GAS u32x4*)(vsrc + ro_ * ldv); } while (0)
#define ATT_STOREB(s) do { if (VAR == 5) break; LAS unsigned char* sb_ = lds + (s) * STG; *(LAS u32x4*)(sb_ + kdst) = kregB; if (DQ == 96) *(LAS u32x4*)(sb_ + kdst2) = kreg2B; *(LAS u32x4*)(sb_ + vdst) = vregB; } while (0)
    ATT_LOAD(t0);
    if (MODE == 2) { for (int i = tid; i < 15 * 31; i += 512) bt[i] = biasp[i] * LOG2E; }
    ATT_STORE(0);
    if (t0 + 1 <= t1) { ATT_LOAD(t0 + 1); ATT_STORE(1); }
    constexpr float THR = 8.0f;
    float m2 = (MODE == 1) ? par1 : 0.0f;
    bool first = (MODE != 1);
    float lsum = (MODE == 1 && hi == 0) ? 1.0f : 0.0f;
    f32x16 o[2];
#pragma unroll
    for (int r = 0; r < 16; ++r) { o[0][r] = 0.f; o[1][r] = 0.f; }
    const int tq = wq0 + r32;
    const int na_ncs = 4 * hi - clampi((tq & 63) - 8, 0, 48), na_l = 4 * hi - (tq & 63) + 15; (void)na_ncs; (void)na_l;
    f32x16 p0, p1, n0, n1;
#pragma unroll
    for (int r = 0; r < 16; ++r) { p0[r] = 0.f; p1[r] = 0.f; n0[r] = 0.f; n1[r] = 0.f; }
#define ATT_QK(D0, D1, stg_) do { const LAS unsigned char* kb_ = lds + (stg_) * STG + hi * 1024 + r32 * 16; const float ni_ = -m2; \
        _Pragma("unroll") for (int r = 0; r < 16; ++r) { D0[r] = ni_; D1[r] = ni_; } \
        _Pragma("unroll") for (int d0 = 0; d0 < ND; ++d0) { \
            const bf16x8 b0_ = *(const LAS bf16x8*)(kb_ + d0 * 2048), b1_ = *(const LAS bf16x8*)(kb_ + d0 * 2048 + 512); \
            D0 = __builtin_amdgcn_mfma_f32_32x32x16_bf16(b0_, qr[d0], D0, 0, 0, 0); \
            D1 = __builtin_amdgcn_mfma_f32_32x32x16_bf16(b1_, qr[d0], D1, 0, 0, 0); } } while (0)
#define ATT_KPRE(stg_) do { if (VAR == 3 || (VAR == 6 && kfinit)) break; kfinit = true; const LAS unsigned char* kb_ = lds + (stg_) * STG + hi * 1024 + r32 * 16; \
        _Pragma("unroll") for (int d0 = 0; d0 < ND; ++d0) { kf[2 * d0] = *(const LAS bf16x8*)(kb_ + d0 * 2048); kf[2 * d0 + 1] = *(const LAS bf16x8*)(kb_ + d0 * 2048 + 512); } } while (0)
#define ATT_QKF(D0, D1) do { const float ni_ = -m2; \
        _Pragma("unroll") for (int r = 0; r < 16; ++r) { D0[r] = ni_; D1[r] = ni_; } \
        if (VAR == 3) break; \
        _Pragma("unroll") for (int d0 = 0; d0 < ND; ++d0) { \
            D0 = __builtin_amdgcn_mfma_f32_32x32x16_bf16(kf[2 * d0], qr[d0], D0, 0, 0, 0); \
            D1 = __builtin_amdgcn_mfma_f32_32x32x16_bf16(kf[2 * d0 + 1], qr[d0], D1, 0, 0, 0); } } while (0)
    __syncthreads();
    constexpr bool PIPE = (MODE != 2);
    int sc_ = 0, sn_ = 1, sw_ = 2;
#define ATT_HEAD(t, p0, p1, n0, n1) do { \
            float rm = -INFINITY; \
            int ncs_ = na_ncs, nbb_ = 0; if (MODE == 2) { asm volatile("" : "+v"(ncs_)); nbb_ = ((t) - (tq >> 6) + 7) * 31 + na_l; }        \
            const LAS float* bp_ = bt + nbb_; \
            float relb_ = 0.f; if (MODE == 1) { relb_ = (float)((t) * 64 + 4 * hi - tq); asm volatile("" : "+v"(relb_)); } \
            _Pragma("unroll") for (int r = 0; r < 16; ++r) { \
                const int kk = crow(r, hi); \
                float v0 = p0[r], v1 = p1[r]; \
                if (MODE == 1) {        \
                    const float rf0 = relb_ + (float)((r & 3) + 8 * (r >> 2)), rf1 = rf0 + 32.0f; \
                    v0 = (__builtin_fabsf(rf0) <= 128.0f) ? __builtin_fmaf(-par0, __builtin_fabsf(rf0), v0) : -INFINITY; \
                    v1 = (__builtin_fabsf(rf1) <= 128.0f) ? __builtin_fmaf(-par0, __builtin_fabsf(rf1), v1) : -INFINITY; \
                } \
                if (MODE == 2) {        \
                    const int cr = (r & 3) + 8 * (r >> 2); \
                    const unsigned d0c = (unsigned)(cr + ncs_), d1c = (unsigned)(cr + 32 + ncs_); \
                    v0 = (d0c < 16u) ? v0 + bp_[cr] : -INFINITY; \
                    v1 = (d1c < 16u) ? v1 + bp_[cr + 32] : -INFINITY; \
                } \
                if (MODE != 0) { p0[r] = v0; p1[r] = v1; } \
                rm = fmaxf(fmaxf(rm, v0), v1); \
            } \
            { auto rr = __builtin_amdgcn_permlane32_swap(__float_as_uint(rm), __float_as_uint(rm), false, false); rm = fmaxf(__uint_as_float(rr[0]), __uint_as_float(rr[1])); } \
            if (first) { \
                first = false; m2 = rm; \
                _Pragma("unroll") for (int r = 0; r < 16; ++r) { p0[r] -= rm; p1[r] -= rm; if (PIPE && MODE != 0) { n0[r] -= rm; n1[r] -= rm; } } \
            } else if (__any(rm > THR)) { \
                const float dl = fmaxf(rm, 0.f); m2 += dl; \
                _Pragma("unroll") for (int r = 0; r < 16; ++r) { p0[r] -= dl; p1[r] -= dl; if (PIPE && MODE != 0) { n0[r] -= dl; n1[r] -= dl; } } \
                const float f = __builtin_amdgcn_exp2f(-dl); \
                lsum *= f; \
                if (hi == 0) wsf[r32] = f; \
                asm volatile("s_waitcnt lgkmcnt(0)" ::: "memory"); \
                _Pragma("unroll") for (int g4 = 0; g4 < 4; ++g4) { const f32x4 f4 = *(const LAS f32x4*)(wsf + 8 * g4 + 4 * hi); \
                    _Pragma("unroll") for (int j = 0; j < 4; ++j) { o[0][4 * g4 + j] *= f4[j]; o[1][4 * g4 + j] *= f4[j]; } } \
                asm volatile("s_waitcnt lgkmcnt(0)" ::: "memory"); \
            } } while (0)
#define ATT_EXP_PV(stg_, p0, p1) do { \
            float sumA = 0.f, sumB = 0.f; \
            _Pragma("unroll") for (int r = 0; r < 16; ++r) { if (VAR != 1) { p0[r] = __builtin_amdgcn_exp2f(p0[r]); p1[r] = __builtin_amdgcn_exp2f(p1[r]); } sumA += p0[r]; sumB += p1[r]; } \
            lsum += sumA + sumB; \
            u32x4 pw[4]; \
            _Pragma("unroll") for (int j = 0; j < 4; ++j) { pw[0][j] = cvt_pk_bf16(p0[2 * j], p0[2 * j + 1]); pw[1][j] = cvt_pk_bf16(p0[8 + 2 * j], p0[8 + 2 * j + 1]); \
                                          pw[2][j] = cvt_pk_bf16(p1[2 * j], p1[2 * j + 1]); pw[3][j] = cvt_pk_bf16(p1[8 + 2 * j], p1[8 + 2 * j + 1]); } \
            const LAS unsigned char* vp = lds + (stg_) * STG + VOFF + ((lane >> 4) & 1) * 32 + (lane & 3) * 8 + (4 * hi + ((lane & 15) >> 2)) * 64; \
            if (VAR != 2) _Pragma("unroll") for (int i = 0; i < 8; ++i) { \
                const int iv_ = (VAR == 7) ? 0 : i; \
                const s16x4 lo = vtr(vp + (iv_ >> 2) * 4096 + (iv_ & 3) * 1024), hh = vtr(vp + (iv_ >> 2) * 4096 + (iv_ & 3) * 1024 + 512); \
                const bf16x8 vf = (bf16x8){lo[0], lo[1], lo[2], lo[3], hh[0], hh[1], hh[2], hh[3]}; \
                o[i >> 2] = __builtin_amdgcn_mfma_f32_32x32x16_bf16(__builtin_bit_cast(bf16x8, pw[i & 3]), vf, o[i >> 2], 0, 0, 0); \
            } } while (0)
#define ATT_ROT() do { const int tmp_ = sc_; sc_ = sn_; sn_ = sw_; sw_ = tmp_; } while (0)
    if constexpr (MODE == 0) {
        bf16x8 kf[2 * ND]; bool kfinit = false;
        ATT_KPRE(0); ATT_QKF(p0, p1);
        if (t0 + 2 <= t1) ATT_LOAD(t0 + 2);
        for (int t = t0; t + 1 < t1; t += 2) {
            if (t + 3 <= t1) ATT_LOADB(t + 3);
            ATT_KPRE(sn_);
            __builtin_amdgcn_sched_barrier(0);
            ATT_HEAD(t, p0, p1, n0, n1);
            ATT_QKF(n0, n1);
            ATT_EXP_PV(sc_, p0, p1);
            if (t + 2 <= t1) ATT_STORE(sw_);
            if (VAR != 4) __syncthreads();
            ATT_ROT();
            if (t + 4 <= t1) ATT_LOAD(t + 4);
            ATT_KPRE(sn_);
            __builtin_amdgcn_sched_barrier(0);
            ATT_HEAD(t + 1, n0, n1, p0, p1);
            ATT_QKF(p0, p1);
            ATT_EXP_PV(sc_, n0, n1);
            if (t + 3 <= t1) ATT_STOREB(sw_);
            if (VAR != 4) __syncthreads();
            ATT_ROT();
        }
        {
            ATT_KPRE(sn_);
            __builtin_amdgcn_sched_barrier(0);
            ATT_HEAD(t1 - 1, p0, p1, n0, n1);
            ATT_QKF(n0, n1);
            ATT_EXP_PV(sc_, p0, p1);
            __syncthreads();
            ATT_ROT();
        }
        ATT_HEAD(t1, n0, n1, p0, p1);
        ATT_EXP_PV(sc_, n0, n1);
        __syncthreads();
    } else {
        if (PIPE && t0 >= wt0 && t0 <= wt1) ATT_QK(p0, p1, 0);
        if (t0 + 2 <= t1) ATT_LOAD(t0 + 2);
#define ATT_STEP(t, LOADN, STOREC) do { \
            if ((t) + 3 <= t1) LOADN((t) + 3); \
            if (PIPE) { const bool nin = ((t) + 1 <= t1) && ((t) + 1 >= wt0) && ((t) + 1 <= wt1); if (nin) ATT_QK(n0, n1, sn_); } \
            else { if ((t) >= wt0 && (t) <= wt1) ATT_QK(p0, p1, sc_); } \
            if ((t) >= wt0 && (t) <= wt1) { ATT_HEAD(t, p0, p1, n0, n1); ATT_EXP_PV(sc_, p0, p1); } \
            if ((t) + 2 <= t1) STOREC(sw_); \
            __syncthreads(); \
            if (PIPE) { p0 = n0; p1 = n1; } \
            ATT_ROT(); } while (0)
        for (int t = t0; t <= t1; t += 2) {
            ATT_STEP(t, ATT_LOADB, ATT_STORE);
            if (t + 1 <= t1) ATT_STEP(t + 1, ATT_LOAD, ATT_STOREB);
        }
#undef ATT_STEP
    }
#undef ATT_HEAD
#undef ATT_EXP_PV
#undef ATT_ROT
#undef ATT_QK
#undef ATT_KPRE
#undef ATT_QKF
#undef ATT_LOAD
#undef ATT_LOADB
#undef ATT_STOREB
#undef ATT_STORE
    { auto rr = __builtin_amdgcn_permlane32_swap(__float_as_uint(lsum), __float_as_uint(lsum), false, false); lsum = __uint_as_float(rr[0]) + __uint_as_float(rr[1]); }
    if (hi == 0) wsf[32 + r32] = lsum;
    asm volatile("s_waitcnt lgkmcnt(0)" ::: "memory");
    float rli[16];
#pragma unroll
    for (int g4 = 0; g4 < 4; ++g4) { const f32x4 l4 = *(const LAS f32x4*)(wsf + 32 + 8 * g4 + 4 * hi);
#pragma unroll
        for (int j = 0; j < 4; ++j) rli[4 * g4 + j] = __builtin_amdgcn_rcpf(l4[j]); }
    LAS bf16_t* stg = (LAS bf16_t*)(lds + LDS_OST) + wid * 2048;
#pragma unroll
    for (int r = 0; r < 16; ++r) { const int orow = crow(r, hi);
#pragma unroll
        for (int d0 = 0; d0 < 2; ++d0) stg[orow * 64 + d0 * 32 + r32] = f2bf(o[d0][r] * rli[r]); }
    asm volatile("s_waitcnt lgkmcnt(0)" ::: "memory");
    bf16_t* Ow = Op + (size_t)wq0 * ldo;
#pragma unroll
    for (int i = 0; i < 4; ++i) { const int row = i * 8 + (lane >> 3), ch = lane & 7; const u32x4 v = *(const LAS u32x4*)(stg + row * 64 + ch * 8);
        if constexpr (O8) { *(GAS u32x2*)((unsigned char*)Op + (size_t)(wq0 + row) * ldo + ch * 8) = bf8_to_fp8x8(v); } else { *(GAS u32x4*)(Ow + (size_t)row * ldo + ch * 8) = v; } }
    asm volatile("s_waitcnt lgkmcnt(0)" ::: "memory");
}

template <int DQ, bool O8 = false>
__device__ __forceinline__ void attn_unit2(const bf16_t* QpA, const bf16_t* QpB, const bf16_t* Kp, const bf16_t* Vp, bf16_t* OpA, bf16_t* OpB, int ldq, int ldk, int ldv, int ldo,
                                           int q0, LAS unsigned char* lds, int tid) {
    asm volatile("" : "+v"(tid));
    const int lane = tid & 63, r32 = lane & 31, hi = lane >> 5; const int wid = __builtin_amdgcn_readfirstlane(tid >> 6);
    constexpr int ND = DQ / 16;
    constexpr int t0 = 0, t1 = SEQ / 64 - 1;
    const int wq0 = q0 + wid * 32;
    LAS float* wsf = (LAS float*)(lds + LDS_WSF) + wid * 128;
    bf16x8 qa[ND], qb[ND];
    { const bf16_t* Qw = QpA + (size_t)(wq0 + r32) * ldq + hi * 8; const bf16_t* Qv = QpB + (size_t)(wq0 + r32) * ldq + hi * 8;
#pragma unroll
      for (int d0 = 0; d0 < ND; ++d0) { qa[d0] = *(const GAS bf16x8*)(Qw + d0 * 16); qb[d0] = *(const GAS bf16x8*)(Qv + d0 * 16); } }
    const bf16_t* ksrc = Kp + (size_t)lane * ldk + wid * 8;
    const int k2off = __builtin_amdgcn_readfirstlane((8 + (wid & 3) - wid) * 8);
    const bf16_t* vsrc = Vp + (size_t)(16 * (wid & 3) + (lane >> 2)) * ldv + (wid >> 2) * 32 + (lane & 3) * 8;
    const int k2d = __builtin_amdgcn_readfirstlane((8 + (wid & 3) - wid) * 1024);
    const unsigned lds0 = (unsigned)(uintptr_t)lds;
#define A2_DMA(t, s) do { const size_t ro_ = (size_t)(t) * 64; const unsigned sb_ = (unsigned)__builtin_amdgcn_readfirstlane((int)(lds0 + (unsigned)((s) * STG + wid * 1024))); \
        glds16(ksrc + ro_ * ldk, sb_); \
        if (DQ == 96) glds16(ksrc + ro_ * ldk + k2off, sb_ + (unsigned)k2d); \
        glds16(vsrc + ro_ * ldv, sb_ + (unsigned)VOFF); } while (0)
    A2_DMA(t0, 0);
    asm volatile("s_waitcnt vmcnt(0)" ::: "memory");
    constexpr float THR = 8.0f;
    float mA = 0.f, mB = 0.f, lA = 0.f, lB = 0.f;
    f32x16 oa[2], ob[2];
#pragma unroll
    for (int r = 0; r < 16; ++r) { oa[0][r] = 0.f; oa[1][r] = 0.f; ob[0][r] = 0.f; ob[1][r] = 0.f; }
    __syncthreads();
#define A2_TILE(t, FIRST) do { \
        const int cur = ((t) - t0) & 1; \
        if ((t) < t1) A2_DMA((t) + 1, cur ^ 1); \
        const LAS unsigned char* Ks = lds + cur * STG; \
        const LAS unsigned char* kb = Ks + hi * 1024 + r32 * 16; \
        f32x16 a0, a1, b0, b1; \
        { const float na = -mA, nb = -mB; \
          _Pragma("unroll") for (int r = 0; r < 16; ++r) { a0[r] = na; a1[r] = na; b0[r] = nb; b1[r] = nb; } } \
        __builtin_amdgcn_s_setprio(1); \
        { bf16x8 k0 = *(const LAS bf16x8*)(kb), k1 = *(const LAS bf16x8*)(kb + 512);        \
          _Pragma("unroll") for (int d0 = 0; d0 < ND; ++d0) { \
            bf16x8 n0 = k0, n1 = k1; \
            if (d0 + 1 < ND) { n0 = *(const LAS bf16x8*)(kb + (d0 + 1) * 2048); n1 = *(const LAS bf16x8*)(kb + (d0 + 1) * 2048 + 512); } \
            a0 = __builtin_amdgcn_mfma_f32_32x32x16_bf16(k0, qa[d0], a0, 0, 0, 0); \
            b0 = __builtin_amdgcn_mfma_f32_32x32x16_bf16(k0, qb[d0], b0, 0, 0, 0); \
            a1 = __builtin_amdgcn_mfma_f32_32x32x16_bf16(k1, qa[d0], a1, 0, 0, 0); \
            b1 = __builtin_amdgcn_mfma_f32_32x32x16_bf16(k1, qb[d0], b1, 0, 0, 0); \
            k0 = n0; k1 = n1; \
            __builtin_amdgcn_sched_barrier(0); } } \
        __builtin_amdgcn_s_setprio(0); \
        float rA = -INFINITY, rB = -INFINITY; \
        _Pragma("unroll") for (int r = 0; r < 16; ++r) { rA = fmaxf(fmaxf(rA, a0[r]), a1[r]); rB = fmaxf(fmaxf(rB, b0[r]), b1[r]); } \
        { auto rr = __builtin_amdgcn_permlane32_swap(__float_as_uint(rA), __float_as_uint(rA), false, false); rA = fmaxf(__uint_as_float(rr[0]), __uint_as_float(rr[1])); } \
        { auto rr = __builtin_amdgcn_permlane32_swap(__float_as_uint(rB), __float_as_uint(rB), false, false); rB = fmaxf(__uint_as_float(rr[0]), __uint_as_float(rr[1])); } \
        if (FIRST) { mA = rA; mB = rB; \
            _Pragma("unroll") for (int r = 0; r < 16; ++r) { a0[r] -= rA; a1[r] -= rA; b0[r] -= rB; b1[r] -= rB; } } \
        float sA = 0.f, sB = 0.f; \
        _Pragma("unroll") for (int r = 0; r < 16; ++r) { a0[r] = __builtin_amdgcn_exp2f(a0[r]); a1[r] = __builtin_amdgcn_exp2f(a1[r]); b0[r] = __builtin_amdgcn_exp2f(b0[r]); b1[r] = __builtin_amdgcn_exp2f(b1[r]); \
            sA += a0[r] + a1[r]; sB += b0[r] + b1[r]; } \
        lA += sA; lB += sB; \
        u32x4 pa[4], pb[4]; \
        _Pragma("unroll") for (int j = 0; j < 4; ++j) { pa[0][j] = cvt_pk_bf16(a0[2 * j], a0[2 * j + 1]); pa[1][j] = cvt_pk_bf16(a0[8 + 2 * j], a0[8 + 2 * j + 1]); \
                                      pa[2][j] = cvt_pk_bf16(a1[2 * j], a1[2 * j + 1]); pa[3][j] = cvt_pk_bf16(a1[8 + 2 * j], a1[8 + 2 * j + 1]); \
                                      pb[0][j] = cvt_pk_bf16(b0[2 * j], b0[2 * j + 1]); pb[1][j] = cvt_pk_bf16(b0[8 + 2 * j], b0[8 + 2 * j + 1]); \
                                      pb[2][j] = cvt_pk_bf16(b1[2 * j], b1[2 * j + 1]); pb[3][j] = cvt_pk_bf16(b1[8 + 2 * j], b1[8 + 2 * j + 1]); } \
        const LAS unsigned char* vp = Ks + VOFF + ((lane >> 4) & 1) * 32 + (lane & 3) * 8 + (4 * hi + ((lane & 15) >> 2)) * 64; \
        __builtin_amdgcn_s_setprio(1); \
        { s16x4 lo = vtr(vp), hh = vtr(vp + 512); \
          __builtin_amdgcn_sched_barrier(0); \
          _Pragma("unroll") for (int i = 0; i < 8; ++i) { \
            s16x4 nlo = lo, nhh = hh; \
            if (i + 1 < 8) { nlo = vtr(vp + ((i + 1) >> 2) * 4096 + ((i + 1) & 3) * 1024); nhh = vtr(vp + ((i + 1) >> 2) * 4096 + ((i + 1) & 3) * 1024 + 512); } \
            const bf16x8 vf = (bf16x8){lo[0], lo[1], lo[2], lo[3], hh[0], hh[1], hh[2], hh[3]}; \
            oa[i >> 2] = __builtin_amdgcn_mfma_f32_32x32x16_bf16(__builtin_bit_cast(bf16x8, pa[i & 3]), vf, oa[i >> 2], 0, 0, 0); \
            ob[i >> 2] = __builtin_amdgcn_mfma_f32_32x32x16_bf16(__builtin_bit_cast(bf16x8, pb[i & 3]), vf, ob[i >> 2], 0, 0, 0); \
            lo = nlo; hh = nhh; \
            __builtin_amdgcn_sched_barrier(0); } } \
        __builtin_amdgcn_s_setprio(0); \
        if (!(FIRST) && __any(rA > THR || rB > THR)) { \
            const float dA = fmaxf(rA, 0.f), dB = fmaxf(rB, 0.f); mA += dA; mB += dB; \
            const float fA = __builtin_amdgcn_exp2f(-dA), fB = __builtin_amdgcn_exp2f(-dB); \
            lA *= fA; lB *= fB; \
            if (hi == 0) { wsf[r32] = fA; wsf[32 + r32] = fB; } \
            asm volatile("s_waitcnt lgkmcnt(0)" ::: "memory"); \
            _Pragma("unroll") for (int g4 = 0; g4 < 4; ++g4) { const f32x4 f4 = *(const LAS f32x4*)(wsf + 8 * g4 + 4 * hi), h4 = *(const LAS f32x4*)(wsf + 32 + 8 * g4 + 4 * hi); \
                _Pragma("unroll") for (int j = 0; j < 4; ++j) { oa[0][4 * g4 + j] *= f4[j]; oa[1][4 * g4 + j] *= f4[j]; ob[0][4 * g4 + j] *= h4[j]; ob[1][4 * g4 + j] *= h4[j]; } } \
            asm volatile("s_waitcnt lgkmcnt(0)" ::: "memory"); \
        } \
        asm volatile("s_waitcnt vmcnt(0)" ::: "memory"); \
        __syncthreads(); } while (0)
    A2_TILE(t0, true);
    for (int t = t0 + 1; t <= t1; ++t) A2_TILE(t, false);
#undef A2_TILE
#undef A2_DMA
    { auto rr = __builtin_amdgcn_permlane32_swap(__float_as_uint(lA), __float_as_uint(lA), false, false); lA = __uint_as_float(rr[0]) + __uint_as_float(rr[1]); }
    { auto rr = __builtin_amdgcn_permlane32_swap(__float_as_uint(lB), __float_as_uint(lB), false, false); lB = __uint_as_float(rr[0]) + __uint_as_float(rr[1]); }
    if (hi == 0) { wsf[64 + r32] = lA; wsf[96 + r32] = lB; }
    asm volatile("s_waitcnt lgkmcnt(0)" ::: "memory");
    LAS bf16_t* stg = (LAS bf16_t*)(lds + LDS_OST) + wid * 2048;
#pragma unroll
    for (int blk = 0; blk < 2; ++blk) {
        float rli[16];
#pragma unroll
        for (int g4 = 0; g4 < 4; ++g4) { const f32x4 l4 = *(const LAS f32x4*)(wsf + 64 + 32 * blk + 8 * g4 + 4 * hi);
#pragma unroll
            for (int j = 0; j < 4; ++j) rli[4 * g4 + j] = __builtin_amdgcn_rcpf(l4[j]); }
#pragma unroll
        for (int r = 0; r < 16; ++r) { const int orow = crow(r, hi);
#pragma unroll
            for (int d0 = 0; d0 < 2; ++d0) stg[orow * 64 + d0 * 32 + r32] = f2bf((blk == 0 ? oa[d0][r] : ob[d0][r]) * rli[r]); }
        asm volatile("s_waitcnt lgkmcnt(0)" ::: "memory");
        bf16_t* Ow = (blk == 0 ? OpA : OpB) + (size_t)wq0 * ldo;
#pragma unroll
        for (int i = 0; i < 4; ++i) { const int row = i * 8 + (lane >> 3), ch = lane & 7; const u32x4 v = *(const LAS u32x4*)(stg + row * 64 + ch * 8);
            if constexpr (O8) { *(GAS u32x2*)((unsigned char*)(blk == 0 ? OpA : OpB) + (size_t)(wq0 + row) * ldo + ch * 8) = bf8_to_fp8x8(v); } else { *(GAS u32x4*)(Ow + (size_t)row * ldo + ch * 8) = v; } }
        asm volatile("s_waitcnt lgkmcnt(0)" ::: "memory");
    }
}
}
constexpr size_t MiB = 1u << 20;
constexpr size_t WS_CTL = 0, CTL_ZERO_BYTES = 1 * MiB;
constexpr size_t WS_MOD = 1 * MiB;
constexpr size_t WS_ROPE = 2 * MiB;

constexpr size_t WS_TOKES = 3 * MiB;
constexpr size_t WS_TOKW = 3 * MiB + 512 * 1024;
constexpr size_t WS_LIST = 4 * MiB;
constexpr size_t WS_W = 8 * MiB;
constexpr size_t W_IN = 0, W_UQ = W_IN + (size_t)NPROJ * 1024 * 2, W_UKV = W_UQ + 512 * 256 * 2, W_BR = W_UKV + 512 * 256 * 2, W_OUT = W_BR + (size_t)4 * 1024 * 256 * 2,
                 W_RT = W_OUT + (size_t)1024 * 1024 * 2, W_E13 = W_RT + 256 * 1024 * 2, W_E2 = W_E13 + (size_t)32 * 512 * 1024 * 2, W_END = W_E2 + (size_t)32 * 1024 * 256 * 2;
static_assert(W_END <= 66 * MiB, "weights region");
constexpr size_t WS_HB = 74 * MiB;
constexpr size_t WS_QC = 138 * MiB, WS_KC = 162 * MiB, WS_VC = 186 * MiB;
constexpr size_t WS_PROJ = 202 * MiB;
constexpr size_t WS_HS = WS_PROJ, WS_YS = WS_PROJ + 40 * MiB;
constexpr size_t WS_END = WS_PROJ + (size_t)MTOK * (LDP * 2 + 4096);
constexpr size_t WS_XB = WS_END, WS_SSQ = WS_END + (size_t)MTOK * DM * 2, WS_END2 = WS_SSQ + (size_t)MTOK * 16 * 4;
static_assert((size_t)SORTROWS * 256 * 2 <= 40 * MiB && WS_YS + (size_t)SORTROWS * 1024 * 2 <= WS_END, "moe overlay");
constexpr size_t WS_W2 = WS_END2;
constexpr size_t WS_END3 = WS_W2 + 66 * MiB;
constexpr size_t WS_HB8 = WS_END3, WS_Y8 = WS_HB8 + (size_t)MTOK * DM, WS_END4 = WS_Y8 + (size_t)MTOK * DM;
constexpr size_t W_G8 = W_IN + (size_t)2304 * 1024 * 2;
constexpr int CW_BAR = 4096;
constexpr int CW_ECNT = 16384;
constexpr int RING_BYTES = 131072;
constexpr int LC_TEND = RING_BYTES, LC_CNT = RING_BYTES + 128, LC_BARW = RING_BYTES + 256, LC_XCH = RING_BYTES + 1024;
constexpr int LDS_BYTES = 147456;
constexpr int NWAVES = 8;

#define RLX_AGENT __ATOMIC_RELAXED, __HIP_MEMORY_SCOPE_AGENT

#define XB_TMO      128
#define XB_XCNT(j)  (256  + 64 * (j))
#define XB_XSUB(j)  (1280 + 64 * (j))
#define XB_XGEN(j)  (2304 + 64 * (j))
#define XB_TOP      3328
#define XB_TOPGEN   3392
#define XCD_BAR_WORDS 3456
#define XB_SPIN_CAP (1u << 18)
__device__ __forceinline__ unsigned xb_ld(unsigned* p)              { return __hip_atomic_load(p, __ATOMIC_RELAXED, __HIP_MEMORY_SCOPE_AGENT); }
__device__ __forceinline__ unsigned xb_add(unsigned* p, unsigned v) { return __hip_atomic_fetch_add(p, v, __ATOMIC_RELAXED, __HIP_MEMORY_SCOPE_AGENT); }
__device__ __forceinline__ unsigned xb_xcc_id() { return (unsigned)__builtin_amdgcn_s_getreg((3 << 11) | 20) & 0xFu; }
#define XB_SPIN(cond, bar) do { unsigned _sp = 0; while (cond) { __builtin_amdgcn_s_sleep(1); \
    if ((++_sp & 255u) == 0u) { if (xb_ld(&(bar)[XB_TMO])) break; if (_sp > XB_SPIN_CAP) { atomicAdd(&(bar)[XB_TMO], 1u); break; } } } } while (0)
struct XcdBarrier { unsigned* bar; unsigned x; volatile LAS unsigned* st; };
__device__ __forceinline__ XcdBarrier xcd_barrier_post(unsigned* bar, volatile LAS unsigned* st) {
    XcdBarrier b; b.bar = bar; b.x = xb_xcc_id(); b.st = st;
    if (threadIdx.x == 0) (void)xb_add(&bar[XB_XCNT(b.x)], 1u);
    return b;
}
__device__ __forceinline__ void xcd_barrier_complete(unsigned* bar, unsigned x, unsigned& nloc, unsigned& nx) {
    const unsigned G = gridDim.x * gridDim.y * gridDim.z;
    unsigned sum, cnt, mine, sp = 0u;
    for (;;) {
        sum = 0u; cnt = 0u; mine = 0u;
#pragma unroll
        for (unsigned j = 0; j < 16; ++j) { const unsigned c = xb_ld(&bar[XB_XCNT(j)]); sum += c; cnt += (c > 0u) ? 1u : 0u; mine = (j == x) ? c : mine; }
        if (sum == G) break;
        __builtin_amdgcn_s_sleep(1);
        if ((++sp & 255u) == 0u) { if (xb_ld(&bar[XB_TMO])) break; if (sp > XB_SPIN_CAP) { atomicAdd(&bar[XB_TMO], 1u); break; } }
    }
    nloc = mine > 0u ? mine : 1u; nx = cnt > 0u ? cnt : 1u;
}
__device__ __forceinline__ void xcd_barrier(const XcdBarrier& b, const bool leader) {
    asm volatile("s_waitcnt vmcnt(0)" ::: "memory");
    __syncthreads();
    if (leader) {
        unsigned* bar = b.bar;
        __builtin_amdgcn_s_waitcnt(0);
        unsigned nloc = b.st[0], nx = b.st[1];
        if (nloc == 0u) { xcd_barrier_complete(bar, b.x, nloc, nx); b.st[0] = nloc; b.st[1] = nx; }
        const unsigned old = xb_add(&bar[XB_XSUB(b.x)], 1u);
        const unsigned gen = old / nloc;
        if (old + 1u == (gen + 1u) * nloc) {
            __builtin_amdgcn_fence(__ATOMIC_RELEASE, "agent");
            asm volatile("s_waitcnt vmcnt(0)" ::: "memory");
            const unsigned og = xb_add(&bar[XB_TOP], 1u);
            const unsigned tg = og / nx;
            if (og + 1u == (tg + 1u) * nx) xb_add(&bar[XB_TOPGEN], 1u);
            else XB_SPIN(xb_ld(&bar[XB_TOPGEN]) == tg, bar);
            __builtin_amdgcn_fence(__ATOMIC_ACQUIRE, "agent");
            xb_add(&bar[XB_XGEN(b.x)], 1u);
            asm volatile("s_waitcnt vmcnt(0)" ::: "memory");
        } else {
            XB_SPIN(xb_ld(&bar[XB_XGEN(b.x)]) == gen, bar);
            __builtin_amdgcn_fence(__ATOMIC_ACQUIRE, "agent");
            asm volatile("s_waitcnt vmcnt(0)" ::: "memory");
        }
    }
    __syncthreads();
}

struct Frame {
    LAS unsigned char* lds;
    unsigned* ctl;
    int tid, lane, wave, vcu, G;
    float* out; unsigned char* ws;
};
struct Args { const float* in[25]; float* out; unsigned char* ws; int ph_lo, ph_hi; };
#define GIN(i) ((const float*)(const GAS float*)KA.in[i])
__device__ __forceinline__ float wave_sum(float v) {
    v += xshfl<1>(v); v += xshfl<2>(v); v += xshfl<4>(v); v += xshfl<8>(v); v += xshfl<16>(v); v += xshfl<32>(v);
    return v;
}
#define LDS_WAIT() asm volatile("s_waitcnt lgkmcnt(0)" ::: "memory")

__device__ __forceinline__ void p0_phase(Frame& F, const Args& KA) {
    LAS float* cact = (LAS float*)F.lds;
    LAS float* part = (LAS float*)(F.lds + 32768);
    const float* c = GIN(1); const float* w_ada = GIN(2); const float* b_ada = GIN(3);
    float* mod = (float*)(F.ws + WS_MOD);
    for (int i = F.tid; i < NB * DM; i += NWAVES * 64) { const float v = c[i]; cact[i] = v / (1.0f + __expf(-v)); }
    __syncthreads();
    for (int cb = blockIdx.x; cb < DEPTH * 96; cb += F.G) {
        const int l = cb / 96, n0 = (cb % 96) * 64;
        const float* w = w_ada + ((size_t)l * DM + F.wave * 128) * 6144 + n0 + F.lane;
        float acc[NB];
#pragma unroll
        for (int b = 0; b < NB; ++b) acc[b] = 0.f;
#pragma unroll 8
        for (int k = 0; k < 128; ++k) { const float wv = w[(size_t)k * 6144];
#pragma unroll
            for (int b = 0; b < NB; ++b) acc[b] += cact[b * DM + F.wave * 128 + k] * wv; }
#pragma unroll
        for (int b = 0; b < NB; ++b) part[(F.wave * NB + b) * 64 + F.lane] = acc[b];
        __syncthreads();
        { const int b = F.tid >> 6; float s = b_ada[l * 6144 + n0 + F.lane];
#pragma unroll
          for (int w8 = 0; w8 < NWAVES; ++w8) s += part[(w8 * NB + b) * 64 + F.lane];
          mod[((size_t)l * NB + b) * 6144 + n0 + F.lane] = s; }
        __syncthreads();
    }
    float* cs = (float*)(F.ws + WS_ROPE);
    for (int id = blockIdx.x * (NWAVES * 64) + F.tid; id < SEQ * 16; id += F.G * NWAVES * 64) {
        const int pos = id >> 4, f = id & 15;
        const float inv = powf(10000.0f, -(float)(2 * f) / 32.0f);
        const float ang = (float)pos * inv;
        cs[id] = cosf(ang); cs[SEQ * 16 + id] = sinf(ang);
    }
}

template <class RowMap>
__device__ __forceinline__ void transpose_item(const float* W, int ldw, int k0, int n0, bf16_t* WT, int ldt, const RowMap& rm, LAS float* scr, int lane, const float* kscale = nullptr, float cscale = 1.0f) {
    { const float* wp = (const float*)(const GAS float*)W + (size_t)(k0 + (lane >> 5)) * ldw + n0 + (lane & 31);
      float wv[32];
#pragma unroll
      for (int i = 0; i < 32; ++i) wv[i] = *(const GAS float*)(wp + (size_t)(2 * i) * ldw);
#pragma unroll
      for (int i = 0; i < 32; ++i) { const int kk = 2 * i + (lane >> 5); float v = wv[i]; if (kscale) v *= kscale[k0 + kk]; scr[kk * 33 + (lane & 31)] = v * cscale; } }
    LDS_WAIT(); asm volatile("" ::: "memory");
    const int c = lane & 7;
#pragma unroll
    for (int j = 0; j < 4; ++j) { const int n = (lane >> 3) + 8 * j; const LAS float* s = scr + (8 * c) * 33 + n;
        u32x4 o; o.x = cvt_pk_bf16(s[0 * 33], s[1 * 33]); o.y = cvt_pk_bf16(s[2 * 33], s[3 * 33]); o.z = cvt_pk_bf16(s[4 * 33], s[5 * 33]); o.w = cvt_pk_bf16(s[6 * 33], s[7 * 33]);
        *(u32x4*)(WT + (size_t)rm(n0 + n) * ldt + k0 + 8 * c) = o; }
    LDS_WAIT(); asm volatile("" ::: "memory");
}
__device__ __forceinline__ void transpose_item_f8(const float* W, int ldw, int k0, int n0, unsigned char* WT, int ldt, int nbase, LAS float* scr, int lane, float cscale) {
    { const float* wp = (const float*)(const GAS float*)W + (size_t)(k0 + (lane >> 5)) * ldw + n0 + (lane & 31);
      float wv[32];
#pragma unroll
      for (int i = 0; i < 32; ++i) wv[i] = *(const GAS float*)(wp + (size_t)(2 * i) * ldw);
#pragma unroll
      for (int i = 0; i < 32; ++i) { const int kk = 2 * i + (lane >> 5); scr[kk * 33 + (lane & 31)] = wv[i] * cscale; } }
    LDS_WAIT(); asm volatile("" ::: "memory");
    const int c = lane & 7;
#pragma unroll
    for (int j = 0; j < 4; ++j) { const int n = (lane >> 3) + 8 * j; const LAS float* s = scr + (8 * c) * 33 + n;
        u32x2 o; o.x = pk_fp8x4(s[0 * 33], s[1 * 33], s[2 * 33], s[3 * 33]); o.y = pk_fp8x4(s[4 * 33], s[5 * 33], s[6 * 33], s[7 * 33]);
        *(u32x2*)(WT + (size_t)(n0 + n - nbase) * ldt + k0 + 8 * c) = o; }
    LDS_WAIT(); asm volatile("" ::: "memory");
}
__device__ __forceinline__ int pairpos(int j) { const int f = j & 15, p = j >> 4; return 8 * (f >> 2) + 4 * p + (f & 3); }
struct MapIn   { __device__ __forceinline__ int operator()(int n) const {
    if (n < 1280) return n;
    if (n < 1728) return n + 512;
    if (n < 1760) return 2240 + pairpos(n - 1728);
    if (n < 2144) { const int d = n - 1760; return 1280 + (d & ~31) + pairpos(d & 31); }
    if (n < 2272) return n - 480;
    return n + 32; } };
struct MapId   { __device__ __forceinline__ int operator()(int n) const { return n; } };
struct MapUkv  { __device__ __forceinline__ int operator()(int n) const { const int h = n >> 7, j = n & 127; return j < 64 ? 64 * h + j : 256 + 64 * h + (j - 64); } };
struct MapE13  { int add; __device__ __forceinline__ int operator()(int n) const { return 8 * (n >> 2) + (n & 3) + add; } };

__device__ __forceinline__ void convert_weights(Frame& F, const Args& KA, int l, unsigned char* wb, int it_lo, int it_hi, int gw, int NGW, bool smalls) {
    LAS float* scr = (LAS float*)(F.lds + F.wave * 16384);
    const float* w_in = GIN(6) + (size_t)l * DM * 6368;
    const float* w_ukv = GIN(12) + (size_t)l * 256 * 512;
    const float* w_br = GIN(15) + (size_t)l * 4 * 256 * DM;
    const float* w_out = GIN(16) + (size_t)l * DM * DM;
    const float* w_e1 = GIN(21) + (size_t)l * NEXP * DM * 256;
    const float* w_e3 = GIN(22) + (size_t)l * NEXP * DM * 256;
    const float* w_e2 = GIN(23) + (size_t)l * NEXP * 256 * DM;
    constexpr int I_IN = 16 * 199, I_BR = 4 * 4 * 32, I_OUT = 16 * 32, I_UKV = 4 * 16, I_E1 = NEXP * 16 * 8, I_E2 = NEXP * 4 * 32;
    constexpr int NITEMS = I_IN + I_BR + I_OUT + I_UKV + 2 * I_E1 + I_E2;
    if (it_hi > NITEMS) it_hi = NITEMS;
    for (int it = it_lo + gw; it < it_hi; it += NGW) {
        int r = it;
        if (r < I_IN) { const int kb = r / 199, nb = r % 199;
            if (nb >= 71) transpose_item_f8(w_in, 6368, 64 * kb, 32 * nb, wb + W_G8, DM, 2272, scr, F.lane, -LOG2E * pg8::GATE_WSCALE);
            else transpose_item(w_in, 6368, 64 * kb, 32 * nb, (bf16_t*)(wb + W_IN), DM, MapIn{}, scr, F.lane); continue; } r -= I_IN;
        if (r < I_BR) { const int n = r >> 7, q = r & 127, kb = q >> 5, nb = q & 31; transpose_item_f8(w_br + (size_t)n * 256 * DM, DM, 64 * kb, 32 * nb, wb + W_BR + (size_t)n * DM * 256, 256, 0, scr, F.lane, pg8::MERGE_WSCALE); continue; } r -= I_BR;
        if (r < I_OUT) { const int kb = r >> 5, nb = r & 31; transpose_item(w_out, DM, 64 * kb, 32 * nb, (bf16_t*)(wb + W_OUT), DM, MapId{}, scr, F.lane); continue; } r -= I_OUT;
        if (r < I_UKV) { const int kb = r >> 4, nb = r & 15; transpose_item(w_ukv, 512, 64 * kb, 32 * nb, (bf16_t*)(wb + W_UKV), 256, MapUkv{}, scr, F.lane, GIN(10) + l * 256); continue; } r -= I_UKV;
        if (r < I_E1) { const int e = r >> 7, q = r & 127, kb = q >> 3, nb = q & 7; transpose_item(w_e1 + (size_t)e * DM * 256, 256, 64 * kb, 32 * nb, (bf16_t*)(wb + W_E13) + (size_t)e * 512 * DM, DM, MapE13{0}, scr, F.lane); continue; } r -= I_E1;
        if (r < I_E1) { const int e = r >> 7, q = r & 127, kb = q >> 3, nb = q & 7; transpose_item(w_e3 + (size_t)e * DM * 256, 256, 64 * kb, 32 * nb, (bf16_t*)(wb + W_E13) + (size_t)e * 512 * DM, DM, MapE13{4}, scr, F.lane); continue; } r -= I_E1;
        { const int e = r >> 7, q = r & 127, kb = q >> 5, nb = q & 31; transpose_item(w_e2 + (size_t)e * 256 * DM, DM, 64 * kb, 32 * nb, (bf16_t*)(wb + W_E2) + (size_t)e * DM * 256, 256, MapId{}, scr, F.lane); }
    }
    if (!smalls) return;
    const float* w_uq = GIN(11) + (size_t)l * 192 * 384;
    const float* w_g = GIN(17) + (size_t)l * DM * 4;
    const float* w_r = GIN(19) + (size_t)l * DM * 32;
    bf16_t* uq = (bf16_t*)(wb + W_UQ); bf16_t* rt = (bf16_t*)(wb + W_RT); bf16_t* win = (bf16_t*)(wb + W_IN);
    const int gt = blockIdx.x * (NWAVES * 64) + F.tid, NT = F.G * NWAVES * 64;
    for (int i = gt; i < 512 * 256; i += NT) {
        const int r = i >> 8, k = i & 255; float v = 0.f;
        if (r < 384 && k < 192) { const int h = r / 96, j = r % 96; int src;
            if (j < 64) src = 96 * h + j;
            else { const int q = j - 64, fb = q >> 3, p = (q >> 2) & 1, f = 4 * fb + (q & 3); src = 96 * h + 64 + 16 * p + f; }
            v = w_uq[(size_t)k * 384 + src] * GIN(9)[l * 192 + k]; }
        uq[i] = f2bf(v);
    }
    for (int i = gt; i < 256 * DM; i += NT) {
        const int r = i >> 10, k = i & 1023; float v = 0.f;
        if (r < 4) v = w_g[k * 4 + r]; else if (r < 36) v = w_r[k * 32 + (r - 4)];
        rt[i] = f2bf(v);
    }
    for (int i = gt; i < 32 * DM; i += NT) win[(size_t)2272 * DM + i] = 0;
}

__device__ __forceinline__ void load_moe_tables(Frame& F, int l) {
    LAS int* tend = (LAS int*)(F.lds + LC_TEND); LAS int* cnt = (LAS int*)(F.lds + LC_CNT);
    if (F.tid < NEXP) cnt[F.tid] = (int)__hip_atomic_load(F.ctl + CW_ECNT + 64 * l + F.tid, RLX_AGENT);
    __syncthreads();
    if (F.tid == 0) { int acc = 0; for (int e = 0; e < NEXP; ++e) { acc += (cnt[e] + 255) >> 8; tend[e] = acc; } }
    __syncthreads();
}

__device__ __forceinline__ void norm_phase(Frame& F, const float* xsrc, const bf16_t* xbsrc, bf16_t* xdst, bool combine, const float* g2prev, const float* gain, const float* shv, const float* scv,
                                           bf16_t* hout, float* fout, const bf16_t* delta = nullptr, unsigned char* h8out = nullptr) {
    const int gw = F.vcu * NWAVES + F.wave, NGW = F.G * NWAVES;
    const int rpw = (((MTOK + NGW - 1) / NGW) + 3) & ~3;
    int m0 = gw * rpw, m1 = m0 + rpw; m1 = m1 > MTOK ? MTOK : m1;
    const LAS int* tend = (const LAS int*)(F.lds + LC_TEND);
    const int* tok_es = (const int*)(F.ws + WS_TOKES); const float* tok_w = (const float*)(F.ws + WS_TOKW);
    const bf16_t* YS = (const bf16_t*)(F.ws + WS_YS);
    f32x4 A[4], B[4], G2[4]; int bcur = -1;
#pragma unroll
    for (int j = 0; j < 4; ++j) { A[j] = (f32x4){0.f, 0.f, 0.f, 0.f}; B[j] = A[j]; G2[j] = A[j]; }
    const int lc = 4 * F.lane;
    for (int m = m0; m < m1; m += 4) {
        const int b = m >> 12;
        if (b != bcur) { bcur = b;
#pragma unroll
            for (int j = 0; j < 4; ++j) { const int col = lc + 256 * j; const f32x4 gn = *(const f32x4*)(gain + col);
                if (scv) { const f32x4 sc = *(const f32x4*)(scv + b * 6144 + col); A[j] = gn * (sc + 1.0f); B[j] = *(const f32x4*)(shv + b * 6144 + col); } else { A[j] = gn; }
                if (combine) G2[j] = *(const f32x4*)(g2prev + b * 6144 + col); } }
        f32x4 v[4][4];
        if (xbsrc) {
            u32x2 xb[4][4];
#pragma unroll
            for (int r = 0; r < 4; ++r)
#pragma unroll
                for (int j = 0; j < 4; ++j) xb[r][j] = __builtin_nontemporal_load((const GAS u32x2*)(xbsrc + (size_t)(m + r) * DM + lc + 256 * j));
#pragma unroll
            for (int r = 0; r < 4; ++r)
#pragma unroll
                for (int j = 0; j < 4; ++j) { const u32x2 y0 = xb[r][j]; v[r][j] = (f32x4){bflo(y0.x), bfhi(y0.x), bflo(y0.y), bfhi(y0.y)}; }
        } else {
#pragma unroll
            for (int r = 0; r < 4; ++r)
#pragma unroll
                for (int j = 0; j < 4; ++j) v[r][j] = *(const GAS f32x4*)(xsrc + (size_t)(m + r) * DM + lc + 256 * j);
        }
        if (delta) {
            u32x2 dl[4][4];
#pragma unroll
            for (int r = 0; r < 4; ++r)
#pragma unroll
                for (int j = 0; j < 4; ++j) dl[r][j] = *(const GAS u32x2*)(delta + (size_t)(m + r) * DM + lc + 256 * j);
#pragma unroll
            for (int r = 0; r < 4; ++r)
#pragma unroll
                for (int j = 0; j < 4; ++j) { const u32x2 y0 = dl[r][j]; v[r][j] = v[r][j] + (f32x4){bflo(y0.x), bfhi(y0.x), bflo(y0.y), bfhi(y0.y)}; }
            if (xdst) {
#pragma unroll
                for (int r = 0; r < 4; ++r)
#pragma unroll
                    for (int j = 0; j < 4; ++j) { u32x2 w_; w_.x = cvt_pk_bf16(v[r][j].x, v[r][j].y); w_.y = cvt_pk_bf16(v[r][j].z, v[r][j].w); *(GAS u32x2*)(xdst + (size_t)(m + r) * DM + lc + 256 * j) = w_; } }
        }
        if (combine) {
            int es[4][2]; float ww[4][2];
#pragma unroll
            for (int r = 0; r < 4; ++r) { es[r][0] = tok_es[2 * (m + r)]; es[r][1] = tok_es[2 * (m + r) + 1]; ww[r][0] = tok_w[2 * (m + r)]; ww[r][1] = tok_w[2 * (m + r) + 1]; }
            u32x2 y[4][2][4];
#pragma unroll
            for (int r = 0; r < 4; ++r)
#pragma unroll
                for (int k = 0; k < 2; ++k) { const int e = es[r][k] >> 16; const int rr = 256 * (e ? tend[e - 1] : 0) + (es[r][k] & 0xffff);
#pragma unroll
                    for (int j = 0; j < 4; ++j) y[r][k][j] = __builtin_nontemporal_load((const GAS u32x2*)(YS + (size_t)rr * DM + lc + 256 * j)); }
#pragma unroll
            for (int r = 0; r < 4; ++r)
#pragma unroll
                for (int j = 0; j < 4; ++j) { const u32x2 y0 = y[r][0][j], y1 = y[r][1][j];
                    const f32x4 a = (f32x4){bflo(y0.x), bfhi(y0.x), bflo(y0.y), bfhi(y0.y)}, c = (f32x4){bflo(y1.x), bfhi(y1.x), bflo(y1.y), bfhi(y1.y)};
                    v[r][j] = v[r][j] + G2[j] * (a * ww[r][0] + c * ww[r][1]); }
            if (xdst) {
#pragma unroll
                for (int r = 0; r < 4; ++r)
#pragma unroll
                    for (int j = 0; j < 4; ++j) { u32x2 w_; w_.x = cvt_pk_bf16(v[r][j].x, v[r][j].y); w_.y = cvt_pk_bf16(v[r][j].z, v[r][j].w); *(GAS u32x2*)(xdst + (size_t)(m + r) * DM + lc + 256 * j) = w_; } }
        }
        float s[4];
#pragma unroll
        for (int r = 0; r < 4; ++r) { s[r] = 0.f;
#pragma unroll
            for (int j = 0; j < 4; ++j) s[r] += (v[r][j].x * v[r][j].x + v[r][j].y * v[r][j].y) + (v[r][j].z * v[r][j].z + v[r][j].w * v[r][j].w); }
#pragma unroll
        for (int r = 0; r < 4; ++r) s[r] += xshfl<1>(s[r]);
#pragma unroll
        for (int r = 0; r < 4; ++r) s[r] += xshfl<2>(s[r]);
#pragma unroll
        for (int r = 0; r < 4; ++r) s[r] += xshfl<4>(s[r]);
#pragma unroll
        for (int r = 0; r < 4; ++r) s[r] += xshfl<8>(s[r]);
#pragma unroll
        for (int r = 0; r < 4; ++r) s[r] += xshfl<16>(s[r]);
#pragma unroll
        for (int r = 0; r < 4; ++r) s[r] += xshfl<32>(s[r]);
#pragma unroll
        for (int r = 0; r < 4; ++r) { const float rstd = rsqrtf(s[r] * (1.0f / DM) + EPS);
#pragma unroll
            for (int j = 0; j < 4; ++j) { const f32x4 o = v[r][j] * rstd * A[j] + B[j];
                if (hout) { u32x2 w; w.x = cvt_pk_bf16(o.x, o.y); w.y = cvt_pk_bf16(o.z, o.w); *(GAS u32x2*)(hout + (size_t)(m + r) * DM + lc + 256 * j) = w; }
                if (h8out) *(GAS unsigned*)(h8out + (size_t)(m + r) * DM + lc + 256 * j) = pk_fp8x4(o.x, o.y, o.z, o.w);
                if (fout) *(GAS f32x4*)(fout + (size_t)(m + r) * DM + lc + 256 * j) = o; } }
    }
}

__device__ __forceinline__ void prep_phase(Frame& F, const Args& KA, int l, bool dummy = false) {
    const int gw = F.vcu * NWAVES + F.wave, NGW = F.G * NWAVES;
    bf16_t* P = (bf16_t*)(F.ws + WS_PROJ); bf16_t* KC = (bf16_t*)(F.ws + WS_KC);
    const float* cs = (const float*)(F.ws + WS_ROPE);
    const float* gq = GIN(9) + l * 192; const float* gkv = GIN(10) + l * 256; const float* gaq = GIN(13) + l * 64; const float* gak = GIN(14) + l * 64;
    const int lane = F.lane;
    const float g_q0 = gq[lane], g_q1 = gq[lane + 64], g_q2 = gq[lane + 128];
    const float g_kv0 = gkv[lane], g_kv1 = gkv[lane + 64], g_kv2 = gkv[lane + 128], g_kv3 = gkv[lane + 192];
    const float g_aq = gaq[lane], g_ak = gak[lane];
    const int rpw = (((MTOK + NGW - 1) / NGW) + 3) & ~3;
    int m0 = gw * rpw, m1 = m0 + rpw; m1 = m1 > MTOK ? MTOK : m1;
    const int f15 = lane & 15;
    for (int mg = m0; mg < m1; mg += 4) {
        float cq[4][3], ckv[4][4], kr1[4], kr2[4], ax[4][6];
#pragma unroll
        for (int r = 0; r < 4; ++r) { const bf16_t* row = P + (size_t)(mg + r) * LDP;
#pragma unroll
            for (int k = 0; k < 3; ++k) cq[r][k] = bf2f(row[PC_CQ + 64 * k + lane]);
#pragma unroll
            for (int k = 0; k < 4; ++k) ckv[r][k] = bf2f(row[PC_CKV + 64 * k + lane]);
            kr1[r] = bf2f(row[PC_KR + f15]); kr2[r] = bf2f(row[PC_KR + 16 + f15]);
#pragma unroll
            for (int hh = 0; hh < 6; ++hh) ax[r][hh] = bf2f(row[(hh < 4 ? PC_AXQ + 64 * hh : PC_AXK + 64 * (hh - 4)) + lane]); }
        float ss[4][8];
#pragma unroll
        for (int r = 0; r < 4; ++r) { ss[r][0] = cq[r][0] * cq[r][0] + cq[r][1] * cq[r][1] + cq[r][2] * cq[r][2];
            ss[r][1] = ckv[r][0] * ckv[r][0] + ckv[r][1] * ckv[r][1] + ckv[r][2] * ckv[r][2] + ckv[r][3] * ckv[r][3];
#pragma unroll
            for (int hh = 0; hh < 6; ++hh) ss[r][2 + hh] = ax[r][hh] * ax[r][hh]; }
#define PREP_BFLY(M) _Pragma("unroll") for (int r = 0; r < 4; ++r) _Pragma("unroll") for (int q = 0; q < 8; ++q) ss[r][q] += xshfl<M>(ss[r][q]);
        PREP_BFLY(1) PREP_BFLY(2) PREP_BFLY(4) PREP_BFLY(8) PREP_BFLY(16) PREP_BFLY(32)
#undef PREP_BFLY
#pragma unroll
        for (int r = 0; r < 4; ++r) { const int m = mg + r; bf16_t* row = dummy ? (bf16_t*)(F.ws + WS_END2) + (size_t)(m & 255) * LDP : P + (size_t)m * LDP;
            const int pos = m & (SEQ - 1), gr = pos >> 6, gc = pos & 63;
            { const float rstd = rsqrtf(ss[r][0] * (1.0f / 192.0f) + EPS);
              row[PC_CQ + lane] = f2bf(cq[r][0] * rstd * g_q0); row[PC_CQ + 64 + lane] = f2bf(cq[r][1] * rstd * g_q1); row[PC_CQ + 128 + lane] = f2bf(cq[r][2] * rstd * g_q2); }
            { const float rstd = rsqrtf(ss[r][1] * (1.0f / 256.0f) + EPS);
              row[PC_CKV + lane] = f2bf(ckv[r][0] * rstd * g_kv0); row[PC_CKV + 64 + lane] = f2bf(ckv[r][1] * rstd * g_kv1); row[PC_CKV + 128 + lane] = f2bf(ckv[r][2] * rstd * g_kv2); row[PC_CKV + 192 + lane] = f2bf(ckv[r][3] * rstd * g_kv3); }
            if (lane < 16) { const int f = lane; const float x1 = kr1[r], x2 = kr2[r];
                const float c = cs[pos * 16 + f], s = cs[SEQ * 16 + pos * 16 + f];
                const unsigned short o1 = f2bf(x1 * c - x2 * s), o2 = f2bf(x1 * s + x2 * c);
                const int p1 = 8 * (f >> 2) + (f & 3), p2 = p1 + 4;
                bf16_t* kr = (dummy ? (bf16_t*)(F.ws + WS_END2) + (size_t)(m & 255) * LDP : KC + (size_t)m * 384) + 64;
#pragma unroll
                for (int h = 0; h < 4; ++h) { kr[96 * h + p1] = o1; kr[96 * h + p2] = o2; } }
            { const int idx = (lane < 32) ? gr : gc;
              const float c = cs[idx * 16 + f15], s = cs[SEQ * 16 + idx * 16 + f15];
#pragma unroll
              for (int hh = 0; hh < 6; ++hh) {
                  bf16_t* p = row + (hh < 4 ? PC_AXQ + 64 * hh : PC_AXK + 64 * (hh - 4)) + lane;
                  const float rstd = rsqrtf(ss[r][2 + hh] * (1.0f / 64.0f) + EPS);
                  const float y = ax[r][hh] * rstd * (hh < 4 ? g_aq * (0.125f * LOG2E) : g_ak);
                  const float pr = xshfl<16>(y);
                  const float o = (lane & 16) ? (pr * s + y * c) : (y * c - pr * s);
                  *p = f2bf(o);
              } }
        }
    }
}
__device__ __forceinline__ void attn_phase(Frame& F, const Args& KA, int l) {
    bf16_t* P = (bf16_t*)(F.ws + WS_PROJ); bf16_t* QC = (bf16_t*)(F.ws + WS_QC); bf16_t* KC = (bf16_t*)(F.ws + WS_KC); bf16_t* VC = (bf16_t*)(F.ws + WS_VC);
    unsigned char* Y8 = F.ws + WS_Y8;
    constexpr int NU = NB * 4 * (SEQ / 256);
#ifndef REP_C
#define REP_C 1
#endif
#ifndef C_UNIT2
#define C_UNIT2 1
#endif
    if (C_UNIT2) {
        for (int L = F.vcu; L < NU / 2; L += F.G) { const int bh = L >> 3, qb = L & 7, b = bh >> 2, h = bh & 3; const size_t rb = (size_t)b * SEQ;
            att::attn_unit2<96, true>(QC + rb * 384 + 96 * h, QC + (rb + 2048) * 384 + 96 * h, KC + rb * 384 + 96 * h, VC + rb * 256 + 64 * h,
                                (bf16_t*)(Y8 + rb * 1024 + 512 + 64 * h), (bf16_t*)(Y8 + (rb + 2048) * 1024 + 512 + 64 * h), 384, 384, 256, 1024, qb * 256, F.lds, F.wave * 64 + lane_now()); }
    } else
    for (int rep = 0; rep < REP_C; ++rep)
    for (int L = F.vcu; L < NU; L += F.G) { const int bh = L >> 4, qb = L & 15, b = bh >> 2, h = bh & 3; const size_t rb = (size_t)b * SEQ;
        att::attn_unit<96, 0>(QC + rb * 384 + 96 * h, KC + rb * 384 + 96 * h, VC + rb * 256 + 64 * h, P + rb * LDP + PC_YC + 64 * h, 384, 384, 256, LDP,
                              qb * 256, 0.10206207261596575f * LOG2E, 0.f, 0.f, nullptr, F.lds, F.wave * 64 + lane_now()); }
#ifndef REP_D
#define REP_D 1
#endif
#ifndef REP_B
#define REP_B 1
#endif
#ifndef REP_A
#define REP_A 1
#endif
    bf16_t* DUMMY = (bf16_t*)(F.ws + WS_END);
    for (int L = F.vcu; L < NU / 2; L += F.G) { const int bk = L >> 4, qb = L & 15, b = bk >> 1, kv = bk & 1; bf16_t* Pb = P + (size_t)b * SEQ * LDP;
        att::attn_unit2<64, true>(Pb + PC_AXQ + 128 * kv, Pb + PC_AXQ + 128 * kv + 64, Pb + PC_AXK + 64 * kv, Pb + PC_AXV + 64 * kv, (bf16_t*)(Y8 + (size_t)b * SEQ * 1024 + 768 + 128 * kv), (bf16_t*)(Y8 + (size_t)b * SEQ * 1024 + 768 + 128 * kv + 64),
                            LDP, LDP, LDP, 1024, qb * 256, F.lds, F.wave * 64 + lane_now()); }
    for (int rep = 0; rep < REP_B; ++rep)
    for (int L = F.vcu; L < NU; L += F.G) { const int bh = L >> 4, qb = L & 15, b = bh >> 2, h = bh & 3; bf16_t* Pb = P + (size_t)b * SEQ * LDP; const bool dm = rep < REP_B - 1;
        const float slope = exp2f(-2.0f * (float)(h + 1)); const float sink = GIN(8)[l * 4 + h];
        att::attn_unit<64, 1, 0, true>(Pb + PC_WQ + 64 * h, Pb + PC_WK + 64 * (h >> 1), Pb + PC_WV + 64 * (h >> 1), (bf16_t*)(Y8 + (size_t)b * SEQ * 1024 + 256 + 64 * h), LDP, LDP, LDP, 1024,
                              qb * 256, 0.125f * LOG2E, slope * LOG2E, sink * LOG2E, nullptr, F.lds, F.wave * 64 + lane_now()); }
    for (int rep = 0; rep < REP_A; ++rep)
    for (int L = F.vcu; L < NU; L += F.G) { const int bh = L >> 4, qb = L & 15, b = bh >> 2, h = bh & 3; bf16_t* Pb = P + (size_t)b * SEQ * LDP; const bool dm = rep < REP_A - 1;
        att::attn_unit<64, 2, 0, true>(Pb + PC_NAQ + 64 * h, Pb + PC_NAK + 64 * h, Pb + PC_NAV + 64 * h, (bf16_t*)(Y8 + (size_t)b * SEQ * 1024 + 64 * h), LDP, LDP, LDP, 1024,
                              qb * 256, 0.125f * LOG2E, 0.f, 0.f, GIN(7) + (size_t)(l * 4 + h) * (15 * 31), F.lds, F.wave * 64 + lane_now()); }
}

#ifndef REP_BAR
#define REP_BAR 1
#endif
#ifndef REP_G2
#define REP_G2 1
#endif
#ifndef REP_G3
#define REP_G3 1
#endif
#ifndef REP_G5
#define REP_G5 1
#endif
#ifndef REP_G6
#define REP_G6 1
#endif
#ifndef REP_AT
#define REP_AT 1
#endif
#ifndef REP_TH
#define REP_TH 1
#endif
#ifndef FILL_G1
#define FILL_G1 0
#endif
#ifndef FILL_GR
#define FILL_GR 0
#endif
#ifndef FILL_G5
#define FILL_G5 9216
#endif
#ifndef FILL_G6
#define FILL_G6 0
#endif
constexpr int FILL_A = FILL_G1, FILL_B = FILL_A + FILL_GR, FILL_C = FILL_B + FILL_G5, FILL_END = FILL_C + FILL_G6;
#define FILLER(lo, hi, skip) do { if ((hi) > (lo) && l + 1 < DEPTH && (int)blockIdx.x >= (skip) && F.G > (skip)) { __syncthreads(); \
        convert_weights(F, KA, l + 1, F.ws + (((l + 1) & 1) ? WS_W2 : WS_W), (lo), (hi), ((int)blockIdx.x - (skip)) * NWAVES + F.wave, (F.G - (skip)) * NWAVES, false); } } while (0)
constexpr int FILL_SKIP = 64;
constexpr int PH_PER_LAYER = 10, N_PHASES = 1 + DEPTH * PH_PER_LAYER + 1;

__global__ void __launch_bounds__(NWAVES * 64, 2) mk_fwd(Args KA) {
    extern __shared__ __attribute__((aligned(16))) unsigned char lds_raw[];
    { const int t0 = threadIdx.x; for (int u = t0; u < (LDS_BYTES - RING_BYTES) / 4; u += NWAVES * 64) ((LAS unsigned*)((LAS unsigned char*)lds_raw + RING_BYTES))[u] = 0u; }
    __syncthreads();
    const int wave0 = __builtin_amdgcn_readfirstlane((int)threadIdx.x >> 6);
    XcdBarrier bar = xcd_barrier_post((unsigned*)(KA.ws + WS_CTL) + CW_BAR, (volatile LAS unsigned*)((LAS unsigned char*)lds_raw + LC_BARW));
#define FRAME() Frame F; { int t_ = wave0 * 64 + lane_now(); asm volatile("" : "+v"(t_)); unsigned char* w_ = KA.ws; float* o_ = KA.out; asm volatile("" : "+s"(w_), "+s"(o_)); \
        F.lds = (LAS unsigned char*)lds_raw; F.tid = t_; F.lane = t_ & 63; F.wave = __builtin_amdgcn_readfirstlane(t_ >> 6); F.G = gridDim.x; \
        { const int bx = blockIdx.x; F.vcu = (F.G % 8 == 0) ? (bx % 8) * (F.G / 8) + bx / 8 : bx; } F.ws = (unsigned char*)(GAS unsigned char*)w_; F.out = (float*)(GAS float*)o_; F.ctl = (unsigned*)(F.ws + WS_CTL); } \
        unsigned char* wb = F.ws + ((l & 1) ? WS_W2 : WS_W); bf16_t* HB = (bf16_t*)(F.ws + WS_HB); bf16_t* P = (bf16_t*)(F.ws + WS_PROJ); float* mod = (float*)(F.ws + WS_MOD); bf16_t* XB = (bf16_t*)(F.ws + WS_XB); (void)XB; \
        const float* modl = mod + (size_t)l * NB * 6144; const float* x_in = GIN(0); (void)wb; (void)HB; (void)P; (void)modl; (void)x_in
    const int lo = KA.ph_lo, hi = KA.ph_hi;
#ifndef PHMASK
#define PHMASK 0xFFFF
#endif
#define EN(j) ((PHMASK >> (j)) & 1)
#define IN(k) (lo <= (k) && (k) < hi)
#define SEAM(k) do { if (IN(k) && IN((k) + 1)) { XcdBarrier b_ = bar; asm volatile("" : "+s"(b_.bar)); for (int r_ = 0; r_ < REP_BAR; ++r_) xcd_barrier(b_, wave0 == 0 && lane_now() == 0); } } while (0)

    if (EN(11) && IN(0)) { const int l = 0; FRAME(); p0_phase(F, KA); SEAM(0); }

    for (int l = 0; l < DEPTH; ++l) {
        const int pb = 1 + PH_PER_LAYER * l;
        if (EN(0) && IN(pb + 0)) { FRAME();
            for (int rep = 0; rep < REP_TH; ++rep) convert_weights(F, KA, l, wb, (l == 0 || F.G <= 128) ? 0 : FILL_END, 1 << 30, F.vcu * NWAVES + F.wave, F.G * NWAVES, true);
            if (l > 0) load_moe_tables(F, l - 1);
#ifndef REP_T1
#define REP_T1 1
#endif
            norm_phase(F, x_in, l == 0 ? nullptr : XB, XB, l > 0, modl - (size_t)NB * 6144 + 5120, GIN(4) + l * DM, modl, modl + 1024, HB, nullptr, nullptr, F.ws + WS_HB8);
            SEAM(pb + 0);
        }
        if (EN(1) && IN(pb + 1)) { FRAME();
            pg8::Gemm g{HB, (const bf16_t*)(wb + W_IN), nullptr}; pg8::StaticOrder S; S.init(MTOK, 2304, F.G, (int)blockIdx.x);
            pg8::EpiProj E{P, (LAS float*)(F.lds + LC_XCH), (float*)(F.ws + WS_SSQ), (const float*)(F.ws + WS_ROPE), (bf16_t*)(F.ws + WS_KC), GIN(13) + l * 64, GIN(14) + l * 64, 0};
            pg8::Gemm g8{(const bf16_t*)(F.ws + WS_HB8), (const bf16_t*)(wb + W_G8), nullptr}; pg8::StaticOrder S8; S8.init(MTOK, 4096, F.G, (int)blockIdx.x, 1);
            pg8::EpiProj E8 = E; E8.pn0 = 9;
#ifndef REP_G1
#define REP_G1 1
#endif
            for (int rep = 0; rep < REP_G1; ++rep) {
                pg8::gemm_phase<pg8::EpiProj, pg8::StaticOrder, false, true, DM, DM, DM, 0>(F.lds, g, S, E, F.tid);
                pg8::gemm_phase<pg8::EpiProj, pg8::StaticOrder, false, true, DM / 2, DM / 2, DM / 2, 0, true>(F.lds, g8, S8, E8, F.tid);
            }
            FILLER(0, FILL_A, 128);
            SEAM(pb + 1);
        }
        if (EN(2) && IN(pb + 2)) { FRAME();
            { pg8::Gemm g{P + PC_CQ, (const bf16_t*)(wb + W_UQ), nullptr}; pg8::StaticOrder S; S.init(MTOK, 512, F.G, (int)blockIdx.x);
              pg8::EpiQup E{(bf16_t*)(F.ws + WS_QC), (const float*)(F.ws + WS_ROPE), (const float*)(F.ws + WS_SSQ)};
              for (int rep = 0; rep < REP_G2; ++rep) pg8::gemm_phase<pg8::EpiQup, pg8::StaticOrder, false, true, LDP, 256, 256, 0>(F.lds, g, S, E, F.tid); }
            { pg8::Gemm g{P + PC_CKV, (const bf16_t*)(wb + W_UKV), nullptr}; pg8::StaticOrder S; S.init(MTOK, 512, F.G, (int)blockIdx.x);
              pg8::EpiKVup E{(bf16_t*)(F.ws + WS_KC), (bf16_t*)(F.ws + WS_VC), (const float*)(F.ws + WS_SSQ)};
              for (int rep = 0; rep < REP_G2; ++rep) pg8::gemm_phase<pg8::EpiKVup, pg8::StaticOrder, false, true, LDP, 256, 256, 0>(F.lds, g, S, E, F.tid); }
            SEAM(pb + 2);
        }
        if (EN(3) && IN(pb + 3)) { FRAME(); for (int rep = 0; rep < REP_AT; ++rep) { attn_phase(F, KA, l); __syncthreads(); } SEAM(pb + 3); }
        if (EN(4) && IN(pb + 4)) { FRAME();
            for (int rep = 0; rep < REP_G3; ++rep) { pg8::merge_phase3(F.lds, P, F.ws + WS_Y8, wb + W_BR, HB, F.G, F.vcu, F.tid); __syncthreads(); }
            SEAM(pb + 4);
        }
        if (EN(5) && IN(pb + 5)) { FRAME();
            pg8::Gemm g{HB, (const bf16_t*)(wb + W_OUT), nullptr}; pg8::StaticOrder S; S.init(MTOK, DM, F.G, (int)blockIdx.x);
            pg8::EpiResid E{l == 0 ? x_in : nullptr, XB, modl + 2048};
            pg8::gemm_phase<pg8::EpiResid, pg8::StaticOrder, false, true, DM, DM, DM, 0>(F.lds, g, S, E, F.tid);
            SEAM(pb + 5);
        }
        if (EN(6) && IN(pb + 6)) { FRAME(); norm_phase(F, nullptr, XB, nullptr, false, nullptr, GIN(5) + l * DM, modl + 3072, modl + 4096, HB, nullptr); SEAM(pb + 6); }
        if (EN(7) && IN(pb + 7)) { FRAME();
            pg8::Gemm g{HB, (const bf16_t*)(wb + W_RT), nullptr}; pg8::StaticOrder S; S.init(MTOK, 256, F.G, (int)blockIdx.x);
            pg8::EpiRoute E{GIN(18) + l * 4, GIN(20) + l * 32, F.ctl + CW_ECNT + 64 * l, (int*)(F.ws + WS_LIST), (int*)(F.ws + WS_TOKES), (float*)(F.ws + WS_TOKW)};
            pg8::gemm_phase<pg8::EpiRoute, pg8::StaticOrder, false, false, DM, DM, DM, 0>(F.lds, g, S, E, F.tid);
            FILLER(FILL_A, FILL_B, 128);
            SEAM(pb + 7);
        }
        if (EN(8) && IN(pb + 8)) { FRAME();
            load_moe_tables(F, l);
            pg8::Gemm g{HB, (const bf16_t*)(wb + W_E13), (const int*)(F.ws + WS_LIST)};
            pg8::MoeOrder S{F.G, (int)blockIdx.x, 1, (const LAS int*)(F.lds + LC_TEND), (const LAS int*)(F.lds + LC_CNT)};
            pg8::EpiExp1 E{(bf16_t*)(F.ws + WS_HS)};
            for (int rep = 0; rep < REP_G5; ++rep) pg8::gemm_phase<pg8::EpiExp1, pg8::MoeOrder, true, true, DM, DM, DM, 512>(F.lds, g, S, E, F.tid);
            FILLER(FILL_B, FILL_C, 64);
            SEAM(pb + 8);
        }
        if (EN(9) && IN(pb + 9)) { FRAME();
            load_moe_tables(F, l);
            pg8::Gemm g{(const bf16_t*)(F.ws + WS_HS), (const bf16_t*)(wb + W_E2), nullptr};
            pg8::MoeOrder S{F.G, (int)blockIdx.x, 2, (const LAS int*)(F.lds + LC_TEND), (const LAS int*)(F.lds + LC_CNT)};
            pg8::EpiStore E{(bf16_t*)(F.ws + WS_YS), DM};
            for (int rep = 0; rep < REP_G6; ++rep) pg8::gemm_phase<pg8::EpiStore, pg8::MoeOrder, false, true, 256, 256, 256, DM>(F.lds, g, S, E, F.tid);
            FILLER(FILL_C, FILL_END, 64);
            SEAM(pb + 9);
        }
    }
    if (EN(12) && IN(N_PHASES - 1)) { const int l = DEPTH - 1; FRAME();
        load_moe_tables(F, DEPTH - 1);
        norm_phase(F, nullptr, XB, nullptr, true, modl + 5120, GIN(24), nullptr, nullptr, nullptr, F.out);
    }
#undef IN
#undef SEAM
}

#ifndef MK_LAUNCH_PER_PHASE
#define MK_LAUNCH_PER_PHASE 0
#endif
extern "C" void kernel_launch(void* const* d_in, const int* in_sizes, int n_in, void* d_out, int out_size, void* d_ws, size_t ws_size, hipStream_t stream) {
    static int grid = 0;
    if (grid == 0) {
        int dev = 0, cus = 0;
        if (n_in != 25 || ws_size < WS_END4 || hipGetDevice(&dev) != hipSuccess || hipDeviceGetAttribute(&cus, hipDeviceAttributeMultiprocessorCount, dev) != hipSuccess) { grid = -1; return; }
        if (hipFuncSetAttribute((const void*)mk_fwd, hipFuncAttributeMaxDynamicSharedMemorySize, LDS_BYTES) != hipSuccess) { grid = -1; return; }
        grid = cus;
    }
    if (grid < 0) return;
    (void)hipMemsetAsync((char*)d_ws + WS_CTL, 0, CTL_ZERO_BYTES, stream);
    Args a{};
    for (int i = 0; i < 25; ++i) a.in[i] = (const float*)d_in[i];
    a.out = (float*)d_out; a.ws = (unsigned char*)d_ws;
#if MK_LAUNCH_PER_PHASE
#ifndef PH_MAX
#define PH_MAX N_PHASES
#endif
    for (int p = 0; p < PH_MAX; ++p) { a.ph_lo = p; a.ph_hi = p + 1; hipLaunchKernelGGL(mk_fwd, dim3(grid), dim3(NWAVES * 64), LDS_BYTES, stream, a); }
#else
    a.ph_lo = 0; a.ph_hi = N_PHASES;
    hipLaunchKernelGGL(mk_fwd, dim3(grid), dim3(NWAVES * 64), LDS_BYTES, stream, a);
#endif
}
```

```cpp
#include <hip/hip_runtime.h>
#include <hip/hip_bf16.h>
#include <cstdio>
#include <cstdint>

#define GAS __attribute__((address_space(1)))
#define LAS __attribute__((address_space(3)))
typedef unsigned short bf16_t;
typedef short bf16x8 __attribute__((ext_vector_type(8)));
typedef short s16x4 __attribute__((ext_vector_type(4)));
typedef float f32x2 __attribute__((ext_vector_type(2)));
typedef float f32x4 __attribute__((ext_vector_type(4)));
typedef float f32x16 __attribute__((ext_vector_type(16)));
typedef unsigned u32x2 __attribute__((ext_vector_type(2)));
typedef unsigned u32x4 __attribute__((ext_vector_type(4)));
typedef __bf16 bf16x2_t __attribute__((ext_vector_type(2)));

constexpr int NB = 8, SEQ = 4096, DM = 1024, DEPTH = 4, MTOK = NB * SEQ;
constexpr int NPROJ = 6400;
constexpr int LDP = 2304;
constexpr size_t GATE_BASE = (size_t)NB * SEQ * LDP * 2;
__device__ __forceinline__ size_t gate_off(int pm, int g, int wid, int ai, int lane) { return GATE_BASE + ((((size_t)(pm * 16 + g) * 8 + wid) * 2 + ai) * 64 + lane) * 64; }
constexpr int PC_NAQ = 0, PC_NAK = 256, PC_NAV = 512, PC_WQ = 768, PC_WK = 1024, PC_WV = 1152, PC_AXQ = 1280, PC_AXK = 1536, PC_AXV = 1664,
              PC_CQ = 1792, PC_CKV = 1984, PC_KR = 2240, PC_GATE = 2304, PC_YC = 1792;
constexpr int NEXP = 32, LISTCAP = 32768, SORTROWS = 2 * MTOK + NEXP * 256;
constexpr float LOG2E = 1.4426950408889634f;
constexpr float EPS = 1e-6f;

__device__ __forceinline__ unsigned cvt_pk_bf16(float lo, float hi) { f32x2 v = {lo, hi}; bf16x2_t b = __builtin_convertvector(v, bf16x2_t); return __builtin_bit_cast(unsigned, b); }
__device__ __forceinline__ float bf2f(unsigned short b) { return __uint_as_float(((unsigned)b) << 16); }
__device__ __forceinline__ float bflo(unsigned w) { return __uint_as_float(w << 16); }
__device__ __forceinline__ float bfhi(unsigned w) { return __uint_as_float(w & 0xffff0000u); }
__device__ __forceinline__ unsigned short f2bf(float f) { return (unsigned short)(cvt_pk_bf16(f, 0.f) & 0xffffu); }
__device__ __forceinline__ int lane_now() { int l; asm volatile("v_mbcnt_lo_u32_b32 %0, -1, 0\n\tv_mbcnt_hi_u32_b32 %0, -1, %0" : "=v"(l)); return l; }
template <int MASK> __device__ __forceinline__ float xshfl(float v) {
    if constexpr (MASK == 32) { auto rr = __builtin_amdgcn_permlane32_swap(__float_as_uint(v), __float_as_uint(v), false, false); return __uint_as_float((lane_now() & 32) ? rr[0] : rr[1]); }
    else return __uint_as_float((unsigned)__builtin_amdgcn_ds_swizzle((int)__float_as_uint(v), (MASK << 10) | 0x1f));
}
__device__ __forceinline__ unsigned pk_fp8x4(float a, float b, float c, float d) { unsigned w = 0u; w = __builtin_amdgcn_cvt_pk_fp8_f32(a, b, w, false); w = __builtin_amdgcn_cvt_pk_fp8_f32(c, d, w, true); return w; }
__device__ __forceinline__ float fast_sigmoid(float x) { return __builtin_amdgcn_rcpf(1.0f + __builtin_amdgcn_exp2f(-x * LOG2E)); }

namespace pg8 {
constexpr int BM = 256, BK = 64, HALF = 128, HTB = HALF * BK * 2, STAGE_BYTES = 8 * HTB, NXCD = 8, WGM = 8;

__host__ __device__ __forceinline__ int lds_byte(int r, int c) { const int st = (r >> 4) * 2 + (c >> 5), rr = r & 15, cc = c & 31, ob = rr * 64 + cc * 2; return st * 1024 + (ob ^ (((ob >> 9) & 1) << 5)); }
__host__ __device__ __forceinline__ void stage_rc(int b, int& R, int& C) { const int st = b / 1024, sb = b % 1024, swz = sb ^ (((sb >> 9) & 1) << 5); R = (st >> 1) * 16 + swz / 64; C = (st & 1) * 32 + (swz % 64) / 2; }
__host__ __device__ __forceinline__ int perm32(int rho) { const int n = rho >> 4, i = rho & 15; return 8 * (i >> 2) + 4 * n + (i & 3); }

typedef int i32x4 __attribute__((ext_vector_type(4)));
typedef int i32x8 __attribute__((ext_vector_type(8)));
struct Unit { int pm, pn, e, acol, lbase, nv; };
struct Gemm { const bf16_t* A; const bf16_t* Bt; const int* list; };

struct StaticOrder {
    int nM, nN, nwg, G, c, skew;
    __device__ __forceinline__ void init(int M, int N, int G_, int c_, int skew_ = 0) { nM = M / BM; nN = N / BM; nwg = nM * nN; G = G_; c = c_; skew = (skew_ && nwg % G_ == 0 && G_ % 16 == 0 && nwg >= 2 * G_) ? 1 : 0; }
    __device__ __forceinline__ bool next(int i, Unit& u) const {
        long L = (long)i * G + c;
        if (skew) { const int R = nwg / G; if (i >= R - 1) { const int k = i - (R - 1); if (c < G / 2 || k >= 2) return false; L = (long)(R - 1) * G + k * (G / 2) + (c - G / 2); } }
        if (L >= nwg) return false;
        int wgid = (int)L; { const int q = nwg / NXCD, r = nwg % NXCD, xcd = wgid % NXCD, off = wgid / NXCD; wgid = (xcd < r ? xcd * (q + 1) : r * (q + 1) + (xcd - r) * q) + off; }
        const int nig = WGM * nN, gid = wgid / nig, fm = gid * WGM, gsz = (nM - fm) < WGM ? (nM - fm) : WGM;
        u.pm = fm + ((wgid % nig) % gsz); u.pn = (wgid % nig) / gsz; u.e = 0; u.acol = 0; u.lbase = 0; u.nv = 256; return true;
    }
};

template <bool GATHER, int LDA>
__device__ __forceinline__ void a_offsets(const Gemm& g, const Unit& u, const int (&Rr)[2], const unsigned (&Cb)[2], unsigned (&vo)[2][2]) {
#pragma unroll
    for (int h = 0; h < 2; ++h)
#pragma unroll
        for (int i = 0; i < 2; ++i) {
            if constexpr (GATHER) {
                int idx = h * HALF + Rr[i]; idx = idx < u.nv ? idx : (u.nv - 1);
                const int row = g.list[u.lbase + idx];
                vo[h][i] = (unsigned)row * (unsigned)(LDA * 2) + Cb[i];
            } else {
                vo[h][i] = (unsigned)(h * HALF + Rr[i]) * (unsigned)(LDA * 2) + Cb[i];
            }
        }
}

template <class Epi, class Sched, bool GATHER, bool ALIGN_EPI, int LDA, int LDB, int KK, int NBE, bool F8 = false>
__device__ __forceinline__ void gemm_phase(LAS unsigned char* lds, const Gemm g, const Sched& S, const Epi& E, int tid) {
    asm volatile("" : "+v"(tid));
    const int wid = __builtin_amdgcn_readfirstlane(tid >> 6), lane = tid & 63, wr = wid >> 2, wc = wid & 3, fr = lane & 15, fq = lane >> 4;
    constexpr int nt = KK / BK;
    int Rr[2]; unsigned Cb[2]; unsigned voffB[2];
#pragma unroll
    for (int i = 0; i < 2; ++i) { int R, C; stage_rc(tid * 16 + i * 8192, R, C); const int Rb = Epi::PERM ? ((R & ~31) + perm32(R & 31)) : R;
        Rr[i] = R; Cb[i] = (unsigned)C * 2u; voffB[i] = (unsigned)(Rb * LDB + C) * 2u; }
    const size_t kstep = (size_t)(BK * 2);
    constexpr size_t hstepB = (size_t)HALF * LDB * 2, hstepA = (size_t)HALF * LDA * 2;
    const unsigned ldsw = (unsigned)wid * 1024u;
    const int aoff = lds_byte(wr * 64 + fr, fq * 8), boff = lds_byte(wc * 32 + fr, fq * 8);
#define PG8_SA(b, h) (((b) * 2 + (h)) * HTB)
#define PG8_SB(b, h) ((4 + (b) * 2 + (h)) * HTB)
#define PG8_STAGE(bufoff, gbase, voff) do { _Pragma("unroll") for (int _i = 0; _i < 2; ++_i) \
        __builtin_amdgcn_global_load_lds((const unsigned*)((const char*)(gbase) + (voff)[_i]), (LAS unsigned*)(lds + (bufoff) + ldsw + _i * 8192), 16, 0, 0); } while (0)
#define PG8_LDA(dst, b, h) do { _Pragma("unroll") for (int m = 0; m < 4; ++m) { if constexpr (F8) { dst##8[m].lo = *(const LAS i32x4*)(lds + PG8_SA(b, h) + aoff + m * 2048); dst##8[m].hi = *(const LAS i32x4*)(lds + PG8_SA(b, h) + aoff + m * 2048 + 1024); } \
        else { _Pragma("unroll") for (int k = 0; k < 2; ++k) dst[m][k] = *(const LAS bf16x8*)(lds + PG8_SA(b, h) + aoff + m * 2048 + k * 1024); } } } while (0)
#define PG8_LDB(dst, b, h) do { _Pragma("unroll") for (int n = 0; n < 2; ++n) { if constexpr (F8) { dst##8[n].lo = *(const LAS i32x4*)(lds + PG8_SB(b, h) + boff + n * 2048); dst##8[n].hi = *(const LAS i32x4*)(lds + PG8_SB(b, h) + boff + n * 2048 + 1024); } \
        else { _Pragma("unroll") for (int k = 0; k < 2; ++k) dst[n][k] = *(const LAS bf16x8*)(lds + PG8_SB(b, h) + boff + n * 2048 + k * 1024); } } } while (0)
#define PG8_MMA(ai, bj, At, Bt) do { __builtin_amdgcn_s_setprio(1); _Pragma("unroll") for (int m = 0; m < 4; ++m) _Pragma("unroll") for (int n = 0; n < 2; ++n) { \
        if constexpr (F8) { asm volatile("v_mfma_scale_f32_16x16x128_f8f6f4 %0, %1, %2, %0, %3, %3 op_sel_hi:[0,0,0]" : "+v"(acc[ai][bj][m][n]) : "v"(Bt##8[n]), "v"(At##8[m]), "v"(sc127)); }   \
        else { _Pragma("unroll") for (int k = 0; k < 2; ++k) acc[ai][bj][m][n] = __builtin_amdgcn_mfma_f32_16x16x32_bf16(Bt[n][k], At[m][k], acc[ai][bj][m][n], 0, 0, 0); } } \
        __builtin_amdgcn_s_setprio(0); } while (0)
#define PG8_WAIT_V(n) asm volatile("s_waitcnt vmcnt(" #n ")" ::: "memory")
#define PG8_WAIT_L(n) asm volatile("s_waitcnt lgkmcnt(" #n ")" ::: "memory")
#define PG8_BAR __builtin_amdgcn_s_barrier()
#define PG8_SCHED __builtin_amdgcn_sched_barrier(0)
#define PG8_STAGE_A(bufoff, gbase, vo, h) do { if constexpr (GATHER) { PG8_STAGE(bufoff, gbase, (vo)[h]); } else { PG8_STAGE(bufoff, (gbase) + (h) * hstepA, (vo)[0]); } } while (0)
#define PG8_ABASE(u) (GATHER ? (size_t)0 : ((size_t)(u).pm * BM * LDA + (size_t)(u).acol) * 2)
#define PG8_BBASE(u) (((size_t)(u).e * NBE + (size_t)(u).pn * BM) * LDB * 2)
    Unit cur, nxt; int ui = 0;
    if (!S.next(0, cur)) return;
    f32x4 acc[2][2][4][2];
#pragma unroll
    for (int a = 0; a < 2; ++a)
#pragma unroll
        for (int b = 0; b < 2; ++b)
#pragma unroll
            for (int m = 0; m < 4; ++m)
#pragma unroll
                for (int n = 0; n < 2; ++n) acc[a][b][m][n] = (f32x4){0.f, 0.f, 0.f, 0.f};
    bf16x8 At[4][2], B0[2][2], B1[2][2];
    i32x8 At8[4], B08[2], B18[2];
    int sc127 = 127; asm volatile("" : "+v"(sc127)); (void)sc127;
    (void)At; (void)B0; (void)B1; (void)At8; (void)B08; (void)B18;
    unsigned voA[2][2];
    a_offsets<GATHER, LDA>(g, cur, Rr, Cb, voA);
    if constexpr (GATHER) { asm volatile("s_waitcnt vmcnt(0)" ::: "memory"); }
    const char* Ab = (const char*)g.A; const char* Bb = (const char*)g.Bt; asm volatile("" : "+s"(Ab), "+s"(Bb)); Ab = (const char*)(const GAS char*)Ab; Bb = (const char*)(const GAS char*)Bb;
    const char* cA = Ab + PG8_ABASE(cur); const char* cB = Bb + PG8_BBASE(cur);
    PG8_STAGE(PG8_SB(0, 0), cB, voffB); PG8_STAGE(PG8_SB(0, 1), cB + hstepB, voffB); PG8_STAGE_A(PG8_SA(0, 0), cA, voA, 0); PG8_STAGE_A(PG8_SA(0, 1), cA, voA, 1);
    if (wr == 1) PG8_BAR;
    PG8_WAIT_V(2); PG8_BAR;
    PG8_STAGE(PG8_SB(1, 0), cB + kstep, voffB); PG8_STAGE_A(PG8_SA(1, 0), cA + kstep, voA, 0); PG8_STAGE(PG8_SB(1, 1), cB + hstepB + kstep, voffB);
    PG8_WAIT_V(6); PG8_BAR;
    for (;;) {
        const bool has_next = S.next(ui + 1, nxt);
        const char* nA = has_next ? Ab + PG8_ABASE(nxt) : cA; const char* nB = has_next ? Bb + PG8_BBASE(nxt) : cB;
#pragma unroll 1
        for (int t = 0; t < nt; t += 2) {
            const bool last = (t == nt - 2);
            const char* a1 = cA + (size_t)(t + 1) * kstep;
            const char* a2 = last ? nA : cA + (size_t)(t + 2) * kstep; const char* b2 = last ? nB : cB + (size_t)(t + 2) * kstep;
            const char* a3 = a2 + kstep; const char* b3 = b2 + kstep;
            PG8_LDB(B0, 0, 0); PG8_LDB(B1, 0, 1); PG8_SCHED; PG8_LDA(At, 0, 0); PG8_STAGE_A(PG8_SA(1, 1), a1, voA, 1);
            if constexpr (GATHER) { if (last && has_next) { a_offsets<GATHER, LDA>(g, nxt, Rr, Cb, voA); asm volatile("s_waitcnt vmcnt(0)" ::: "memory"); } }
            PG8_WAIT_V(8); PG8_WAIT_L(0); PG8_BAR; PG8_MMA(0, 0, At, B0); PG8_MMA(0, 1, At, B1); PG8_BAR; PG8_SCHED;
            PG8_LDA(At, 0, 1); PG8_STAGE(PG8_SB(0, 0), b2, voffB); PG8_STAGE(PG8_SB(0, 1), b2 + hstepB, voffB); PG8_STAGE_A(PG8_SA(0, 0), a2, voA, 0);
            PG8_WAIT_V(8); PG8_WAIT_L(0); PG8_BAR; PG8_MMA(1, 0, At, B0); PG8_MMA(1, 1, At, B1); PG8_BAR; PG8_SCHED;
            PG8_LDB(B0, 1, 0); PG8_LDB(B1, 1, 1); PG8_SCHED; PG8_LDA(At, 1, 0); PG8_STAGE_A(PG8_SA(0, 1), a2, voA, 1);
            PG8_WAIT_V(8); PG8_WAIT_L(0); PG8_BAR; PG8_MMA(0, 0, At, B0); PG8_MMA(0, 1, At, B1); PG8_BAR; PG8_SCHED;
            PG8_LDA(At, 1, 1); PG8_STAGE(PG8_SB(1, 0), b3, voffB); PG8_STAGE(PG8_SB(1, 1), b3 + hstepB, voffB); PG8_STAGE_A(PG8_SA(1, 0), a3, voA, 0);
            PG8_WAIT_V(8); PG8_WAIT_L(0); PG8_BAR; PG8_MMA(1, 0, At, B0); PG8_MMA(1, 1, At, B1); PG8_BAR; PG8_SCHED;
        }
        if constexpr (F8) { asm volatile("s_nop 15\n\ts_nop 15\n\ts_nop 15" ::: "memory"); }
        if constexpr (ALIGN_EPI) { if (wr == 0) PG8_BAR; }
        if constexpr (!Epi::AFTER_DRAIN) { E(acc, cur, wr, wc, fr, fq); }
        if (!has_next) break;
#pragma unroll
        for (int a = 0; a < 2; ++a)
#pragma unroll
            for (int b = 0; b < 2; ++b)
#pragma unroll
                for (int m = 0; m < 4; ++m)
#pragma unroll
                    for (int n = 0; n < 2; ++n) acc[a][b][m][n] = (f32x4){0.f, 0.f, 0.f, 0.f};
        cur = nxt; cA = nA; cB = nB; ++ui;
        if constexpr (ALIGN_EPI) { if (wr == 1) PG8_BAR; }
    }
    PG8_WAIT_V(0);
    if constexpr (!ALIGN_EPI) { if (wr == 0) PG8_BAR; }
    PG8_BAR;
    if constexpr (Epi::AFTER_DRAIN) { E.fused(acc, cur, wr, wc, fr, fq, lds, wid, lane); }
#undef PG8_SA
#undef PG8_SB
#undef PG8_STAGE
#undef PG8_LDA
#undef PG8_LDB
#undef PG8_MMA
#undef PG8_WAIT_V
#undef PG8_WAIT_L
#undef PG8_BAR
#undef PG8_SCHED
#undef PG8_STAGE_A
#undef PG8_ABASE
#undef PG8_BBASE
}
}
namespace pg8 {
typedef f32x4 AccT[2][2][4][2];

__device__ __forceinline__ u32x4 pack8(const f32x4 v0, const f32x4 v1) {
    u32x4 w; w.x = cvt_pk_bf16(v0[0], v0[1]); w.y = cvt_pk_bf16(v0[2], v0[3]); w.z = cvt_pk_bf16(v1[0], v1[1]); w.w = cvt_pk_bf16(v1[2], v1[3]); return w;
}
__device__ __forceinline__ void unpack8(const u32x4 w, f32x4& v0, f32x4& v1) {
    v0 = (f32x4){bflo(w.x), bfhi(w.x), bflo(w.y), bfhi(w.y)}; v1 = (f32x4){bflo(w.z), bfhi(w.z), bflo(w.w), bfhi(w.w)};
}

constexpr float MERGE_WSCALE = 16.0f;
constexpr float GATE_WSCALE = 64.0f, GATE_WINV = 1.0f / 64.0f;
struct EpiProj {
    static constexpr bool PERM = true, AFTER_DRAIN = false;
    bf16_t* O; LAS float* xch; float* ssq; const float* cs; bf16_t* KC; const float* gaq; const float* gak; int pn0;
    __device__ __forceinline__ void operator()(const AccT& acc, const Unit& u_, int wr, int wc, int fr, int fq) const {
        Unit u = u_; u.pn += pn0;
        const bool gate = u.pn >= 9;
        const float qs = (u.pn == 0 || u.pn == 3) ? 0.125f * LOG2E : 1.0f;
        const int row0 = u.pm * BM + wr * 64 + fr, col0 = u.pn * BM + wc * 32 + 8 * fq;
        if (gate) {
            int lx = fq * 16 + fr; asm volatile("" : "+v"(lx));
            unsigned char* gt = (unsigned char*)O + gate_off(u.pm, u.pn - 9, wr * 4 + wc, 0, lx);
#pragma unroll
            for (int ai = 0; ai < 2; ++ai)
#pragma unroll
                for (int m = 0; m < 4; ++m) { u32x4 w4;
#pragma unroll
                    for (int bj = 0; bj < 2; ++bj) { const f32x4 v0 = acc[ai][bj][m][0], v1 = acc[ai][bj][m][1]; unsigned q[8];
#pragma unroll
                        for (int j = 0; j < 4; ++j) {
                            q[j] = (unsigned)fmaxf(__builtin_amdgcn_rcpf(1.0f + __builtin_amdgcn_exp2f(v0[j] * GATE_WINV)) * 255.0f + 0.5f, 1.0f); q[4 + j] = (unsigned)fmaxf(__builtin_amdgcn_rcpf(1.0f + __builtin_amdgcn_exp2f(v1[j] * GATE_WINV)) * 255.0f + 0.5f, 1.0f); }
                        const unsigned lo = q[0] | (q[1] << 8) | (q[2] << 16) | (q[3] << 24), hi = q[4] | (q[5] << 8) | (q[6] << 16) | (q[7] << 24);
                        if (bj == 0) { w4.x = lo; w4.y = hi; } else { w4.z = lo; w4.w = hi; } }
                    *(GAS u32x4*)(gt + ai * 4096 + m * 16) = w4; }
        } else if (u.pn == 5 || u.pn == 6) {
            const bool isq = u.pn == 5;
            int frx = fr; asm volatile("" : "+v"(frx));
#pragma unroll
            for (int ai = 0; ai < 2; ++ai)
#pragma unroll
                for (int m = 0; m < 4; ++m)
#pragma unroll
                    for (int bj = 0; bj < 2; ++bj) { const f32x4 v0 = acc[ai][bj][m][0], v1 = acc[ai][bj][m][1];
                        float p = (v0[0] * v0[0] + v0[1] * v0[1]) + (v0[2] * v0[2] + v0[3] * v0[3]) + (v1[0] * v1[0] + v1[1] * v1[1]) + (v1[2] * v1[2] + v1[3] * v1[3]);
                        p += xshfl<16>(p); p += xshfl<32>(p);
                        if (fq == 0 && (isq || bj == 0)) xch[(ai * HALF + wr * 64 + m * 16 + frx) * 8 + 4 * bj + wc] = p; }
            asm volatile("s_waitcnt lgkmcnt(0)\n\ts_barrier" ::: "memory");
#pragma unroll
            for (int ai = 0; ai < 2; ++ai)
#pragma unroll
                for (int m = 0; m < 4; ++m) { const int rl = ai * HALF + wr * 64 + m * 16 + frx, row = u.pm * BM + rl; const int pos = row & (SEQ - 1);
                    bf16_t* rowp = O + (size_t)row * LDP + col0;
#pragma unroll
                    for (int bj = 0; bj < 2; ++bj) { f32x4 v0 = acc[ai][bj][m][0], v1 = acc[ai][bj][m][1];
                        if (isq || bj == 0) {
                            const f32x2 pr_ = *(const LAS f32x2*)(xch + rl * 8 + ((4 * bj + wc) & ~1)); const float tot = pr_.x + pr_.y;
                            const float rstd = rsqrtf(tot * (1.0f / 64.0f) + EPS) * (isq ? 0.125f * LOG2E : 1.0f);
                            const int hf = wc & 1;
                            const float* G = (isq ? gaq : gak) + 32 * hf + 4 * fq;
                            { const f32x4 g0 = *(const GAS f32x4*)G; v0 = v0 * rstd * g0; }
                            { const f32x4 g1 = *(const GAS f32x4*)(G + 16); v1 = v1 * rstd * g1; }
                            const int idx = hf ? (pos & 63) : (pos >> 6);
                            const f32x4 c4 = *(const GAS f32x4*)(cs + idx * 16 + 4 * fq), s4 = *(const GAS f32x4*)(cs + SEQ * 16 + idx * 16 + 4 * fq);
                            const f32x4 o0 = v0 * c4 - v1 * s4, o1 = v0 * s4 + v1 * c4; v0 = o0; v1 = o1; }
                        *(GAS u32x4*)(rowp + bj * HALF) = pack8(v0, v1);
                        asm volatile("" ::: "memory"); }
                    asm volatile("" ::: "memory"); }
        } else if (u.pn == 7 || u.pn == 8) {
#pragma unroll
            for (int ai = 0; ai < 2; ++ai)
#pragma unroll
                for (int m = 0; m < 4; ++m) { const int row = row0 + ai * HALF + m * 16; bf16_t* rowp = O + (size_t)row * LDP + col0;
#pragma unroll
                    for (int bj = 0; bj < 2; ++bj) { const f32x4 v0 = acc[ai][bj][m][0], v1 = acc[ai][bj][m][1];
                        *(GAS u32x4*)(rowp + bj * HALF) = pack8(v0, v1);
                        const int lc = 128 * bj + 32 * wc;
                        const int grp = lc >> 5;
                        const int slot = (u.pn == 7) ? (grp < 6 ? grp : 8 + (grp - 6)) : (grp < 6 ? 10 + grp : -1);
                        if (slot >= 0) {
                            float p = (v0[0] * v0[0] + v0[1] * v0[1]) + (v0[2] * v0[2] + v0[3] * v0[3]) + (v1[0] * v1[0] + v1[1] * v1[1]) + (v1[2] * v1[2] + v1[3] * v1[3]);
                            p += xshfl<16>(p); p += xshfl<32>(p);
                            if (fq == 0) ssq[(size_t)row * 16 + slot] = p;
                        } else if (lc == 192) {
                            const int pos = row & (SEQ - 1);
                            const f32x4 c4 = *(const GAS f32x4*)(cs + pos * 16 + 4 * fq), s4 = *(const GAS f32x4*)(cs + SEQ * 16 + pos * 16 + 4 * fq);
                            const u32x4 w = pack8(v0 * c4 - v1 * s4, v0 * s4 + v1 * c4);
                            bf16_t* kr = KC + (size_t)row * 384 + 64 + 8 * fq;
#pragma unroll
                            for (int h = 0; h < 4; ++h) *(GAS u32x4*)(kr + 96 * h) = w;
                        } } }
        } else {
#pragma unroll
            for (int ai = 0; ai < 2; ++ai)
#pragma unroll
                for (int m = 0; m < 4; ++m) { bf16_t* rowp = O + (size_t)(row0 + ai * HALF + m * 16) * LDP + col0;
#pragma unroll
                    for (int bj = 0; bj < 2; ++bj) *(GAS u32x4*)(rowp + bj * HALF) = pack8(acc[ai][bj][m][0] * qs, acc[ai][bj][m][1] * qs); }
        }
    }
};

struct EpiNone {
    static constexpr bool PERM = true, AFTER_DRAIN = false;
    float* sink;
    __device__ __forceinline__ void operator()(const AccT& acc, const Unit& u, int wr, int wc, int fr, int fq) const {
        float s = 0.f;
#pragma unroll
        for (int ai = 0; ai < 2; ++ai)
#pragma unroll
            for (int bj = 0; bj < 2; ++bj)
#pragma unroll
                for (int m = 0; m < 4; ++m) s += acc[ai][bj][m][0][0] + acc[ai][bj][m][1][3];
        if (s == 1.2345e30f) sink[0] = s;
    }
};

struct EpiQup {
    static constexpr bool PERM = true, AFTER_DRAIN = false;
    bf16_t* QC; const float* cs; const float* ssq;
    __device__ __forceinline__ void operator()(const AccT& acc, const Unit& u, int wr, int wc, int fr, int fq) const {
        const int row0 = u.pm * BM + wr * 64 + fr;
#pragma unroll
        for (int bj = 0; bj < 2; ++bj) {
            const int gi = 8 * u.pn + 4 * bj + wc;
            if (gi >= 12) continue;
            const bool rope = (gi % 3) == 2;
            const int col = 32 * gi + 8 * fq;
#pragma unroll
            for (int ai = 0; ai < 2; ++ai)
#pragma unroll
                for (int m = 0; m < 4; ++m) { const int row = row0 + ai * HALF + m * 16; const f32x4 sa_ = *(const GAS f32x4*)(ssq + (size_t)row * 16); const f32x2 sb_ = *(const GAS f32x2*)(ssq + (size_t)row * 16 + 4);
                    const float rs_ = rsqrtf((((sa_[0] + sa_[1]) + (sa_[2] + sa_[3])) + (sb_[0] + sb_[1])) * (1.0f / 192.0f) + EPS) * (0.10206207261596575f * LOG2E);
                    f32x4 v0 = acc[ai][bj][m][0] * rs_, v1 = acc[ai][bj][m][1] * rs_;
                    if (rope) { const int pos = row & (SEQ - 1);
                        const f32x4 c4 = *(const GAS f32x4*)(cs + pos * 16 + 4 * fq), s4 = *(const GAS f32x4*)(cs + SEQ * 16 + pos * 16 + 4 * fq);
                        const f32x4 o1 = v0 * c4 - v1 * s4, o2 = v0 * s4 + v1 * c4; v0 = o1; v1 = o2; }
                    *(GAS u32x4*)(QC + (size_t)row * 384 + col) = pack8(v0, v1); asm volatile("" ::: "memory"); }
        }
    }
};

struct EpiKVup {
    static constexpr bool PERM = true, AFTER_DRAIN = false;
    bf16_t* KC; bf16_t* VC; const float* ssq;
    __device__ __forceinline__ void operator()(const AccT& acc, const Unit& u, int wr, int wc, int fr, int fq) const {
        const int row0 = u.pm * BM + wr * 64 + fr;
#pragma unroll
        for (int bj = 0; bj < 2; ++bj) {
            const int col = 128 * bj + 32 * wc + 8 * fq;
            bf16_t* base = (u.pn == 0) ? KC : VC; const int ld = (u.pn == 0) ? 384 : 256; const int coff = (u.pn == 0) ? (96 * (col >> 6) + (col & 63)) : col;
#pragma unroll
            for (int ai = 0; ai < 2; ++ai)
#pragma unroll
                for (int m = 0; m < 4; ++m) { const int row = row0 + ai * HALF + m * 16;
                    const f32x4 sa_ = *(const GAS f32x4*)(ssq + (size_t)row * 16 + 8), sb_ = *(const GAS f32x4*)(ssq + (size_t)row * 16 + 12);
                    const float rs_ = rsqrtf((((sa_[0] + sa_[1]) + (sa_[2] + sa_[3])) + ((sb_[0] + sb_[1]) + (sb_[2] + sb_[3]))) * (1.0f / 256.0f) + EPS);
                    *(GAS u32x4*)(base + (size_t)row * ld + coff) = pack8(acc[ai][bj][m][0] * rs_, acc[ai][bj][m][1] * rs_); }
        }
    }
};

struct EpiMerge {
    static constexpr bool PERM = true, AFTER_DRAIN = false;
    const bf16_t* P; bf16_t* HB;
    __device__ __forceinline__ void operator()(const AccT& acc, const Unit& u, int wr, int wc, int fr, int fq) const {
        const int row0 = u.pm * BM + wr * 64 + fr, col0 = u.pn * BM + wc * 32 + 8 * fq, n = u.e;
#pragma unroll
        for (int ai = 0; ai < 2; ++ai) {
            u32x2 gw[4][2]; u32x4 ow[4][2];
#pragma unroll
            for (int m = 0; m < 4; ++m)
#pragma unroll
                for (int bj = 0; bj < 2; ++bj) { const int row = row0 + ai * HALF + m * 16, col = col0 + bj * HALF;
                    gw[m][bj] = *(const GAS u32x2*)((const unsigned char*)(P + (size_t)row * LDP + PC_GATE) + 1024 * n + col);
                    if (n > 0) ow[m][bj] = *(const GAS u32x4*)(HB + (size_t)row * DM + col); else ow[m][bj] = (u32x4){0u, 0u, 0u, 0u}; }
#pragma unroll
            for (int m = 0; m < 4; ++m)
#pragma unroll
                for (int bj = 0; bj < 2; ++bj) { const int row = row0 + ai * HALF + m * 16, col = col0 + bj * HALF;
                    const unsigned ga = gw[m][bj].x, gb = gw[m][bj].y; constexpr float K = 1.0f / 255.0f;
                    const f32x4 g0 = (f32x4){(float)(ga & 0xffu), (float)((ga >> 8) & 0xffu), (float)((ga >> 16) & 0xffu), (float)(ga >> 24)} * K;
                    const f32x4 g1 = (f32x4){(float)(gb & 0xffu), (float)((gb >> 8) & 0xffu), (float)((gb >> 16) & 0xffu), (float)(gb >> 24)} * K;
                    f32x4 o0, o1; unpack8(ow[m][bj], o0, o1);
                    const f32x4 v0 = g0 * acc[ai][bj][m][0] + o0, v1 = g1 * acc[ai][bj][m][1] + o1;
                    *(GAS u32x4*)(HB + (size_t)row * DM + col) = pack8(v0, v1); }
            asm volatile("" ::: "memory");
        }
    }
};

struct EpiOut {
    static constexpr bool PERM = false, AFTER_DRAIN = false;
    const float* base; float* out; const float* gvec;
    __device__ __forceinline__ void operator()(const AccT& acc, const Unit& u, int wr, int wc, int fr, int fq) const {
        const int b = u.pm >> 4;
        const int row0 = u.pm * BM + wr * 64 + fr, col0 = u.pn * BM + wc * 32 + 4 * fq;
#pragma unroll
        for (int bj = 0; bj < 2; ++bj)
#pragma unroll
            for (int n = 0; n < 2; ++n) {
                const int col = col0 + bj * HALF + n * 16; const f32x4 gv = *(const GAS f32x4*)(gvec + b * 6144 + col);
                f32x4 bs[2][4];
#pragma unroll
                for (int ai = 0; ai < 2; ++ai)
#pragma unroll
                    for (int m = 0; m < 4; ++m) bs[ai][m] = *(const GAS f32x4*)(base + (size_t)(row0 + ai * HALF + m * 16) * DM + col);
#pragma unroll
                for (int ai = 0; ai < 2; ++ai)
#pragma unroll
                    for (int m = 0; m < 4; ++m) *(GAS f32x4*)(out + (size_t)(row0 + ai * HALF + m * 16) * DM + col) = bs[ai][m] + gv * acc[ai][bj][m][n];
                asm volatile("" ::: "memory");
            }
    }
};

struct EpiResid {
    static constexpr bool PERM = true, AFTER_DRAIN = false;
    const float* xf; bf16_t* XBo; const float* gvec;
    __device__ __forceinline__ void operator()(const AccT& acc, const Unit& u, int wr, int wc, int fr, int fq) const {
        const int b = u.pm >> 4;
        const int row0 = u.pm * BM + wr * 64 + fr, col0 = u.pn * BM + wc * 32 + 8 * fq;
#pragma unroll
        for (int bj = 0; bj < 2; ++bj) { const int col = col0 + bj * HALF;
            const f32x4 g0 = *(const GAS f32x4*)(gvec + b * 6144 + col), g1 = *(const GAS f32x4*)(gvec + b * 6144 + col + 4);
#pragma unroll
            for (int ai = 0; ai < 2; ++ai) {
                f32x4 x0[4], x1[4];
                if (xf) {
#pragma unroll
                    for (int m = 0; m < 4; ++m) { const size_t off = (size_t)(row0 + ai * HALF + m * 16) * DM + col; x0[m] = *(const GAS f32x4*)(xf + off); x1[m] = *(const GAS f32x4*)(xf + off + 4); }
                } else {
                    u32x4 xw[4];
#pragma unroll
                    for (int m = 0; m < 4; ++m) xw[m] = *(const GAS u32x4*)(XBo + (size_t)(row0 + ai * HALF + m * 16) * DM + col);
#pragma unroll
                    for (int m = 0; m < 4; ++m) unpack8(xw[m], x0[m], x1[m]);
                }
#pragma unroll
                for (int m = 0; m < 4; ++m) *(GAS u32x4*)(XBo + (size_t)(row0 + ai * HALF + m * 16) * DM + col) = pack8(x0[m] + acc[ai][bj][m][0] * g0, x1[m] + acc[ai][bj][m][1] * g1);
                asm volatile("" ::: "memory"); } }
    }
};

struct EpiRoute {
    static constexpr bool PERM = true, AFTER_DRAIN = true;
    const float* bg; const float* br; unsigned* ecnt; int* list; int* tok_es; float* tok_w;
    __device__ __forceinline__ void fused(const AccT& acc, const Unit& u, int wr, int wc, int fr, int fq, LAS unsigned char* lds, int wid, int lane) const {
        LAS float* LG = (LAS float*)lds;
        LAS unsigned* lcnt = (LAS unsigned*)(lds + 256 * 40 * 4);
        LAS unsigned* lbase = lcnt + 32;
        int tid = wid * 64 + lane; asm volatile("" : "+v"(tid));
        if (wc < 2) {
#pragma unroll
            for (int ai = 0; ai < 2; ++ai)
#pragma unroll
                for (int m = 0; m < 4; ++m) { const int rl = ai * HALF + wr * 64 + m * 16 + fr; const f32x4 v0 = acc[ai][0][m][0], v1 = acc[ai][0][m][1];
                    if (wc == 0) { *(LAS f32x4*)(LG + rl * 40 + 8 * fq) = v0; *(LAS f32x4*)(LG + rl * 40 + 8 * fq + 4) = v1; }
                    else if (fq == 0) { *(LAS f32x4*)(LG + rl * 40 + 32) = v0; } }
        }
        if (tid < 32) lcnt[tid] = 0u;
        __syncthreads();
        int e1 = 0, e2 = 0; unsigned r1 = 0, r2 = 0; float w1 = 0.f, w2 = 0.f;
        if (tid < 256) {
            const LAS float* lg = LG + tid * 40;
            float g[4];
#pragma unroll
            for (int j = 0; j < 4; ++j) g[j] = lg[j] + bg[j];
            int gs = 0; float gm = g[0];
#pragma unroll
            for (int j = 1; j < 4; ++j) if (g[j] > gm) { gm = g[j]; gs = j; }
            float gsum = 0.f;
#pragma unroll
            for (int j = 0; j < 4; ++j) gsum += __expf(g[j] - gm);
            const float gw = 1.0f / gsum;
            float el[8];
#pragma unroll
            for (int j = 0; j < 8; ++j) el[j] = lg[4 + 8 * gs + j] + br[8 * gs + j];
            int i1 = 0; float m1 = el[0];
#pragma unroll
            for (int j = 1; j < 8; ++j) if (el[j] > m1) { m1 = el[j]; i1 = j; }
            int i2 = -1; float m2 = 0.f;
#pragma unroll
            for (int j = 0; j < 8; ++j) if (j != i1 && (i2 < 0 || el[j] > m2)) { m2 = el[j]; i2 = j; }
            const float t = __expf(m2 - m1);
            w1 = gw / (1.0f + t); w2 = gw * t / (1.0f + t);
            e1 = 8 * gs + i1; e2 = 8 * gs + i2;
            r1 = atomicAdd((unsigned*)(lcnt + e1), 1u); r2 = atomicAdd((unsigned*)(lcnt + e2), 1u);
        }
        __syncthreads();
        if (tid < 32) lbase[tid] = __hip_atomic_fetch_add(ecnt + tid, lcnt[tid], __ATOMIC_RELAXED, __HIP_MEMORY_SCOPE_AGENT);
        __syncthreads();
        if (tid < 256) {
            const int token = u.pm * BM + tid;
            const int s1 = (int)(lbase[e1] + r1), s2 = (int)(lbase[e2] + r2);
            list[e1 * LISTCAP + s1] = token; list[e2 * LISTCAP + s2] = token;
            tok_es[2 * token] = (e1 << 16) | s1; tok_es[2 * token + 1] = (e2 << 16) | s2;
            tok_w[2 * token] = w1; tok_w[2 * token + 1] = w2;
        }
    }
};

struct EpiExp1 {
    static constexpr bool PERM = true, AFTER_DRAIN = false;
    bf16_t* HS;
    __device__ __forceinline__ void operator()(const AccT& acc, const Unit& u, int wr, int wc, int fr, int fq) const {
        const int row0 = u.pm * BM + wr * 64 + fr;
#pragma unroll
        for (int ai = 0; ai < 2; ++ai)
#pragma unroll
            for (int m = 0; m < 4; ++m) { bf16_t* rowp = HS + (size_t)(row0 + ai * HALF + m * 16) * 256;
#pragma unroll
                for (int bj = 0; bj < 2; ++bj) { const f32x4 a = acc[ai][bj][m][0], b = acc[ai][bj][m][1]; float h[4];
#pragma unroll
                    for (int j = 0; j < 4; ++j) h[j] = a[j] * fast_sigmoid(a[j]) * b[j];
                    u32x2 w; w.x = cvt_pk_bf16(h[0], h[1]); w.y = cvt_pk_bf16(h[2], h[3]);
                    *(GAS u32x2*)(rowp + u.pn * 128 + 64 * bj + 16 * wc + 4 * fq) = w; } }
    }
};

struct EpiStore {
    static constexpr bool PERM = true, AFTER_DRAIN = false;
    bf16_t* O; int ldc;
    __device__ __forceinline__ void operator()(const AccT& acc, const Unit& u, int wr, int wc, int fr, int fq) const {
        const int row0 = u.pm * BM + wr * 64 + fr, col0 = u.pn * BM + wc * 32 + 8 * fq;
#pragma unroll
        for (int ai = 0; ai < 2; ++ai)
#pragma unroll
            for (int m = 0; m < 4; ++m) { bf16_t* rowp = O + (size_t)(row0 + ai * HALF + m * 16) * ldc + col0;
#pragma unroll
                for (int bj = 0; bj < 2; ++bj) *(GAS u32x4*)(rowp + bj * HALF) = pack8(acc[ai][bj][m][0], acc[ai][bj][m][1]); }
    }
};

struct MergeOrder {
    int G, vc;
    __device__ bool next(int i, Unit& u) const {
        const int tile = vc + G * (i >> 2); if (tile >= (MTOK / BM) * (DM / BM)) return false;
        u.pm = tile >> 2; u.pn = tile & 3; u.e = i & 3; u.lbase = 0; u.nv = 256;
        u.acol = (u.e == 0) ? PC_NAQ : (u.e == 1) ? PC_WQ : (u.e == 2) ? PC_YC : PC_AXQ;
        return true;
    }
};

struct MoeOrder {
    int G, c, sh; const LAS int* tend; const LAS int* cnt;
    __device__ bool next(int i, Unit& u) const {
        const int L = i * G + c, tau = L >> sh;
        const int total = __builtin_amdgcn_readfirstlane(tend[NEXP - 1]);
        if (tau >= total) return false;
        int e = 0;
        while (e < NEXP - 1 && __builtin_amdgcn_readfirstlane(tend[e]) <= tau) ++e;
        const int ts = e ? __builtin_amdgcn_readfirstlane(tend[e - 1]) : 0, lt = tau - ts;
        int nv = __builtin_amdgcn_readfirstlane(cnt[e]) - 256 * lt; nv = nv > 256 ? 256 : nv;
        u.pm = tau; u.pn = L & ((1 << sh) - 1); u.e = e; u.acol = 0; u.lbase = e * LISTCAP + 256 * lt; u.nv = nv;
        return true;
    }
};
}
namespace pg8 {
struct MUnit { int pm, pn; };
__device__ __forceinline__ void merge_phase(LAS unsigned char* lds, const bf16_t* Pp, const bf16_t* Wbt, bf16_t* HBo, int G, int vc, int tid) {
    asm volatile("" : "+v"(tid));
    const int wid = __builtin_amdgcn_readfirstlane(tid >> 6), lane = tid & 63, wr = wid >> 2, wc = wid & 3, fr = lane & 15, fq = lane >> 4;
    constexpr int nt = 16, NU = (MTOK / 128) * (DM / 256);
    unsigned voffA[2], voffB[2];
#pragma unroll
    for (int i = 0; i < 2; ++i) { int R, C; stage_rc(tid * 16 + i * 8192, R, C); const int Rb = (R & ~31) + perm32(R & 31);
        voffA[i] = (unsigned)(R * LDP + C) * 2u; voffB[i] = (unsigned)(Rb * 256 + C) * 2u; }
    const unsigned ldsw = (unsigned)wid * 1024u;
    const int aoff = lds_byte(wr * 64 + fr, fq * 8), boff = lds_byte(wc * 32 + fr, fq * 8);
#define MG_SA(b) (((b) * 2) * HTB)
#define MG_SB(b, h) ((4 + (b) * 2 + (h)) * HTB)
#define MG_STAGE(bufoff, gbase, voff) do { _Pragma("unroll") for (int _i = 0; _i < 2; ++_i) \
        __builtin_amdgcn_global_load_lds((const unsigned*)((const char*)(gbase) + (voff)[_i]), (LAS unsigned*)(lds + (bufoff) + ldsw + _i * 8192), 16, 0, 0); } while (0)
#define MG_LDA(dst, b) do { _Pragma("unroll") for (int m = 0; m < 4; ++m) _Pragma("unroll") for (int k = 0; k < 2; ++k) dst[m][k] = *(const LAS bf16x8*)(lds + MG_SA(b) + aoff + m * 2048 + k * 1024); } while (0)
#define MG_LDB(dst, b, h) do { _Pragma("unroll") for (int n = 0; n < 2; ++n) _Pragma("unroll") for (int k = 0; k < 2; ++k) dst[n][k] = *(const LAS bf16x8*)(lds + MG_SB(b, h) + boff + n * 2048 + k * 1024); } while (0)
#define MG_MMA(bj, At, Bt) do { __builtin_amdgcn_s_setprio(1); _Pragma("unroll") for (int m = 0; m < 4; ++m) _Pragma("unroll") for (int n = 0; n < 2; ++n) _Pragma("unroll") for (int k = 0; k < 2; ++k) \
        acc[bj][m][n] = __builtin_amdgcn_mfma_f32_16x16x32_bf16(Bt[n][k], At[m][k], acc[bj][m][n], 0, 0, 0); __builtin_amdgcn_s_setprio(0); } while (0)
#define MG_WAIT_V(n) asm volatile("s_waitcnt vmcnt(" #n ")" ::: "memory")
#define MG_WAIT_L(n) asm volatile("s_waitcnt lgkmcnt(" #n ")" ::: "memory")
#define MG_BAR __builtin_amdgcn_s_barrier()
#define MG_SCHED __builtin_amdgcn_sched_barrier(0)
    const char* Ab = (const char*)Pp; const char* Bb = (const char*)Wbt; asm volatile("" : "+s"(Ab), "+s"(Bb)); Ab = (const char*)(const GAS char*)Ab; Bb = (const char*)(const GAS char*)Bb;
#define MG_ACOL(n) ((n) == 0 ? PC_NAQ : (n) == 1 ? PC_WQ : (n) == 2 ? PC_YC : PC_AXQ)
#define MG_A(u, kt) (Ab + ((size_t)(u).pm * 128 * LDP + MG_ACOL((kt) >> 2) + ((kt) & 3) * 64) * 2)
#define MG_B(u, kt) (Bb + ((size_t)(((kt) >> 2) * DM + (u).pn * 256) * 256 + ((kt) & 3) * 64) * 2)
    constexpr size_t hstepB = (size_t)HALF * 256 * 2, kstep = 128;
    MUnit cur, nxt; int ui = 0;
    { const int idx = vc; if (idx >= NU) return; cur.pm = idx >> 2; cur.pn = idx & 3; }
    f32x4 acc[2][4][2], sum[2][4][2];
#pragma unroll
    for (int b = 0; b < 2; ++b)
#pragma unroll
        for (int m = 0; m < 4; ++m)
#pragma unroll
            for (int n = 0; n < 2; ++n) { acc[b][m][n] = (f32x4){0.f, 0.f, 0.f, 0.f}; sum[b][m][n] = (f32x4){0.f, 0.f, 0.f, 0.f}; }
    bf16x8 At[4][2], B0[2][2], B1[2][2];
    u32x2 gw[4][2];
#pragma unroll
    for (int m = 0; m < 4; ++m) { gw[m][0] = (u32x2){0u, 0u}; gw[m][1] = (u32x2){0u, 0u}; }
    { const char* b0_ = MG_B(cur, 0); MG_STAGE(MG_SB(0, 0), b0_, voffB); MG_STAGE(MG_SB(0, 1), b0_ + hstepB, voffB); MG_STAGE(MG_SA(0), MG_A(cur, 0), voffA); }
    if (wr == 1) MG_BAR;
    MG_WAIT_V(0); MG_BAR;
    { const char* b1_ = MG_B(cur, 1); MG_STAGE(MG_SB(1, 0), b1_, voffB); MG_STAGE(MG_SA(1), MG_A(cur, 1), voffA); MG_STAGE(MG_SB(1, 1), b1_ + hstepB, voffB); }
    MG_WAIT_V(6); MG_BAR;
    for (;;) {
        bool has_next; { const int idx = vc + G * (ui + 1); has_next = idx < NU; nxt.pm = idx >> 2; nxt.pn = idx & 3; }
#pragma unroll 1
        for (int t = 0; t < nt; t += 2) {
            const bool last = (t == nt - 2);
            const char* a2 = last ? (has_next ? MG_A(nxt, 0) : MG_A(cur, 0)) : MG_A(cur, t + 2);
            const char* b2 = last ? (has_next ? MG_B(nxt, 0) : MG_B(cur, 0)) : MG_B(cur, t + 2);
            const char* a3 = a2 + kstep; const char* b3 = b2 + kstep;
            if ((t & 3) == 0) {
                const int n = t >> 2; int lx = lane; asm volatile("" : "+v"(lx));
                const unsigned char* gp = (const unsigned char*)Pp + gate_off(cur.pm >> 1, 4 * n + cur.pn, wid, cur.pm & 1, lx);
#pragma unroll
                for (int m = 0; m < 4; ++m) { const u32x4 w4 = *(const GAS u32x4*)(gp + m * 16); gw[m][0] = (u32x2){w4.x, w4.y}; gw[m][1] = (u32x2){w4.z, w4.w}; }
            }
            MG_LDB(B0, 0, 0); MG_LDB(B1, 0, 1); MG_SCHED; MG_LDA(At, 0);
            MG_WAIT_L(0); MG_BAR; MG_MMA(0, At, B0); MG_MMA(1, At, B1); MG_BAR; MG_SCHED;
            MG_STAGE(MG_SB(0, 0), b2, voffB); MG_STAGE(MG_SB(0, 1), b2 + hstepB, voffB); MG_STAGE(MG_SA(0), a2, voffA);
            if ((t & 3) == 0) MG_WAIT_V(10); else MG_WAIT_V(6);
            MG_WAIT_L(0); MG_BAR; MG_BAR; MG_SCHED;
            MG_LDB(B0, 1, 0); MG_LDB(B1, 1, 1); MG_SCHED; MG_LDA(At, 1);
            MG_WAIT_L(0); MG_BAR; MG_MMA(0, At, B0); MG_MMA(1, At, B1); MG_BAR; MG_SCHED;
            if ((t & 3) == 2) {
#pragma unroll
                for (int m = 0; m < 4; ++m)
#pragma unroll
                    for (int bj = 0; bj < 2; ++bj) { const unsigned ga = gw[m][bj].x, gb = gw[m][bj].y; constexpr float Kq = 1.0f / 255.0f;
                        const f32x4 g0 = (f32x4){(float)(ga & 0xffu), (float)((ga >> 8) & 0xffu), (float)((ga >> 16) & 0xffu), (float)(ga >> 24)} * Kq;
                        const f32x4 g1 = (f32x4){(float)(gb & 0xffu), (float)((gb >> 8) & 0xffu), (float)((gb >> 16) & 0xffu), (float)(gb >> 24)} * Kq;
                        sum[bj][m][0] += g0 * acc[bj][m][0]; sum[bj][m][1] += g1 * acc[bj][m][1];
                        acc[bj][m][0] = (f32x4){0.f, 0.f, 0.f, 0.f}; acc[bj][m][1] = (f32x4){0.f, 0.f, 0.f, 0.f}; }
                asm volatile("" ::: "memory");
            }
            MG_STAGE(MG_SB(1, 0), b3, voffB); MG_STAGE(MG_SB(1, 1), b3 + hstepB, voffB); MG_STAGE(MG_SA(1), a3, voffA);
            MG_WAIT_V(6); MG_WAIT_L(0); MG_BAR; MG_BAR; MG_SCHED;
        }
        if (wr == 0) MG_BAR;
        { const int row0 = cur.pm * 128 + wr * 64 + fr, col0 = cur.pn * 256 + wc * 32 + 8 * fq;
#pragma unroll
          for (int m = 0; m < 4; ++m)
#pragma unroll
              for (int bj = 0; bj < 2; ++bj) { *(GAS u32x4*)(HBo + (size_t)(row0 + m * 16) * DM + col0 + bj * HALF) = pack8(sum[bj][m][0], sum[bj][m][1]);
                  sum[bj][m][0] = (f32x4){0.f, 0.f, 0.f, 0.f}; sum[bj][m][1] = (f32x4){0.f, 0.f, 0.f, 0.f}; } }
        if (!has_next) break;
        cur = nxt; ++ui;
        if (wr == 1) MG_BAR;
    }
    MG_WAIT_V(0);
    MG_BAR;
#undef MG_SA
#undef MG_SB
#undef MG_STAGE
#undef MG_LDA
#undef MG_LDB
#undef MG_MMA
#undef MG_WAIT_V
#undef MG_WAIT_L
#undef MG_BAR
#undef MG_SCHED
#undef MG_ACOL
#undef MG_A
#undef MG_B
}
}

namespace pg8 {
__device__ __forceinline__ f32x4 gate_q4(unsigned w) {
    f32x4 q = (f32x4){(float)(w & 0xffu), (float)((w >> 8) & 0xffu), (float)((w >> 16) & 0xffu), (float)(w >> 24)};
    return q;
}
__device__ __forceinline__ f32x4 rcp4(f32x4 v) { return (f32x4){__builtin_amdgcn_rcpf(v[0]), __builtin_amdgcn_rcpf(v[1]), __builtin_amdgcn_rcpf(v[2]), __builtin_amdgcn_rcpf(v[3])}; }
__device__ __forceinline__ void merge_phase2(LAS unsigned char* lds, const bf16_t* Pp, const bf16_t* Wbt, bf16_t* HBo, int G, int vc, int tid) {
    asm volatile("" : "+v"(tid));
    const int wid = __builtin_amdgcn_readfirstlane(tid >> 6), lane = tid & 63, wr = wid >> 2, wc = wid & 3, fr = lane & 15, fq = lane >> 4;
    constexpr int nt = 16, NU = (MTOK / 256) * (DM / 256);
    unsigned voffA[2], voffB[2];
#pragma unroll
    for (int i = 0; i < 2; ++i) { int R, C; stage_rc(tid * 16 + i * 8192, R, C); const int Rb = (R & ~31) + perm32(R & 31);
        voffA[i] = (unsigned)(R * LDP + C) * 2u; voffB[i] = (unsigned)(Rb * 256 + C) * 2u; }
    const unsigned ldsw = (unsigned)wid * 1024u;
    const int aoff = lds_byte(wr * 64 + fr, fq * 8), boff = lds_byte(wc * 32 + fr, fq * 8);
#define M2_SA(b, h) (((b) * 2 + (h)) * HTB)
#define M2_SB(b, h) ((4 + (b) * 2 + (h)) * HTB)
#define M2_STAGE(bufoff, gbase, voff) do { _Pragma("unroll") for (int _i = 0; _i < 2; ++_i) \
        __builtin_amdgcn_global_load_lds((const unsigned*)((const char*)(gbase) + (voff)[_i]), (LAS unsigned*)(lds + (bufoff) + ldsw + _i * 8192), 16, 0, 0); } while (0)
#define M2_LDA(dst, b, h) do { _Pragma("unroll") for (int m = 0; m < 4; ++m) _Pragma("unroll") for (int k = 0; k < 2; ++k) dst[m][k] = *(const LAS bf16x8*)(lds + M2_SA(b, h) + aoff + m * 2048 + k * 1024); } while (0)
#define M2_LDB(dst, b, h) do { _Pragma("unroll") for (int n = 0; n < 2; ++n) _Pragma("unroll") for (int k = 0; k < 2; ++k) dst[n][k] = *(const LAS bf16x8*)(lds + M2_SB(b, h) + boff + n * 2048 + k * 1024); } while (0)
#define M2_MMA(ai, bj, At, Bt) do { __builtin_amdgcn_s_setprio(1); _Pragma("unroll") for (int m = 0; m < 4; ++m) _Pragma("unroll") for (int n = 0; n < 2; ++n) _Pragma("unroll") for (int k = 0; k < 2; ++k) \
        acc[ai][bj][m][n] = __builtin_amdgcn_mfma_f32_16x16x32_bf16(Bt[n][k], At[m][k], acc[ai][bj][m][n], 0, 0, 0); __builtin_amdgcn_s_setprio(0); } while (0)
#define M2_WAIT_V(n) asm volatile("s_waitcnt vmcnt(" #n ")" ::: "memory")
#define M2_WAIT_L(n) asm volatile("s_waitcnt lgkmcnt(" #n ")" ::: "memory")
#define M2_BAR __builtin_amdgcn_s_barrier()
#define M2_SCHED __builtin_amdgcn_sched_barrier(0)
    const char* Ab = (const char*)Pp; const char* Bb = (const char*)Wbt; asm volatile("" : "+s"(Ab), "+s"(Bb)); Ab = (const char*)(const GAS char*)Ab; Bb = (const char*)(const GAS char*)Bb;
#define M2_ACOL(n) ((n) == 0 ? PC_NAQ : (n) == 1 ? PC_WQ : (n) == 2 ? PC_YC : PC_AXQ)
#define M2_A(u, kt) (Ab + ((size_t)(u).pm * 256 * LDP + M2_ACOL((kt) >> 2) + ((kt) & 3) * 64) * 2)
#define M2_B(u, kt) (Bb + ((size_t)(((kt) >> 2) * DM + (u).pn * 256) * 256 + ((kt) & 3) * 64) * 2)
    constexpr size_t hstepB = (size_t)HALF * 256 * 2, hstepA = (size_t)HALF * LDP * 2, kstep = 128;
    MUnit cur, nxt; int ui = 0;
    { const int idx = vc; if (idx >= NU) return; cur.pm = idx >> 2; cur.pn = idx & 3; }
    f32x4 acc[2][2][4][2];
#pragma unroll
    for (int a = 0; a < 2; ++a)
#pragma unroll
        for (int b = 0; b < 2; ++b)
#pragma unroll
            for (int m = 0; m < 4; ++m)
#pragma unroll
                for (int n = 0; n < 2; ++n) acc[a][b][m][n] = (f32x4){0.f, 0.f, 0.f, 0.f};
    bf16x8 At[4][2], B0[2][2], B1[2][2];
    u32x2 ga[4][2], gb[4][2];
#pragma unroll
    for (int m = 0; m < 4; ++m) { ga[m][0] = (u32x2){0u, 0u}; ga[m][1] = ga[m][0]; gb[m][0] = ga[m][0]; gb[m][1] = ga[m][0]; }
#define M2_GLOAD(ai, n) do { int lx = lane; asm volatile("" : "+v"(lx)); const unsigned char* gp = (const unsigned char*)Pp + gate_off(cur.pm, 4 * (n) + cur.pn, wid, (ai), lx); \
        _Pragma("unroll") for (int m = 0; m < 4; ++m) { const u32x4 wa = *(const GAS u32x4*)(gp + m * 16), wb_ = *(const GAS u32x4*)(gp + 4 * 65536 + m * 16); \
            ga[m][0] = (u32x2){wa.x, wa.y}; ga[m][1] = (u32x2){wa.z, wa.w}; gb[m][0] = (u32x2){wb_.x, wb_.y}; gb[m][1] = (u32x2){wb_.z, wb_.w}; } } while (0)
#define M2_GSCALE(ai) do { _Pragma("unroll") for (int m = 0; m < 4; ++m) _Pragma("unroll") for (int bj = 0; bj < 2; ++bj) { \
            acc[ai][bj][m][0] = acc[ai][bj][m][0] * (gate_q4(ga[m][bj].x) * rcp4(gate_q4(gb[m][bj].x))); \
            acc[ai][bj][m][1] = acc[ai][bj][m][1] * (gate_q4(ga[m][bj].y) * rcp4(gate_q4(gb[m][bj].y))); } } while (0)
    { const char* cA = M2_A(cur, 0); const char* cB = M2_B(cur, 0);
      M2_STAGE(M2_SB(0, 0), cB, voffB); M2_STAGE(M2_SB(0, 1), cB + hstepB, voffB); M2_STAGE(M2_SA(0, 0), cA, voffA); M2_STAGE(M2_SA(0, 1), cA + hstepA, voffA);
      if (wr == 1) M2_BAR;
      M2_WAIT_V(2); M2_BAR;
      M2_STAGE(M2_SB(1, 0), cB + kstep, voffB); M2_STAGE(M2_SA(1, 0), cA + kstep, voffA); M2_STAGE(M2_SB(1, 1), cB + hstepB + kstep, voffB);
      M2_WAIT_V(6); M2_BAR; }
    for (;;) {
        bool has_next; { const int idx = vc + G * (ui + 1); has_next = idx < NU; nxt.pm = idx >> 2; nxt.pn = idx & 3; }
#pragma unroll 1
        for (int t = 0; t < nt; t += 2) {
            const bool last = (t == nt - 2);
            const bool bnd = ((t & 3) == 2) && !last;
            const bool pend = ((t & 3) == 0) && t != 0;
            const char* a1 = M2_A(cur, t) + kstep;
            const char* a2 = last ? (has_next ? M2_A(nxt, 0) : M2_A(cur, 0)) : M2_A(cur, t + 2);
            const char* b2 = last ? (has_next ? M2_B(nxt, 0) : M2_B(cur, 0)) : M2_B(cur, t + 2);
            const char* a3 = a2 + kstep; const char* b3 = b2 + kstep;
            M2_LDB(B0, 0, 0); M2_LDB(B1, 0, 1); M2_SCHED; M2_LDA(At, 0, 0); M2_STAGE(M2_SA(1, 1), a1 + hstepA, voffA);
            if (pend) M2_WAIT_V(16); else M2_WAIT_V(8);
            M2_WAIT_L(0); M2_BAR; M2_MMA(0, 0, At, B0); M2_MMA(0, 1, At, B1); M2_BAR; M2_SCHED;
            if (pend) { M2_WAIT_V(2); M2_GSCALE(1); M2_SCHED; }
            M2_LDA(At, 0, 1); M2_STAGE(M2_SB(0, 0), b2, voffB); M2_STAGE(M2_SB(0, 1), b2 + hstepB, voffB); M2_STAGE(M2_SA(0, 0), a2, voffA);
            M2_WAIT_V(8); M2_WAIT_L(0); M2_BAR; M2_MMA(1, 0, At, B0); M2_MMA(1, 1, At, B1); M2_BAR; M2_SCHED;
            if (bnd) { M2_GLOAD(0, t >> 2); }
            M2_LDB(B0, 1, 0); M2_LDB(B1, 1, 1); M2_SCHED; M2_LDA(At, 1, 0); M2_STAGE(M2_SA(0, 1), a2 + hstepA, voffA);
            if (bnd) M2_WAIT_V(16); else M2_WAIT_V(8);
            M2_WAIT_L(0); M2_BAR; M2_MMA(0, 0, At, B0); M2_MMA(0, 1, At, B1); M2_BAR; M2_SCHED;
            M2_LDA(At, 1, 1); M2_STAGE(M2_SB(1, 0), b3, voffB); M2_STAGE(M2_SB(1, 1), b3 + hstepB, voffB); M2_STAGE(M2_SA(1, 0), a3, voffA);
            M2_WAIT_V(8); M2_WAIT_L(0); M2_BAR; M2_MMA(1, 0, At, B0); M2_MMA(1, 1, At, B1); if (bnd) { M2_SCHED; M2_GSCALE(0); } M2_BAR;
            if (bnd) { M2_GLOAD(1, t >> 2); }
            M2_SCHED;
        }
        if (wr == 0) M2_BAR;
        { int frx = fr; asm volatile("" : "+v"(frx)); const int row0 = cur.pm * 256 + wr * 64 + frx, col0 = cur.pn * 256 + wc * 32 + 8 * fq;
#pragma unroll
          for (int ai = 0; ai < 2; ++ai) {
              u32x2 g3[4][2];
              { const unsigned char* gp = (const unsigned char*)Pp + gate_off(cur.pm, 12 + cur.pn, wid, ai, frx + 16 * fq);
#pragma unroll
                for (int m = 0; m < 4; ++m) { const u32x4 w4 = *(const GAS u32x4*)(gp + m * 16); g3[m][0] = (u32x2){w4.x, w4.y}; g3[m][1] = (u32x2){w4.z, w4.w}; } }
#pragma unroll
              for (int m = 0; m < 4; ++m)
#pragma unroll
                  for (int bj = 0; bj < 2; ++bj) { constexpr float Kq = 1.0f / 255.0f;
                      *(GAS u32x4*)(HBo + (size_t)(row0 + ai * HALF + m * 16) * DM + col0 + bj * HALF) = pack8(acc[ai][bj][m][0] * (gate_q4(g3[m][bj].x) * Kq), acc[ai][bj][m][1] * (gate_q4(g3[m][bj].y) * Kq));
                      acc[ai][bj][m][0] = (f32x4){0.f, 0.f, 0.f, 0.f}; acc[ai][bj][m][1] = (f32x4){0.f, 0.f, 0.f, 0.f}; }
              asm volatile("" ::: "memory"); } }
        if (!has_next) break;
        cur = nxt; ++ui;
        if (wr == 1) M2_BAR;
    }
    M2_WAIT_V(0);
    M2_BAR;
#undef M2_SA
#undef M2_SB
#undef M2_STAGE
#undef M2_LDA
#undef M2_LDB
#undef M2_MMA
#undef M2_WAIT_V
#undef M2_WAIT_L
#undef M2_BAR
#undef M2_SCHED
#undef M2_GLOAD
#undef M2_GSCALE
#undef M2_ACOL
#undef M2_A
#undef M2_B
}
__device__ __forceinline__ void merge_phase3(LAS unsigned char* lds, const bf16_t* Pp, const unsigned char* Y8, const unsigned char* Wb8, bf16_t* HBo, int G, int vc, int tid) {
    asm volatile("" : "+v"(tid));
    const int wid = __builtin_amdgcn_readfirstlane(tid >> 6), lane = tid & 63, wr = wid >> 2, wc = wid & 3, fr = lane & 15, fq = lane >> 4;
    constexpr int nt = 8, NU = (MTOK / 256) * (DM / 256);
    unsigned voffA[2], voffB[2];
#pragma unroll
    for (int i = 0; i < 2; ++i) { int R, C; stage_rc(tid * 16 + i * 8192, R, C); const int Rb = (R & ~31) + perm32(R & 31);
        voffA[i] = (unsigned)(R * 1024 + C * 2); voffB[i] = (unsigned)(Rb * 256 + C * 2); }
    const unsigned ldsw = (unsigned)wid * 1024u;
    const int aoff = lds_byte(wr * 64 + fr, fq * 8), boff = lds_byte(wc * 32 + fr, fq * 8);
#define M2_SA(b, h) (((b) * 2 + (h)) * HTB)
#define M2_SB(b, h) ((4 + (b) * 2 + (h)) * HTB)
#define M2_STAGE(bufoff, gbase, voff) do { _Pragma("unroll") for (int _i = 0; _i < 2; ++_i) \
        __builtin_amdgcn_global_load_lds((const unsigned*)((const char*)(gbase) + (voff)[_i]), (LAS unsigned*)(lds + (bufoff) + ldsw + _i * 8192), 16, 0, 0); } while (0)
#define M2_LDA(dst, b, h) do { _Pragma("unroll") for (int m = 0; m < 4; ++m) { dst[m].lo = *(const LAS i32x4*)(lds + M2_SA(b, h) + aoff + m * 2048); dst[m].hi = *(const LAS i32x4*)(lds + M2_SA(b, h) + aoff + m * 2048 + 1024); } } while (0)
#define M2_LDB(dst, b, h) do { _Pragma("unroll") for (int n = 0; n < 2; ++n) { dst[n].lo = *(const LAS i32x4*)(lds + M2_SB(b, h) + boff + n * 2048); dst[n].hi = *(const LAS i32x4*)(lds + M2_SB(b, h) + boff + n * 2048 + 1024); } } while (0)
#define M2_MMA(ai, bj, At, Bt) do { __builtin_amdgcn_s_setprio(1); _Pragma("unroll") for (int m = 0; m < 4; ++m) _Pragma("unroll") for (int n = 0; n < 2; ++n) \
        asm volatile("v_mfma_scale_f32_16x16x128_f8f6f4 %0, %1, %2, %0, %3, %3 op_sel_hi:[0,0,0]" : "+v"(acc[ai][bj][m][n]) : "v"(Bt[n]), "v"(At[m]), "v"(sc127)); __builtin_amdgcn_s_setprio(0); } while (0)
#define M2_WAIT_V(n) asm volatile("s_waitcnt vmcnt(" #n ")" ::: "memory")
#define M2_WAIT_L(n) asm volatile("s_waitcnt lgkmcnt(" #n ")" ::: "memory")
#define M2_BAR __builtin_amdgcn_s_barrier()
#define M2_SCHED __builtin_amdgcn_sched_barrier(0)
    const char* Ab = (const char*)Y8; const char* Bb = (const char*)Wb8; asm volatile("" : "+s"(Ab), "+s"(Bb)); Ab = (const char*)(const GAS char*)Ab; Bb = (const char*)(const GAS char*)Bb;
#define M2_A(u, kt) (Ab + ((size_t)(u).pm * 256 * 1024 + ((kt) >> 1) * 256 + ((kt) & 1) * 128))
#define M2_B(u, kt) (Bb + ((size_t)(((kt) >> 1) * DM + (u).pn * 256) * 256 + ((kt) & 1) * 128))
    constexpr size_t hstepB = (size_t)HALF * 256, hstepA = (size_t)HALF * 1024, kstep = 128;
    MUnit cur, nxt; int ui = 0;
    { const int idx = vc; if (idx >= NU) return; cur.pm = idx >> 2; cur.pn = idx & 3; }
    f32x4 acc[2][2][4][2];
    i32x8 At[4], B0[2], B1[2];
    int sc127 = 127; asm volatile("" : "+v"(sc127));
    u32x4 ga4[4], gb4[4];
#define M2_GLOAD(ai, n) do { const int lx = lane_now(); const unsigned char* gp = (const unsigned char*)Pp + gate_off(cur.pm, 4 * (n) + cur.pn, wid, (ai), lx); \
        _Pragma("unroll") for (int m = 0; m < 4; ++m) { ga4[m] = *(const GAS u32x4*)(gp + m * 16); gb4[m] = *(const GAS u32x4*)(gp + 4 * 65536 + m * 16); } } while (0)
#define M2_GSCALE(ai) do { _Pragma("unroll") for (int m = 0; m < 4; ++m) { \
            acc[ai][0][m][0] = acc[ai][0][m][0] * (gate_q4(ga4[m].x) * rcp4(gate_q4(gb4[m].x))); acc[ai][0][m][1] = acc[ai][0][m][1] * (gate_q4(ga4[m].y) * rcp4(gate_q4(gb4[m].y))); \
            acc[ai][1][m][0] = acc[ai][1][m][0] * (gate_q4(ga4[m].z) * rcp4(gate_q4(gb4[m].z))); acc[ai][1][m][1] = acc[ai][1][m][1] * (gate_q4(ga4[m].w) * rcp4(gate_q4(gb4[m].w))); } } while (0)
    { const char* cA = M2_A(cur, 0); const char* cB = M2_B(cur, 0);
      M2_STAGE(M2_SB(0, 0), cB, voffB); M2_SCHED; M2_STAGE(M2_SB(0, 1), cB + hstepB, voffB); M2_SCHED; M2_STAGE(M2_SA(0, 0), cA, voffA); M2_SCHED; M2_STAGE(M2_SA(0, 1), cA + hstepA, voffA); M2_SCHED;
      if (wr == 1) M2_BAR;
      M2_WAIT_V(2); M2_BAR;
      M2_STAGE(M2_SB(1, 0), cB + kstep, voffB); M2_SCHED; M2_STAGE(M2_SA(1, 0), cA + kstep, voffA); M2_SCHED; M2_STAGE(M2_SB(1, 1), cB + hstepB + kstep, voffB); M2_SCHED;
      M2_WAIT_V(6); M2_BAR; }
    M2_SCHED;
#pragma unroll
    for (int a = 0; a < 2; ++a)
#pragma unroll
        for (int b = 0; b < 2; ++b)
#pragma unroll
            for (int m = 0; m < 4; ++m)
#pragma unroll
                for (int n = 0; n < 2; ++n) acc[a][b][m][n] = (f32x4){0.f, 0.f, 0.f, 0.f};
    for (;;) {
        asm volatile("" : "+s"(Ab), "+s"(Bb));
        bool has_next; { const int idx = vc + G * (ui + 1); has_next = idx < NU; nxt.pm = idx >> 2; nxt.pn = idx & 3; }
#pragma unroll 1
        for (int t = 0; t < nt; t += 2) {
            const bool last = (t == nt - 2);
            asm volatile("" : "+v"(voffA[0]), "+v"(voffA[1]), "+v"(voffB[0]), "+v"(voffB[1]));
            const bool bnd = !last;
            const bool pend = t != 0;
            const char* a1 = M2_A(cur, t) + kstep;
            const char* a2 = last ? (has_next ? M2_A(nxt, 0) : M2_A(cur, 0)) : M2_A(cur, t + 2);
            const char* b2 = last ? (has_next ? M2_B(nxt, 0) : M2_B(cur, 0)) : M2_B(cur, t + 2);
            const char* a3 = a2 + kstep; const char* b3 = b2 + kstep;
            M2_LDB(B0, 0, 0); M2_LDB(B1, 0, 1); M2_SCHED; M2_LDA(At, 0, 0); M2_STAGE(M2_SA(1, 1), a1 + hstepA, voffA);
            if (pend) M2_WAIT_V(16); else M2_WAIT_V(8);
            M2_WAIT_L(0); M2_BAR; M2_MMA(0, 0, At, B0); M2_MMA(0, 1, At, B1); M2_BAR; M2_SCHED;
            if (pend) { M2_WAIT_V(2); M2_GSCALE(1); M2_SCHED; }
            M2_LDA(At, 0, 1); M2_STAGE(M2_SB(0, 0), b2, voffB); M2_STAGE(M2_SB(0, 1), b2 + hstepB, voffB); M2_STAGE(M2_SA(0, 0), a2, voffA);
            M2_WAIT_V(8); M2_WAIT_L(0); M2_BAR; M2_MMA(1, 0, At, B0); M2_MMA(1, 1, At, B1); M2_BAR; M2_SCHED;
            if (bnd) { M2_GLOAD(0, t >> 1); }
            M2_LDB(B0, 1, 0); M2_LDB(B1, 1, 1); M2_SCHED; M2_LDA(At, 1, 0); M2_STAGE(M2_SA(0, 1), a2 + hstepA, voffA);
            if (bnd) M2_WAIT_V(16); else M2_WAIT_V(8);
            M2_WAIT_L(0); M2_BAR; M2_MMA(0, 0, At, B0); M2_MMA(0, 1, At, B1); M2_BAR; M2_SCHED;
            M2_LDA(At, 1, 1); M2_STAGE(M2_SB(1, 0), b3, voffB); M2_STAGE(M2_SB(1, 1), b3 + hstepB, voffB); M2_STAGE(M2_SA(1, 0), a3, voffA);
            M2_WAIT_V(8); M2_WAIT_L(0); M2_BAR; M2_MMA(1, 0, At, B0); M2_MMA(1, 1, At, B1); if (bnd) { M2_SCHED; M2_GSCALE(0); } M2_BAR;
            if (bnd) { M2_GLOAD(1, t >> 1); }
            M2_SCHED;
        }
        asm volatile("s_nop 15\n\ts_nop 15\n\ts_nop 15" ::: "memory");
        if (wr == 0) M2_BAR;
        { const int lnx = lane_now(), frx = lnx & 15, fqx = lnx >> 4; const int row0 = cur.pm * 256 + wr * 64 + frx, col0 = cur.pn * 256 + wc * 32 + 8 * fqx;
#pragma unroll
          for (int ai = 0; ai < 2; ++ai) {
              u32x2 g3[4][2];
              { const unsigned char* gp = (const unsigned char*)Pp + gate_off(cur.pm, 12 + cur.pn, wid, ai, lnx);
#pragma unroll
                for (int m = 0; m < 4; ++m) { const u32x4 w4 = *(const GAS u32x4*)(gp + m * 16); g3[m][0] = (u32x2){w4.x, w4.y}; g3[m][1] = (u32x2){w4.z, w4.w}; } }
#pragma unroll
              for (int m = 0; m < 4; ++m)
#pragma unroll
                  for (int bj = 0; bj < 2; ++bj) { constexpr float Kq = 1.0f / (255.0f * 256.0f);
                      *(GAS u32x4*)(HBo + (size_t)(row0 + ai * HALF + m * 16) * DM + col0 + bj * HALF) = pack8(acc[ai][bj][m][0] * (gate_q4(g3[m][bj].x) * Kq), acc[ai][bj][m][1] * (gate_q4(g3[m][bj].y) * Kq));
                      acc[ai][bj][m][0] = (f32x4){0.f, 0.f, 0.f, 0.f}; acc[ai][bj][m][1] = (f32x4){0.f, 0.f, 0.f, 0.f}; }
              asm volatile("" ::: "memory"); } }
        if (!has_next) break;
        cur = nxt; ++ui;
        if (wr == 1) M2_BAR;
    }
    M2_WAIT_V(0);
    M2_BAR;
#undef M2_SA
#undef M2_SB
#undef M2_STAGE
#undef M2_LDA
#undef M2_LDB
#undef M2_MMA
#undef M2_WAIT_V
#undef M2_WAIT_L
#undef M2_BAR
#undef M2_SCHED
#undef M2_GLOAD
#undef M2_GSCALE
#undef M2_A
#undef M2_B
}
}
namespace att {
constexpr int STG = 20480, VOFF = 12288;
constexpr int LDS_WSF = 3 * STG;
constexpr int LDS_OST = LDS_WSF + 8 * 512;
constexpr int LDS_BIAS = LDS_OST + 8 * 4096;
constexpr int LDS_BYTES = LDS_BIAS + 2048;
typedef short v4i16_t __attribute__((ext_vector_type(4)));

__device__ __forceinline__ int crow(int r, int hi) { return (r & 3) + 8 * (r >> 2) + 4 * hi; }
__device__ __forceinline__ s16x4 vtr(const LAS unsigned char* p) { return __builtin_bit_cast(s16x4, __builtin_amdgcn_ds_read_tr16_b64_v4i16((LAS v4i16_t*)p)); }
__device__ __forceinline__ void glds16(const void* gsrc, unsigned lds_dst) { unsigned keep;
    asm volatile("s_mov_b32 %0, m0\n\ts_mov_b32 m0, %2\n\ts_nop 0\n\tglobal_load_lds_dwordx4 %1, off\n\ts_mov_b32 m0, %0" : "=&s"(keep) : "v"(gsrc), "s"(lds_dst) : "memory"); }
__device__ __forceinline__ int clampi(int v, int lo, int hi) { return v < lo ? lo : (v > hi ? hi : v); }

__device__ __forceinline__ u32x2 bf8_to_fp8x8(const u32x4 v) { u32x2 w;
    w.x = pk_fp8x4(bflo(v.x) * 16.0f, bfhi(v.x) * 16.0f, bflo(v.y) * 16.0f, bfhi(v.y) * 16.0f); w.y = pk_fp8x4(bflo(v.z) * 16.0f, bfhi(v.z) * 16.0f, bflo(v.w) * 16.0f, bfhi(v.w) * 16.0f); return w; }
template <int DQ, int MODE, int VAR = 0, bool O8 = false>
__device__ __forceinline__ void attn_unit(const bf16_t* Qp, const bf16_t* Kp, const bf16_t* Vp, bf16_t* Op, int ldq, int ldk, int ldv, int ldo,
                                          int q0, float sc2, float par0, float par1, const float* biasp, LAS unsigned char* lds, int tid) {
    asm volatile("" : "+v"(tid));
    const int lane = tid & 63, r32 = lane & 31, hi = lane >> 5; const int wid = __builtin_amdgcn_readfirstlane(tid >> 6);
    constexpr int ND = DQ / 16;
    int t0 = 0, t1 = SEQ / 64 - 1;
    const int wq0 = q0 + wid * 32;
    int wt0 = 0, wt1 = SEQ / 64 - 1;
    if (MODE == 1) { t0 = (q0 >> 6) - 2; t0 = t0 < 0 ? 0 : t0; t1 = (q0 >> 6) + 5; t1 = t1 > 63 ? 63 : t1;
        int klo = wq0 - 128; klo = klo < 0 ? 0 : klo; int khi = wq0 + 31 + 128; khi = khi > SEQ - 1 ? SEQ - 1 : khi; wt0 = klo >> 6; wt1 = khi >> 6; }
    if (MODE == 2) { const int R0 = q0 >> 6; t0 = clampi(R0 - 4, 0, 56); t1 = clampi(R0 + 3 - 4, 0, 56) + 7; const int R = wq0 >> 6; wt0 = clampi(R - 4, 0, 56); wt1 = wt0 + 7; }
    LAS float* wsf = (LAS float*)(lds + LDS_WSF) + wid * 128;
    LAS float* bt = (LAS float*)(lds + LDS_BIAS);
    bf16x8 qr[ND];
    { const bf16_t* Qw = Qp + (size_t)(wq0 + r32) * ldq + hi * 8;
#pragma unroll
      for (int d0 = 0; d0 < ND; ++d0) qr[d0] = *(const GAS bf16x8*)(Qw + d0 * 16); }
    const bf16_t* ksrc = Kp + (size_t)lane * ldk + wid * 8;
    const bf16_t* ksrc2 = Kp + (size_t)lane * ldk + (8 + (wid & 3)) * 8;
    const bf16_t* vsrc = Vp + (size_t)(16 * (wid & 3) + (lane >> 2)) * ldv + (wid >> 2) * 32 + (lane & 3) * 8;
    const int kdst = wid * 1024 + lane * 16, kdst2 = (8 + (wid & 3)) * 1024 + lane * 16, vdst = VOFF + wid * 1024 + lane * 16;
    u32x4 kreg, kreg2, vreg; kreg2 = (u32x4){0u, 0u, 0u, 0u};
    u32x4 kregB, kreg2B, vregB; kreg2B = (u32x4){0u, 0u, 0u, 0u};
#define ATT_LOAD(t) do { if (VAR == 5) break; const size_t ro_ = (size_t)(t) * 64; kreg = *(const GAS u32x4*)(ksrc + ro_ * ldk); if (DQ == 96) kreg2 = *(const GAS u32x4*)(ksrc2 + ro_ * ldk); vreg = *(const GAS u32x4*)(vsrc + ro_ * ldv); } while (0)
#define ATT_STORE(s) do { if (VAR == 5) break; LAS unsigned char* sb_ = lds + (s) * STG; *(LAS u32x4*)(sb_ + kdst) = kreg; if (DQ == 96) *(LAS u32x4*)(sb_ + kdst2) = kreg2; *(LAS u32x4*)(sb_ + vdst) = vreg; } while (0)
#define ATT_LOADB(t) do { if (VAR == 5) break; const size_t ro_ = (size_t)(t) * 64; kregB = *(const GAS u32x4*)(ksrc + ro_ * ldk); if (DQ == 96) kreg2B = *(const GAS u32x4*)(ksrc2 + ro_ * ldk); vregB = *(const GAS u32x4*)(vsrc + ro_ * ldv); } while (0)
#define ATT_STOREB(s) do { if (VAR == 5) break; LAS unsigned char* sb_ = lds + (s) * STG; *(LAS u32x4*)(sb_ + kdst) = kregB; if (DQ == 96) *(LAS u32x4*)(sb_ + kdst2) = kreg2B; *(LAS u32x4*)(sb_ + vdst) = vregB; } while (0)
    ATT_LOAD(t0);
    if (MODE == 2) { for (int i = tid; i < 15 * 31; i += 512) bt[i] = biasp[i] * LOG2E; }
    ATT_STORE(0);
    if (t0 + 1 <= t1) { ATT_LOAD(t0 + 1); ATT_STORE(1); }
    constexpr float THR = 8.0f;
    float m2 = (MODE == 1) ? par1 : 0.0f;
    bool first = (MODE != 1);
    float lsum = (MODE == 1 && hi == 0) ? 1.0f : 0.0f;
    f32x16 o[2];
#pragma unroll
    for (int r = 0; r < 16; ++r) { o[0][r] = 0.f; o[1][r] = 0.f; }
    const int tq = wq0 + r32;
    const int na_ncs = 4 * hi - clampi((tq & 63) - 8, 0, 48), na_l = 4 * hi - (tq & 63) + 15; (void)na_ncs; (void)na_l;
    f32x16 p0, p1, n0, n1;
#pragma unroll
    for (int r = 0; r < 16; ++r) { p0[r] = 0.f; p1[r] = 0.f; n0[r] = 0.f; n1[r] = 0.f; }
#define ATT_QK(D0, D1, stg_) do { const LAS unsigned char* kb_ = lds + (stg_) * STG + hi * 1024 + r32 * 16; const float ni_ = -m2; \
        _Pragma("unroll") for (int r = 0; r < 16; ++r) { D0[r] = ni_; D1[r] = ni_; } \
        _Pragma("unroll") for (int d0 = 0; d0 < ND; ++d0) { \
            const bf16x8 b0_ = *(const LAS bf16x8*)(kb_ + d0 * 2048), b1_ = *(const LAS bf16x8*)(kb_ + d0 * 2048 + 512); \
            D0 = __builtin_amdgcn_mfma_f32_32x32x16_bf16(b0_, qr[d0], D0, 0, 0, 0); \
            D1 = __builtin_amdgcn_mfma_f32_32x32x16_bf16(b1_, qr[d0], D1, 0, 0, 0); } } while (0)
#define ATT_KPRE(stg_) do { if (VAR == 3 || (VAR == 6 && kfinit)) break; kfinit = true; const LAS unsigned char* kb_ = lds + (stg_) * STG + hi * 1024 + r32 * 16; \
        _Pragma("unroll") for (int d0 = 0; d0 < ND; ++d0) { kf[2 * d0] = *(const LAS bf16x8*)(kb_ + d0 * 2048); kf[2 * d0 + 1] = *(const LAS bf16x8*)(kb_ + d0 * 2048 + 512); } } while (0)
#define ATT_QKF(D0, D1) do { const float ni_ = -m2; \
        _Pragma("unroll") for (int r = 0; r < 16; ++r) { D0[r] = ni_; D1[r] = ni_; } \
        if (VAR == 3) break; \
        _Pragma("unroll") for (int d0 = 0; d0 < ND; ++d0) { \
            D0 = __builtin_amdgcn_mfma_f32_32x32x16_bf16(kf[2 * d0], qr[d0], D0, 0, 0, 0); \
            D1 = __builtin_amdgcn_mfma_f32_32x32x16_bf16(kf[2 * d0 + 1], qr[d0], D1, 0, 0, 0); } } while (0)
    __syncthreads();
    constexpr bool PIPE = true;
    int sc_ = 0, sn_ = 1, sw_ = 2;
#define ATT_HEAD(t, p0, p1, n0, n1) do { \
            float rm = -INFINITY; \
            int ncs_ = na_ncs, nbb_ = 0; if (MODE == 2) { asm volatile("" : "+v"(ncs_)); nbb_ = ((t) - (tq >> 6) + 7) * 31 + na_l; }        \
            const LAS float* bp_ = bt + nbb_; \
            float relb_ = 0.f; if (MODE == 1) { relb_ = (float)((t) * 64 + 4 * hi - tq); asm volatile("" : "+v"(relb_)); } \
            _Pragma("unroll") for (int r = 0; r < 16; ++r) { \
                const int kk = crow(r, hi); \
                float v0 = p0[r], v1 = p1[r]; \
                if (MODE == 1) {        \
                    const float rf0 = relb_ + (float)((r & 3) + 8 * (r >> 2)), rf1 = rf0 + 32.0f; \
                    v0 = (__builtin_fabsf(rf0) <= 128.0f) ? __builtin_fmaf(-par0, __builtin_fabsf(rf0), v0) : -INFINITY; \
                    v1 = (__builtin_fabsf(rf1) <= 128.0f) ? __builtin_fmaf(-par0, __builtin_fabsf(rf1), v1) : -INFINITY; \
                } \
                if (MODE == 2) {        \
                    const int cr = (r & 3) + 8 * (r >> 2); \
                    const unsigned d0c = (unsigned)(cr + ncs_), d1c = (unsigned)(cr + 32 + ncs_); \
                    v0 = (d0c < 16u) ? v0 + bp_[cr] : -INFINITY; \
                    v1 = (d1c < 16u) ? v1 + bp_[cr + 32] : -INFINITY; \
                } \
                if (MODE != 0) { p0[r] = v0; p1[r] = v1; } \
                rm = fmaxf(fmaxf(rm, v0), v1); \
            } \
            { auto rr = __builtin_amdgcn_permlane32_swap(__float_as_uint(rm), __float_as_uint(rm), false, false); rm = fmaxf(__uint_as_float(rr[0]), __uint_as_float(rr[1])); } \
            if (first) { \
                first = false; m2 = rm; \
                _Pragma("unroll") for (int r = 0; r < 16; ++r) { p0[r] -= rm; p1[r] -= rm; if (PIPE && MODE != 0) { n0[r] -= rm; n1[r] -= rm; } } \
            } else if (__any(rm > THR)) { \
                const float dl = fmaxf(rm, 0.f); m2 += dl; \
                _Pragma("unroll") for (int r = 0; r < 16; ++r) { p0[r] -= dl; p1[r] -= dl; if (PIPE && MODE != 0) { n0[r] -= dl; n1[r] -= dl; } } \
                const float f = __builtin_amdgcn_exp2f(-dl); \
                lsum *= f; \
                if (hi == 0) wsf[r32] = f; \
                asm volatile("s_waitcnt lgkmcnt(0)" ::: "memory"); \
                _Pragma("unroll") for (int g4 = 0; g4 < 4; ++g4) { const f32x4 f4 = *(const LAS f32x4*)(wsf + 8 * g4 + 4 * hi); \
                    _Pragma("unroll") for (int j = 0; j < 4; ++j) { o[0][4 * g4 + j] *= f4[j]; o[1][4 * g4 + j] *= f4[j]; } } \
                asm volatile("s_waitcnt lgkmcnt(0)" ::: "memory"); \
            } } while (0)
#define ATT_EXP_PV(stg_, p0, p1) do { \
            float sumA = 0.f, sumB = 0.f; \
            _Pragma("unroll") for (int r = 0; r < 16; ++r) { if (VAR != 1) { p0[r] = __builtin_amdgcn_exp2f(p0[r]); p1[r] = __builtin_amdgcn_exp2f(p1[r]); } sumA += p0[r]; sumB += p1[r]; } \
            lsum += sumA + sumB; \
            u32x4 pw[4]; \
            _Pragma("unroll") for (int j = 0; j < 4; ++j) { pw[0][j] = cvt_pk_bf16(p0[2 * j], p0[2 * j + 1]); pw[1][j] = cvt_pk_bf16(p0[8 + 2 * j], p0[8 + 2 * j + 1]); \
                                          pw[2][j] = cvt_pk_bf16(p1[2 * j], p1[2 * j + 1]); pw[3][j] = cvt_pk_bf16(p1[8 + 2 * j], p1[8 + 2 * j + 1]); } \
            const LAS unsigned char* vp = lds + (stg_) * STG + VOFF + ((lane >> 4) & 1) * 32 + (lane & 3) * 8 + (4 * hi + ((lane & 15) >> 2)) * 64; \
            if (VAR != 2) _Pragma("unroll") for (int i = 0; i < 8; ++i) { \
                const int iv_ = (VAR == 7) ? 0 : i; \
                const s16x4 lo = vtr(vp + (iv_ >> 2) * 4096 + (iv_ & 3) * 1024), hh = vtr(vp + (iv_ >> 2) * 4096 + (iv_ & 3) * 1024 + 512); \
                const bf16x8 vf = (bf16x8){lo[0], lo[1], lo[2], lo[3], hh[0], hh[1], hh[2], hh[3]}; \
                o[i >> 2] = __builtin_amdgcn_mfma_f32_32x32x16_bf16(__builtin_bit_cast(bf16x8, pw[i & 3]), vf, o[i >> 2], 0, 0, 0); \
            } } while (0)
#define ATT_ROT() do { const int tmp_ = sc_; sc_ = sn_; sn_ = sw_; sw_ = tmp_; } while (0)
    if constexpr (MODE == 0) {
        bf16x8 kf[2 * ND]; bool kfinit = false;
        ATT_KPRE(0); ATT_QKF(p0, p1);
        if (t0 + 2 <= t1) ATT_LOAD(t0 + 2);
        for (int t = t0; t + 1 < t1; t += 2) {
            if (t + 3 <= t1) ATT_LOADB(t + 3);
            ATT_KPRE(sn_);
            __builtin_amdgcn_sched_barrier(0);
            ATT_HEAD(t, p0, p1, n0, n1);
            ATT_QKF(n0, n1);
            ATT_EXP_PV(sc_, p0, p1);
            if (t + 2 <= t1) ATT_STORE(sw_);
            if (VAR != 4) __syncthreads();
            ATT_ROT();
            if (t + 4 <= t1) ATT_LOAD(t + 4);
            ATT_KPRE(sn_);
            __builtin_amdgcn_sched_barrier(0);
            ATT_HEAD(t + 1, n0, n1, p0, p1);
            ATT_QKF(p0, p1);
            ATT_EXP_PV(sc_, n0, n1);
            if (t + 3 <= t1) ATT_STOREB(sw_);
            if (VAR != 4) __syncthreads();
            ATT_ROT();
        }
        {
            ATT_KPRE(sn_);
            __builtin_amdgcn_sched_barrier(0);
            ATT_HEAD(t1 - 1, p0, p1, n0, n1);
            ATT_QKF(n0, n1);
            ATT_EXP_PV(sc_, p0, p1);
            __syncthreads();
            ATT_ROT();
        }
        ATT_HEAD(t1, n0, n1, p0, p1);
        ATT_EXP_PV(sc_, n0, n1);
        __syncthreads();
    } else {
        if (PIPE && t0 >= wt0 && t0 <= wt1) ATT_QK(p0, p1, 0);
        for (int t = t0; t <= t1; ++t) {
            if (t + 2 <= t1) ATT_LOAD(t + 2);
            if (PIPE) { const bool nin = (t + 1 <= t1) && (t + 1 >= wt0) && (t + 1 <= wt1); if (nin) ATT_QK(n0, n1, sn_); }
            else { if (t >= wt0 && t <= wt1) ATT_QK(p0, p1, sc_); }
            if (t >= wt0 && t <= wt1) { ATT_HEAD(t, p0, p1, n0, n1); ATT_EXP_PV(sc_, p0, p1); }
            if (t + 2 <= t1) ATT_STORE(sw_);
            __syncthreads();
            if (PIPE) { p0 = n0; p1 = n1; }
            ATT_ROT();
        }
    }
#undef ATT_HEAD
#undef ATT_EXP_PV
#undef ATT_ROT
#undef ATT_QK
#undef ATT_KPRE
#undef ATT_QKF
#undef ATT_LOAD
#undef ATT_LOADB
#undef ATT_STOREB
#undef ATT_STORE
    { auto rr = __builtin_amdgcn_permlane32_swap(__float_as_uint(lsum), __float_as_uint(lsum), false, false); lsum = __uint_as_float(rr[0]) + __uint_as_float(rr[1]); }
    if (hi == 0) wsf[32 + r32] = lsum;
    asm volatile("s_waitcnt lgkmcnt(0)" ::: "memory");
    float rli[16];
#pragma unroll
    for (int g4 = 0; g4 < 4; ++g4) { const f32x4 l4 = *(const LAS f32x4*)(wsf + 32 + 8 * g4 + 4 * hi);
#pragma unroll
        for (int j = 0; j < 4; ++j) rli[4 * g4 + j] = __builtin_amdgcn_rcpf(l4[j]); }
    LAS bf16_t* stg = (LAS bf16_t*)(lds + LDS_OST) + wid * 2048;
#pragma unroll
    for (int r = 0; r < 16; ++r) { const int orow = crow(r, hi);
#pragma unroll
        for (int d0 = 0; d0 < 2; ++d0) stg[orow * 64 + d0 * 32 + r32] = f2bf(o[d0][r] * rli[r]); }
    asm volatile("s_waitcnt lgkmcnt(0)" ::: "memory");
    bf16_t* Ow = Op + (size_t)wq0 * ldo;
#pragma unroll
    for (int i = 0; i < 4; ++i) { const int row = i * 8 + (lane >> 3), ch = lane & 7; const u32x4 v = *(const LAS u32x4*)(stg + row * 64 + ch * 8);
        if constexpr (O8) { *(GAS u32x2*)((unsigned char*)Op + (size_t)(wq0 + row) * ldo + ch * 8) = bf8_to_fp8x8(v); } else { *(GAS u32x4*)(Ow + (size_t)row * ldo + ch * 8) = v; } }
    asm volatile("s_waitcnt lgkmcnt(0)" ::: "memory");
}

template <int DQ, bool O8 = false>
__device__ __forceinline__ void attn_unit2(const bf16_t* QpA, const bf16_t* QpB, const bf16_t* Kp, const bf16_t* Vp, bf16_t* OpA, bf16_t* OpB, int ldq, int ldk, int ldv, int ldo,
                                           int q0, LAS unsigned char* lds, int tid) {
    asm volatile("" : "+v"(tid));
    const int lane = tid & 63, r32 = lane & 31, hi = lane >> 5; const int wid = __builtin_amdgcn_readfirstlane(tid >> 6);
    constexpr int ND = DQ / 16;
    constexpr int t0 = 0, t1 = SEQ / 64 - 1;
    const int wq0 = q0 + wid * 32;
    LAS float* wsf = (LAS float*)(lds + LDS_WSF) + wid * 128;
    bf16x8 qa[ND], qb[ND];
    { const bf16_t* Qw = QpA + (size_t)(wq0 + r32) * ldq + hi * 8; const bf16_t* Qv = QpB + (size_t)(wq0 + r32) * ldq + hi * 8;
#pragma unroll
      for (int d0 = 0; d0 < ND; ++d0) { qa[d0] = *(const GAS bf16x8*)(Qw + d0 * 16); qb[d0] = *(const GAS bf16x8*)(Qv + d0 * 16); } }
    const bf16_t* ksrc = Kp + (size_t)lane * ldk + wid * 8;
    const int k2off = __builtin_amdgcn_readfirstlane((8 + (wid & 3) - wid) * 8);
    const bf16_t* vsrc = Vp + (size_t)(16 * (wid & 3) + (lane >> 2)) * ldv + (wid >> 2) * 32 + (lane & 3) * 8;
    const int k2d = __builtin_amdgcn_readfirstlane((8 + (wid & 3) - wid) * 1024);
    const unsigned lds0 = (unsigned)(uintptr_t)lds;
#define A2_DMA(t, s) do { const size_t ro_ = (size_t)(t) * 64; const unsigned sb_ = (unsigned)__builtin_amdgcn_readfirstlane((int)(lds0 + (unsigned)((s) * STG + wid * 1024))); \
        glds16(ksrc + ro_ * ldk, sb_); \
        if (DQ == 96) glds16(ksrc + ro_ * ldk + k2off, sb_ + (unsigned)k2d); \
        glds16(vsrc + ro_ * ldv, sb_ + (unsigned)VOFF); } while (0)
    A2_DMA(t0, 0);
    asm volatile("s_waitcnt vmcnt(0)" ::: "memory");
    constexpr float THR = 8.0f;
    float mA = 0.f, mB = 0.f, lA = 0.f, lB = 0.f;
    f32x16 oa[2], ob[2];
#pragma unroll
    for (int r = 0; r < 16; ++r) { oa[0][r] = 0.f; oa[1][r] = 0.f; ob[0][r] = 0.f; ob[1][r] = 0.f; }
    __syncthreads();
#define A2_TILE(t, FIRST) do { \
        const int cur = ((t) - t0) & 1; \
        if ((t) < t1) A2_DMA((t) + 1, cur ^ 1); \
        const LAS unsigned char* Ks = lds + cur * STG; \
        const LAS unsigned char* kb = Ks + hi * 1024 + r32 * 16; \
        f32x16 a0, a1, b0, b1; \
        { const float na = -mA, nb = -mB; \
          _Pragma("unroll") for (int r = 0; r < 16; ++r) { a0[r] = na; a1[r] = na; b0[r] = nb; b1[r] = nb; } } \
        __builtin_amdgcn_s_setprio(1); \
        { bf16x8 k0 = *(const LAS bf16x8*)(kb), k1 = *(const LAS bf16x8*)(kb + 512);        \
          _Pragma("unroll") for (int d0 = 0; d0 < ND; ++d0) { \
            bf16x8 n0 = k0, n1 = k1; \
            if (d0 + 1 < ND) { n0 = *(const LAS bf16x8*)(kb + (d0 + 1) * 2048); n1 = *(const LAS bf16x8*)(kb + (d0 + 1) * 2048 + 512); } \
            a0 = __builtin_amdgcn_mfma_f32_32x32x16_bf16(k0, qa[d0], a0, 0, 0, 0); \
            b0 = __builtin_amdgcn_mfma_f32_32x32x16_bf16(k0, qb[d0], b0, 0, 0, 0); \
            a1 = __builtin_amdgcn_mfma_f32_32x32x16_bf16(k1, qa[d0], a1, 0, 0, 0); \
            b1 = __builtin_amdgcn_mfma_f32_32x32x16_bf16(k1, qb[d0], b1, 0, 0, 0); \
            k0 = n0; k1 = n1; \
            __builtin_amdgcn_sched_barrier(0); } } \
        __builtin_amdgcn_s_setprio(0); \
        float rA = -INFINITY, rB = -INFINITY; \
        _Pragma("unroll") for (int r = 0; r < 16; ++r) { rA = fmaxf(fmaxf(rA, a0[r]), a1[r]); rB = fmaxf(fmaxf(rB, b0[r]), b1[r]); } \
        { auto rr = __builtin_amdgcn_permlane32_swap(__float_as_uint(rA), __float_as_uint(rA), false, false); rA = fmaxf(__uint_as_float(rr[0]), __uint_as_float(rr[1])); } \
        { auto rr = __builtin_amdgcn_permlane32_swap(__float_as_uint(rB), __float_as_uint(rB), false, false); rB = fmaxf(__uint_as_float(rr[0]), __uint_as_float(rr[1])); } \
        if (FIRST) { mA = rA; mB = rB; \
            _Pragma("unroll") for (int r = 0; r < 16; ++r) { a0[r] -= rA; a1[r] -= rA; b0[r] -= rB; b1[r] -= rB; } } \
        float sA = 0.f, sB = 0.f; \
        _Pragma("unroll") for (int r = 0; r < 16; ++r) { a0[r] = __builtin_amdgcn_exp2f(a0[r]); a1[r] = __builtin_amdgcn_exp2f(a1[r]); b0[r] = __builtin_amdgcn_exp2f(b0[r]); b1[r] = __builtin_amdgcn_exp2f(b1[r]); \
            sA += a0[r] + a1[r]; sB += b0[r] + b1[r]; } \
        lA += sA; lB += sB; \
        u32x4 pa[4], pb[4]; \
        _Pragma("unroll") for (int j = 0; j < 4; ++j) { pa[0][j] = cvt_pk_bf16(a0[2 * j], a0[2 * j + 1]); pa[1][j] = cvt_pk_bf16(a0[8 + 2 * j], a0[8 + 2 * j + 1]); \
                                      pa[2][j] = cvt_pk_bf16(a1[2 * j], a1[2 * j + 1]); pa[3][j] = cvt_pk_bf16(a1[8 + 2 * j], a1[8 + 2 * j + 1]); \
                                      pb[0][j] = cvt_pk_bf16(b0[2 * j], b0[2 * j + 1]); pb[1][j] = cvt_pk_bf16(b0[8 + 2 * j], b0[8 + 2 * j + 1]); \
                                      pb[2][j] = cvt_pk_bf16(b1[2 * j], b1[2 * j + 1]); pb[3][j] = cvt_pk_bf16(b1[8 + 2 * j], b1[8 + 2 * j + 1]); } \
        const LAS unsigned char* vp = Ks + VOFF + ((lane >> 4) & 1) * 32 + (lane & 3) * 8 + (4 * hi + ((lane & 15) >> 2)) * 64; \
        __builtin_amdgcn_s_setprio(1); \
        { s16x4 lo = vtr(vp), hh = vtr(vp + 512); \
          __builtin_amdgcn_sched_barrier(0); \
          _Pragma("unroll") for (int i = 0; i < 8; ++i) { \
            s16x4 nlo = lo, nhh = hh; \
            if (i + 1 < 8) { nlo = vtr(vp + ((i + 1) >> 2) * 4096 + ((i + 1) & 3) * 1024); nhh = vtr(vp + ((i + 1) >> 2) * 4096 + ((i + 1) & 3) * 1024 + 512); } \
            const bf16x8 vf = (bf16x8){lo[0], lo[1], lo[2], lo[3], hh[0], hh[1], hh[2], hh[3]}; \
            oa[i >> 2] = __builtin_amdgcn_mfma_f32_32x32x16_bf16(__builtin_bit_cast(bf16x8, pa[i & 3]), vf, oa[i >> 2], 0, 0, 0); \
            ob[i >> 2] = __builtin_amdgcn_mfma_f32_32x32x16_bf16(__builtin_bit_cast(bf16x8, pb[i & 3]), vf, ob[i >> 2], 0, 0, 0); \
            lo = nlo; hh = nhh; \
            __builtin_amdgcn_sched_barrier(0); } } \
        __builtin_amdgcn_s_setprio(0); \
        if (!(FIRST) && __any(rA > THR || rB > THR)) { \
            const float dA = fmaxf(rA, 0.f), dB = fmaxf(rB, 0.f); mA += dA; mB += dB; \
            const float fA = __builtin_amdgcn_exp2f(-dA), fB = __builtin_amdgcn_exp2f(-dB); \
            lA *= fA; lB *= fB; \
            if (hi == 0) { wsf[r32] = fA; wsf[32 + r32] = fB; } \
            asm volatile("s_waitcnt lgkmcnt(0)" ::: "memory"); \
            _Pragma("unroll") for (int g4 = 0; g4 < 4; ++g4) { const f32x4 f4 = *(const LAS f32x4*)(wsf + 8 * g4 + 4 * hi), h4 = *(const LAS f32x4*)(wsf + 32 + 8 * g4 + 4 * hi); \
                _Pragma("unroll") for (int j = 0; j < 4; ++j) { oa[0][4 * g4 + j] *= f4[j]; oa[1][4 * g4 + j] *= f4[j]; ob[0][4 * g4 + j] *= h4[j]; ob[1][4 * g4 + j] *= h4[j]; } } \
            asm volatile("s_waitcnt lgkmcnt(0)" ::: "memory"); \
        } \
        asm volatile("s_waitcnt vmcnt(0)" ::: "memory"); \
        __syncthreads(); } while (0)
    A2_TILE(t0, true);
    for (int t = t0 + 1; t <= t1; ++t) A2_TILE(t, false);
#undef A2_TILE
#undef A2_DMA
    { auto rr = __builtin_amdgcn_permlane32_swap(__float_as_uint(lA), __float_as_uint(lA), false, false); lA = __uint_as_float(rr[0]) + __uint_as_float(rr[1]); }
    { auto rr = __builtin_amdgcn_permlane32_swap(__float_as_uint(lB), __float_as_uint(lB), false, false); lB = __uint_as_float(rr[0]) + __uint_as_float(rr[1]); }
    if (hi == 0) { wsf[64 + r32] = lA; wsf[96 + r32] = lB; }
    asm volatile("s_waitcnt lgkmcnt(0)" ::: "memory");
    LAS bf16_t* stg = (LAS bf16_t*)(lds + LDS_OST) + wid * 2048;
#pragma unroll
    for (int blk = 0; blk < 2; ++blk) {
        float rli[16];
#pragma unroll
        for (int g4 = 0; g4 < 4; ++g4) { const f32x4 l4 = *(const LAS f32x4*)(wsf + 64 + 32 * blk + 8 * g4 + 4 * hi);
#pragma unroll
            for (int j = 0; j < 4; ++j) rli[4 * g4 + j] = __builtin_amdgcn_rcpf(l4[j]); }
#pragma unroll
        for (int r = 0; r < 16; ++r) { const int orow = crow(r, hi);
#pragma unroll
            for (int d0 = 0; d0 < 2; ++d0) stg[orow * 64 + d0 * 32 + r32] = f2bf((blk == 0 ? oa[d0][r] : ob[d0][r]) * rli[r]); }
        asm volatile("s_waitcnt lgkmcnt(0)" ::: "memory");
        bf16_t* Ow = (blk == 0 ? OpA : OpB) + (size_t)wq0 * ldo;
#pragma unroll
        for (int i = 0; i < 4; ++i) { const int row = i * 8 + (lane >> 3), ch = lane & 7; const u32x4 v = *(const LAS u32x4*)(stg + row * 64 + ch * 8);
            if constexpr (O8) { *(GAS u32x2*)((unsigned char*)(blk == 0 ? OpA : OpB) + (size_t)(wq0 + row) * ldo + ch * 8) = bf8_to_fp8x8(v); } else { *(GAS u32x4*)(Ow + (size_t)row * ldo + ch * 8) = v; } }
        asm volatile("s_waitcnt lgkmcnt(0)" ::: "memory");
    }
}
}
constexpr size_t MiB = 1u << 20;
constexpr size_t WS_CTL = 0, CTL_ZERO_BYTES = 1 * MiB;
constexpr size_t WS_MOD = 1 * MiB;
constexpr size_t WS_ROPE = 2 * MiB;

constexpr size_t WS_TOKES = 3 * MiB;
constexpr size_t WS_TOKW = 3 * MiB + 512 * 1024;
constexpr size_t WS_LIST = 4 * MiB;
constexpr size_t WS_W = 8 * MiB;
constexpr size_t W_IN = 0, W_UQ = W_IN + (size_t)NPROJ * 1024 * 2, W_UKV = W_UQ + 512 * 256 * 2, W_BR = W_UKV + 512 * 256 * 2, W_OUT = W_BR + (size_t)4 * 1024 * 256 * 2,
                 W_RT = W_OUT + (size_t)1024 * 1024 * 2, W_E13 = W_RT + 256 * 1024 * 2, W_E2 = W_E13 + (size_t)32 * 512 * 1024 * 2, W_END = W_E2 + (size_t)32 * 1024 * 256 * 2;
static_assert(W_END <= 66 * MiB, "weights region");
constexpr size_t WS_HB = 74 * MiB;
constexpr size_t WS_QC = 138 * MiB, WS_KC = 162 * MiB, WS_VC = 186 * MiB;
constexpr size_t WS_PROJ = 202 * MiB;
constexpr size_t WS_HS = WS_PROJ, WS_YS = WS_PROJ + 40 * MiB;
constexpr size_t WS_END = WS_PROJ + (size_t)MTOK * (LDP * 2 + 4096);
constexpr size_t WS_XB = WS_END, WS_SSQ = WS_END + (size_t)MTOK * DM * 2, WS_END2 = WS_SSQ + (size_t)MTOK * 16 * 4;
static_assert((size_t)SORTROWS * 256 * 2 <= 40 * MiB && WS_YS + (size_t)SORTROWS * 1024 * 2 <= WS_END, "moe overlay");
constexpr size_t WS_W2 = WS_END2;
constexpr size_t WS_END3 = WS_W2 + 66 * MiB;
constexpr size_t WS_HB8 = WS_END3, WS_Y8 = WS_HB8 + (size_t)MTOK * DM, WS_END4 = WS_Y8 + (size_t)MTOK * DM;
constexpr size_t W_G8 = W_IN + (size_t)2304 * 1024 * 2;
constexpr int CW_BAR = 4096;
constexpr int CW_ECNT = 16384;
constexpr int RING_BYTES = 131072;
constexpr int LC_TEND = RING_BYTES, LC_CNT = RING_BYTES + 128, LC_BARW = RING_BYTES + 256, LC_XCH = RING_BYTES + 1024;
constexpr int LDS_BYTES = 147456;
constexpr int NWAVES = 8;

#define RLX_AGENT __ATOMIC_RELAXED, __HIP_MEMORY_SCOPE_AGENT

#define XB_TMO      128
#define XB_XCNT(j)  (256  + 64 * (j))
#define XB_XSUB(j)  (1280 + 64 * (j))
#define XB_XGEN(j)  (2304 + 64 * (j))
#define XB_TOP      3328
#define XB_TOPGEN   3392
#define XCD_BAR_WORDS 3456
#define XB_SPIN_CAP (1u << 18)
__device__ __forceinline__ unsigned xb_ld(unsigned* p)              { return __hip_atomic_load(p, __ATOMIC_RELAXED, __HIP_MEMORY_SCOPE_AGENT); }
__device__ __forceinline__ unsigned xb_add(unsigned* p, unsigned v) { return __hip_atomic_fetch_add(p, v, __ATOMIC_RELAXED, __HIP_MEMORY_SCOPE_AGENT); }
__device__ __forceinline__ unsigned xb_xcc_id() { return (unsigned)__builtin_amdgcn_s_getreg((3 << 11) | 20) & 0xFu; }
#define XB_SPIN(cond, bar) do { unsigned _sp = 0; while (cond) { __builtin_amdgcn_s_sleep(1); \
    if ((++_sp & 255u) == 0u) { if (xb_ld(&(bar)[XB_TMO])) break; if (_sp > XB_SPIN_CAP) { atomicAdd(&(bar)[XB_TMO], 1u); break; } } } } while (0)
struct XcdBarrier { unsigned* bar; unsigned x; volatile LAS unsigned* st; };
__device__ __forceinline__ XcdBarrier xcd_barrier_post(unsigned* bar, volatile LAS unsigned* st) {
    XcdBarrier b; b.bar = bar; b.x = xb_xcc_id(); b.st = st;
    if (threadIdx.x == 0) (void)xb_add(&bar[XB_XCNT(b.x)], 1u);
    return b;
}
__device__ __forceinline__ void xcd_barrier_complete(unsigned* bar, unsigned x, unsigned& nloc, unsigned& nx) {
    const unsigned G = gridDim.x * gridDim.y * gridDim.z;
    unsigned sum, cnt, mine, sp = 0u;
    for (;;) {
        sum = 0u; cnt = 0u; mine = 0u;
#pragma unroll
        for (unsigned j = 0; j < 16; ++j) { const unsigned c = xb_ld(&bar[XB_XCNT(j)]); sum += c; cnt += (c > 0u) ? 1u : 0u; mine = (j == x) ? c : mine; }
        if (sum == G) break;
        __builtin_amdgcn_s_sleep(1);
        if ((++sp & 255u) == 0u) { if (xb_ld(&bar[XB_TMO])) break; if (sp > XB_SPIN_CAP) { atomicAdd(&bar[XB_TMO], 1u); break; } }
    }
    nloc = mine > 0u ? mine : 1u; nx = cnt > 0u ? cnt : 1u;
}
__device__ __forceinline__ void xcd_barrier(const XcdBarrier& b, const bool leader) {
    asm volatile("s_waitcnt vmcnt(0)" ::: "memory");
    __syncthreads();
    if (leader) {
        unsigned* bar = b.bar;
        __builtin_amdgcn_s_waitcnt(0);
        unsigned nloc = b.st[0], nx = b.st[1];
        if (nloc == 0u) { xcd_barrier_complete(bar, b.x, nloc, nx); b.st[0] = nloc; b.st[1] = nx; }
        const unsigned old = xb_add(&bar[XB_XSUB(b.x)], 1u);
        const unsigned gen = old / nloc;
        if (old + 1u == (gen + 1u) * nloc) {
            __builtin_amdgcn_fence(__ATOMIC_RELEASE, "agent");
            asm volatile("s_waitcnt vmcnt(0)" ::: "memory");
            const unsigned og = xb_add(&bar[XB_TOP], 1u);
            const unsigned tg = og / nx;
            if (og + 1u == (tg + 1u) * nx) xb_add(&bar[XB_TOPGEN], 1u);
            else XB_SPIN(xb_ld(&bar[XB_TOPGEN]) == tg, bar);
            __builtin_amdgcn_fence(__ATOMIC_ACQUIRE, "agent");
            xb_add(&bar[XB_XGEN(b.x)], 1u);
            asm volatile("s_waitcnt vmcnt(0)" ::: "memory");
        } else {
            XB_SPIN(xb_ld(&bar[XB_XGEN(b.x)]) == gen, bar);
            __builtin_amdgcn_fence(__ATOMIC_ACQUIRE, "agent");
            asm volatile("s_waitcnt vmcnt(0)" ::: "memory");
        }
    }
    __syncthreads();
}

struct Frame {
    LAS unsigned char* lds;
    unsigned* ctl;
    int tid, lane, wave, vcu, G;
    float* out; unsigned char* ws;
};
struct Args { const float* in[25]; float* out; unsigned char* ws; int ph_lo, ph_hi; };
#define GIN(i) ((const float*)(const GAS float*)KA.in[i])
__device__ __forceinline__ float wave_sum(float v) {
    v += xshfl<1>(v); v += xshfl<2>(v); v += xshfl<4>(v); v += xshfl<8>(v); v += xshfl<16>(v); v += xshfl<32>(v);
    return v;
}
#define LDS_WAIT() asm volatile("s_waitcnt lgkmcnt(0)" ::: "memory")

__device__ __forceinline__ void p0_phase(Frame& F, const Args& KA) {
    LAS float* cact = (LAS float*)F.lds;
    LAS float* part = (LAS float*)(F.lds + 32768);
    const float* c = GIN(1); const float* w_ada = GIN(2); const float* b_ada = GIN(3);
    float* mod = (float*)(F.ws + WS_MOD);
    for (int i = F.tid; i < NB * DM; i += NWAVES * 64) { const float v = c[i]; cact[i] = v / (1.0f + __expf(-v)); }
    __syncthreads();
    for (int cb = blockIdx.x; cb < DEPTH * 96; cb += F.G) {
        const int l = cb / 96, n0 = (cb % 96) * 64;
        const float* w = w_ada + ((size_t)l * DM + F.wave * 128) * 6144 + n0 + F.lane;
        float acc[NB];
#pragma unroll
        for (int b = 0; b < NB; ++b) acc[b] = 0.f;
#pragma unroll 8
        for (int k = 0; k < 128; ++k) { const float wv = w[(size_t)k * 6144];
#pragma unroll
            for (int b = 0; b < NB; ++b) acc[b] += cact[b * DM + F.wave * 128 + k] * wv; }
#pragma unroll
        for (int b = 0; b < NB; ++b) part[(F.wave * NB + b) * 64 + F.lane] = acc[b];
        __syncthreads();
        { const int b = F.tid >> 6; float s = b_ada[l * 6144 + n0 + F.lane];
#pragma unroll
          for (int w8 = 0; w8 < NWAVES; ++w8) s += part[(w8 * NB + b) * 64 + F.lane];
          mod[((size_t)l * NB + b) * 6144 + n0 + F.lane] = s; }
        __syncthreads();
    }
    float* cs = (float*)(F.ws + WS_ROPE);
    for (int id = blockIdx.x * (NWAVES * 64) + F.tid; id < SEQ * 16; id += F.G * NWAVES * 64) {
        const int pos = id >> 4, f = id & 15;
        const float inv = powf(10000.0f, -(float)(2 * f) / 32.0f);
        const float ang = (float)pos * inv;
        cs[id] = cosf(ang); cs[SEQ * 16 + id] = sinf(ang);
    }
}

template <class RowMap>
__device__ __forceinline__ void transpose_item(const float* W, int ldw, int k0, int n0, bf16_t* WT, int ldt, const RowMap& rm, LAS float* scr, int lane, const float* kscale = nullptr, float cscale = 1.0f) {
    { const float* wp = (const float*)(const GAS float*)W + (size_t)(k0 + (lane >> 5)) * ldw + n0 + (lane & 31);
      float wv[32];
#pragma unroll
      for (int i = 0; i < 32; ++i) wv[i] = *(const GAS float*)(wp + (size_t)(2 * i) * ldw);
#pragma unroll
      for (int i = 0; i < 32; ++i) { const int kk = 2 * i + (lane >> 5); float v = wv[i]; if (kscale) v *= kscale[k0 + kk]; scr[kk * 33 + (lane & 31)] = v * cscale; } }
    LDS_WAIT(); asm volatile("" ::: "memory");
    const int c = lane & 7;
#pragma unroll
    for (int j = 0; j < 4; ++j) { const int n = (lane >> 3) + 8 * j; const LAS float* s = scr + (8 * c) * 33 + n;
        u32x4 o; o.x = cvt_pk_bf16(s[0 * 33], s[1 * 33]); o.y = cvt_pk_bf16(s[2 * 33], s[3 * 33]); o.z = cvt_pk_bf16(s[4 * 33], s[5 * 33]); o.w = cvt_pk_bf16(s[6 * 33], s[7 * 33]);
        *(u32x4*)(WT + (size_t)rm(n0 + n) * ldt + k0 + 8 * c) = o; }
    LDS_WAIT(); asm volatile("" ::: "memory");
}
__device__ __forceinline__ void transpose_item_f8(const float* W, int ldw, int k0, int n0, unsigned char* WT, int ldt, int nbase, LAS float* scr, int lane, float cscale) {
    { const float* wp = (const float*)(const GAS float*)W + (size_t)(k0 + (lane >> 5)) * ldw + n0 + (lane & 31);
      float wv[32];
#pragma unroll
      for (int i = 0; i < 32; ++i) wv[i] = *(const GAS float*)(wp + (size_t)(2 * i) * ldw);
#pragma unroll
      for (int i = 0; i < 32; ++i) { const int kk = 2 * i + (lane >> 5); scr[kk * 33 + (lane & 31)] = wv[i] * cscale; } }
    LDS_WAIT(); asm volatile("" ::: "memory");
    const int c = lane & 7;
#pragma unroll
    for (int j = 0; j < 4; ++j) { const int n = (lane >> 3) + 8 * j; const LAS float* s = scr + (8 * c) * 33 + n;
        u32x2 o; o.x = pk_fp8x4(s[0 * 33], s[1 * 33], s[2 * 33], s[3 * 33]); o.y = pk_fp8x4(s[4 * 33], s[5 * 33], s[6 * 33], s[7 * 33]);
        *(u32x2*)(WT + (size_t)(n0 + n - nbase) * ldt + k0 + 8 * c) = o; }
    LDS_WAIT(); asm volatile("" ::: "memory");
}
__device__ __forceinline__ int pairpos(int j) { const int f = j & 15, p = j >> 4; return 8 * (f >> 2) + 4 * p + (f & 3); }
struct MapIn   { __device__ __forceinline__ int operator()(int n) const {
    if (n < 1280) return n;
    if (n < 1728) return n + 512;
    if (n < 1760) return 2240 + pairpos(n - 1728);
    if (n < 2144) { const int d = n - 1760; return 1280 + (d & ~31) + pairpos(d & 31); }
    if (n < 2272) return n - 480;
    return n + 32; } };
struct MapId   { __device__ __forceinline__ int operator()(int n) const { return n; } };
struct MapUkv  { __device__ __forceinline__ int operator()(int n) const { const int h = n >> 7, j = n & 127; return j < 64 ? 64 * h + j : 256 + 64 * h + (j - 64); } };
struct MapE13  { int add; __device__ __forceinline__ int operator()(int n) const { return 8 * (n >> 2) + (n & 3) + add; } };

__device__ __forceinline__ void convert_weights(Frame& F, const Args& KA, int l, unsigned char* wb, int it_lo, int it_hi, int gw, int NGW, bool smalls) {
    LAS float* scr = (LAS float*)(F.lds + F.wave * 16384);
    const float* w_in = GIN(6) + (size_t)l * DM * 6368;
    const float* w_ukv = GIN(12) + (size_t)l * 256 * 512;
    const float* w_br = GIN(15) + (size_t)l * 4 * 256 * DM;
    const float* w_out = GIN(16) + (size_t)l * DM * DM;
    const float* w_e1 = GIN(21) + (size_t)l * NEXP * DM * 256;
    const float* w_e3 = GIN(22) + (size_t)l * NEXP * DM * 256;
    const float* w_e2 = GIN(23) + (size_t)l * NEXP * 256 * DM;
    constexpr int I_IN = 16 * 199, I_BR = 4 * 4 * 32, I_OUT = 16 * 32, I_UKV = 4 * 16, I_E1 = NEXP * 16 * 8, I_E2 = NEXP * 4 * 32;
    constexpr int NITEMS = I_IN + I_BR + I_OUT + I_UKV + 2 * I_E1 + I_E2;
    if (it_hi > NITEMS) it_hi = NITEMS;
    for (int it = it_lo + gw; it < it_hi; it += NGW) {
        int r = it;
        if (r < I_IN) { const int kb = r / 199, nb = r % 199;
            if (nb >= 71) transpose_item_f8(w_in, 6368, 64 * kb, 32 * nb, wb + W_G8, DM, 2272, scr, F.lane, -LOG2E * pg8::GATE_WSCALE);
            else transpose_item(w_in, 6368, 64 * kb, 32 * nb, (bf16_t*)(wb + W_IN), DM, MapIn{}, scr, F.lane); continue; } r -= I_IN;
        if (r < I_BR) { const int n = r >> 7, q = r & 127, kb = q >> 5, nb = q & 31; transpose_item_f8(w_br + (size_t)n * 256 * DM, DM, 64 * kb, 32 * nb, wb + W_BR + (size_t)n * DM * 256, 256, 0, scr, F.lane, pg8::MERGE_WSCALE); continue; } r -= I_BR;
        if (r < I_OUT) { const int kb = r >> 5, nb = r & 31; transpose_item(w_out, DM, 64 * kb, 32 * nb, (bf16_t*)(wb + W_OUT), DM, MapId{}, scr, F.lane); continue; } r -= I_OUT;
        if (r < I_UKV) { const int kb = r >> 4, nb = r & 15; transpose_item(w_ukv, 512, 64 * kb, 32 * nb, (bf16_t*)(wb + W_UKV), 256, MapUkv{}, scr, F.lane, GIN(10) + l * 256); continue; } r -= I_UKV;
        if (r < I_E1) { const int e = r >> 7, q = r & 127, kb = q >> 3, nb = q & 7; transpose_item(w_e1 + (size_t)e * DM * 256, 256, 64 * kb, 32 * nb, (bf16_t*)(wb + W_E13) + (size_t)e * 512 * DM, DM, MapE13{0}, scr, F.lane); continue; } r -= I_E1;
        if (r < I_E1) { const int e = r >> 7, q = r & 127, kb = q >> 3, nb = q & 7; transpose_item(w_e3 + (size_t)e * DM * 256, 256, 64 * kb, 32 * nb, (bf16_t*)(wb + W_E13) + (size_t)e * 512 * DM, DM, MapE13{4}, scr, F.lane); continue; } r -= I_E1;
        { const int e = r >> 7, q = r & 127, kb = q >> 5, nb = q & 31; transpose_item(w_e2 + (size_t)e * 256 * DM, DM, 64 * kb, 32 * nb, (bf16_t*)(wb + W_E2) + (size_t)e * DM * 256, 256, MapId{}, scr, F.lane); }
    }
    if (!smalls) return;
    const float* w_uq = GIN(11) + (size_t)l * 192 * 384;
    const float* w_g = GIN(17) + (size_t)l * DM * 4;
    const float* w_r = GIN(19) + (size_t)l * DM * 32;
    bf16_t* uq = (bf16_t*)(wb + W_UQ); bf16_t* rt = (bf16_t*)(wb + W_RT); bf16_t* win = (bf16_t*)(wb + W_IN);
    const int gt = blockIdx.x * (NWAVES * 64) + F.tid, NT = F.G * NWAVES * 64;
    for (int i = gt; i < 512 * 256; i += NT) {
        const int r = i >> 8, k = i & 255; float v = 0.f;
        if (r < 384 && k < 192) { const int h = r / 96, j = r % 96; int src;
            if (j < 64) src = 96 * h + j;
            else { const int q = j - 64, fb = q >> 3, p = (q >> 2) & 1, f = 4 * fb + (q & 3); src = 96 * h + 64 + 16 * p + f; }
            v = w_uq[(size_t)k * 384 + src] * GIN(9)[l * 192 + k]; }
        uq[i] = f2bf(v);
    }
    for (int i = gt; i < 256 * DM; i += NT) {
        const int r = i >> 10, k = i & 1023; float v = 0.f;
        if (r < 4) v = w_g[k * 4 + r]; else if (r < 36) v = w_r[k * 32 + (r - 4)];
        rt[i] = f2bf(v);
    }
    for (int i = gt; i < 32 * DM; i += NT) win[(size_t)2272 * DM + i] = 0;
}

__device__ __forceinline__ void load_moe_tables(Frame& F, int l) {
    LAS int* tend = (LAS int*)(F.lds + LC_TEND); LAS int* cnt = (LAS int*)(F.lds + LC_CNT);
    if (F.tid < NEXP) cnt[F.tid] = (int)__hip_atomic_load(F.ctl + CW_ECNT + 64 * l + F.tid, RLX_AGENT);
    __syncthreads();
    if (F.tid == 0) { int acc = 0; for (int e = 0; e < NEXP; ++e) { acc += (cnt[e] + 255) >> 8; tend[e] = acc; } }
    __syncthreads();
}

__device__ __forceinline__ void norm_phase(Frame& F, const float* xsrc, const bf16_t* xbsrc, bf16_t* xdst, bool combine, const float* g2prev, const float* gain, const float* shv, const float* scv,
                                           bf16_t* hout, float* fout, const bf16_t* delta = nullptr, unsigned char* h8out = nullptr) {
    const int gw = F.vcu * NWAVES + F.wave, NGW = F.G * NWAVES;
    const int rpw = (((MTOK + NGW - 1) / NGW) + 3) & ~3;
    int m0 = gw * rpw, m1 = m0 + rpw; m1 = m1 > MTOK ? MTOK : m1;
    const LAS int* tend = (const LAS int*)(F.lds + LC_TEND);
    const int* tok_es = (const int*)(F.ws + WS_TOKES); const float* tok_w = (const float*)(F.ws + WS_TOKW);
    const bf16_t* YS = (const bf16_t*)(F.ws + WS_YS);
    f32x4 A[4], B[4], G2[4]; int bcur = -1;
#pragma unroll
    for (int j = 0; j < 4; ++j) { A[j] = (f32x4){0.f, 0.f, 0.f, 0.f}; B[j] = A[j]; G2[j] = A[j]; }
    const int lc = 4 * F.lane;
    for (int m = m0; m < m1; m += 4) {
        const int b = m >> 12;
        if (b != bcur) { bcur = b;
#pragma unroll
            for (int j = 0; j < 4; ++j) { const int col = lc + 256 * j; const f32x4 gn = *(const f32x4*)(gain + col);
                if (scv) { const f32x4 sc = *(const f32x4*)(scv + b * 6144 + col); A[j] = gn * (sc + 1.0f); B[j] = *(const f32x4*)(shv + b * 6144 + col); } else { A[j] = gn; }
                if (combine) G2[j] = *(const f32x4*)(g2prev + b * 6144 + col); } }
        f32x4 v[4][4];
        if (xbsrc) {
            u32x2 xb[4][4];
#pragma unroll
            for (int r = 0; r < 4; ++r)
#pragma unroll
                for (int j = 0; j < 4; ++j) xb[r][j] = __builtin_nontemporal_load((const GAS u32x2*)(xbsrc + (size_t)(m + r) * DM + lc + 256 * j));
#pragma unroll
            for (int r = 0; r < 4; ++r)
#pragma unroll
                for (int j = 0; j < 4; ++j) { const u32x2 y0 = xb[r][j]; v[r][j] = (f32x4){bflo(y0.x), bfhi(y0.x), bflo(y0.y), bfhi(y0.y)}; }
        } else {
#pragma unroll
            for (int r = 0; r < 4; ++r)
#pragma unroll
                for (int j = 0; j < 4; ++j) v[r][j] = *(const GAS f32x4*)(xsrc + (size_t)(m + r) * DM + lc + 256 * j);
        }
        if (delta) {
            u32x2 dl[4][4];
#pragma unroll
            for (int r = 0; r < 4; ++r)
#pragma unroll
                for (int j = 0; j < 4; ++j) dl[r][j] = *(const GAS u32x2*)(delta + (size_t)(m + r) * DM + lc + 256 * j);
#pragma unroll
            for (int r = 0; r < 4; ++r)
#pragma unroll
                for (int j = 0; j < 4; ++j) { const u32x2 y0 = dl[r][j]; v[r][j] = v[r][j] + (f32x4){bflo(y0.x), bfhi(y0.x), bflo(y0.y), bfhi(y0.y)}; }
            if (xdst) {
#pragma unroll
                for (int r = 0; r < 4; ++r)
#pragma unroll
                    for (int j = 0; j < 4; ++j) { u32x2 w_; w_.x = cvt_pk_bf16(v[r][j].x, v[r][j].y); w_.y = cvt_pk_bf16(v[r][j].z, v[r][j].w); *(GAS u32x2*)(xdst + (size_t)(m + r) * DM + lc + 256 * j) = w_; } }
        }
        if (combine) {
            int es[4][2]; float ww[4][2];
#pragma unroll
            for (int r = 0; r < 4; ++r) { es[r][0] = tok_es[2 * (m + r)]; es[r][1] = tok_es[2 * (m + r) + 1]; ww[r][0] = tok_w[2 * (m + r)]; ww[r][1] = tok_w[2 * (m + r) + 1]; }
            u32x2 y[4][2][4];
#pragma unroll
            for (int r = 0; r < 4; ++r)
#pragma unroll
                for (int k = 0; k < 2; ++k) { const int e = es[r][k] >> 16; const int rr = 256 * (e ? tend[e - 1] : 0) + (es[r][k] & 0xffff);
#pragma unroll
                    for (int j = 0; j < 4; ++j) y[r][k][j] = __builtin_nontemporal_load((const GAS u32x2*)(YS + (size_t)rr * DM + lc + 256 * j)); }
#pragma unroll
            for (int r = 0; r < 4; ++r)
#pragma unroll
                for (int j = 0; j < 4; ++j) { const u32x2 y0 = y[r][0][j], y1 = y[r][1][j];
                    const f32x4 a = (f32x4){bflo(y0.x), bfhi(y0.x), bflo(y0.y), bfhi(y0.y)}, c = (f32x4){bflo(y1.x), bfhi(y1.x), bflo(y1.y), bfhi(y1.y)};
                    v[r][j] = v[r][j] + G2[j] * (a * ww[r][0] + c * ww[r][1]); }
            if (xdst) {
#pragma unroll
                for (int r = 0; r < 4; ++r)
#pragma unroll
                    for (int j = 0; j < 4; ++j) { u32x2 w_; w_.x = cvt_pk_bf16(v[r][j].x, v[r][j].y); w_.y = cvt_pk_bf16(v[r][j].z, v[r][j].w); *(GAS u32x2*)(xdst + (size_t)(m + r) * DM + lc + 256 * j) = w_; } }
        }
        float s[4];
#pragma unroll
        for (int r = 0; r < 4; ++r) { s[r] = 0.f;
#pragma unroll
            for (int j = 0; j < 4; ++j) s[r] += (v[r][j].x * v[r][j].x + v[r][j].y * v[r][j].y) + (v[r][j].z * v[r][j].z + v[r][j].w * v[r][j].w); }
#pragma unroll
        for (int r = 0; r < 4; ++r) s[r] += xshfl<1>(s[r]);
#pragma unroll
        for (int r = 0; r < 4; ++r) s[r] += xshfl<2>(s[r]);
#pragma unroll
        for (int r = 0; r < 4; ++r) s[r] += xshfl<4>(s[r]);
#pragma unroll
        for (int r = 0; r < 4; ++r) s[r] += xshfl<8>(s[r]);
#pragma unroll
        for (int r = 0; r < 4; ++r) s[r] += xshfl<16>(s[r]);
#pragma unroll
        for (int r = 0; r < 4; ++r) s[r] += xshfl<32>(s[r]);
#pragma unroll
        for (int r = 0; r < 4; ++r) { const float rstd = rsqrtf(s[r] * (1.0f / DM) + EPS);
#pragma unroll
            for (int j = 0; j < 4; ++j) { const f32x4 o = v[r][j] * rstd * A[j] + B[j];
                if (hout) { u32x2 w; w.x = cvt_pk_bf16(o.x, o.y); w.y = cvt_pk_bf16(o.z, o.w); *(GAS u32x2*)(hout + (size_t)(m + r) * DM + lc + 256 * j) = w; }
                if (h8out) *(GAS unsigned*)(h8out + (size_t)(m + r) * DM + lc + 256 * j) = pk_fp8x4(o.x, o.y, o.z, o.w);
                if (fout) *(GAS f32x4*)(fout + (size_t)(m + r) * DM + lc + 256 * j) = o; } }
    }
}

__device__ __forceinline__ void prep_phase(Frame& F, const Args& KA, int l, bool dummy = false) {
    const int gw = F.vcu * NWAVES + F.wave, NGW = F.G * NWAVES;
    bf16_t* P = (bf16_t*)(F.ws + WS_PROJ); bf16_t* KC = (bf16_t*)(F.ws + WS_KC);
    const float* cs = (const float*)(F.ws + WS_ROPE);
    const float* gq = GIN(9) + l * 192; const float* gkv = GIN(10) + l * 256; const float* gaq = GIN(13) + l * 64; const float* gak = GIN(14) + l * 64;
    const int lane = F.lane;
    const float g_q0 = gq[lane], g_q1 = gq[lane + 64], g_q2 = gq[lane + 128];
    const float g_kv0 = gkv[lane], g_kv1 = gkv[lane + 64], g_kv2 = gkv[lane + 128], g_kv3 = gkv[lane + 192];
    const float g_aq = gaq[lane], g_ak = gak[lane];
    const int rpw = (((MTOK + NGW - 1) / NGW) + 3) & ~3;
    int m0 = gw * rpw, m1 = m0 + rpw; m1 = m1 > MTOK ? MTOK : m1;
    const int f15 = lane & 15;
    for (int mg = m0; mg < m1; mg += 4) {
        float cq[4][3], ckv[4][4], kr1[4], kr2[4], ax[4][6];
#pragma unroll
        for (int r = 0; r < 4; ++r) { const bf16_t* row = P + (size_t)(mg + r) * LDP;
#pragma unroll
            for (int k = 0; k < 3; ++k) cq[r][k] = bf2f(row[PC_CQ + 64 * k + lane]);
#pragma unroll
            for (int k = 0; k < 4; ++k) ckv[r][k] = bf2f(row[PC_CKV + 64 * k + lane]);
            kr1[r] = bf2f(row[PC_KR + f15]); kr2[r] = bf2f(row[PC_KR + 16 + f15]);
#pragma unroll
            for (int hh = 0; hh < 6; ++hh) ax[r][hh] = bf2f(row[(hh < 4 ? PC_AXQ + 64 * hh : PC_AXK + 64 * (hh - 4)) + lane]); }
        float ss[4][8];
#pragma unroll
        for (int r = 0; r < 4; ++r) { ss[r][0] = cq[r][0] * cq[r][0] + cq[r][1] * cq[r][1] + cq[r][2] * cq[r][2];
            ss[r][1] = ckv[r][0] * ckv[r][0] + ckv[r][1] * ckv[r][1] + ckv[r][2] * ckv[r][2] + ckv[r][3] * ckv[r][3];
#pragma unroll
            for (int hh = 0; hh < 6; ++hh) ss[r][2 + hh] = ax[r][hh] * ax[r][hh]; }
#define PREP_BFLY(M) _Pragma("unroll") for (int r = 0; r < 4; ++r) _Pragma("unroll") for (int q = 0; q < 8; ++q) ss[r][q] += xshfl<M>(ss[r][q]);
        PREP_BFLY(1) PREP_BFLY(2) PREP_BFLY(4) PREP_BFLY(8) PREP_BFLY(16) PREP_BFLY(32)
#undef PREP_BFLY
#pragma unroll
        for (int r = 0; r < 4; ++r) { const int m = mg + r; bf16_t* row = dummy ? (bf16_t*)(F.ws + WS_END2) + (size_t)(m & 255) * LDP : P + (size_t)m * LDP;
            const int pos = m & (SEQ - 1), gr = pos >> 6, gc = pos & 63;
            { const float rstd = rsqrtf(ss[r][0] * (1.0f / 192.0f) + EPS);
              row[PC_CQ + lane] = f2bf(cq[r][0] * rstd * g_q0); row[PC_CQ + 64 + lane] = f2bf(cq[r][1] * rstd * g_q1); row[PC_CQ + 128 + lane] = f2bf(cq[r][2] * rstd * g_q2); }
            { const float rstd = rsqrtf(ss[r][1] * (1.0f / 256.0f) + EPS);
              row[PC_CKV + lane] = f2bf(ckv[r][0] * rstd * g_kv0); row[PC_CKV + 64 + lane] = f2bf(ckv[r][1] * rstd * g_kv1); row[PC_CKV + 128 + lane] = f2bf(ckv[r][2] * rstd * g_kv2); row[PC_CKV + 192 + lane] = f2bf(ckv[r][3] * rstd * g_kv3); }
            if (lane < 16) { const int f = lane; const float x1 = kr1[r], x2 = kr2[r];
                const float c = cs[pos * 16 + f], s = cs[SEQ * 16 + pos * 16 + f];
                const unsigned short o1 = f2bf(x1 * c - x2 * s), o2 = f2bf(x1 * s + x2 * c);
                const int p1 = 8 * (f >> 2) + (f & 3), p2 = p1 + 4;
                bf16_t* kr = (dummy ? (bf16_t*)(F.ws + WS_END2) + (size_t)(m & 255) * LDP : KC + (size_t)m * 384) + 64;
#pragma unroll
                for (int h = 0; h < 4; ++h) { kr[96 * h + p1] = o1; kr[96 * h + p2] = o2; } }
            { const int idx = (lane < 32) ? gr : gc;
              const float c = cs[idx * 16 + f15], s = cs[SEQ * 16 + idx * 16 + f15];
#pragma unroll
              for (int hh = 0; hh < 6; ++hh) {
                  bf16_t* p = row + (hh < 4 ? PC_AXQ + 64 * hh : PC_AXK + 64 * (hh - 4)) + lane;
                  const float rstd = rsqrtf(ss[r][2 + hh] * (1.0f / 64.0f) + EPS);
                  const float y = ax[r][hh] * rstd * (hh < 4 ? g_aq * (0.125f * LOG2E) : g_ak);
                  const float pr = xshfl<16>(y);
                  const float o = (lane & 16) ? (pr * s + y * c) : (y * c - pr * s);
                  *p = f2bf(o);
              } }
        }
    }
}
__device__ __forceinline__ void attn_phase(Frame& F, const Args& KA, int l) {
    bf16_t* P = (bf16_t*)(F.ws + WS_PROJ); bf16_t* QC = (bf16_t*)(F.ws + WS_QC); bf16_t* KC = (bf16_t*)(F.ws + WS_KC); bf16_t* VC = (bf16_t*)(F.ws + WS_VC);
    unsigned char* Y8 = F.ws + WS_Y8;
    constexpr int NU = NB * 4 * (SEQ / 256);
#ifndef REP_C
#define REP_C 1
#endif
#ifndef C_UNIT2
#define C_UNIT2 1
#endif
    if (C_UNIT2) {
        for (int L = F.vcu; L < NU / 2; L += F.G) { const int bh = L >> 3, qb = L & 7, b = bh >> 2, h = bh & 3; const size_t rb = (size_t)b * SEQ;
            att::attn_unit2<96, true>(QC + rb * 384 + 96 * h, QC + (rb + 2048) * 384 + 96 * h, KC + rb * 384 + 96 * h, VC + rb * 256 + 64 * h,
                                (bf16_t*)(Y8 + rb * 1024 + 512 + 64 * h), (bf16_t*)(Y8 + (rb + 2048) * 1024 + 512 + 64 * h), 384, 384, 256, 1024, qb * 256, F.lds, F.wave * 64 + lane_now()); }
    } else
    for (int rep = 0; rep < REP_C; ++rep)
    for (int L = F.vcu; L < NU; L += F.G) { const int bh = L >> 4, qb = L & 15, b = bh >> 2, h = bh & 3; const size_t rb = (size_t)b * SEQ;
        att::attn_unit<96, 0>(QC + rb * 384 + 96 * h, KC + rb * 384 + 96 * h, VC + rb * 256 + 64 * h, P + rb * LDP + PC_YC + 64 * h, 384, 384, 256, LDP,
                              qb * 256, 0.10206207261596575f * LOG2E, 0.f, 0.f, nullptr, F.lds, F.wave * 64 + lane_now()); }
#ifndef REP_D
#define REP_D 1
#endif
#ifndef REP_B
#define REP_B 1
#endif
#ifndef REP_A
#define REP_A 1
#endif
    bf16_t* DUMMY = (bf16_t*)(F.ws + WS_END);
    for (int L = F.vcu; L < NU / 2; L += F.G) { const int bk = L >> 4, qb = L & 15, b = bk >> 1, kv = bk & 1; bf16_t* Pb = P + (size_t)b * SEQ * LDP;
        att::attn_unit2<64, true>(Pb + PC_AXQ + 128 * kv, Pb + PC_AXQ + 128 * kv + 64, Pb + PC_AXK + 64 * kv, Pb + PC_AXV + 64 * kv, (bf16_t*)(Y8 + (size_t)b * SEQ * 1024 + 768 + 128 * kv), (bf16_t*)(Y8 + (size_t)b * SEQ * 1024 + 768 + 128 * kv + 64),
                            LDP, LDP, LDP, 1024, qb * 256, F.lds, F.wave * 64 + lane_now()); }
    for (int rep = 0; rep < REP_B; ++rep)
    for (int L = F.vcu; L < NU; L += F.G) { const int bh = L >> 4, qb = L & 15, b = bh >> 2, h = bh & 3; bf16_t* Pb = P + (size_t)b * SEQ * LDP; const bool dm = rep < REP_B - 1;
        const float slope = exp2f(-2.0f * (float)(h + 1)); const float sink = GIN(8)[l * 4 + h];
        att::attn_unit<64, 1, 0, true>(Pb + PC_WQ + 64 * h, Pb + PC_WK + 64 * (h >> 1), Pb + PC_WV + 64 * (h >> 1), (bf16_t*)(Y8 + (size_t)b * SEQ * 1024 + 256 + 64 * h), LDP, LDP, LDP, 1024,
                              qb * 256, 0.125f * LOG2E, slope * LOG2E, sink * LOG2E, nullptr, F.lds, F.wave * 64 + lane_now()); }
    for (int rep = 0; rep < REP_A; ++rep)
    for (int L = F.vcu; L < NU; L += F.G) { const int bh = L >> 4, qb = L & 15, b = bh >> 2, h = bh & 3; bf16_t* Pb = P + (size_t)b * SEQ * LDP; const bool dm = rep < REP_A - 1;
        att::attn_unit<64, 2, 0, true>(Pb + PC_NAQ + 64 * h, Pb + PC_NAK + 64 * h, Pb + PC_NAV + 64 * h, (bf16_t*)(Y8 + (size_t)b * SEQ * 1024 + 64 * h), LDP, LDP, LDP, 1024,
                              qb * 256, 0.125f * LOG2E, 0.f, 0.f, GIN(7) + (size_t)(l * 4 + h) * (15 * 31), F.lds, F.wave * 64 + lane_now()); }
}

#ifndef REP_BAR
#define REP_BAR 1
#endif
#ifndef REP_G2
#define REP_G2 1
#endif
#ifndef REP_G3
#define REP_G3 1
#endif
#ifndef REP_G5
#define REP_G5 1
#endif
#ifndef REP_G6
#define REP_G6 1
#endif
#ifndef REP_AT
#define REP_AT 1
#endif
#ifndef REP_TH
#define REP_TH 1
#endif
#ifndef FILL_G1
#define FILL_G1 0
#endif
#ifndef FILL_GR
#define FILL_GR 0
#endif
#ifndef FILL_G5
#define FILL_G5 9216
#endif
#ifndef FILL_G6
#define FILL_G6 0
#endif
constexpr int FILL_A = FILL_G1, FILL_B = FILL_A + FILL_GR, FILL_C = FILL_B + FILL_G5, FILL_END = FILL_C + FILL_G6;
#define FILLER(lo, hi, skip) do { if ((hi) > (lo) && l + 1 < DEPTH && (int)blockIdx.x >= (skip) && F.G > (skip)) { __syncthreads(); \
        convert_weights(F, KA, l + 1, F.ws + (((l + 1) & 1) ? WS_W2 : WS_W), (lo), (hi), ((int)blockIdx.x - (skip)) * NWAVES + F.wave, (F.G - (skip)) * NWAVES, false); } } while (0)
constexpr int FILL_SKIP = 64;
constexpr int PH_PER_LAYER = 10, N_PHASES = 1 + DEPTH * PH_PER_LAYER + 1;

__global__ void __launch_bounds__(NWAVES * 64, 2) mk_fwd(Args KA) {
    extern __shared__ __attribute__((aligned(16))) unsigned char lds_raw[];
    { const int t0 = threadIdx.x; for (int u = t0; u < (LDS_BYTES - RING_BYTES) / 4; u += NWAVES * 64) ((LAS unsigned*)((LAS unsigned char*)lds_raw + RING_BYTES))[u] = 0u; }
    __syncthreads();
    const int wave0 = __builtin_amdgcn_readfirstlane((int)threadIdx.x >> 6);
    XcdBarrier bar = xcd_barrier_post((unsigned*)(KA.ws + WS_CTL) + CW_BAR, (volatile LAS unsigned*)((LAS unsigned char*)lds_raw + LC_BARW));
#define FRAME() Frame F; { int t_ = wave0 * 64 + lane_now(); asm volatile("" : "+v"(t_)); unsigned char* w_ = KA.ws; float* o_ = KA.out; asm volatile("" : "+s"(w_), "+s"(o_)); \
        F.lds = (LAS unsigned char*)lds_raw; F.tid = t_; F.lane = t_ & 63; F.wave = __builtin_amdgcn_readfirstlane(t_ >> 6); F.G = gridDim.x; \
        { const int bx = blockIdx.x; F.vcu = (F.G % 8 == 0) ? (bx % 8) * (F.G / 8) + bx / 8 : bx; } F.ws = (unsigned char*)(GAS unsigned char*)w_; F.out = (float*)(GAS float*)o_; F.ctl = (unsigned*)(F.ws + WS_CTL); } \
        unsigned char* wb = F.ws + ((l & 1) ? WS_W2 : WS_W); bf16_t* HB = (bf16_t*)(F.ws + WS_HB); bf16_t* P = (bf16_t*)(F.ws + WS_PROJ); float* mod = (float*)(F.ws + WS_MOD); bf16_t* XB = (bf16_t*)(F.ws + WS_XB); (void)XB; \
        const float* modl = mod + (size_t)l * NB * 6144; const float* x_in = GIN(0); (void)wb; (void)HB; (void)P; (void)modl; (void)x_in
    const int lo = KA.ph_lo, hi = KA.ph_hi;
#ifndef PHMASK
#define PHMASK 0xFFFF
#endif
#define EN(j) ((PHMASK >> (j)) & 1)
#define IN(k) (lo <= (k) && (k) < hi)
#define SEAM(k) do { if (IN(k) && IN((k) + 1)) { XcdBarrier b_ = bar; asm volatile("" : "+s"(b_.bar)); for (int r_ = 0; r_ < REP_BAR; ++r_) xcd_barrier(b_, wave0 == 0 && lane_now() == 0); } } while (0)

    if (EN(11) && IN(0)) { const int l = 0; FRAME(); p0_phase(F, KA); SEAM(0); }

    for (int l = 0; l < DEPTH; ++l) {
        const int pb = 1 + PH_PER_LAYER * l;
        if (EN(0) && IN(pb + 0)) { FRAME();
            for (int rep = 0; rep < REP_TH; ++rep) convert_weights(F, KA, l, wb, (l == 0 || F.G <= 128) ? 0 : FILL_END, 1 << 30, F.vcu * NWAVES + F.wave, F.G * NWAVES, true);
            if (l > 0) load_moe_tables(F, l - 1);
#ifndef REP_T1
#define REP_T1 1
#endif
            norm_phase(F, x_in, l == 0 ? nullptr : XB, XB, l > 0, modl - (size_t)NB * 6144 + 5120, GIN(4) + l * DM, modl, modl + 1024, HB, nullptr, nullptr, F.ws + WS_HB8);
            SEAM(pb + 0);
        }
        if (EN(1) && IN(pb + 1)) { FRAME();
            pg8::Gemm g{HB, (const bf16_t*)(wb + W_IN), nullptr}; pg8::StaticOrder S; S.init(MTOK, 2304, F.G, (int)blockIdx.x);
            pg8::EpiProj E{P, (LAS float*)(F.lds + LC_XCH), (float*)(F.ws + WS_SSQ), (const float*)(F.ws + WS_ROPE), (bf16_t*)(F.ws + WS_KC), GIN(13) + l * 64, GIN(14) + l * 64, 0};
            pg8::Gemm g8{(const bf16_t*)(F.ws + WS_HB8), (const bf16_t*)(wb + W_G8), nullptr}; pg8::StaticOrder S8; S8.init(MTOK, 4096, F.G, (int)blockIdx.x, 1);
            pg8::EpiProj E8 = E; E8.pn0 = 9;
#ifndef REP_G1
#define REP_G1 1
#endif
            for (int rep = 0; rep < REP_G1; ++rep) {
                pg8::gemm_phase<pg8::EpiProj, pg8::StaticOrder, false, true, DM, DM, DM, 0>(F.lds, g, S, E, F.tid);
                pg8::gemm_phase<pg8::EpiProj, pg8::StaticOrder, false, true, DM / 2, DM / 2, DM / 2, 0, true>(F.lds, g8, S8, E8, F.tid);
            }
            FILLER(0, FILL_A, 128);
            SEAM(pb + 1);
        }
        if (EN(2) && IN(pb + 2)) { FRAME();
            { pg8::Gemm g{P + PC_CQ, (const bf16_t*)(wb + W_UQ), nullptr}; pg8::StaticOrder S; S.init(MTOK, 512, F.G, (int)blockIdx.x);
              pg8::EpiQup E{(bf16_t*)(F.ws + WS_QC), (const float*)(F.ws + WS_ROPE), (const float*)(F.ws + WS_SSQ)};
              for (int rep = 0; rep < REP_G2; ++rep) pg8::gemm_phase<pg8::EpiQup, pg8::StaticOrder, false, true, LDP, 256, 256, 0>(F.lds, g, S, E, F.tid); }
            { pg8::Gemm g{P + PC_CKV, (const bf16_t*)(wb + W_UKV), nullptr}; pg8::StaticOrder S; S.init(MTOK, 512, F.G, (int)blockIdx.x);
              pg8::EpiKVup E{(bf16_t*)(F.ws + WS_KC), (bf16_t*)(F.ws + WS_VC), (const float*)(F.ws + WS_SSQ)};
              for (int rep = 0; rep < REP_G2; ++rep) pg8::gemm_phase<pg8::EpiKVup, pg8::StaticOrder, false, true, LDP, 256, 256, 0>(F.lds, g, S, E, F.tid); }
            SEAM(pb + 2);
        }
        if (EN(3) && IN(pb + 3)) { FRAME(); for (int rep = 0; rep < REP_AT; ++rep) { attn_phase(F, KA, l); __syncthreads(); } SEAM(pb + 3); }
        if (EN(4) && IN(pb + 4)) { FRAME();
            for (int rep = 0; rep < REP_G3; ++rep) { pg8::merge_phase3(F.lds, P, F.ws + WS_Y8, wb + W_BR, HB, F.G, F.vcu, F.tid); __syncthreads(); }
            SEAM(pb + 4);
        }
        if (EN(5) && IN(pb + 5)) { FRAME();
            pg8::Gemm g{HB, (const bf16_t*)(wb + W_OUT), nullptr}; pg8::StaticOrder S; S.init(MTOK, DM, F.G, (int)blockIdx.x);
            pg8::EpiResid E{l == 0 ? x_in : nullptr, XB, modl + 2048};
            pg8::gemm_phase<pg8::EpiResid, pg8::StaticOrder, false, true, DM, DM, DM, 0>(F.lds, g, S, E, F.tid);
            SEAM(pb + 5);
        }
        if (EN(6) && IN(pb + 6)) { FRAME(); norm_phase(F, nullptr, XB, nullptr, false, nullptr, GIN(5) + l * DM, modl + 3072, modl + 4096, HB, nullptr); SEAM(pb + 6); }
        if (EN(7) && IN(pb + 7)) { FRAME();
            pg8::Gemm g{HB, (const bf16_t*)(wb + W_RT), nullptr}; pg8::StaticOrder S; S.init(MTOK, 256, F.G, (int)blockIdx.x);
            pg8::EpiRoute E{GIN(18) + l * 4, GIN(20) + l * 32, F.ctl + CW_ECNT + 64 * l, (int*)(F.ws + WS_LIST), (int*)(F.ws + WS_TOKES), (float*)(F.ws + WS_TOKW)};
            pg8::gemm_phase<pg8::EpiRoute, pg8::StaticOrder, false, false, DM, DM, DM, 0>(F.lds, g, S, E, F.tid);
            FILLER(FILL_A, FILL_B, 128);
            SEAM(pb + 7);
        }
        if (EN(8) && IN(pb + 8)) { FRAME();
            load_moe_tables(F, l);
            pg8::Gemm g{HB, (const bf16_t*)(wb + W_E13), (const int*)(F.ws + WS_LIST)};
            pg8::MoeOrder S{F.G, (int)blockIdx.x, 1, (const LAS int*)(F.lds + LC_TEND), (const LAS int*)(F.lds + LC_CNT)};
            pg8::EpiExp1 E{(bf16_t*)(F.ws + WS_HS)};
            for (int rep = 0; rep < REP_G5; ++rep) pg8::gemm_phase<pg8::EpiExp1, pg8::MoeOrder, true, true, DM, DM, DM, 512>(F.lds, g, S, E, F.tid);
            FILLER(FILL_B, FILL_C, 64);
            SEAM(pb + 8);
        }
        if (EN(9) && IN(pb + 9)) { FRAME();
            load_moe_tables(F, l);
            pg8::Gemm g{(const bf16_t*)(F.ws + WS_HS), (const bf16_t*)(wb + W_E2), nullptr};
            pg8::MoeOrder S{F.G, (int)blockIdx.x, 2, (const LAS int*)(F.lds + LC_TEND), (const LAS int*)(F.lds + LC_CNT)};
            pg8::EpiStore E{(bf16_t*)(F.ws + WS_YS), DM};
            for (int rep = 0; rep < REP_G6; ++rep) pg8::gemm_phase<pg8::EpiStore, pg8::MoeOrder, false, true, 256, 256, 256, DM>(F.lds, g, S, E, F.tid);
            FILLER(FILL_C, FILL_END, 64);
            SEAM(pb + 9);
        }
    }
    if (EN(12) && IN(N_PHASES - 1)) { const int l = DEPTH - 1; FRAME();
        load_moe_tables(F, DEPTH - 1);
        norm_phase(F, nullptr, XB, nullptr, true, modl + 5120, GIN(24), nullptr, nullptr, nullptr, F.out);
    }
#undef IN
#undef SEAM
}

#ifndef MK_LAUNCH_PER_PHASE
#define MK_LAUNCH_PER_PHASE 0
#endif
extern "C" void kernel_launch(void* const* d_in, const int* in_sizes, int n_in, void* d_out, int out_size, void* d_ws, size_t ws_size, hipStream_t stream) {
    static int grid = 0;
    if (grid == 0) {
        int dev = 0, cus = 0;
        if (n_in != 25 || ws_size < WS_END4 || hipGetDevice(&dev) != hipSuccess || hipDeviceGetAttribute(&cus, hipDeviceAttributeMultiprocessorCount, dev) != hipSuccess) { grid = -1; return; }
        if (hipFuncSetAttribute((const void*)mk_fwd, hipFuncAttributeMaxDynamicSharedMemorySize, LDS_BYTES) != hipSuccess) { grid = -1; return; }
        grid = cus;
    }
    if (grid < 0) return;
    (void)hipMemsetAsync((char*)d_ws + WS_CTL, 0, CTL_ZERO_BYTES, stream);
    Args a{};
    for (int i = 0; i < 25; ++i) a.in[i] = (const float*)d_in[i];
    a.out = (float*)d_out; a.ws = (unsigned char*)d_ws;
#if MK_LAUNCH_PER_PHASE
#ifndef PH_MAX
#define PH_MAX N_PHASES
#endif
    for (int p = 0; p < PH_MAX; ++p) { a.ph_lo = p; a.ph_hi = p + 1; hipLaunchKernelGGL(mk_fwd, dim3(grid), dim3(NWAVES * 64), LDS_BYTES, stream, a); }
#else
    a.ph_lo = 0; a.ph_hi = N_PHASES;
    hipLaunchKernelGGL(mk_fwd, dim3(grid), dim3(NWAVES * 64), LDS_BYTES, stream, a);
#endif
}
```

```cpp
#include <hip/hip_runtime.h>
#include <hip/hip_bf16.h>
#include <cstdio>
#include <cstdint>

#define GAS __attribute__((address_space(1)))
#define LAS __attribute__((address_space(3)))
typedef unsigned short bf16_t;
typedef short bf16x8 __attribute__((ext_vector_type(8)));
typedef short s16x4 __attribute__((ext_vector_type(4)));
typedef float f32x2 __attribute__((ext_vector_type(2)));
typedef float f32x4 __attribute__((ext_vector_type(4)));
typedef float f32x16 __attribute__((ext_vector_type(16)));
typedef unsigned u32x2 __attribute__((ext_vector_type(2)));
typedef unsigned u32x4 __attribute__((ext_vector_type(4)));
typedef __bf16 bf16x2_t __attribute__((ext_vector_type(2)));

constexpr int NB = 8, SEQ = 4096, DM = 1024, DEPTH = 4, MTOK = NB * SEQ;
constexpr int NPROJ = 6400;
constexpr int LDP = 2304;
constexpr size_t GATE_BASE = (size_t)NB * SEQ * LDP * 2;
__device__ __forceinline__ size_t gate_off(int pm, int g, int wid, int ai, int lane) { return GATE_BASE + ((((size_t)(pm * 16 + g) * 8 + wid) * 2 + ai) * 64 + lane) * 64; }
constexpr int PC_NAQ = 0, PC_NAK = 256, PC_NAV = 512, PC_WQ = 768, PC_WK = 1024, PC_WV = 1152, PC_AXQ = 1280, PC_AXK = 1536, PC_AXV = 1664,
              PC_CQ = 1792, PC_CKV = 1984, PC_KR = 2240, PC_GATE = 2304, PC_YC = 1792;
constexpr int NEXP = 32, LISTCAP = 32768, SORTROWS = 2 * MTOK + NEXP * 256;
constexpr float LOG2E = 1.4426950408889634f;
constexpr float EPS = 1e-6f;

__device__ __forceinline__ unsigned cvt_pk_bf16(float lo, float hi) { f32x2 v = {lo, hi}; bf16x2_t b = __builtin_convertvector(v, bf16x2_t); return __builtin_bit_cast(unsigned, b); }
__device__ __forceinline__ float bf2f(unsigned short b) { return __uint_as_float(((unsigned)b) << 16); }
__device__ __forceinline__ float bflo(unsigned w) { return __uint_as_float(w << 16); }
__device__ __forceinline__ float bfhi(unsigned w) { return __uint_as_float(w & 0xffff0000u); }
__device__ __forceinline__ unsigned short f2bf(float f) { return (unsigned short)(cvt_pk_bf16(f, 0.f) & 0xffffu); }
__device__ __forceinline__ int lane_now() { int l; asm volatile("v_mbcnt_lo_u32_b32 %0, -1, 0\n\tv_mbcnt_hi_u32_b32 %0, -1, %0" : "=v"(l)); return l; }
template <int MASK> __device__ __forceinline__ float xshfl(float v) {
    if constexpr (MASK == 32) { auto rr = __builtin_amdgcn_permlane32_swap(__float_as_uint(v), __float_as_uint(v), false, false); return __uint_as_float((lane_now() & 32) ? rr[0] : rr[1]); }
    else return __uint_as_float((unsigned)__builtin_amdgcn_ds_swizzle((int)__float_as_uint(v), (MASK << 10) | 0x1f));
}
__device__ __forceinline__ unsigned pk_fp8x4(float a, float b, float c, float d) { unsigned w = 0u; w = __builtin_amdgcn_cvt_pk_fp8_f32(a, b, w, false); w = __builtin_amdgcn_cvt_pk_fp8_f32(c, d, w, true); return w; }
__device__ __forceinline__ float fast_sigmoid(float x) { return __builtin_amdgcn_rcpf(1.0f + __builtin_amdgcn_exp2f(-x * LOG2E)); }

namespace pg8 {
constexpr int BM = 256, BK = 64, HALF = 128, HTB = HALF * BK * 2, STAGE_BYTES = 8 * HTB, NXCD = 8, WGM = 8;

__host__ __device__ __forceinline__ int lds_byte(int r, int c) { const int st = (r >> 4) * 2 + (c >> 5), rr = r & 15, cc = c & 31, ob = rr * 64 + cc * 2; return st * 1024 + (ob ^ (((ob >> 9) & 1) << 5)); }
__host__ __device__ __forceinline__ void stage_rc(int b, int& R, int& C) { const int st = b / 1024, sb = b % 1024, swz = sb ^ (((sb >> 9) & 1) << 5); R = (st >> 1) * 16 + swz / 64; C = (st & 1) * 32 + (swz % 64) / 2; }
__host__ __device__ __forceinline__ int perm32(int rho) { const int n = rho >> 4, i = rho & 15; return 8 * (i >> 2) + 4 * n + (i & 3); }

typedef int i32x4 __attribute__((ext_vector_type(4)));
typedef int i32x8 __attribute__((ext_vector_type(8)));
struct Unit { int pm, pn, e, acol, lbase, nv; };
struct Gemm { const bf16_t* A; const bf16_t* Bt; const int* list; };

struct StaticOrder {
    int nM, nN, nwg, G, c, skew;
    __device__ __forceinline__ void init(int M, int N, int G_, int c_, int skew_ = 0) { nM = M / BM; nN = N / BM; nwg = nM * nN; G = G_; c = c_; skew = (skew_ && nwg % G_ == 0 && G_ % 16 == 0 && nwg >= 2 * G_) ? 1 : 0; }
    __device__ __forceinline__ bool next(int i, Unit& u) const {
        long L = (long)i * G + c;
        if (skew) { const int R = nwg / G; if (i >= R - 1) { const int k = i - (R - 1); if (c < G / 2 || k >= 2) return false; L = (long)(R - 1) * G + k * (G / 2) + (c - G / 2); } }
        if (L >= nwg) return false;
        int wgid = (int)L; { const int q = nwg / NXCD, r = nwg % NXCD, xcd = wgid % NXCD, off = wgid / NXCD; wgid = (xcd < r ? xcd * (q + 1) : r * (q + 1) + (xcd - r) * q) + off; }
        const int nig = WGM * nN, gid = wgid / nig, fm = gid * WGM, gsz = (nM - fm) < WGM ? (nM - fm) : WGM;
        u.pm = fm + ((wgid % nig) % gsz); u.pn = (wgid % nig) / gsz; u.e = 0; u.acol = 0; u.lbase = 0; u.nv = 256; return true;
    }
};

template <bool GATHER, int LDA>
__device__ __forceinline__ void a_offsets(const Gemm& g, const Unit& u, const int (&Rr)[2], const unsigned (&Cb)[2], unsigned (&vo)[2][2]) {
#pragma unroll
    for (int h = 0; h < 2; ++h)
#pragma unroll
        for (int i = 0; i < 2; ++i) {
            if constexpr (GATHER) {
                int idx = h * HALF + Rr[i]; idx = idx < u.nv ? idx : (u.nv - 1);
                const int row = g.list[u.lbase + idx];
                vo[h][i] = (unsigned)row * (unsigned)(LDA * 2) + Cb[i];
            } else {
                vo[h][i] = (unsigned)(h * HALF + Rr[i]) * (unsigned)(LDA * 2) + Cb[i];
            }
        }
}

template <class Epi, class Sched, bool GATHER, bool ALIGN_EPI, int LDA, int LDB, int KK, int NBE, bool F8 = false>
__device__ __forceinline__ void gemm_phase(LAS unsigned char* lds, const Gemm g, const Sched& S, const Epi& E, int tid) {
    asm volatile("" : "+v"(tid));
    const int wid = __builtin_amdgcn_readfirstlane(tid >> 6), lane = tid & 63, wr = wid >> 2, wc = wid & 3, fr = lane & 15, fq = lane >> 4;
    constexpr int nt = KK / BK;
    int Rr[2]; unsigned Cb[2]; unsigned voffB[2];
#pragma unroll
    for (int i = 0; i < 2; ++i) { int R, C; stage_rc(tid * 16 + i * 8192, R, C); const int Rb = Epi::PERM ? ((R & ~31) + perm32(R & 31)) : R;
        Rr[i] = R; Cb[i] = (unsigned)C * 2u; voffB[i] = (unsigned)(Rb * LDB + C) * 2u; }
    const size_t kstep = (size_t)(BK * 2);
    constexpr size_t hstepB = (size_t)HALF * LDB * 2, hstepA = (size_t)HALF * LDA * 2;
    const unsigned ldsw = (unsigned)wid * 1024u;
    const int aoff = lds_byte(wr * 64 + fr, fq * 8), boff = lds_byte(wc * 32 + fr, fq * 8);
#define PG8_SA(b, h) (((b) * 2 + (h)) * HTB)
#define PG8_SB(b, h) ((4 + (b) * 2 + (h)) * HTB)
#define PG8_STAGE(bufoff, gbase, voff) do { _Pragma("unroll") for (int _i = 0; _i < 2; ++_i) \
        __builtin_amdgcn_global_load_lds((const unsigned*)((const char*)(gbase) + (voff)[_i]), (LAS unsigned*)(lds + (bufoff) + ldsw + _i * 8192), 16, 0, 0); } while (0)
#define PG8_LDA(dst, b, h) do { _Pragma("unroll") for (int m = 0; m < 4; ++m) { if constexpr (F8) { dst##8[m].lo = *(const LAS i32x4*)(lds + PG8_SA(b, h) + aoff + m * 2048); dst##8[m].hi = *(const LAS i32x4*)(lds + PG8_SA(b, h) + aoff + m * 2048 + 1024); } \
        else { _Pragma("unroll") for (int k = 0; k < 2; ++k) dst[m][k] = *(const LAS bf16x8*)(lds + PG8_SA(b, h) + aoff + m * 2048 + k * 1024); } } } while (0)
#define PG8_LDB(dst, b, h) do { _Pragma("unroll") for (int n = 0; n < 2; ++n) { if constexpr (F8) { dst##8[n].lo = *(const LAS i32x4*)(lds + PG8_SB(b, h) + boff + n * 2048); dst##8[n].hi = *(const LAS i32x4*)(lds + PG8_SB(b, h) + boff + n * 2048 + 1024); } \
        else { _Pragma("unroll") for (int k = 0; k < 2; ++k) dst[n][k] = *(const LAS bf16x8*)(lds + PG8_SB(b, h) + boff + n * 2048 + k * 1024); } } } while (0)
#define PG8_MMA(ai, bj, At, Bt) do { __builtin_amdgcn_s_setprio(1); _Pragma("unroll") for (int m = 0; m < 4; ++m) _Pragma("unroll") for (int n = 0; n < 2; ++n) { \
        if constexpr (F8) { asm volatile("v_mfma_scale_f32_16x16x128_f8f6f4 %0, %1, %2, %0, %3, %3 op_sel_hi:[0,0,0]" : "+v"(acc[ai][bj][m][n]) : "v"(Bt##8[n]), "v"(At##8[m]), "v"(sc127)); }   \
        else { _Pragma("unroll") for (int k = 0; k < 2; ++k) acc[ai][bj][m][n] = __builtin_amdgcn_mfma_f32_16x16x32_bf16(Bt[n][k], At[m][k], acc[ai][bj][m][n], 0, 0, 0); } } \
        __builtin_amdgcn_s_setprio(0); } while (0)
#define PG8_WAIT_V(n) asm volatile("s_waitcnt vmcnt(" #n ")" ::: "memory")
#define PG8_WAIT_L(n) asm volatile("s_waitcnt lgkmcnt(" #n ")" ::: "memory")
#define PG8_BAR __builtin_amdgcn_s_barrier()
#define PG8_SCHED __builtin_amdgcn_sched_barrier(0)
#define PG8_STAGE_A(bufoff, gbase, vo, h) do { if constexpr (GATHER) { PG8_STAGE(bufoff, gbase, (vo)[h]); } else { PG8_STAGE(bufoff, (gbase) + (h) * hstepA, (vo)[0]); } } while (0)
#define PG8_ABASE(u) (GATHER ? (size_t)0 : ((size_t)(u).pm * BM * LDA + (size_t)(u).acol) * 2)
#define PG8_BBASE(u) (((size_t)(u).e * NBE + (size_t)(u).pn * BM) * LDB * 2)
    Unit cur, nxt; int ui = 0;
    if (!S.next(0, cur)) return;
    f32x4 acc[2][2][4][2];
#pragma unroll
    for (int a = 0; a < 2; ++a)
#pragma unroll
        for (int b = 0; b < 2; ++b)
#pragma unroll
            for (int m = 0; m < 4; ++m)
#pragma unroll
                for (int n = 0; n < 2; ++n) acc[a][b][m][n] = (f32x4){0.f, 0.f, 0.f, 0.f};
    bf16x8 At[4][2], B0[2][2], B1[2][2];
    i32x8 At8[4], B08[2], B18[2];
    int sc127 = 127; asm volatile("" : "+v"(sc127)); (void)sc127;
    (void)At; (void)B0; (void)B1; (void)At8; (void)B08; (void)B18;
    unsigned voA[2][2];
    a_offsets<GATHER, LDA>(g, cur, Rr, Cb, voA);
    if constexpr (GATHER) { asm volatile("s_waitcnt vmcnt(0)" ::: "memory"); }
    const char* Ab = (const char*)g.A; const char* Bb = (const char*)g.Bt; asm volatile("" : "+s"(Ab), "+s"(Bb)); Ab = (const char*)(const GAS char*)Ab; Bb = (const char*)(const GAS char*)Bb;
    const char* cA = Ab + PG8_ABASE(cur); const char* cB = Bb + PG8_BBASE(cur);
    PG8_STAGE(PG8_SB(0, 0), cB, voffB); PG8_STAGE(PG8_SB(0, 1), cB + hstepB, voffB); PG8_STAGE_A(PG8_SA(0, 0), cA, voA, 0); PG8_STAGE_A(PG8_SA(0, 1), cA, voA, 1);
    if (wr == 1) PG8_BAR;
    PG8_WAIT_V(2); PG8_BAR;
    PG8_STAGE(PG8_SB(1, 0), cB + kstep, voffB); PG8_STAGE_A(PG8_SA(1, 0), cA + kstep, voA, 0); PG8_STAGE(PG8_SB(1, 1), cB + hstepB + kstep, voffB);
    PG8_WAIT_V(6); PG8_BAR;
    for (;;) {
        const bool has_next = S.next(ui + 1, nxt);
        const char* nA = has_next ? Ab + PG8_ABASE(nxt) : cA; const char* nB = has_next ? Bb + PG8_BBASE(nxt) : cB;
#pragma unroll 1
        for (int t = 0; t < nt; t += 2) {
            const bool last = (t == nt - 2);
            const char* a1 = cA + (size_t)(t + 1) * kstep;
            const char* a2 = last ? nA : cA + (size_t)(t + 2) * kstep; const char* b2 = last ? nB : cB + (size_t)(t + 2) * kstep;
            const char* a3 = a2 + kstep; const char* b3 = b2 + kstep;
            PG8_LDB(B0, 0, 0); PG8_LDB(B1, 0, 1); PG8_SCHED; PG8_LDA(At, 0, 0); PG8_STAGE_A(PG8_SA(1, 1), a1, voA, 1);
            if constexpr (GATHER) { if (last && has_next) { a_offsets<GATHER, LDA>(g, nxt, Rr, Cb, voA); asm volatile("s_waitcnt vmcnt(0)" ::: "memory"); } }
            PG8_WAIT_V(8); PG8_WAIT_L(0); PG8_BAR; PG8_MMA(0, 0, At, B0); PG8_MMA(0, 1, At, B1); PG8_BAR; PG8_SCHED;
            PG8_LDA(At, 0, 1); PG8_STAGE(PG8_SB(0, 0), b2, voffB); PG8_STAGE(PG8_SB(0, 1), b2 + hstepB, voffB); PG8_STAGE_A(PG8_SA(0, 0), a2, voA, 0);
            PG8_WAIT_V(8); PG8_WAIT_L(0); PG8_BAR; PG8_MMA(1, 0, At, B0); PG8_MMA(1, 1, At, B1); PG8_BAR; PG8_SCHED;
            PG8_LDB(B0, 1, 0); PG8_LDB(B1, 1, 1); PG8_SCHED; PG8_LDA(At, 1, 0); PG8_STAGE_A(PG8_SA(0, 1), a2, voA, 1);
            PG8_WAIT_V(8); PG8_WAIT_L(0); PG8_BAR; PG8_MMA(0, 0, At, B0); PG8_MMA(0, 1, At, B1); PG8_BAR; PG8_SCHED;
            PG8_LDA(At, 1, 1); PG8_STAGE(PG8_SB(1, 0), b3, voffB); PG8_STAGE(PG8_SB(1, 1), b3 + hstepB, voffB); PG8_STAGE_A(PG8_SA(1, 0), a3, voA, 0);
            PG8_WAIT_V(8); PG8_WAIT_L(0); PG8_BAR; PG8_MMA(1, 0, At, B0); PG8_MMA(1, 1, At, B1); PG8_BAR; PG8_SCHED;
        }
        if constexpr (F8) { asm volatile("s_nop 15\n\ts_nop 15\n\ts_nop 15" ::: "memory"); }
        if constexpr (ALIGN_EPI) { if (wr == 0) PG8_BAR; }
        if constexpr (!Epi::AFTER_DRAIN) { E(acc, cur, wr, wc, fr, fq); }
        if (!has_next) break;
#pragma unroll
        for (int a = 0; a < 2; ++a)
#pragma unroll
            for (int b = 0; b < 2; ++b)
#pragma unroll
                for (int m = 0; m < 4; ++m)
#pragma unroll
                    for (int n = 0; n < 2; ++n) acc[a][b][m][n] = (f32x4){0.f, 0.f, 0.f, 0.f};
        cur = nxt; cA = nA; cB = nB; ++ui;
        if constexpr (ALIGN_EPI) { if (wr == 1) PG8_BAR; }
    }
    PG8_WAIT_V(0);
    if constexpr (!ALIGN_EPI) { if (wr == 0) PG8_BAR; }
    PG8_BAR;
    if constexpr (Epi::AFTER_DRAIN) { E.fused(acc, cur, wr, wc, fr, fq, lds, wid, lane); }
#undef PG8_SA
#undef PG8_SB
#undef PG8_STAGE
#undef PG8_LDA
#undef PG8_LDB
#undef PG8_MMA
#undef PG8_WAIT_V
#undef PG8_WAIT_L
#undef PG8_BAR
#undef PG8_SCHED
#undef PG8_STAGE_A
#undef PG8_ABASE
#undef PG8_BBASE
}
}
namespace pg8 {
typedef f32x4 AccT[2][2][4][2];

__device__ __forceinline__ u32x4 pack8(const f32x4 v0, const f32x4 v1) {
    u32x4 w; w.x = cvt_pk_bf16(v0[0], v0[1]); w.y = cvt_pk_bf16(v0[2], v0[3]); w.z = cvt_pk_bf16(v1[0], v1[1]); w.w = cvt_pk_bf16(v1[2], v1[3]); return w;
}
__device__ __forceinline__ void unpack8(const u32x4 w, f32x4& v0, f32x4& v1) {
    v0 = (f32x4){bflo(w.x), bfhi(w.x), bflo(w.y), bfhi(w.y)}; v1 = (f32x4){bflo(w.z), bfhi(w.z), bflo(w.w), bfhi(w.w)};
}

constexpr float MERGE_WSCALE = 16.0f;
constexpr float GATE_WSCALE = 64.0f, GATE_WINV = 1.0f / 64.0f;
struct EpiProj {
    static constexpr bool PERM = true, AFTER_DRAIN = false;
    bf16_t* O; LAS float* xch; float* ssq; const float* cs; bf16_t* KC; const float* gaq; const float* gak; int pn0;
    __device__ __forceinline__ void operator()(const AccT& acc, const Unit& u_, int wr, int wc, int fr, int fq) const {
        Unit u = u_; u.pn += pn0;
        const bool gate = u.pn >= 9;
        const float qs = (u.pn == 0 || u.pn == 3) ? 0.125f * LOG2E : 1.0f;
        const int row0 = u.pm * BM + wr * 64 + fr, col0 = u.pn * BM + wc * 32 + 8 * fq;
        if (gate) {
            int lx = fq * 16 + fr; asm volatile("" : "+v"(lx));
            unsigned char* gt = (unsigned char*)O + gate_off(u.pm, u.pn - 9, wr * 4 + wc, 0, lx);
#pragma unroll
            for (int ai = 0; ai < 2; ++ai)
#pragma unroll
                for (int m = 0; m < 4; ++m) { u32x4 w4;
#pragma unroll
                    for (int bj = 0; bj < 2; ++bj) { const f32x4 v0 = acc[ai][bj][m][0], v1 = acc[ai][bj][m][1]; unsigned q[8];
#pragma unroll
                        for (int j = 0; j < 4; ++j) {
                            q[j] = (unsigned)fmaxf(__builtin_amdgcn_rcpf(1.0f + __builtin_amdgcn_exp2f(v0[j] * GATE_WINV)) * 255.0f + 0.5f, 1.0f); q[4 + j] = (unsigned)fmaxf(__builtin_amdgcn_rcpf(1.0f + __builtin_amdgcn_exp2f(v1[j] * GATE_WINV)) * 255.0f + 0.5f, 1.0f); }
                        const unsigned lo = q[0] | (q[1] << 8) | (q[2] << 16) | (q[3] << 24), hi = q[4] | (q[5] << 8) | (q[6] << 16) | (q[7] << 24);
                        if (bj == 0) { w4.x = lo; w4.y = hi; } else { w4.z = lo; w4.w = hi; } }
                    *(GAS u32x4*)(gt + ai * 4096 + m * 16) = w4; }
        } else if (u.pn == 5 || u.pn == 6) {
            const bool isq = u.pn == 5;
            int frx = fr; asm volatile("" : "+v"(frx));
#pragma unroll
            for (int ai = 0; ai < 2; ++ai)
#pragma unroll
                for (int m = 0; m < 4; ++m)
#pragma unroll
                    for (int bj = 0; bj < 2; ++bj) { const f32x4 v0 = acc[ai][bj][m][0], v1 = acc[ai][bj][m][1];
                        float p = (v0[0] * v0[0] + v0[1] * v0[1]) + (v0[2] * v0[2] + v0[3] * v0[3]) + (v1[0] * v1[0] + v1[1] * v1[1]) + (v1[2] * v1[2] + v1[3] * v1[3]);
                        p += xshfl<16>(p); p += xshfl<32>(p);
                        if (fq == 0 && (isq || bj == 0)) xch[(ai * HALF + wr * 64 + m * 16 + frx) * 8 + 4 * bj + wc] = p; }
            asm volatile("s_waitcnt lgkmcnt(0)\n\ts_barrier" ::: "memory");
            const int hf = wc & 1;
            f32x4 g0, g1;
            { const float* G = (isq ? gaq : gak) + 32 * hf + 4 * fq; g0 = *(const GAS f32x4*)G; g1 = *(const GAS f32x4*)(G + 16); }
#pragma unroll
            for (int ai = 0; ai < 2; ++ai) {
                f32x4 c4[4], s4[4];
#pragma unroll
                for (int m = 0; m < 4; ++m) { const int pos = (u.pm * BM + ai * HALF + wr * 64 + m * 16 + frx) & (SEQ - 1); const int idx = hf ? (pos & 63) : (pos >> 6);
                    c4[m] = *(const GAS f32x4*)(cs + idx * 16 + 4 * fq); s4[m] = *(const GAS f32x4*)(cs + SEQ * 16 + idx * 16 + 4 * fq); }
#pragma unroll
                for (int m = 0; m < 4; ++m) { const int rl = ai * HALF + wr * 64 + m * 16 + frx, row = u.pm * BM + rl;
                    bf16_t* rowp = O + (size_t)row * LDP + col0;
#pragma unroll
                    for (int bj = 0; bj < 2; ++bj) { f32x4 v0 = acc[ai][bj][m][0], v1 = acc[ai][bj][m][1];
                        if (isq || bj == 0) {
                            const f32x2 pr_ = *(const LAS f32x2*)(xch + rl * 8 + ((4 * bj + wc) & ~1)); const float tot = pr_.x + pr_.y;
                            const float rstd = rsqrtf(tot * (1.0f / 64.0f) + EPS) * (isq ? 0.125f * LOG2E : 1.0f);
                            v0 = v0 * rstd * g0; v1 = v1 * rstd * g1;
                            const f32x4 o0 = v0 * c4[m] - v1 * s4[m], o1 = v0 * s4[m] + v1 * c4[m]; v0 = o0; v1 = o1; }
                        *(GAS u32x4*)(rowp + bj * HALF) = pack8(v0, v1); } }
                asm volatile("" ::: "memory"); }
        } else if (u.pn == 7 || u.pn == 8) {
#pragma unroll
            for (int ai = 0; ai < 2; ++ai)
#pragma unroll
                for (int m = 0; m < 4; ++m) { const int row = row0 + ai * HALF + m * 16; bf16_t* rowp = O + (size_t)row * LDP + col0;
#pragma unroll
                    for (int bj = 0; bj < 2; ++bj) { const f32x4 v0 = acc[ai][bj][m][0], v1 = acc[ai][bj][m][1];
                        *(GAS u32x4*)(rowp + bj * HALF) = pack8(v0, v1);
                        const int lc = 128 * bj + 32 * wc;
                        const int grp = lc >> 5;
                        const int slot = (u.pn == 7) ? (grp < 6 ? grp : 8 + (grp - 6)) : (grp < 6 ? 10 + grp : -1);
                        if (slot >= 0) {
                            float p = (v0[0] * v0[0] + v0[1] * v0[1]) + (v0[2] * v0[2] + v0[3] * v0[3]) + (v1[0] * v1[0] + v1[1] * v1[1]) + (v1[2] * v1[2] + v1[3] * v1[3]);
                            p += xshfl<16>(p); p += xshfl<32>(p);
                            if (fq == 0) ssq[(size_t)row * 16 + slot] = p;
                        } else if (lc == 192) {
                            const int pos = row & (SEQ - 1);
                            const f32x4 c4 = *(const GAS f32x4*)(cs + pos * 16 + 4 * fq), s4 = *(const GAS f32x4*)(cs + SEQ * 16 + pos * 16 + 4 * fq);
                            const u32x4 w = pack8(v0 * c4 - v1 * s4, v0 * s4 + v1 * c4);
                            bf16_t* kr = KC + (size_t)row * 384 + 64 + 8 * fq;
#pragma unroll
                            for (int h = 0; h < 4; ++h) *(GAS u32x4*)(kr + 96 * h) = w;
                        } } }
        } else {
#pragma unroll
            for (int ai = 0; ai < 2; ++ai)
#pragma unroll
                for (int m = 0; m < 4; ++m) { bf16_t* rowp = O + (size_t)(row0 + ai * HALF + m * 16) * LDP + col0;
#pragma unroll
                    for (int bj = 0; bj < 2; ++bj) *(GAS u32x4*)(rowp + bj * HALF) = pack8(acc[ai][bj][m][0] * qs, acc[ai][bj][m][1] * qs); }
        }
    }
};

struct EpiNone {
    static constexpr bool PERM = true, AFTER_DRAIN = false;
    float* sink;
    __device__ __forceinline__ void operator()(const AccT& acc, const Unit& u, int wr, int wc, int fr, int fq) const {
        float s = 0.f;
#pragma unroll
        for (int ai = 0; ai < 2; ++ai)
#pragma unroll
            for (int bj = 0; bj < 2; ++bj)
#pragma unroll
                for (int m = 0; m < 4; ++m) s += acc[ai][bj][m][0][0] + acc[ai][bj][m][1][3];
        if (s == 1.2345e30f) sink[0] = s;
    }
};

struct EpiQup {
    static constexpr bool PERM = true, AFTER_DRAIN = false;
    bf16_t* QC; const float* cs; const float* ssq;
    __device__ __forceinline__ void operator()(const AccT& acc, const Unit& u, int wr, int wc, int fr, int fq) const {
        int frx = fr; asm volatile("" : "+v"(frx));
        const int row0 = u.pm * BM + wr * 64 + frx;
        float rs[2][4];
        { f32x4 sa_[2][4]; f32x2 sb_[2][4];
#pragma unroll
          for (int ai = 0; ai < 2; ++ai)
#pragma unroll
              for (int m = 0; m < 4; ++m) { const float* sp = ssq + (size_t)(row0 + ai * HALF + m * 16) * 16; sa_[ai][m] = *(const GAS f32x4*)sp; sb_[ai][m] = *(const GAS f32x2*)(sp + 4); }
#pragma unroll
          for (int ai = 0; ai < 2; ++ai)
#pragma unroll
              for (int m = 0; m < 4; ++m) rs[ai][m] = rsqrtf((((sa_[ai][m][0] + sa_[ai][m][1]) + (sa_[ai][m][2] + sa_[ai][m][3])) + (sb_[ai][m][0] + sb_[ai][m][1])) * (1.0f / 192.0f) + EPS) * (0.10206207261596575f * LOG2E); }
#pragma unroll
        for (int bj = 0; bj < 2; ++bj) {
            const int gi = 8 * u.pn + 4 * bj + wc;
            if (gi >= 12) continue;
            const bool rope = (gi % 3) == 2;
            const int col = 32 * gi + 8 * fq;
#pragma unroll
            for (int ai = 0; ai < 2; ++ai) {
                f32x4 c4[4], s4[4];
                if (rope) {
#pragma unroll
                    for (int m = 0; m < 4; ++m) { const int pos = (row0 + ai * HALF + m * 16) & (SEQ - 1); c4[m] = *(const GAS f32x4*)(cs + pos * 16 + 4 * fq); s4[m] = *(const GAS f32x4*)(cs + SEQ * 16 + pos * 16 + 4 * fq); }
                }
#pragma unroll
                for (int m = 0; m < 4; ++m) { const int row = row0 + ai * HALF + m * 16; const float rs_ = rs[ai][m];
                    f32x4 v0 = acc[ai][bj][m][0] * rs_, v1 = acc[ai][bj][m][1] * rs_;
                    if (rope) { const f32x4 o1 = v0 * c4[m] - v1 * s4[m], o2 = v0 * s4[m] + v1 * c4[m]; v0 = o1; v1 = o2; }
                    *(GAS u32x4*)(QC + (size_t)row * 384 + col) = pack8(v0, v1); }
                asm volatile("" ::: "memory"); }
        }
    }
};

struct EpiKVup {
    static constexpr bool PERM = true, AFTER_DRAIN = false;
    bf16_t* KC; bf16_t* VC; const float* ssq;
    __device__ __forceinline__ void operator()(const AccT& acc, const Unit& u, int wr, int wc, int fr, int fq) const {
        int frx = fr; asm volatile("" : "+v"(frx));
        const int row0 = u.pm * BM + wr * 64 + frx;
        float rs[2][4];
        { f32x4 sa_[2][4], sb_[2][4];
#pragma unroll
          for (int ai = 0; ai < 2; ++ai)
#pragma unroll
              for (int m = 0; m < 4; ++m) { const float* sp = ssq + (size_t)(row0 + ai * HALF + m * 16) * 16 + 8; sa_[ai][m] = *(const GAS f32x4*)sp; sb_[ai][m] = *(const GAS f32x4*)(sp + 4); }
#pragma unroll
          for (int ai = 0; ai < 2; ++ai)
#pragma unroll
              for (int m = 0; m < 4; ++m) rs[ai][m] = rsqrtf((((sa_[ai][m][0] + sa_[ai][m][1]) + (sa_[ai][m][2] + sa_[ai][m][3])) + ((sb_[ai][m][0] + sb_[ai][m][1]) + (sb_[ai][m][2] + sb_[ai][m][3]))) * (1.0f / 256.0f) + EPS); }
#pragma unroll
        for (int bj = 0; bj < 2; ++bj) {
            const int col = 128 * bj + 32 * wc + 8 * fq;
            bf16_t* base = (u.pn == 0) ? KC : VC; const int ld = (u.pn == 0) ? 384 : 256; const int coff = (u.pn == 0) ? (96 * (col >> 6) + (col & 63)) : col;
#pragma unroll
            for (int ai = 0; ai < 2; ++ai)
#pragma unroll
                for (int m = 0; m < 4; ++m) { const int row = row0 + ai * HALF + m * 16; const float rs_ = rs[ai][m];
                    *(GAS u32x4*)(base + (size_t)row * ld + coff) = pack8(acc[ai][bj][m][0] * rs_, acc[ai][bj][m][1] * rs_); }
        }
    }
};

struct EpiMerge {
    static constexpr bool PERM = true, AFTER_DRAIN = false;
    const bf16_t* P; bf16_t* HB;
    __device__ __forceinline__ void operator()(const AccT& acc, const Unit& u, int wr, int wc, int fr, int fq) const {
        const int row0 = u.pm * BM + wr * 64 + fr, col0 = u.pn * BM + wc * 32 + 8 * fq, n = u.e;
#pragma unroll
        for (int ai = 0; ai < 2; ++ai) {
            u32x2 gw[4][2]; u32x4 ow[4][2];
#pragma unroll
            for (int m = 0; m < 4; ++m)
#pragma unroll
                for (int bj = 0; bj < 2; ++bj) { const int row = row0 + ai * HALF + m * 16, col = col0 + bj * HALF;
                    gw[m][bj] = *(const GAS u32x2*)((const unsigned char*)(P + (size_t)row * LDP + PC_GATE) + 1024 * n + col);
                    if (n > 0) ow[m][bj] = *(const GAS u32x4*)(HB + (size_t)row * DM + col); else ow[m][bj] = (u32x4){0u, 0u, 0u, 0u}; }
#pragma unroll
            for (int m = 0; m < 4; ++m)
#pragma unroll
                for (int bj = 0; bj < 2; ++bj) { const int row = row0 + ai * HALF + m * 16, col = col0 + bj * HALF;
                    const unsigned ga = gw[m][bj].x, gb = gw[m][bj].y; constexpr float K = 1.0f / 255.0f;
                    const f32x4 g0 = (f32x4){(float)(ga & 0xffu), (float)((ga >> 8) & 0xffu), (float)((ga >> 16) & 0xffu), (float)(ga >> 24)} * K;
                    const f32x4 g1 = (f32x4){(float)(gb & 0xffu), (float)((gb >> 8) & 0xffu), (float)((gb >> 16) & 0xffu), (float)(gb >> 24)} * K;
                    f32x4 o0, o1; unpack8(ow[m][bj], o0, o1);
                    const f32x4 v0 = g0 * acc[ai][bj][m][0] + o0, v1 = g1 * acc[ai][bj][m][1] + o1;
                    *(GAS u32x4*)(HB + (size_t)row * DM + col) = pack8(v0, v1); }
            asm volatile("" ::: "memory");
        }
    }
};

struct EpiOut {
    static constexpr bool PERM = false, AFTER_DRAIN = false;
    const float* base; float* out; const float* gvec;
    __device__ __forceinline__ void operator()(const AccT& acc, const Unit& u, int wr, int wc, int fr, int fq) const {
        const int b = u.pm >> 4;
        const int row0 = u.pm * BM + wr * 64 + fr, col0 = u.pn * BM + wc * 32 + 4 * fq;
#pragma unroll
        for (int bj = 0; bj < 2; ++bj)
#pragma unroll
            for (int n = 0; n < 2; ++n) {
                const int col = col0 + bj * HALF + n * 16; const f32x4 gv = *(const GAS f32x4*)(gvec + b * 6144 + col);
                f32x4 bs[2][4];
#pragma unroll
                for (int ai = 0; ai < 2; ++ai)
#pragma unroll
                    for (int m = 0; m < 4; ++m) bs[ai][m] = *(const GAS f32x4*)(base + (size_t)(row0 + ai * HALF + m * 16) * DM + col);
#pragma unroll
                for (int ai = 0; ai < 2; ++ai)
#pragma unroll
                    for (int m = 0; m < 4; ++m) *(GAS f32x4*)(out + (size_t)(row0 + ai * HALF + m * 16) * DM + col) = bs[ai][m] + gv * acc[ai][bj][m][n];
                asm volatile("" ::: "memory");
            }
    }
};

struct EpiResid {
    static constexpr bool PERM = true, AFTER_DRAIN = false;
    const float* xf; bf16_t* XBo; const float* gvec;
    __device__ __forceinline__ void operator()(const AccT& acc, const Unit& u, int wr, int wc, int fr, int fq) const {
        const int b = u.pm >> 4;
        const int row0 = u.pm * BM + wr * 64 + fr, col0 = u.pn * BM + wc * 32 + 8 * fq;
#pragma unroll
        for (int bj = 0; bj < 2; ++bj) { const int col = col0 + bj * HALF;
            const f32x4 g0 = *(const GAS f32x4*)(gvec + b * 6144 + col), g1 = *(const GAS f32x4*)(gvec + b * 6144 + col + 4);
#pragma unroll
            for (int ai = 0; ai < 2; ++ai) {
                f32x4 x0[4], x1[4];
                if (xf) {
#pragma unroll
                    for (int m = 0; m < 4; ++m) { const size_t off = (size_t)(row0 + ai * HALF + m * 16) * DM + col; x0[m] = *(const GAS f32x4*)(xf + off); x1[m] = *(const GAS f32x4*)(xf + off + 4); }
                } else {
                    u32x4 xw[4];
#pragma unroll
                    for (int m = 0; m < 4; ++m) xw[m] = *(const GAS u32x4*)(XBo + (size_t)(row0 + ai * HALF + m * 16) * DM + col);
#pragma unroll
                    for (int m = 0; m < 4; ++m) unpack8(xw[m], x0[m], x1[m]);
                }
#pragma unroll
                for (int m = 0; m < 4; ++m) *(GAS u32x4*)(XBo + (size_t)(row0 + ai * HALF + m * 16) * DM + col) = pack8(x0[m] + acc[ai][bj][m][0] * g0, x1[m] + acc[ai][bj][m][1] * g1);
                asm volatile("" ::: "memory"); } }
    }
};

struct EpiRoute {
    static constexpr bool PERM = true, AFTER_DRAIN = true;
    const float* bg; const float* br; unsigned* ecnt; int* list; int* tok_es; float* tok_w;
    __device__ __forceinline__ void fused(const AccT& acc, const Unit& u, int wr, int wc, int fr, int fq, LAS unsigned char* lds, int wid, int lane) const {
        LAS float* LG = (LAS float*)lds;
        LAS unsigned* lcnt = (LAS unsigned*)(lds + 256 * 40 * 4);
        LAS unsigned* lbase = lcnt + 32;
        int tid = wid * 64 + lane; asm volatile("" : "+v"(tid));
        if (wc < 2) {
#pragma unroll
            for (int ai = 0; ai < 2; ++ai)
#pragma unroll
                for (int m = 0; m < 4; ++m) { const int rl = ai * HALF + wr * 64 + m * 16 + fr; const f32x4 v0 = acc[ai][0][m][0], v1 = acc[ai][0][m][1];
                    if (wc == 0) { *(LAS f32x4*)(LG + rl * 40 + 8 * fq) = v0; *(LAS f32x4*)(LG + rl * 40 + 8 * fq + 4) = v1; }
                    else if (fq == 0) { *(LAS f32x4*)(LG + rl * 40 + 32) = v0; } }
        }
        if (tid < 32) lcnt[tid] = 0u;
        __syncthreads();
        int e1 = 0, e2 = 0; unsigned r1 = 0, r2 = 0; float w1 = 0.f, w2 = 0.f;
        if (tid < 256) {
            const LAS float* lg = LG + tid * 40;
            float g[4];
#pragma unroll
            for (int j = 0; j < 4; ++j) g[j] = lg[j] + bg[j];
            int gs = 0; float gm = g[0];
#pragma unroll
            for (int j = 1; j < 4; ++j) if (g[j] > gm) { gm = g[j]; gs = j; }
            float gsum = 0.f;
#pragma unroll
            for (int j = 0; j < 4; ++j) gsum += __expf(g[j] - gm);
            const float gw = 1.0f / gsum;
            float el[8];
#pragma unroll
            for (int j = 0; j < 8; ++j) el[j] = lg[4 + 8 * gs + j] + br[8 * gs + j];
            int i1 = 0; float m1 = el[0];
#pragma unroll
            for (int j = 1; j < 8; ++j) if (el[j] > m1) { m1 = el[j]; i1 = j; }
            int i2 = -1; float m2 = 0.f;
#pragma unroll
            for (int j = 0; j < 8; ++j) if (j != i1 && (i2 < 0 || el[j] > m2)) { m2 = el[j]; i2 = j; }
            const float t = __expf(m2 - m1);
            w1 = gw / (1.0f + t); w2 = gw * t / (1.0f + t);
            e1 = 8 * gs + i1; e2 = 8 * gs + i2;
            r1 = atomicAdd((unsigned*)(lcnt + e1), 1u); r2 = atomicAdd((unsigned*)(lcnt + e2), 1u);
        }
        __syncthreads();
        if (tid < 32) lbase[tid] = __hip_atomic_fetch_add(ecnt + tid, lcnt[tid], __ATOMIC_RELAXED, __HIP_MEMORY_SCOPE_AGENT);
        __syncthreads();
        if (tid < 256) {
            const int token = u.pm * BM + tid;
            const int s1 = (int)(lbase[e1] + r1), s2 = (int)(lbase[e2] + r2);
            list[e1 * LISTCAP + s1] = token; list[e2 * LISTCAP + s2] = token;
            tok_es[2 * token] = (e1 << 16) | s1; tok_es[2 * token + 1] = (e2 << 16) | s2;
            tok_w[2 * token] = w1; tok_w[2 * token + 1] = w2;
        }
    }
};

struct EpiExp1 {
    static constexpr bool PERM = true, AFTER_DRAIN = false;
    bf16_t* HS;
    __device__ __forceinline__ void operator()(const AccT& acc, const Unit& u, int wr, int wc, int fr, int fq) const {
        const int row0 = u.pm * BM + wr * 64 + fr;
#pragma unroll
        for (int ai = 0; ai < 2; ++ai)
#pragma unroll
            for (int m = 0; m < 4; ++m) { bf16_t* rowp = HS + (size_t)(row0 + ai * HALF + m * 16) * 256;
#pragma unroll
                for (int bj = 0; bj < 2; ++bj) { const f32x4 a = acc[ai][bj][m][0], b = acc[ai][bj][m][1]; float h[4];
#pragma unroll
                    for (int j = 0; j < 4; ++j) h[j] = a[j] * fast_sigmoid(a[j]) * b[j];
                    u32x2 w; w.x = cvt_pk_bf16(h[0], h[1]); w.y = cvt_pk_bf16(h[2], h[3]);
                    *(GAS u32x2*)(rowp + u.pn * 128 + 64 * bj + 16 * wc + 4 * fq) = w; } }
    }
};

struct EpiStore {
    static constexpr bool PERM = true, AFTER_DRAIN = false;
    bf16_t* O; int ldc;
    __device__ __forceinline__ void operator()(const AccT& acc, const Unit& u, int wr, int wc, int fr, int fq) const {
        const int row0 = u.pm * BM + wr * 64 + fr, col0 = u.pn * BM + wc * 32 + 8 * fq;
#pragma unroll
        for (int ai = 0; ai < 2; ++ai)
#pragma unroll
            for (int m = 0; m < 4; ++m) { bf16_t* rowp = O + (size_t)(row0 + ai * HALF + m * 16) * ldc + col0;
#pragma unroll
                for (int bj = 0; bj < 2; ++bj) *(GAS u32x4*)(rowp + bj * HALF) = pack8(acc[ai][bj][m][0], acc[ai][bj][m][1]); }
    }
};

struct MergeOrder {
    int G, vc;
    __device__ bool next(int i, Unit& u) const {
        const int tile = vc + G * (i >> 2); if (tile >= (MTOK / BM) * (DM / BM)) return false;
        u.pm = tile >> 2; u.pn = tile & 3; u.e = i & 3; u.lbase = 0; u.nv = 256;
        u.acol = (u.e == 0) ? PC_NAQ : (u.e == 1) ? PC_WQ : (u.e == 2) ? PC_YC : PC_AXQ;
        return true;
    }
};

struct MoeOrder {
    int G, c, sh; const LAS int* tend; const LAS int* cnt;
    __device__ bool next(int i, Unit& u) const {
        const int L = i * G + c, tau = L >> sh;
        const int total = __builtin_amdgcn_readfirstlane(tend[NEXP - 1]);
        if (tau >= total) return false;
        int e = 0;
        while (e < NEXP - 1 && __builtin_amdgcn_readfirstlane(tend[e]) <= tau) ++e;
        const int ts = e ? __builtin_amdgcn_readfirstlane(tend[e - 1]) : 0, lt = tau - ts;
        int nv = __builtin_amdgcn_readfirstlane(cnt[e]) - 256 * lt; nv = nv > 256 ? 256 : nv;
        u.pm = tau; u.pn = L & ((1 << sh) - 1); u.e = e; u.acol = 0; u.lbase = e * LISTCAP + 256 * lt; u.nv = nv;
        return true;
    }
};
}
namespace pg8 {
struct MUnit { int pm, pn; };
__device__ __forceinline__ void merge_phase(LAS unsigned char* lds, const bf16_t* Pp, const bf16_t* Wbt, bf16_t* HBo, int G, int vc, int tid) {
    asm volatile("" : "+v"(tid));
    const int wid = __builtin_amdgcn_readfirstlane(tid >> 6), lane = tid & 63, wr = wid >> 2, wc = wid & 3, fr = lane & 15, fq = lane >> 4;
    constexpr int nt = 16, NU = (MTOK / 128) * (DM / 256);
    unsigned voffA[2], voffB[2];
#pragma unroll
    for (int i = 0; i < 2; ++i) { int R, C; stage_rc(tid * 16 + i * 8192, R, C); const int Rb = (R & ~31) + perm32(R & 31);
        voffA[i] = (unsigned)(R * LDP + C) * 2u; voffB[i] = (unsigned)(Rb * 256 + C) * 2u; }
    const unsigned ldsw = (unsigned)wid * 1024u;
    const int aoff = lds_byte(wr * 64 + fr, fq * 8), boff = lds_byte(wc * 32 + fr, fq * 8);
#define MG_SA(b) (((b) * 2) * HTB)
#define MG_SB(b, h) ((4 + (b) * 2 + (h)) * HTB)
#define MG_STAGE(bufoff, gbase, voff) do { _Pragma("unroll") for (int _i = 0; _i < 2; ++_i) \
        __builtin_amdgcn_global_load_lds((const unsigned*)((const char*)(gbase) + (voff)[_i]), (LAS unsigned*)(lds + (bufoff) + ldsw + _i * 8192), 16, 0, 0); } while (0)
#define MG_LDA(dst, b) do { _Pragma("unroll") for (int m = 0; m < 4; ++m) _Pragma("unroll") for (int k = 0; k < 2; ++k) dst[m][k] = *(const LAS bf16x8*)(lds + MG_SA(b) + aoff + m * 2048 + k * 1024); } while (0)
#define MG_LDB(dst, b, h) do { _Pragma("unroll") for (int n = 0; n < 2; ++n) _Pragma("unroll") for (int k = 0; k < 2; ++k) dst[n][k] = *(const LAS bf16x8*)(lds + MG_SB(b, h) + boff + n * 2048 + k * 1024); } while (0)
#define MG_MMA(bj, At, Bt) do { __builtin_amdgcn_s_setprio(1); _Pragma("unroll") for (int m = 0; m < 4; ++m) _Pragma("unroll") for (int n = 0; n < 2; ++n) _Pragma("unroll") for (int k = 0; k < 2; ++k) \
        acc[bj][m][n] = __builtin_amdgcn_mfma_f32_16x16x32_bf16(Bt[n][k], At[m][k], acc[bj][m][n], 0, 0, 0); __builtin_amdgcn_s_setprio(0); } while (0)
#define MG_WAIT_V(n) asm volatile("s_waitcnt vmcnt(" #n ")" ::: "memory")
#define MG_WAIT_L(n) asm volatile("s_waitcnt lgkmcnt(" #n ")" ::: "memory")
#define MG_BAR __builtin_amdgcn_s_barrier()
#define MG_SCHED __builtin_amdgcn_sched_barrier(0)
    const char* Ab = (const char*)Pp; const char* Bb = (const char*)Wbt; asm volatile("" : "+s"(Ab), "+s"(Bb)); Ab = (const char*)(const GAS char*)Ab; Bb = (const char*)(const GAS char*)Bb;
#define MG_ACOL(n) ((n) == 0 ? PC_NAQ : (n) == 1 ? PC_WQ : (n) == 2 ? PC_YC : PC_AXQ)
#define MG_A(u, kt) (Ab + ((size_t)(u).pm * 128 * LDP + MG_ACOL((kt) >> 2) + ((kt) & 3) * 64) * 2)
#define MG_B(u, kt) (Bb + ((size_t)(((kt) >> 2) * DM + (u).pn * 256) * 256 + ((kt) & 3) * 64) * 2)
    constexpr size_t hstepB = (size_t)HALF * 256 * 2, kstep = 128;
    MUnit cur, nxt; int ui = 0;
    { const int idx = vc; if (idx >= NU) return; cur.pm = idx >> 2; cur.pn = idx & 3; }
    f32x4 acc[2][4][2], sum[2][4][2];
#pragma unroll
    for (int b = 0; b < 2; ++b)
#pragma unroll
        for (int m = 0; m < 4; ++m)
#pragma unroll
            for (int n = 0; n < 2; ++n) { acc[b][m][n] = (f32x4){0.f, 0.f, 0.f, 0.f}; sum[b][m][n] = (f32x4){0.f, 0.f, 0.f, 0.f}; }
    bf16x8 At[4][2], B0[2][2], B1[2][2];
    u32x2 gw[4][2];
#pragma unroll
    for (int m = 0; m < 4; ++m) { gw[m][0] = (u32x2){0u, 0u}; gw[m][1] = (u32x2){0u, 0u}; }
    { const char* b0_ = MG_B(cur, 0); MG_STAGE(MG_SB(0, 0), b0_, voffB); MG_STAGE(MG_SB(0, 1), b0_ + hstepB, voffB); MG_STAGE(MG_SA(0), MG_A(cur, 0), voffA); }
    if (wr == 1) MG_BAR;
    MG_WAIT_V(0); MG_BAR;
    { const char* b1_ = MG_B(cur, 1); MG_STAGE(MG_SB(1, 0), b1_, voffB); MG_STAGE(MG_SA(1), MG_A(cur, 1), voffA); MG_STAGE(MG_SB(1, 1), b1_ + hstepB, voffB); }
    MG_WAIT_V(6); MG_BAR;
    for (;;) {
        bool has_next; { const int idx = vc + G * (ui + 1); has_next = idx < NU; nxt.pm = idx >> 2; nxt.pn = idx & 3; }
#pragma unroll 1
        for (int t = 0; t < nt; t += 2) {
            const bool last = (t == nt - 2);
            const char* a2 = last ? (has_next ? MG_A(nxt, 0) : MG_A(cur, 0)) : MG_A(cur, t + 2);
            const char* b2 = last ? (has_next ? MG_B(nxt, 0) : MG_B(cur, 0)) : MG_B(cur, t + 2);
            const char* a3 = a2 + kstep; const char* b3 = b2 + kstep;
            if ((t & 3) == 0) {
                const int n = t >> 2; int lx = lane; asm volatile("" : "+v"(lx));
                const unsigned char* gp = (const unsigned char*)Pp + gate_off(cur.pm >> 1, 4 * n + cur.pn, wid, cur.pm & 1, lx);
#pragma unroll
                for (int m = 0; m < 4; ++m) { const u32x4 w4 = *(const GAS u32x4*)(gp + m * 16); gw[m][0] = (u32x2){w4.x, w4.y}; gw[m][1] = (u32x2){w4.z, w4.w}; }
            }
            MG_LDB(B0, 0, 0); MG_LDB(B1, 0, 1); MG_SCHED; MG_LDA(At, 0);
            MG_WAIT_L(0); MG_BAR; MG_MMA(0, At, B0); MG_MMA(1, At, B1); MG_BAR; MG_SCHED;
            MG_STAGE(MG_SB(0, 0), b2, voffB); MG_STAGE(MG_SB(0, 1), b2 + hstepB, voffB); MG_STAGE(MG_SA(0), a2, voffA);
            if ((t & 3) == 0) MG_WAIT_V(10); else MG_WAIT_V(6);
            MG_WAIT_L(0); MG_BAR; MG_BAR; MG_SCHED;
            MG_LDB(B0, 1, 0); MG_LDB(B1, 1, 1); MG_SCHED; MG_LDA(At, 1);
            MG_WAIT_L(0); MG_BAR; MG_MMA(0, At, B0); MG_MMA(1, At, B1); MG_BAR; MG_SCHED;
            if ((t & 3) == 2) {
#pragma unroll
                for (int m = 0; m < 4; ++m)
#pragma unroll
                    for (int bj = 0; bj < 2; ++bj) { const unsigned ga = gw[m][bj].x, gb = gw[m][bj].y; constexpr float Kq = 1.0f / 255.0f;
                        const f32x4 g0 = (f32x4){(float)(ga & 0xffu), (float)((ga >> 8) & 0xffu), (float)((ga >> 16) & 0xffu), (float)(ga >> 24)} * Kq;
                        const f32x4 g1 = (f32x4){(float)(gb & 0xffu), (float)((gb >> 8) & 0xffu), (float)((gb >> 16) & 0xffu), (float)(gb >> 24)} * Kq;
                        sum[bj][m][0] += g0 * acc[bj][m][0]; sum[bj][m][1] += g1 * acc[bj][m][1];
                        acc[bj][m][0] = (f32x4){0.f, 0.f, 0.f, 0.f}; acc[bj][m][1] = (f32x4){0.f, 0.f, 0.f, 0.f}; }
                asm volatile("" ::: "memory");
            }
            MG_STAGE(MG_SB(1, 0), b3, voffB); MG_STAGE(MG_SB(1, 1), b3 + hstepB, voffB); MG_STAGE(MG_SA(1), a3, voffA);
            MG_WAIT_V(6); MG_WAIT_L(0); MG_BAR; MG_BAR; MG_SCHED;
        }
        if (wr == 0) MG_BAR;
        { const int row0 = cur.pm * 128 + wr * 64 + fr, col0 = cur.pn * 256 + wc * 32 + 8 * fq;
#pragma unroll
          for (int m = 0; m < 4; ++m)
#pragma unroll
              for (int bj = 0; bj < 2; ++bj) { *(GAS u32x4*)(HBo + (size_t)(row0 + m * 16) * DM + col0 + bj * HALF) = pack8(sum[bj][m][0], sum[bj][m][1]);
                  sum[bj][m][0] = (f32x4){0.f, 0.f, 0.f, 0.f}; sum[bj][m][1] = (f32x4){0.f, 0.f, 0.f, 0.f}; } }
        if (!has_next) break;
        cur = nxt; ++ui;
        if (wr == 1) MG_BAR;
    }
    MG_WAIT_V(0);
    MG_BAR;
#undef MG_SA
#undef MG_SB
#undef MG_STAGE
#undef MG_LDA
#undef MG_LDB
#undef MG_MMA
#undef MG_WAIT_V
#undef MG_WAIT_L
#undef MG_BAR
#undef MG_SCHED
#undef MG_ACOL
#undef MG_A
#undef MG_B
}
}

namespace pg8 {
__device__ __forceinline__ f32x4 gate_q4(unsigned w) {
    f32x4 q = (f32x4){(float)(w & 0xffu), (float)((w >> 8) & 0xffu), (float)((w >> 16) & 0xffu), (float)(w >> 24)};
    return q;
}
__device__ __forceinline__ f32x4 rcp4(f32x4 v) { return (f32x4){__builtin_amdgcn_rcpf(v[0]), __builtin_amdgcn_rcpf(v[1]), __builtin_amdgcn_rcpf(v[2]), __builtin_amdgcn_rcpf(v[3])}; }
__device__ __forceinline__ void merge_phase2(LAS unsigned char* lds, const bf16_t* Pp, const bf16_t* Wbt, bf16_t* HBo, int G, int vc, int tid) {
    asm volatile("" : "+v"(tid));
    const int wid = __builtin_amdgcn_readfirstlane(tid >> 6), lane = tid & 63, wr = wid >> 2, wc = wid & 3, fr = lane & 15, fq = lane >> 4;
    constexpr int nt = 16, NU = (MTOK / 256) * (DM / 256);
    unsigned voffA[2], voffB[2];
#pragma unroll
    for (int i = 0; i < 2; ++i) { int R, C; stage_rc(tid * 16 + i * 8192, R, C); const int Rb = (R & ~31) + perm32(R & 31);
        voffA[i] = (unsigned)(R * LDP + C) * 2u; voffB[i] = (unsigned)(Rb * 256 + C) * 2u; }
    const unsigned ldsw = (unsigned)wid * 1024u;
    const int aoff = lds_byte(wr * 64 + fr, fq * 8), boff = lds_byte(wc * 32 + fr, fq * 8);
#define M2_SA(b, h) (((b) * 2 + (h)) * HTB)
#define M2_SB(b, h) ((4 + (b) * 2 + (h)) * HTB)
#define M2_STAGE(bufoff, gbase, voff) do { _Pragma("unroll") for (int _i = 0; _i < 2; ++_i) \
        __builtin_amdgcn_global_load_lds((const unsigned*)((const char*)(gbase) + (voff)[_i]), (LAS unsigned*)(lds + (bufoff) + ldsw + _i * 8192), 16, 0, 0); } while (0)
#define M2_LDA(dst, b, h) do { _Pragma("unroll") for (int m = 0; m < 4; ++m) _Pragma("unroll") for (int k = 0; k < 2; ++k) dst[m][k] = *(const LAS bf16x8*)(lds + M2_SA(b, h) + aoff + m * 2048 + k * 1024); } while (0)
#define M2_LDB(dst, b, h) do { _Pragma("unroll") for (int n = 0; n < 2; ++n) _Pragma("unroll") for (int k = 0; k < 2; ++k) dst[n][k] = *(const LAS bf16x8*)(lds + M2_SB(b, h) + boff + n * 2048 + k * 1024); } while (0)
#define M2_MMA(ai, bj, At, Bt) do { __builtin_amdgcn_s_setprio(1); _Pragma("unroll") for (int m = 0; m < 4; ++m) _Pragma("unroll") for (int n = 0; n < 2; ++n) _Pragma("unroll") for (int k = 0; k < 2; ++k) \
        acc[ai][bj][m][n] = __builtin_amdgcn_mfma_f32_16x16x32_bf16(Bt[n][k], At[m][k], acc[ai][bj][m][n], 0, 0, 0); __builtin_amdgcn_s_setprio(0); } while (0)
#define M2_WAIT_V(n) asm volatile("s_waitcnt vmcnt(" #n ")" ::: "memory")
#define M2_WAIT_L(n) asm volatile("s_waitcnt lgkmcnt(" #n ")" ::: "memory")
#define M2_BAR __builtin_amdgcn_s_barrier()
#define M2_SCHED __builtin_amdgcn_sched_barrier(0)
    const char* Ab = (const char*)Pp; const char* Bb = (const char*)Wbt; asm volatile("" : "+s"(Ab), "+s"(Bb)); Ab = (const char*)(const GAS char*)Ab; Bb = (const char*)(const GAS char*)Bb;
#define M2_ACOL(n) ((n) == 0 ? PC_NAQ : (n) == 1 ? PC_WQ : (n) == 2 ? PC_YC : PC_AXQ)
#define M2_A(u, kt) (Ab + ((size_t)(u).pm * 256 * LDP + M2_ACOL((kt) >> 2) + ((kt) & 3) * 64) * 2)
#define M2_B(u, kt) (Bb + ((size_t)(((kt) >> 2) * DM + (u).pn * 256) * 256 + ((kt) & 3) * 64) * 2)
    constexpr size_t hstepB = (size_t)HALF * 256 * 2, hstepA = (size_t)HALF * LDP * 2, kstep = 128;
    MUnit cur, nxt; int ui = 0;
    { const int idx = vc; if (idx >= NU) return; cur.pm = idx >> 2; cur.pn = idx & 3; }
    f32x4 acc[2][2][4][2];
#pragma unroll
    for (int a = 0; a < 2; ++a)
#pragma unroll
        for (int b = 0; b < 2; ++b)
#pragma unroll
            for (int m = 0; m < 4; ++m)
#pragma unroll
                for (int n = 0; n < 2; ++n) acc[a][b][m][n] = (f32x4){0.f, 0.f, 0.f, 0.f};
    bf16x8 At[4][2], B0[2][2], B1[2][2];
    u32x2 ga[4][2], gb[4][2];
#pragma unroll
    for (int m = 0; m < 4; ++m) { ga[m][0] = (u32x2){0u, 0u}; ga[m][1] = ga[m][0]; gb[m][0] = ga[m][0]; gb[m][1] = ga[m][0]; }
#define M2_GLOAD(ai, n) do { int lx = lane; asm volatile("" : "+v"(lx)); const unsigned char* gp = (const unsigned char*)Pp + gate_off(cur.pm, 4 * (n) + cur.pn, wid, (ai), lx); \
        _Pragma("unroll") for (int m = 0; m < 4; ++m) { const u32x4 wa = *(const GAS u32x4*)(gp + m * 16), wb_ = *(const GAS u32x4*)(gp + 4 * 65536 + m * 16); \
            ga[m][0] = (u32x2){wa.x, wa.y}; ga[m][1] = (u32x2){wa.z, wa.w}; gb[m][0] = (u32x2){wb_.x, wb_.y}; gb[m][1] = (u32x2){wb_.z, wb_.w}; } } while (0)
#define M2_GSCALE(ai) do { _Pragma("unroll") for (int m = 0; m < 4; ++m) _Pragma("unroll") for (int bj = 0; bj < 2; ++bj) { \
            acc[ai][bj][m][0] = acc[ai][bj][m][0] * (gate_q4(ga[m][bj].x) * rcp4(gate_q4(gb[m][bj].x))); \
            acc[ai][bj][m][1] = acc[ai][bj][m][1] * (gate_q4(ga[m][bj].y) * rcp4(gate_q4(gb[m][bj].y))); } } while (0)
    { const char* cA = M2_A(cur, 0); const char* cB = M2_B(cur, 0);
      M2_STAGE(M2_SB(0, 0), cB, voffB); M2_STAGE(M2_SB(0, 1), cB + hstepB, voffB); M2_STAGE(M2_SA(0, 0), cA, voffA); M2_STAGE(M2_SA(0, 1), cA + hstepA, voffA);
      if (wr == 1) M2_BAR;
      M2_WAIT_V(2); M2_BAR;
      M2_STAGE(M2_SB(1, 0), cB + kstep, voffB); M2_STAGE(M2_SA(1, 0), cA + kstep, voffA); M2_STAGE(M2_SB(1, 1), cB + hstepB + kstep, voffB);
      M2_WAIT_V(6); M2_BAR; }
    for (;;) {
        bool has_next; { const int idx = vc + G * (ui + 1); has_next = idx < NU; nxt.pm = idx >> 2; nxt.pn = idx & 3; }
#pragma unroll 1
        for (int t = 0; t < nt; t += 2) {
            const bool last = (t == nt - 2);
            const bool bnd = ((t & 3) == 2) && !last;
            const bool pend = ((t & 3) == 0) && t != 0;
            const char* a1 = M2_A(cur, t) + kstep;
            const char* a2 = last ? (has_next ? M2_A(nxt, 0) : M2_A(cur, 0)) : M2_A(cur, t + 2);
            const char* b2 = last ? (has_next ? M2_B(nxt, 0) : M2_B(cur, 0)) : M2_B(cur, t + 2);
            const char* a3 = a2 + kstep; const char* b3 = b2 + kstep;
            M2_LDB(B0, 0, 0); M2_LDB(B1, 0, 1); M2_SCHED; M2_LDA(At, 0, 0); M2_STAGE(M2_SA(1, 1), a1 + hstepA, voffA);
            if (pend) M2_WAIT_V(16); else M2_WAIT_V(8);
            M2_WAIT_L(0); M2_BAR; M2_MMA(0, 0, At, B0); M2_MMA(0, 1, At, B1); M2_BAR; M2_SCHED;
            if (pend) { M2_WAIT_V(2); M2_GSCALE(1); M2_SCHED; }
            M2_LDA(At, 0, 1); M2_STAGE(M2_SB(0, 0), b2, voffB); M2_STAGE(M2_SB(0, 1), b2 + hstepB, voffB); M2_STAGE(M2_SA(0, 0), a2, voffA);
            M2_WAIT_V(8); M2_WAIT_L(0); M2_BAR; M2_MMA(1, 0, At, B0); M2_MMA(1, 1, At, B1); M2_BAR; M2_SCHED;
            if (bnd) { M2_GLOAD(0, t >> 2); }
            M2_LDB(B0, 1, 0); M2_LDB(B1, 1, 1); M2_SCHED; M2_LDA(At, 1, 0); M2_STAGE(M2_SA(0, 1), a2 + hstepA, voffA);
            if (bnd) M2_WAIT_V(16); else M2_WAIT_V(8);
            M2_WAIT_L(0); M2_BAR; M2_MMA(0, 0, At, B0); M2_MMA(0, 1, At, B1); M2_BAR; M2_SCHED;
            M2_LDA(At, 1, 1); M2_STAGE(M2_SB(1, 0), b3, voffB); M2_STAGE(M2_SB(1, 1), b3 + hstepB, voffB); M2_STAGE(M2_SA(1, 0), a3, voffA);
            M2_WAIT_V(8); M2_WAIT_L(0); M2_BAR; M2_MMA(1, 0, At, B0); M2_MMA(1, 1, At, B1); if (bnd) { M2_SCHED; M2_GSCALE(0); } M2_BAR;
            if (bnd) { M2_GLOAD(1, t >> 2); }
            M2_SCHED;
        }
        if (wr == 0) M2_BAR;
        { int frx = fr; asm volatile("" : "+v"(frx)); const int row0 = cur.pm * 256 + wr * 64 + frx, col0 = cur.pn * 256 + wc * 32 + 8 * fq;
#pragma unroll
          for (int ai = 0; ai < 2; ++ai) {
              u32x2 g3[4][2];
              { const unsigned char* gp = (const unsigned char*)Pp + gate_off(cur.pm, 12 + cur.pn, wid, ai, frx + 16 * fq);
#pragma unroll
                for (int m = 0; m < 4; ++m) { const u32x4 w4 = *(const GAS u32x4*)(gp + m * 16); g3[m][0] = (u32x2){w4.x, w4.y}; g3[m][1] = (u32x2){w4.z, w4.w}; } }
#pragma unroll
              for (int m = 0; m < 4; ++m)
#pragma unroll
                  for (int bj = 0; bj < 2; ++bj) { constexpr float Kq = 1.0f / 255.0f;
                      *(GAS u32x4*)(HBo + (size_t)(row0 + ai * HALF + m * 16) * DM + col0 + bj * HALF) = pack8(acc[ai][bj][m][0] * (gate_q4(g3[m][bj].x) * Kq), acc[ai][bj][m][1] * (gate_q4(g3[m][bj].y) * Kq));
                      acc[ai][bj][m][0] = (f32x4){0.f, 0.f, 0.f, 0.f}; acc[ai][bj][m][1] = (f32x4){0.f, 0.f, 0.f, 0.f}; }
              asm volatile("" ::: "memory"); } }
        if (!has_next) break;
        cur = nxt; ++ui;
        if (wr == 1) M2_BAR;
    }
    M2_WAIT_V(0);
    M2_BAR;
#undef M2_SA
#undef M2_SB
#undef M2_STAGE
#undef M2_LDA
#undef M2_LDB
#undef M2_MMA
#undef M2_WAIT_V
#undef M2_WAIT_L
#undef M2_BAR
#undef M2_SCHED
#undef M2_GLOAD
#undef M2_GSCALE
#undef M2_ACOL
#undef M2_A
#undef M2_B
}
__device__ __forceinline__ void merge_phase3(LAS unsigned char* lds, const bf16_t* Pp, const unsigned char* Y8, const unsigned char* Wb8, bf16_t* HBo, int G, int vc, int tid) {
    asm volatile("" : "+v"(tid));
    const int wid = __builtin_amdgcn_readfirstlane(tid >> 6), lane = tid & 63, wr = wid >> 2, wc = wid & 3, fr = lane & 15, fq = lane >> 4;
    constexpr int nt = 8, NU = (MTOK / 256) * (DM / 256);
    unsigned voffA[2], voffB[2];
#pragma unroll
    for (int i = 0; i < 2; ++i) { int R, C; stage_rc(tid * 16 + i * 8192, R, C); const int Rb = (R & ~31) + perm32(R & 31);
        voffA[i] = (unsigned)(R * 1024 + C * 2); voffB[i] = (unsigned)(Rb * 256 + C * 2); }
    const unsigned ldsw = (unsigned)wid * 1024u;
    const int aoff = lds_byte(wr * 64 + fr, fq * 8), boff = lds_byte(wc * 32 + fr, fq * 8);
#define M2_SA(b, h) (((b) * 2 + (h)) * HTB)
#define M2_SB(b, h) ((4 + (b) * 2 + (h)) * HTB)
#define M2_STAGE(bufoff, gbase, voff) do { _Pragma("unroll") for (int _i = 0; _i < 2; ++_i) \
        __builtin_amdgcn_global_load_lds((const unsigned*)((const char*)(gbase) + (voff)[_i]), (LAS unsigned*)(lds + (bufoff) + ldsw + _i * 8192), 16, 0, 0); } while (0)
#define M2_LDA(dst, b, h) do { _Pragma("unroll") for (int m = 0; m < 4; ++m) { dst[m].lo = *(const LAS i32x4*)(lds + M2_SA(b, h) + aoff + m * 2048); dst[m].hi = *(const LAS i32x4*)(lds + M2_SA(b, h) + aoff + m * 2048 + 1024); } } while (0)
#define M2_LDB(dst, b, h) do { _Pragma("unroll") for (int n = 0; n < 2; ++n) { dst[n].lo = *(const LAS i32x4*)(lds + M2_SB(b, h) + boff + n * 2048); dst[n].hi = *(const LAS i32x4*)(lds + M2_SB(b, h) + boff + n * 2048 + 1024); } } while (0)
#define M2_MMA(ai, bj, At, Bt) do { __builtin_amdgcn_s_setprio(1); _Pragma("unroll") for (int m = 0; m < 4; ++m) _Pragma("unroll") for (int n = 0; n < 2; ++n) \
        asm volatile("v_mfma_scale_f32_16x16x128_f8f6f4 %0, %1, %2, %0, %3, %3 op_sel_hi:[0,0,0]" : "+v"(acc[ai][bj][m][n]) : "v"(Bt[n]), "v"(At[m]), "v"(sc127)); __builtin_amdgcn_s_setprio(0); } while (0)
#define M2_WAIT_V(n) asm volatile("s_waitcnt vmcnt(" #n ")" ::: "memory")
#define M2_WAIT_L(n) asm volatile("s_waitcnt lgkmcnt(" #n ")" ::: "memory")
#define M2_BAR __builtin_amdgcn_s_barrier()
#define M2_SCHED __builtin_amdgcn_sched_barrier(0)
    const char* Ab = (const char*)Y8; const char* Bb = (const char*)Wb8; asm volatile("" : "+s"(Ab), "+s"(Bb)); Ab = (const char*)(const GAS char*)Ab; Bb = (const char*)(const GAS char*)Bb;
#define M2_A(u, kt) (Ab + ((size_t)(u).pm * 256 * 1024 + ((kt) >> 1) * 256 + ((kt) & 1) * 128))
#define M2_B(u, kt) (Bb + ((size_t)(((kt) >> 1) * DM + (u).pn * 256) * 256 + ((kt) & 1) * 128))
    constexpr size_t hstepB = (size_t)HALF * 256, hstepA = (size_t)HALF * 1024, kstep = 128;
    MUnit cur, nxt; int ui = 0;
    { const int idx = vc; if (idx >= NU) return; cur.pm = idx >> 2; cur.pn = idx & 3; }
    f32x4 acc[2][2][4][2];
    i32x8 At[4], B0[2], B1[2];
    int sc127 = 127; asm volatile("" : "+v"(sc127));
    u32x4 ga4[4], gb4[4];
#define M2_GLOAD(ai, n) do { const int lx = lane_now(); const unsigned char* gp = (const unsigned char*)Pp + gate_off(cur.pm, 4 * (n) + cur.pn, wid, (ai), lx); \
        _Pragma("unroll") for (int m = 0; m < 4; ++m) { ga4[m] = *(const GAS u32x4*)(gp + m * 16); gb4[m] = *(const GAS u32x4*)(gp + 4 * 65536 + m * 16); } } while (0)
#define M2_GSCALE(ai) do { _Pragma("unroll") for (int m = 0; m < 4; ++m) { \
            acc[ai][0][m][0] = acc[ai][0][m][0] * (gate_q4(ga4[m].x) * rcp4(gate_q4(gb4[m].x))); acc[ai][0][m][1] = acc[ai][0][m][1] * (gate_q4(ga4[m].y) * rcp4(gate_q4(gb4[m].y))); \
            acc[ai][1][m][0] = acc[ai][1][m][0] * (gate_q4(ga4[m].z) * rcp4(gate_q4(gb4[m].z))); acc[ai][1][m][1] = acc[ai][1][m][1] * (gate_q4(ga4[m].w) * rcp4(gate_q4(gb4[m].w))); } } while (0)
    { const char* cA = M2_A(cur, 0); const char* cB = M2_B(cur, 0);
      M2_STAGE(M2_SB(0, 0), cB, voffB); M2_SCHED; M2_STAGE(M2_SB(0, 1), cB + hstepB, voffB); M2_SCHED; M2_STAGE(M2_SA(0, 0), cA, voffA); M2_SCHED; M2_STAGE(M2_SA(0, 1), cA + hstepA, voffA); M2_SCHED;
      if (wr == 1) M2_BAR;
      M2_WAIT_V(2); M2_BAR;
      M2_STAGE(M2_SB(1, 0), cB + kstep, voffB); M2_SCHED; M2_STAGE(M2_SA(1, 0), cA + kstep, voffA); M2_SCHED; M2_STAGE(M2_SB(1, 1), cB + hstepB + kstep, voffB); M2_SCHED;
      M2_WAIT_V(6); M2_BAR; }
    M2_SCHED;
#pragma unroll
    for (int a = 0; a < 2; ++a)
#pragma unroll
        for (int b = 0; b < 2; ++b)
#pragma unroll
            for (int m = 0; m < 4; ++m)
#pragma unroll
                for (int n = 0; n < 2; ++n) acc[a][b][m][n] = (f32x4){0.f, 0.f, 0.f, 0.f};
    for (;;) {
        asm volatile("" : "+s"(Ab), "+s"(Bb));
        bool has_next; { const int idx = vc + G * (ui + 1); has_next = idx < NU; nxt.pm = idx >> 2; nxt.pn = idx & 3; }
#pragma unroll 1
        for (int t = 0; t < nt; t += 2) {
            const bool last = (t == nt - 2);
            asm volatile("" : "+v"(voffA[0]), "+v"(voffA[1]), "+v"(voffB[0]), "+v"(voffB[1]));
            const bool bnd = !last;
            const bool pend = t != 0;
            const char* a1 = M2_A(cur, t) + kstep;
            const char* a2 = last ? (has_next ? M2_A(nxt, 0) : M2_A(cur, 0)) : M2_A(cur, t + 2);
            const char* b2 = last ? (has_next ? M2_B(nxt, 0) : M2_B(cur, 0)) : M2_B(cur, t + 2);
            const char* a3 = a2 + kstep; const char* b3 = b2 + kstep;
            M2_LDB(B0, 0, 0); M2_LDB(B1, 0, 1); M2_SCHED; M2_LDA(At, 0, 0); M2_STAGE(M2_SA(1, 1), a1 + hstepA, voffA);
            if (pend) M2_WAIT_V(16); else M2_WAIT_V(8);
            M2_WAIT_L(0); M2_BAR; M2_MMA(0, 0, At, B0); M2_MMA(0, 1, At, B1); M2_BAR; M2_SCHED;
            if (pend) { M2_WAIT_V(2); M2_GSCALE(1); M2_SCHED; }
            M2_LDA(At, 0, 1); M2_STAGE(M2_SB(0, 0), b2, voffB); M2_STAGE(M2_SB(0, 1), b2 + hstepB, voffB); M2_STAGE(M2_SA(0, 0), a2, voffA);
            M2_WAIT_V(8); M2_WAIT_L(0); M2_BAR; M2_MMA(1, 0, At, B0); M2_MMA(1, 1, At, B1); M2_BAR; M2_SCHED;
            if (bnd) { M2_GLOAD(0, t >> 1); }
            M2_LDB(B0, 1, 0); M2_LDB(B1, 1, 1); M2_SCHED; M2_LDA(At, 1, 0); M2_STAGE(M2_SA(0, 1), a2 + hstepA, voffA);
            if (bnd) M2_WAIT_V(16); else M2_WAIT_V(8);
            M2_WAIT_L(0); M2_BAR; M2_MMA(0, 0, At, B0); M2_MMA(0, 1, At, B1); M2_BAR; M2_SCHED;
            M2_LDA(At, 1, 1); M2_STAGE(M2_SB(1, 0), b3, voffB); M2_STAGE(M2_SB(1, 1), b3 + hstepB, voffB); M2_STAGE(M2_SA(1, 0), a3, voffA);
            M2_WAIT_V(8); M2_WAIT_L(0); M2_BAR; M2_MMA(1, 0, At, B0); M2_MMA(1, 1, At, B1); if (bnd) { M2_SCHED; M2_GSCALE(0); } M2_BAR;
            if (bnd) { M2_GLOAD(1, t >> 1); }
            M2_SCHED;
        }
        asm volatile("s_nop 15\n\ts_nop 15\n\ts_nop 15" ::: "memory");
        if (wr == 0) M2_BAR;
        { const int lnx = lane_now(), frx = lnx & 15, fqx = lnx >> 4; const int row0 = cur.pm * 256 + wr * 64 + frx, col0 = cur.pn * 256 + wc * 32 + 8 * fqx;
#pragma unroll
          for (int ai = 0; ai < 2; ++ai) {
              u32x2 g3[4][2];
              { const unsigned char* gp = (const unsigned char*)Pp + gate_off(cur.pm, 12 + cur.pn, wid, ai, lnx);
#pragma unroll
                for (int m = 0; m < 4; ++m) { const u32x4 w4 = *(const GAS u32x4*)(gp + m * 16); g3[m][0] = (u32x2){w4.x, w4.y}; g3[m][1] = (u32x2){w4.z, w4.w}; } }
#pragma unroll
              for (int m = 0; m < 4; ++m)
#pragma unroll
                  for (int bj = 0; bj < 2; ++bj) { constexpr float Kq = 1.0f / (255.0f * 256.0f);
                      *(GAS u32x4*)(HBo + (size_t)(row0 + ai * HALF + m * 16) * DM + col0 + bj * HALF) = pack8(acc[ai][bj][m][0] * (gate_q4(g3[m][bj].x) * Kq), acc[ai][bj][m][1] * (gate_q4(g3[m][bj].y) * Kq));
                      acc[ai][bj][m][0] = (f32x4){0.f, 0.f, 0.f, 0.f}; acc[ai][bj][m][1] = (f32x4){0.f, 0.f, 0.f, 0.f}; }
              asm volatile("" ::: "memory"); } }
        if (!has_next) break;
        cur = nxt; ++ui;
        if (wr == 1) M2_BAR;
    }
    M2_WAIT_V(0);
    M2_BAR;
#undef M2_SA
#undef M2_SB
#undef M2_STAGE
#undef M2_LDA
#undef M2_LDB
#undef M2_MMA
#undef M2_WAIT_V
#undef M2_WAIT_L
#undef M2_BAR
#undef M2_SCHED
#undef M2_GLOAD
#undef M2_GSCALE
#undef M2_A
#undef M2_B
}
}
namespace att {
constexpr int STG = 20480, VOFF = 12288;
constexpr int LDS_WSF = 3 * STG;
constexpr int LDS_OST = LDS_WSF + 8 * 512;
constexpr int LDS_BIAS = LDS_OST + 8 * 4096;
constexpr int LDS_BYTES = LDS_BIAS + 2048;
typedef short v4i16_t __attribute__((ext_vector_type(4)));

__device__ __forceinline__ int crow(int r, int hi) { return (r & 3) + 8 * (r >> 2) + 4 * hi; }
__device__ __forceinline__ s16x4 vtr(const LAS unsigned char* p) { return __builtin_bit_cast(s16x4, __builtin_amdgcn_ds_read_tr16_b64_v4i16((LAS v4i16_t*)p)); }
__device__ __forceinline__ void glds16(const void* gsrc, unsigned lds_dst) { unsigned keep;
    asm volatile("s_mov_b32 %0, m0\n\ts_mov_b32 m0, %2\n\ts_nop 0\n\tglobal_load_lds_dwordx4 %1, off\n\ts_mov_b32 m0, %0" : "=&s"(keep) : "v"(gsrc), "s"(lds_dst) : "memory"); }
__device__ __forceinline__ int clampi(int v, int lo, int hi) { return v < lo ? lo : (v > hi ? hi : v); }

__device__ __forceinline__ u32x2 bf8_to_fp8x8(const u32x4 v) { u32x2 w;
    w.x = pk_fp8x4(bflo(v.x) * 16.0f, bfhi(v.x) * 16.0f, bflo(v.y) * 16.0f, bfhi(v.y) * 16.0f); w.y = pk_fp8x4(bflo(v.z) * 16.0f, bfhi(v.z) * 16.0f, bflo(v.w) * 16.0f, bfhi(v.w) * 16.0f); return w; }
template <int DQ, int MODE, int VAR = 0, bool O8 = false>
__device__ __forceinline__ void attn_unit(const bf16_t* Qp, const bf16_t* Kp, const bf16_t* Vp, bf16_t* Op, int ldq, int ldk, int ldv, int ldo,
                                          int q0, float sc2, float par0, float par1, const float* biasp, LAS unsigned char* lds, int tid) {
    asm volatile("" : "+v"(tid));
    const int lane = tid & 63, r32 = lane & 31, hi = lane >> 5; const int wid = __builtin_amdgcn_readfirstlane(tid >> 6);
    constexpr int ND = DQ / 16;
    int t0 = 0, t1 = SEQ / 64 - 1;
    const int wq0 = q0 + wid * 32;
    int wt0 = 0, wt1 = SEQ / 64 - 1;
    if (MODE == 1) { t0 = (q0 >> 6) - 2; t0 = t0 < 0 ? 0 : t0; t1 = (q0 >> 6) + 5; t1 = t1 > 63 ? 63 : t1;
        int klo = wq0 - 128; klo = klo < 0 ? 0 : klo; int khi = wq0 + 31 + 128; khi = khi > SEQ - 1 ? SEQ - 1 : khi; wt0 = klo >> 6; wt1 = khi >> 6; }
    if (MODE == 2) { const int R0 = q0 >> 6; t0 = clampi(R0 - 4, 0, 56); t1 = clampi(R0 + 3 - 4, 0, 56) + 7; const int R = wq0 >> 6; wt0 = clampi(R - 4, 0, 56); wt1 = wt0 + 7; }
    LAS float* wsf = (LAS float*)(lds + LDS_WSF) + wid * 128;
    LAS float* bt = (LAS float*)(lds + LDS_BIAS);
    bf16x8 qr[ND];
    { const bf16_t* Qw = Qp + (size_t)(wq0 + r32) * ldq + hi * 8;
#pragma unroll
      for (int d0 = 0; d0 < ND; ++d0) qr[d0] = *(const GAS bf16x8*)(Qw + d0 * 16); }
    const bf16_t* ksrc = Kp + (size_t)lane * ldk + wid * 8;
    const bf16_t* ksrc2 = Kp + (size_t)lane * ldk + (8 + (wid & 3)) * 8;
    const bf16_t* vsrc = Vp + (size_t)(16 * (wid & 3) + (lane >> 2)) * ldv + (wid >> 2) * 32 + (lane & 3) * 8;
    const int kdst = wid * 1024 + lane * 16, kdst2 = (8 + (wid & 3)) * 1024 + lane * 16, vdst = VOFF + wid * 1024 + lane * 16;
    u32x4 kreg, kreg2, vreg; kreg2 = (u32x4){0u, 0u, 0u, 0u};
    u32x4 kregB, kreg2B, vregB; kreg2B = (u32x4){0u, 0u, 0u, 0u};
#define ATT_LOAD(t) do { if (VAR == 5) break; const size_t ro_ = (size_t)(t) * 64; kreg = *(const GAS u32x4*)(ksrc + ro_ * ldk); if (DQ == 96) kreg2 = *(const GAS u32x4*)(ksrc2 + ro_ * ldk); vreg = *(const GAS u32x4*)(vsrc + ro_ * ldv); } while (0)
#define ATT_STORE(s) do { if (VAR == 5) break; LAS unsigned char* sb_ = lds + (s) * STG; *(LAS u32x4*)(sb_ + kdst) = kreg; if (DQ == 96) *(LAS u32x4*)(sb_ + kdst2) = kreg2; *(LAS u32x4*)(sb_ + vdst) = vreg; } while (0)
#define ATT_LOADB(t) do { if (VAR == 5) break; const size_t ro_ = (size_t)(t) * 64; kregB = *(const GAS u32x4*)(ksrc + ro_ * ldk); if (DQ == 96) kreg2B = *(const GAS u32x4*)(ksrc2 + ro_ * ldk); vregB = *(const GAS u32x4*)(vsrc + ro_ * ldv); } while (0)
#define ATT_STOREB(s) do { if (VAR == 5) break; LAS unsigned char* sb_ = lds + (s) * STG; *(LAS u32x4*)(sb_ + kdst) = kregB; if (DQ == 96) *(LAS u32x4*)(sb_ + kdst2) = kreg2B; *(LAS u32x4*)(sb_ + vdst) = vregB; } while (0)
    ATT_LOAD(t0);
    if (MODE == 2) { for (int i = tid; i < 15 * 31; i += 512) bt[i] = biasp[i] * LOG2E; }
    ATT_STORE(0);
    if (t0 + 1 <= t1) { ATT_LOAD(t0 + 1); ATT_STORE(1); }
    constexpr float THR = 8.0f;
    float m2 = (MODE == 1) ? par1 : 0.0f;
    bool first = (MODE != 1);
    float lsum = (MODE == 1 && hi == 0) ? 1.0f : 0.0f;
    f32x16 o[2];
#pragma unroll
    for (int r = 0; r < 16; ++r) { o[0][r] = 0.f; o[1][r] = 0.f; }
    const int tq = wq0 + r32;
    const int na_ncs = 4 * hi - clampi((tq & 63) - 8, 0, 48), na_l = 4 * hi - (tq & 63) + 15; (void)na_ncs; (void)na_l;
    f32x16 p0, p1, n0, n1;
#pragma unroll
    for (int r = 0; r < 16; ++r) { p0[r] = 0.f; p1[r] = 0.f; n0[r] = 0.f; n1[r] = 0.f; }
#define ATT_QK(D0, D1, stg_) do { const LAS unsigned char* kb_ = lds + (stg_) * STG + hi * 1024 + r32 * 16; const float ni_ = -m2; \
        _Pragma("unroll") for (int r = 0; r < 16; ++r) { D0[r] = ni_; D1[r] = ni_; } \
        _Pragma("unroll") for (int d0 = 0; d0 < ND; ++d0) { \
            const bf16x8 b0_ = *(const LAS bf16x8*)(kb_ + d0 * 2048), b1_ = *(const LAS bf16x8*)(kb_ + d0 * 2048 + 512); \
            D0 = __builtin_amdgcn_mfma_f32_32x32x16_bf16(b0_, qr[d0], D0, 0, 0, 0); \
            D1 = __builtin_amdgcn_mfma_f32_32x32x16_bf16(b1_, qr[d0], D1, 0, 0, 0); } } while (0)
#define ATT_KPRE(stg_) do { if (VAR == 3 || (VAR == 6 && kfinit)) break; kfinit = true; const LAS unsigned char* kb_ = lds + (stg_) * STG + hi * 1024 + r32 * 16; \
        _Pragma("unroll") for (int d0 = 0; d0 < ND; ++d0) { kf[2 * d0] = *(const LAS bf16x8*)(kb_ + d0 * 2048); kf[2 * d0 + 1] = *(const LAS bf16x8*)(kb_ + d0 * 2048 + 512); } } while (0)
#define ATT_QKF(D0, D1) do { const float ni_ = -m2; \
        _Pragma("unroll") for (int r = 0; r < 16; ++r) { D0[r] = ni_; D1[r] = ni_; } \
        if (VAR == 3) break; \
        _Pragma("unroll") for (int d0 = 0; d0 < ND; ++d0) { \
            D0 = __builtin_amdgcn_mfma_f32_32x32x16_bf16(kf[2 * d0], qr[d0], D0, 0, 0, 0); \
            D1 = __builtin_amdgcn_mfma_f32_32x32x16_bf16(kf[2 * d0 + 1], qr[d0], D1, 0, 0, 0); } } while (0)
    __syncthreads();
    constexpr bool PIPE = true;
    int sc_ = 0, sn_ = 1, sw_ = 2;
#define ATT_HEAD(t, p0, p1, n0, n1) do { \
            float rm = -INFINITY; \
            int ncs_ = na_ncs, nbb_ = 0; if (MODE == 2) { asm volatile("" : "+v"(ncs_)); nbb_ = ((t) - (tq >> 6) + 7) * 31 + na_l; }        \
            const LAS float* bp_ = bt + nbb_; \
            float relb_ = 0.f; if (MODE == 1) { relb_ = (float)((t) * 64 + 4 * hi - tq); asm volatile("" : "+v"(relb_)); } \
            _Pragma("unroll") for (int r = 0; r < 16; ++r) { \
                const int kk = crow(r, hi); \
                float v0 = p0[r], v1 = p1[r]; \
                if (MODE == 1) {        \
                    const float rf0 = relb_ + (float)((r & 3) + 8 * (r >> 2)), rf1 = rf0 + 32.0f; \
                    v0 = (__builtin_fabsf(rf0) <= 128.0f) ? __builtin_fmaf(-par0, __builtin_fabsf(rf0), v0) : -INFINITY; \
                    v1 = (__builtin_fabsf(rf1) <= 128.0f) ? __builtin_fmaf(-par0, __builtin_fabsf(rf1), v1) : -INFINITY; \
                } \
                if (MODE == 2) {        \
                    const int cr = (r & 3) + 8 * (r >> 2); \
                    const unsigned d0c = (unsigned)(cr + ncs_), d1c = (unsigned)(cr + 32 + ncs_); \
                    v0 = (d0c < 16u) ? v0 + bp_[cr] : -INFINITY; \
                    v1 = (d1c < 16u) ? v1 + bp_[cr + 32] : -INFINITY; \
                } \
                if (MODE != 0) { p0[r] = v0; p1[r] = v1; } \
                rm = fmaxf(fmaxf(rm, v0), v1); \
            } \
            { auto rr = __builtin_amdgcn_permlane32_swap(__float_as_uint(rm), __float_as_uint(rm), false, false); rm = fmaxf(__uint_as_float(rr[0]), __uint_as_float(rr[1])); } \
            if (first) { \
                first = false; m2 = rm; \
                _Pragma("unroll") for (int r = 0; r < 16; ++r) { p0[r] -= rm; p1[r] -= rm; if (PIPE && MODE != 0) { n0[r] -= rm; n1[r] -= rm; } } \
            } else if (__any(rm > THR)) { \
                const float dl = fmaxf(rm, 0.f); m2 += dl; \
                _Pragma("unroll") for (int r = 0; r < 16; ++r) { p0[r] -= dl; p1[r] -= dl; if (PIPE && MODE != 0) { n0[r] -= dl; n1[r] -= dl; } } \
                const float f = __builtin_amdgcn_exp2f(-dl); \
                lsum *= f; \
                if (hi == 0) wsf[r32] = f; \
                asm volatile("s_waitcnt lgkmcnt(0)" ::: "memory"); \
                _Pragma("unroll") for (int g4 = 0; g4 < 4; ++g4) { const f32x4 f4 = *(const LAS f32x4*)(wsf + 8 * g4 + 4 * hi); \
                    _Pragma("unroll") for (int j = 0; j < 4; ++j) { o[0][4 * g4 + j] *= f4[j]; o[1][4 * g4 + j] *= f4[j]; } } \
                asm volatile("s_waitcnt lgkmcnt(0)" ::: "memory"); \
            } } while (0)
#define ATT_EXP_PV(stg_, p0, p1) do { \
            float sumA = 0.f, sumB = 0.f; \
            _Pragma("unroll") for (int r = 0; r < 16; ++r) { if (VAR != 1) { p0[r] = __builtin_amdgcn_exp2f(p0[r]); p1[r] = __builtin_amdgcn_exp2f(p1[r]); } sumA += p0[r]; sumB += p1[r]; } \
            lsum += sumA + sumB; \
            u32x4 pw[4]; \
            _Pragma("unroll") for (int j = 0; j < 4; ++j) { pw[0][j] = cvt_pk_bf16(p0[2 * j], p0[2 * j + 1]); pw[1][j] = cvt_pk_bf16(p0[8 + 2 * j], p0[8 + 2 * j + 1]); \
                                          pw[2][j] = cvt_pk_bf16(p1[2 * j], p1[2 * j + 1]); pw[3][j] = cvt_pk_bf16(p1[8 + 2 * j], p1[8 + 2 * j + 1]); } \
            const LAS unsigned char* vp = lds + (stg_) * STG + VOFF + ((lane >> 4) & 1) * 32 + (lane & 3) * 8 + (4 * hi + ((lane & 15) >> 2)) * 64; \
            if (VAR != 2) _Pragma("unroll") for (int i = 0; i < 8; ++i) { \
                const int iv_ = (VAR == 7) ? 0 : i; \
                const s16x4 lo = vtr(vp + (iv_ >> 2) * 4096 + (iv_ & 3) * 1024), hh = vtr(vp + (iv_ >> 2) * 4096 + (iv_ & 3) * 1024 + 512); \
                const bf16x8 vf = (bf16x8){lo[0], lo[1], lo[2], lo[3], hh[0], hh[1], hh[2], hh[3]}; \
                o[i >> 2] = __builtin_amdgcn_mfma_f32_32x32x16_bf16(__builtin_bit_cast(bf16x8, pw[i & 3]), vf, o[i >> 2], 0, 0, 0); \
            } } while (0)
#define ATT_ROT() do { const int tmp_ = sc_; sc_ = sn_; sn_ = sw_; sw_ = tmp_; } while (0)
    if constexpr (MODE == 0) {
        bf16x8 kf[2 * ND]; bool kfinit = false;
        ATT_KPRE(0); ATT_QKF(p0, p1);
        if (t0 + 2 <= t1) ATT_LOAD(t0 + 2);
        for (int t = t0; t + 1 < t1; t += 2) {
            if (t + 3 <= t1) ATT_LOADB(t + 3);
            ATT_KPRE(sn_);
            __builtin_amdgcn_sched_barrier(0);
            ATT_HEAD(t, p0, p1, n0, n1);
            ATT_QKF(n0, n1);
            ATT_EXP_PV(sc_, p0, p1);
            if (t + 2 <= t1) ATT_STORE(sw_);
            if (VAR != 4) __syncthreads();
            ATT_ROT();
            if (t + 4 <= t1) ATT_LOAD(t + 4);
            ATT_KPRE(sn_);
            __builtin_amdgcn_sched_barrier(0);
            ATT_HEAD(t + 1, n0, n1, p0, p1);
            ATT_QKF(p0, p1);
            ATT_EXP_PV(sc_, n0, n1);
            if (t + 3 <= t1) ATT_STOREB(sw_);
            if (VAR != 4) __syncthreads();
            ATT_ROT();
        }
        {
            ATT_KPRE(sn_);
            __builtin_amdgcn_sched_barrier(0);
            ATT_HEAD(t1 - 1, p0, p1, n0, n1);
            ATT_QKF(n0, n1);
            ATT_EXP_PV(sc_, p0, p1);
            __syncthreads();
            ATT_ROT();
        }
        ATT_HEAD(t1, n0, n1, p0, p1);
        ATT_EXP_PV(sc_, n0, n1);
        __syncthreads();
    } else {
        if (PIPE && t0 >= wt0 && t0 <= wt1) ATT_QK(p0, p1, 0);
        for (int t = t0; t <= t1; ++t) {
            if (t + 2 <= t1) ATT_LOAD(t + 2);
            if (PIPE) { const bool nin = (t + 1 <= t1) && (t + 1 >= wt0) && (t + 1 <= wt1); if (nin) ATT_QK(n0, n1, sn_); }
            else { if (t >= wt0 && t <= wt1) ATT_QK(p0, p1, sc_); }
            if (t >= wt0 && t <= wt1) { ATT_HEAD(t, p0, p1, n0, n1); ATT_EXP_PV(sc_, p0, p1); }
            if (t + 2 <= t1) ATT_STORE(sw_);
            __syncthreads();
            if (PIPE) { p0 = n0; p1 = n1; }
            ATT_ROT();
        }
    }
#undef ATT_HEAD
#undef ATT_EXP_PV
#undef ATT_ROT
#undef ATT_QK
#undef ATT_KPRE
#undef ATT_QKF
#undef ATT_LOAD
#undef ATT_LOADB
#undef ATT_STOREB
#undef ATT_STORE
    { auto rr = __builtin_amdgcn_permlane32_swap(__float_as_uint(lsum), __float_as_uint(lsum), false, false); lsum = __uint_as_float(rr[0]) + __uint_as_float(rr[1]); }
    if (hi == 0) wsf[32 + r32] = lsum;
    asm volatile("s_waitcnt lgkmcnt(0)" ::: "memory");
    float rli[16];
#pragma unroll
    for (int g4 = 0; g4 < 4; ++g4) { const f32x4 l4 = *(const LAS f32x4*)(wsf + 32 + 8 * g4 + 4 * hi);
#pragma unroll
        for (int j = 0; j < 4; ++j) rli[4 * g4 + j] = __builtin_amdgcn_rcpf(l4[j]); }
    LAS bf16_t* stg = (LAS bf16_t*)(lds + LDS_OST) + wid * 2048;
#pragma unroll
    for (int r = 0; r < 16; ++r) { const int orow = crow(r, hi);
#pragma unroll
        for (int d0 = 0; d0 < 2; ++d0) stg[orow * 64 + d0 * 32 + r32] = f2bf(o[d0][r] * rli[r]); }
    asm volatile("s_waitcnt lgkmcnt(0)" ::: "memory");
    bf16_t* Ow = Op + (size_t)wq0 * ldo;
#pragma unroll
    for (int i = 0; i < 4; ++i) { const int row = i * 8 + (lane >> 3), ch = lane & 7; const u32x4 v = *(const LAS u32x4*)(stg + row * 64 + ch * 8);
        if constexpr (O8) { *(GAS u32x2*)((unsigned char*)Op + (size_t)(wq0 + row) * ldo + ch * 8) = bf8_to_fp8x8(v); } else { *(GAS u32x4*)(Ow + (size_t)row * ldo + ch * 8) = v; } }
    asm volatile("s_waitcnt lgkmcnt(0)" ::: "memory");
}

template <int DQ, bool O8 = false>
__device__ __forceinline__ void attn_unit2(const bf16_t* QpA, const bf16_t* QpB, const bf16_t* Kp, const bf16_t* Vp, bf16_t* OpA, bf16_t* OpB, int ldq, int ldk, int ldv, int ldo,
                                           int q0, LAS unsigned char* lds, int tid) {
    asm volatile("" : "+v"(tid));
    const int lane = tid & 63, r32 = lane & 31, hi = lane >> 5; const int wid = __builtin_amdgcn_readfirstlane(tid >> 6);
    constexpr int ND = DQ / 16;
    constexpr int t0 = 0, t1 = SEQ / 64 - 1;
    const int wq0 = q0 + wid * 32;
    LAS float* wsf = (LAS float*)(lds + LDS_WSF) + wid * 128;
    bf16x8 qa[ND], qb[ND];
    { const bf16_t* Qw = QpA + (size_t)(wq0 + r32) * ldq + hi * 8; const bf16_t* Qv = QpB + (size_t)(wq0 + r32) * ldq + hi * 8;
#pragma unroll
      for (int d0 = 0; d0 < ND; ++d0) { qa[d0] = *(const GAS bf16x8*)(Qw + d0 * 16); qb[d0] = *(const GAS bf16x8*)(Qv + d0 * 16); } }
    const bf16_t* ksrc = Kp + (size_t)lane * ldk + wid * 8;
    const int k2off = __builtin_amdgcn_readfirstlane((8 + (wid & 3) - wid) * 8);
    const bf16_t* vsrc = Vp + (size_t)(16 * (wid & 3) + (lane >> 2)) * ldv + (wid >> 2) * 32 + (lane & 3) * 8;
    const int k2d = __builtin_amdgcn_readfirstlane((8 + (wid & 3) - wid) * 1024);
    const unsigned lds0 = (unsigned)(uintptr_t)lds;
#define A2_DMA(t, s) do { const size_t ro_ = (size_t)(t) * 64; const unsigned sb_ = (unsigned)__builtin_amdgcn_readfirstlane((int)(lds0 + (unsigned)((s) * STG + wid * 1024))); \
        glds16(ksrc + ro_ * ldk, sb_); \
        if (DQ == 96) glds16(ksrc + ro_ * ldk + k2off, sb_ + (unsigned)k2d); \
        glds16(vsrc + ro_ * ldv, sb_ + (unsigned)VOFF); } while (0)
    A2_DMA(t0, 0);
    asm volatile("s_waitcnt vmcnt(0)" ::: "memory");
    constexpr float THR = 8.0f;
    float mA = 0.f, mB = 0.f, lA = 0.f, lB = 0.f;
    f32x16 oa[2], ob[2];
#pragma unroll
    for (int r = 0; r < 16; ++r) { oa[0][r] = 0.f; oa[1][r] = 0.f; ob[0][r] = 0.f; ob[1][r] = 0.f; }
    __syncthreads();
#define A2_TILE(t, FIRST) do { \
        const int cur = ((t) - t0) & 1; \
        if ((t) < t1) A2_DMA((t) + 1, cur ^ 1); \
        const LAS unsigned char* Ks = lds + cur * STG; \
        const LAS unsigned char* kb = Ks + hi * 1024 + r32 * 16; \
        f32x16 a0, a1, b0, b1; \
        { const float na = -mA, nb = -mB; \
          _Pragma("unroll") for (int r = 0; r < 16; ++r) { a0[r] = na; a1[r] = na; b0[r] = nb; b1[r] = nb; } } \
        __builtin_amdgcn_s_setprio(1); \
        { bf16x8 k0 = *(const LAS bf16x8*)(kb), k1 = *(const LAS bf16x8*)(kb + 512);        \
          _Pragma("unroll") for (int d0 = 0; d0 < ND; ++d0) { \
            bf16x8 n0 = k0, n1 = k1; \
            if (d0 + 1 < ND) { n0 = *(const LAS bf16x8*)(kb + (d0 + 1) * 2048); n1 = *(const LAS bf16x8*)(kb + (d0 + 1) * 2048 + 512); } \
            a0 = __builtin_amdgcn_mfma_f32_32x32x16_bf16(k0, qa[d0], a0, 0, 0, 0); \
            b0 = __builtin_amdgcn_mfma_f32_32x32x16_bf16(k0, qb[d0], b0, 0, 0, 0); \
            a1 = __builtin_amdgcn_mfma_f32_32x32x16_bf16(k1, qa[d0], a1, 0, 0, 0); \
            b1 = __builtin_amdgcn_mfma_f32_32x32x16_bf16(k1, qb[d0], b1, 0, 0, 0); \
            k0 = n0; k1 = n1; \
            __builtin_amdgcn_sched_barrier(0); } } \
        __builtin_amdgcn_s_setprio(0); \
        float rA = -INFINITY, rB = -INFINITY; \
        _Pragma("unroll") for (int r = 0; r < 16; ++r) { rA = fmaxf(fmaxf(rA, a0[r]), a1[r]); rB = fmaxf(fmaxf(rB, b0[r]), b1[r]); } \
        { auto rr = __builtin_amdgcn_permlane32_swap(__float_as_uint(rA), __float_as_uint(rA), false, false); rA = fmaxf(__uint_as_float(rr[0]), __uint_as_float(rr[1])); } \
        { auto rr = __builtin_amdgcn_permlane32_swap(__float_as_uint(rB), __float_as_uint(rB), false, false); rB = fmaxf(__uint_as_float(rr[0]), __uint_as_float(rr[1])); } \
        if (FIRST) { mA = rA; mB = rB; \
            _Pragma("unroll") for (int r = 0; r < 16; ++r) { a0[r] -= rA; a1[r] -= rA; b0[r] -= rB; b1[r] -= rB; } } \
        float sA = 0.f, sB = 0.f; \
        _Pragma("unroll") for (int r = 0; r < 16; ++r) { a0[r] = __builtin_amdgcn_exp2f(a0[r]); a1[r] = __builtin_amdgcn_exp2f(a1[r]); b0[r] = __builtin_amdgcn_exp2f(b0[r]); b1[r] = __builtin_amdgcn_exp2f(b1[r]); \
            sA += a0[r] + a1[r]; sB += b0[r] + b1[r]; } \
        lA += sA; lB += sB; \
        u32x4 pa[4], pb[4]; \
        _Pragma("unroll") for (int j = 0; j < 4; ++j) { pa[0][j] = cvt_pk_bf16(a0[2 * j], a0[2 * j + 1]); pa[1][j] = cvt_pk_bf16(a0[8 + 2 * j], a0[8 + 2 * j + 1]); \
                                      pa[2][j] = cvt_pk_bf16(a1[2 * j], a1[2 * j + 1]); pa[3][j] = cvt_pk_bf16(a1[8 + 2 * j], a1[8 + 2 * j + 1]); \
                                      pb[0][j] = cvt_pk_bf16(b0[2 * j], b0[2 * j + 1]); pb[1][j] = cvt_pk_bf16(b0[8 + 2 * j], b0[8 + 2 * j + 1]); \
                                      pb[2][j] = cvt_pk_bf16(b1[2 * j], b1[2 * j + 1]); pb[3][j] = cvt_pk_bf16(b1[8 + 2 * j], b1[8 + 2 * j + 1]); } \
        const LAS unsigned char* vp = Ks + VOFF + ((lane >> 4) & 1) * 32 + (lane & 3) * 8 + (4 * hi + ((lane & 15) >> 2)) * 64; \
        __builtin_amdgcn_s_setprio(1); \
        { s16x4 lo = vtr(vp), hh = vtr(vp + 512); \
          __builtin_amdgcn_sched_barrier(0); \
          _Pragma("unroll") for (int i = 0; i < 8; ++i) { \
            s16x4 nlo = lo, nhh = hh; \
            if (i + 1 < 8) { nlo = vtr(vp + ((i + 1) >> 2) * 4096 + ((i + 1) & 3) * 1024); nhh = vtr(vp + ((i + 1) >> 2) * 4096 + ((i + 1) & 3) * 1024 + 512); } \
            const bf16x8 vf = (bf16x8){lo[0], lo[1], lo[2], lo[3], hh[0], hh[1], hh[2], hh[3]}; \
            oa[i >> 2] = __builtin_amdgcn_mfma_f32_32x32x16_bf16(__builtin_bit_cast(bf16x8, pa[i & 3]), vf, oa[i >> 2], 0, 0, 0); \
            ob[i >> 2] = __builtin_amdgcn_mfma_f32_32x32x16_bf16(__builtin_bit_cast(bf16x8, pb[i & 3]), vf, ob[i >> 2], 0, 0, 0); \
            lo = nlo; hh = nhh; \
            __builtin_amdgcn_sched_barrier(0); } } \
        __builtin_amdgcn_s_setprio(0); \
        if (!(FIRST) && __any(rA > THR || rB > THR)) { \
            const float dA = fmaxf(rA, 0.f), dB = fmaxf(rB, 0.f); mA += dA; mB += dB; \
            const float fA = __builtin_amdgcn_exp2f(-dA), fB = __builtin_amdgcn_exp2f(-dB); \
            lA *= fA; lB *= fB; \
            if (hi == 0) { wsf[r32] = fA; wsf[32 + r32] = fB; } \
            asm volatile("s_waitcnt lgkmcnt(0)" ::: "memory"); \
            _Pragma("unroll") for (int g4 = 0; g4 < 4; ++g4) { const f32x4 f4 = *(const LAS f32x4*)(wsf + 8 * g4 + 4 * hi), h4 = *(const LAS f32x4*)(wsf + 32 + 8 * g4 + 4 * hi); \
                _Pragma("unroll") for (int j = 0; j < 4; ++j) { oa[0][4 * g4 + j] *= f4[j]; oa[1][4 * g4 + j] *= f4[j]; ob[0][4 * g4 + j] *= h4[j]; ob[1][4 * g4 + j] *= h4[j]; } } \
            asm volatile("s_waitcnt lgkmcnt(0)" ::: "memory"); \
        } \
        asm volatile("s_waitcnt vmcnt(0)" ::: "memory"); \
        __syncthreads(); } while (0)
    A2_TILE(t0, true);
    for (int t = t0 + 1; t <= t1; ++t) A2_TILE(t, false);
#undef A2_TILE
#undef A2_DMA
    { auto rr = __builtin_amdgcn_permlane32_swap(__float_as_uint(lA), __float_as_uint(lA), false, false); lA = __uint_as_float(rr[0]) + __uint_as_float(rr[1]); }
    { auto rr = __builtin_amdgcn_permlane32_swap(__float_as_uint(lB), __float_as_uint(lB), false, false); lB = __uint_as_float(rr[0]) + __uint_as_float(rr[1]); }
    if (hi == 0) { wsf[64 + r32] = lA; wsf[96 + r32] = lB; }
    asm volatile("s_waitcnt lgkmcnt(0)" ::: "memory");
    LAS bf16_t* stg = (LAS bf16_t*)(lds + LDS_OST) + wid * 2048;
#pragma unroll
    for (int blk = 0; blk < 2; ++blk) {
        float rli[16];
#pragma unroll
        for (int g4 = 0; g4 < 4; ++g4) { const f32x4 l4 = *(const LAS f32x4*)(wsf + 64 + 32 * blk + 8 * g4 + 4 * hi);
#pragma unroll
            for (int j = 0; j < 4; ++j) rli[4 * g4 + j] = __builtin_amdgcn_rcpf(l4[j]); }
#pragma unroll
        for (int r = 0; r < 16; ++r) { const int orow = crow(r, hi);
#pragma unroll
            for (int d0 = 0; d0 < 2; ++d0) stg[orow * 64 + d0 * 32 + r32] = f2bf((blk == 0 ? oa[d0][r] : ob[d0][r]) * rli[r]); }
        asm volatile("s_waitcnt lgkmcnt(0)" ::: "memory");
        bf16_t* Ow = (blk == 0 ? OpA : OpB) + (size_t)wq0 * ldo;
#pragma unroll
        for (int i = 0; i < 4; ++i) { const int row = i * 8 + (lane >> 3), ch = lane & 7; const u32x4 v = *(const LAS u32x4*)(stg + row * 64 + ch * 8);
            if constexpr (O8) { *(GAS u32x2*)((unsigned char*)(blk == 0 ? OpA : OpB) + (size_t)(wq0 + row) * ldo + ch * 8) = bf8_to_fp8x8(v); } else { *(GAS u32x4*)(Ow + (size_t)row * ldo + ch * 8) = v; } }
        asm volatile("s_waitcnt lgkmcnt(0)" ::: "memory");
    }
}
}
constexpr size_t MiB = 1u << 20;
constexpr size_t WS_CTL = 0, CTL_ZERO_BYTES = 1 * MiB;
constexpr size_t WS_MOD = 1 * MiB;
constexpr size_t WS_ROPE = 2 * MiB;

constexpr size_t WS_TOKES = 3 * MiB;
constexpr size_t WS_TOKW = 3 * MiB + 512 * 1024;
constexpr size_t WS_LIST = 4 * MiB;
constexpr size_t WS_W = 8 * MiB;
constexpr size_t W_IN = 0, W_UQ = W_IN + (size_t)NPROJ * 1024 * 2, W_UKV = W_UQ + 512 * 256 * 2, W_BR = W_UKV + 512 * 256 * 2, W_OUT = W_BR + (size_t)4 * 1024 * 256 * 2,
                 W_RT = W_OUT + (size_t)1024 * 1024 * 2, W_E13 = W_RT + 256 * 1024 * 2, W_E2 = W_E13 + (size_t)32 * 512 * 1024 * 2, W_END = W_E2 + (size_t)32 * 1024 * 256 * 2;
static_assert(W_END <= 66 * MiB, "weights region");
constexpr size_t WS_HB = 74 * MiB;
constexpr size_t WS_QC = 138 * MiB, WS_KC = 162 * MiB, WS_VC = 186 * MiB;
constexpr size_t WS_PROJ = 202 * MiB;
constexpr size_t WS_HS = WS_PROJ, WS_YS = WS_PROJ + 40 * MiB;
constexpr size_t WS_END = WS_PROJ + (size_t)MTOK * (LDP * 2 + 4096);
constexpr size_t WS_XB = WS_END, WS_SSQ = WS_END + (size_t)MTOK * DM * 2, WS_END2 = WS_SSQ + (size_t)MTOK * 16 * 4;
static_assert((size_t)SORTROWS * 256 * 2 <= 40 * MiB && WS_YS + (size_t)SORTROWS * 1024 * 2 <= WS_END, "moe overlay");
constexpr size_t WS_W2 = WS_END2;
constexpr size_t WS_END3 = WS_W2 + 66 * MiB;
constexpr size_t WS_HB8 = WS_END3, WS_Y8 = WS_HB8 + (size_t)MTOK * DM, WS_END4 = WS_Y8 + (size_t)MTOK * DM;
constexpr size_t W_G8 = W_IN + (size_t)2304 * 1024 * 2;
constexpr int CW_BAR = 4096;
constexpr int CW_ECNT = 16384;
constexpr int RING_BYTES = 131072;
constexpr int LC_TEND = RING_BYTES, LC_CNT = RING_BYTES + 128, LC_BARW = RING_BYTES + 256, LC_XCH = RING_BYTES + 1024;
constexpr int LDS_BYTES = 147456;
constexpr int NWAVES = 8;

#define RLX_AGENT __ATOMIC_RELAXED, __HIP_MEMORY_SCOPE_AGENT

#define XB_TMO      128
#define XB_XCNT(j)  (256  + 64 * (j))
#define XB_XSUB(j)  (1280 + 64 * (j))
#define XB_XGEN(j)  (2304 + 64 * (j))
#define XB_TOP      3328
#define XB_TOPGEN   3392
#define XCD_BAR_WORDS 3456
#define XB_SPIN_CAP (1u << 18)
__device__ __forceinline__ unsigned xb_ld(unsigned* p)              { return __hip_atomic_load(p, __ATOMIC_RELAXED, __HIP_MEMORY_SCOPE_AGENT); }
__device__ __forceinline__ unsigned xb_add(unsigned* p, unsigned v) { return __hip_atomic_fetch_add(p, v, __ATOMIC_RELAXED, __HIP_MEMORY_SCOPE_AGENT); }
__device__ __forceinline__ unsigned xb_xcc_id() { return (unsigned)__builtin_amdgcn_s_getreg((3 << 11) | 20) & 0xFu; }
#define XB_SPIN(cond, bar) do { unsigned _sp = 0; while (cond) { __builtin_amdgcn_s_sleep(1); \
    if ((++_sp & 255u) == 0u) { if (xb_ld(&(bar)[XB_TMO])) break; if (_sp > XB_SPIN_CAP) { atomicAdd(&(bar)[XB_TMO], 1u); break; } } } } while (0)
struct XcdBarrier { unsigned* bar; unsigned x; volatile LAS unsigned* st; };
__device__ __forceinline__ XcdBarrier xcd_barrier_post(unsigned* bar, volatile LAS unsigned* st) {
    XcdBarrier b; b.bar = bar; b.x = xb_xcc_id(); b.st = st;
    if (threadIdx.x == 0) (void)xb_add(&bar[XB_XCNT(b.x)], 1u);
    return b;
}
__device__ __forceinline__ void xcd_barrier_complete(unsigned* bar, unsigned x, unsigned& nloc, unsigned& nx) {
    const unsigned G = gridDim.x * gridDim.y * gridDim.z;
    unsigned sum, cnt, mine, sp = 0u;
    for (;;) {
        sum = 0u; cnt = 0u; mine = 0u;
#pragma unroll
        for (unsigned j = 0; j < 16; ++j) { const unsigned c = xb_ld(&bar[XB_XCNT(j)]); sum += c; cnt += (c > 0u) ? 1u : 0u; mine = (j == x) ? c : mine; }
        if (sum == G) break;
        __builtin_amdgcn_s_sleep(1);
        if ((++sp & 255u) == 0u) { if (xb_ld(&bar[XB_TMO])) break; if (sp > XB_SPIN_CAP) { atomicAdd(&bar[XB_TMO], 1u); break; } }
    }
    nloc = mine > 0u ? mine : 1u; nx = cnt > 0u ? cnt : 1u;
}
__device__ __forceinline__ void xcd_barrier(const XcdBarrier& b, const bool leader) {
    asm volatile("s_waitcnt vmcnt(0)" ::: "memory");
    __syncthreads();
    if (leader) {
        unsigned* bar = b.bar;
        __builtin_amdgcn_s_waitcnt(0);
        unsigned nloc = b.st[0], nx = b.st[1];
        if (nloc == 0u) { xcd_barrier_complete(bar, b.x, nloc, nx); b.st[0] = nloc; b.st[1] = nx; }
        const unsigned old = xb_add(&bar[XB_XSUB(b.x)], 1u);
        const unsigned gen = old / nloc;
        if (old + 1u == (gen + 1u) * nloc) {
            __builtin_amdgcn_fence(__ATOMIC_RELEASE, "agent");
            asm volatile("s_waitcnt vmcnt(0)" ::: "memory");
            const unsigned og = xb_add(&bar[XB_TOP], 1u);
            const unsigned tg = og / nx;
            if (og + 1u == (tg + 1u) * nx) xb_add(&bar[XB_TOPGEN], 1u);
            else XB_SPIN(xb_ld(&bar[XB_TOPGEN]) == tg, bar);
            __builtin_amdgcn_fence(__ATOMIC_ACQUIRE, "agent");
            xb_add(&bar[XB_XGEN(b.x)], 1u);
            asm volatile("s_waitcnt vmcnt(0)" ::: "memory");
        } else {
            XB_SPIN(xb_ld(&bar[XB_XGEN(b.x)]) == gen, bar);
            __builtin_amdgcn_fence(__ATOMIC_ACQUIRE, "agent");
            asm volatile("s_waitcnt vmcnt(0)" ::: "memory");
        }
    }
    __syncthreads();
}

struct Frame {
    LAS unsigned char* lds;
    unsigned* ctl;
    int tid, lane, wave, vcu, G;
    float* out; unsigned char* ws;
};
struct Args { const float* in[25]; float* out; unsigned char* ws; int ph_lo, ph_hi; };
#define GIN(i) ((const float*)(const GAS float*)KA.in[i])
__device__ __forceinline__ float wave_sum(float v) {
    v += xshfl<1>(v); v += xshfl<2>(v); v += xshfl<4>(v); v += xshfl<8>(v); v += xshfl<16>(v); v += xshfl<32>(v);
    return v;
}
#define LDS_WAIT() asm volatile("s_waitcnt lgkmcnt(0)" ::: "memory")

__device__ __forceinline__ void p0_phase(Frame& F, const Args& KA) {
    LAS float* cact = (LAS float*)F.lds;
    LAS float* part = (LAS float*)(F.lds + 32768);
    const float* c = GIN(1); const float* w_ada = GIN(2); const float* b_ada = GIN(3);
    float* mod = (float*)(F.ws + WS_MOD);
    for (int i = F.tid; i < NB * DM; i += NWAVES * 64) { const float v = c[i]; cact[i] = v / (1.0f + __expf(-v)); }
    __syncthreads();
    for (int cb = blockIdx.x; cb < DEPTH * 96; cb += F.G) {
        const int l = cb / 96, n0 = (cb % 96) * 64;
        const float* w = w_ada + ((size_t)l * DM + F.wave * 128) * 6144 + n0 + F.lane;
        float acc[NB];
#pragma unroll
        for (int b = 0; b < NB; ++b) acc[b] = 0.f;
#pragma unroll 8
        for (int k = 0; k < 128; ++k) { const float wv = w[(size_t)k * 6144];
#pragma unroll
            for (int b = 0; b < NB; ++b) acc[b] += cact[b * DM + F.wave * 128 + k] * wv; }
#pragma unroll
        for (int b = 0; b < NB; ++b) part[(F.wave * NB + b) * 64 + F.lane] = acc[b];
        __syncthreads();
        { const int b = F.tid >> 6; float s = b_ada[l * 6144 + n0 + F.lane];
#pragma unroll
          for (int w8 = 0; w8 < NWAVES; ++w8) s += part[(w8 * NB + b) * 64 + F.lane];
          mod[((size_t)l * NB + b) * 6144 + n0 + F.lane] = s; }
        __syncthreads();
    }
    float* cs = (float*)(F.ws + WS_ROPE);
    for (int id = blockIdx.x * (NWAVES * 64) + F.tid; id < SEQ * 16; id += F.G * NWAVES * 64) {
        const int pos = id >> 4, f = id & 15;
        const float inv = powf(10000.0f, -(float)(2 * f) / 32.0f);
        const float ang = (float)pos * inv;
        cs[id] = cosf(ang); cs[SEQ * 16 + id] = sinf(ang);
    }
}

template <class RowMap>
__device__ __forceinline__ void transpose_item(const float* W, int ldw, int k0, int n0, bf16_t* WT, int ldt, const RowMap& rm, LAS float* scr, int lane, const float* kscale = nullptr, float cscale = 1.0f) {
    { const float* wp = (const float*)(const GAS float*)W + (size_t)(k0 + (lane >> 5)) * ldw + n0 + (lane & 31);
      float wv[32];
#pragma unroll
      for (int i = 0; i < 32; ++i) wv[i] = *(const GAS float*)(wp + (size_t)(2 * i) * ldw);
#pragma unroll
      for (int i = 0; i < 32; ++i) { const int kk = 2 * i + (lane >> 5); float v = wv[i]; if (kscale) v *= kscale[k0 + kk]; scr[kk * 33 + (lane & 31)] = v * cscale; } }
    LDS_WAIT(); asm volatile("" ::: "memory");
    const int c = lane & 7;
#pragma unroll
    for (int j = 0; j < 4; ++j) { const int n = (lane >> 3) + 8 * j; const LAS float* s = scr + (8 * c) * 33 + n;
        u32x4 o; o.x = cvt_pk_bf16(s[0 * 33], s[1 * 33]); o.y = cvt_pk_bf16(s[2 * 33], s[3 * 33]); o.z = cvt_pk_bf16(s[4 * 33], s[5 * 33]); o.w = cvt_pk_bf16(s[6 * 33], s[7 * 33]);
        *(u32x4*)(WT + (size_t)rm(n0 + n) * ldt + k0 + 8 * c) = o; }
    LDS_WAIT(); asm volatile("" ::: "memory");
}
__device__ __forceinline__ void transpose_item_f8(const float* W, int ldw, int k0, int n0, unsigned char* WT, int ldt, int nbase, LAS float* scr, int lane, float cscale) {
    { const float* wp = (const float*)(const GAS float*)W + (size_t)(k0 + (lane >> 5)) * ldw + n0 + (lane & 31);
      float wv[32];
#pragma unroll
      for (int i = 0; i < 32; ++i) wv[i] = *(const GAS float*)(wp + (size_t)(2 * i) * ldw);
#pragma unroll
      for (int i = 0; i < 32; ++i) { const int kk = 2 * i + (lane >> 5); scr[kk * 33 + (lane & 31)] = wv[i] * cscale; } }
    LDS_WAIT(); asm volatile("" ::: "memory");
    const int c = lane & 7;
#pragma unroll
    for (int j = 0; j < 4; ++j) { const int n = (lane >> 3) + 8 * j; const LAS float* s = scr + (8 * c) * 33 + n;
        u32x2 o; o.x = pk_fp8x4(s[0 * 33], s[1 * 33], s[2 * 33], s[3 * 33]); o.y = pk_fp8x4(s[4 * 33], s[5 * 33], s[6 * 33], s[7 * 33]);
        *(u32x2*)(WT + (size_t)(n0 + n - nbase) * ldt + k0 + 8 * c) = o; }
    LDS_WAIT(); asm volatile("" ::: "memory");
}
__device__ __forceinline__ int pairpos(int j) { const int f = j & 15, p = j >> 4; return 8 * (f >> 2) + 4 * p + (f & 3); }
struct MapIn   { __device__ __forceinline__ int operator()(int n) const {
    if (n < 1280) return n;
    if (n < 1728) return n + 512;
    if (n < 1760) return 2240 + pairpos(n - 1728);
    if (n < 2144) { const int d = n - 1760; return 1280 + (d & ~31) + pairpos(d & 31); }
    if (n < 2272) return n - 480;
    return n + 32; } };
struct MapId   { __device__ __forceinline__ int operator()(int n) const { return n; } };
struct MapUkv  { __device__ __forceinline__ int operator()(int n) const { const int h = n >> 7, j = n & 127; return j < 64 ? 64 * h + j : 256 + 64 * h + (j - 64); } };
struct MapE13  { int add; __device__ __forceinline__ int operator()(int n) const { return 8 * (n >> 2) + (n & 3) + add; } };

__device__ __forceinline__ void convert_weights(Frame& F, const Args& KA, int l, unsigned char* wb, int it_lo, int it_hi, int gw, int NGW, bool smalls) {
    LAS float* scr = (LAS float*)(F.lds + F.wave * 16384);
    const float* w_in = GIN(6) + (size_t)l * DM * 6368;
    const float* w_ukv = GIN(12) + (size_t)l * 256 * 512;
    const float* w_br = GIN(15) + (size_t)l * 4 * 256 * DM;
    const float* w_out = GIN(16) + (size_t)l * DM * DM;
    const float* w_e1 = GIN(21) + (size_t)l * NEXP * DM * 256;
    const float* w_e3 = GIN(22) + (size_t)l * NEXP * DM * 256;
    const float* w_e2 = GIN(23) + (size_t)l * NEXP * 256 * DM;
    constexpr int I_IN = 16 * 199, I_BR = 4 * 4 * 32, I_OUT = 16 * 32, I_UKV = 4 * 16, I_E1 = NEXP * 16 * 8, I_E2 = NEXP * 4 * 32;
    constexpr int NITEMS = I_IN + I_BR + I_OUT + I_UKV + 2 * I_E1 + I_E2;
    if (it_hi > NITEMS) it_hi = NITEMS;
    for (int it = it_lo + gw; it < it_hi; it += NGW) {
        int r = it;
        if (r < I_IN) { const int kb = r / 199, nb = r % 199;
            if (nb >= 71) transpose_item_f8(w_in, 6368, 64 * kb, 32 * nb, wb + W_G8, DM, 2272, scr, F.lane, -LOG2E * pg8::GATE_WSCALE);
            else transpose_item(w_in, 6368, 64 * kb, 32 * nb, (bf16_t*)(wb + W_IN), DM, MapIn{}, scr, F.lane); continue; } r -= I_IN;
        if (r < I_BR) { const int n = r >> 7, q = r & 127, kb = q >> 5, nb = q & 31; transpose_item_f8(w_br + (size_t)n * 256 * DM, DM, 64 * kb, 32 * nb, wb + W_BR + (size_t)n * DM * 256, 256, 0, scr, F.lane, pg8::MERGE_WSCALE); continue; } r -= I_BR;
        if (r < I_OUT) { const int kb = r >> 5, nb = r & 31; transpose_item(w_out, DM, 64 * kb, 32 * nb, (bf16_t*)(wb + W_OUT), DM, MapId{}, scr, F.lane); continue; } r -= I_OUT;
        if (r < I_UKV) { const int kb = r >> 4, nb = r & 15; transpose_item(w_ukv, 512, 64 * kb, 32 * nb, (bf16_t*)(wb + W_UKV), 256, MapUkv{}, scr, F.lane, GIN(10) + l * 256); continue; } r -= I_UKV;
        if (r < I_E1) { const int e = r >> 7, q = r & 127, kb = q >> 3, nb = q & 7; transpose_item(w_e1 + (size_t)e * DM * 256, 256, 64 * kb, 32 * nb, (bf16_t*)(wb + W_E13) + (size_t)e * 512 * DM, DM, MapE13{0}, scr, F.lane); continue; } r -= I_E1;
        if (r < I_E1) { const int e = r >> 7, q = r & 127, kb = q >> 3, nb = q & 7; transpose_item(w_e3 + (size_t)e * DM * 256, 256, 64 * kb, 32 * nb, (bf16_t*)(wb + W_E13) + (size_t)e * 512 * DM, DM, MapE13{4}, scr, F.lane); continue; } r -= I_E1;
        { const int e = r >> 7, q = r & 127, kb = q >> 5, nb = q & 31; transpose_item(w_e2 + (size_t)e * 256 * DM, DM, 64 * kb, 32 * nb, (bf16_t*)(wb + W_E2) + (size_t)e * DM * 256, 256, MapId{}, scr, F.lane); }
    }
    if (!smalls) return;
    const float* w_uq = GIN(11) + (size_t)l * 192 * 384;
    const float* w_g = GIN(17) + (size_t)l * DM * 4;
    const float* w_r = GIN(19) + (size_t)l * DM * 32;
    bf16_t* uq = (bf16_t*)(wb + W_UQ); bf16_t* rt = (bf16_t*)(wb + W_RT); bf16_t* win = (bf16_t*)(wb + W_IN);
    const int gt = blockIdx.x * (NWAVES * 64) + F.tid, NT = F.G * NWAVES * 64;
    for (int i = gt; i < 512 * 256; i += NT) {
        const int r = i >> 8, k = i & 255; float v = 0.f;
        if (r < 384 && k < 192) { const int h = r / 96, j = r % 96; int src;
            if (j < 64) src = 96 * h + j;
            else { const int q = j - 64, fb = q >> 3, p = (q >> 2) & 1, f = 4 * fb + (q & 3); src = 96 * h + 64 + 16 * p + f; }
            v = w_uq[(size_t)k * 384 + src] * GIN(9)[l * 192 + k]; }
        uq[i] = f2bf(v);
    }
    for (int i = gt; i < 256 * DM; i += NT) {
        const int r = i >> 10, k = i & 1023; float v = 0.f;
        if (r < 4) v = w_g[k * 4 + r]; else if (r < 36) v = w_r[k * 32 + (r - 4)];
        rt[i] = f2bf(v);
    }
    for (int i = gt; i < 32 * DM; i += NT) win[(size_t)2272 * DM + i] = 0;
}

__device__ __forceinline__ void load_moe_tables(Frame& F, int l) {
    LAS int* tend = (LAS int*)(F.lds + LC_TEND); LAS int* cnt = (LAS int*)(F.lds + LC_CNT);
    if (F.tid < NEXP) cnt[F.tid] = (int)__hip_atomic_load(F.ctl + CW_ECNT + 64 * l + F.tid, RLX_AGENT);
    __syncthreads();
    if (F.tid == 0) { int acc = 0; for (int e = 0; e < NEXP; ++e) { acc += (cnt[e] + 255) >> 8; tend[e] = acc; } }
    __syncthreads();
}

__device__ __forceinline__ void norm_phase(Frame& F, const float* xsrc, const bf16_t* xbsrc, bf16_t* xdst, bool combine, const float* g2prev, const float* gain, const float* shv, const float* scv,
                                           bf16_t* hout, float* fout, const bf16_t* delta = nullptr, unsigned char* h8out = nullptr) {
    const int gw = F.vcu * NWAVES + F.wave, NGW = F.G * NWAVES;
    const int rpw = (((MTOK + NGW - 1) / NGW) + 3) & ~3;
    int m0 = gw * rpw, m1 = m0 + rpw; m1 = m1 > MTOK ? MTOK : m1;
    const LAS int* tend = (const LAS int*)(F.lds + LC_TEND);
    const int* tok_es = (const int*)(F.ws + WS_TOKES); const float* tok_w = (const float*)(F.ws + WS_TOKW);
    const bf16_t* YS = (const bf16_t*)(F.ws + WS_YS);
    f32x4 A[4], B[4], G2[4]; int bcur = -1;
#pragma unroll
    for (int j = 0; j < 4; ++j) { A[j] = (f32x4){0.f, 0.f, 0.f, 0.f}; B[j] = A[j]; G2[j] = A[j]; }
    const int lc = 4 * F.lane;
    for (int m = m0; m < m1; m += 4) {
        const int b = m >> 12;
        if (b != bcur) { bcur = b;
#pragma unroll
            for (int j = 0; j < 4; ++j) { const int col = lc + 256 * j; const f32x4 gn = *(const f32x4*)(gain + col);
                if (scv) { const f32x4 sc = *(const f32x4*)(scv + b * 6144 + col); A[j] = gn * (sc + 1.0f); B[j] = *(const f32x4*)(shv + b * 6144 + col); } else { A[j] = gn; }
                if (combine) G2[j] = *(const f32x4*)(g2prev + b * 6144 + col); } }
        f32x4 v[4][4];
        if (xbsrc) {
            u32x2 xb[4][4];
#pragma unroll
            for (int r = 0; r < 4; ++r)
#pragma unroll
                for (int j = 0; j < 4; ++j) xb[r][j] = __builtin_nontemporal_load((const GAS u32x2*)(xbsrc + (size_t)(m + r) * DM + lc + 256 * j));
#pragma unroll
            for (int r = 0; r < 4; ++r)
#pragma unroll
                for (int j = 0; j < 4; ++j) { const u32x2 y0 = xb[r][j]; v[r][j] = (f32x4){bflo(y0.x), bfhi(y0.x), bflo(y0.y), bfhi(y0.y)}; }
        } else {
#pragma unroll
            for (int r = 0; r < 4; ++r)
#pragma unroll
                for (int j = 0; j < 4; ++j) v[r][j] = *(const GAS f32x4*)(xsrc + (size_t)(m + r) * DM + lc + 256 * j);
        }
        if (delta) {
            u32x2 dl[4][4];
#pragma unroll
            for (int r = 0; r < 4; ++r)
#pragma unroll
                for (int j = 0; j < 4; ++j) dl[r][j] = *(const GAS u32x2*)(delta + (size_t)(m + r) * DM + lc + 256 * j);
#pragma unroll
            for (int r = 0; r < 4; ++r)
#pragma unroll
                for (int j = 0; j < 4; ++j) { const u32x2 y0 = dl[r][j]; v[r][j] = v[r][j] + (f32x4){bflo(y0.x), bfhi(y0.x), bflo(y0.y), bfhi(y0.y)}; }
            if (xdst) {
#pragma unroll
                for (int r = 0; r < 4; ++r)
#pragma unroll
                    for (int j = 0; j < 4; ++j) { u32x2 w_; w_.x = cvt_pk_bf16(v[r][j].x, v[r][j].y); w_.y = cvt_pk_bf16(v[r][j].z, v[r][j].w); *(GAS u32x2*)(xdst + (size_t)(m + r) * DM + lc + 256 * j) = w_; } }
        }
        if (combine) {
            int es[4][2]; float ww[4][2];
#pragma unroll
            for (int r = 0; r < 4; ++r) { es[r][0] = tok_es[2 * (m + r)]; es[r][1] = tok_es[2 * (m + r) + 1]; ww[r][0] = tok_w[2 * (m + r)]; ww[r][1] = tok_w[2 * (m + r) + 1]; }
            u32x2 y[4][2][4];
#pragma unroll
            for (int r = 0; r < 4; ++r)
#pragma unroll
                for (int k = 0; k < 2; ++k) { const int e = es[r][k] >> 16; const int rr = 256 * (e ? tend[e - 1] : 0) + (es[r][k] & 0xffff);
#pragma unroll
                    for (int j = 0; j < 4; ++j) y[r][k][j] = __builtin_nontemporal_load((const GAS u32x2*)(YS + (size_t)rr * DM + lc + 256 * j)); }
#pragma unroll
            for (int r = 0; r < 4; ++r)
#pragma unroll
                for (int j = 0; j < 4; ++j) { const u32x2 y0 = y[r][0][j], y1 = y[r][1][j];
                    const f32x4 a = (f32x4){bflo(y0.x), bfhi(y0.x), bflo(y0.y), bfhi(y0.y)}, c = (f32x4){bflo(y1.x), bfhi(y1.x), bflo(y1.y), bfhi(y1.y)};
                    v[r][j] = v[r][j] + G2[j] * (a * ww[r][0] + c * ww[r][1]); }
            if (xdst) {
#pragma unroll
                for (int r = 0; r < 4; ++r)
#pragma unroll
                    for (int j = 0; j < 4; ++j) { u32x2 w_; w_.x = cvt_pk_bf16(v[r][j].x, v[r][j].y); w_.y = cvt_pk_bf16(v[r][j].z, v[r][j].w); *(GAS u32x2*)(xdst + (size_t)(m + r) * DM + lc + 256 * j) = w_; } }
        }
        float s[4];
#pragma unroll
        for (int r = 0; r < 4; ++r) { s[r] = 0.f;
#pragma unroll
            for (int j = 0; j < 4; ++j) s[r] += (v[r][j].x * v[r][j].x + v[r][j].y * v[r][j].y) + (v[r][j].z * v[r][j].z + v[r][j].w * v[r][j].w); }
#pragma unroll
        for (int r = 0; r < 4; ++r) s[r] += xshfl<1>(s[r]);
#pragma unroll
        for (int r = 0; r < 4; ++r) s[r] += xshfl<2>(s[r]);
#pragma unroll
        for (int r = 0; r < 4; ++r) s[r] += xshfl<4>(s[r]);
#pragma unroll
        for (int r = 0; r < 4; ++r) s[r] += xshfl<8>(s[r]);
#pragma unroll
        for (int r = 0; r < 4; ++r) s[r] += xshfl<16>(s[r]);
#pragma unroll
        for (int r = 0; r < 4; ++r) s[r] += xshfl<32>(s[r]);
#pragma unroll
        for (int r = 0; r < 4; ++r) { const float rstd = rsqrtf(s[r] * (1.0f / DM) + EPS);
#pragma unroll
            for (int j = 0; j < 4; ++j) { const f32x4 o = v[r][j] * rstd * A[j] + B[j];
                if (hout) { u32x2 w; w.x = cvt_pk_bf16(o.x, o.y); w.y = cvt_pk_bf16(o.z, o.w); *(GAS u32x2*)(hout + (size_t)(m + r) * DM + lc + 256 * j) = w; }
                if (h8out) *(GAS unsigned*)(h8out + (size_t)(m + r) * DM + lc + 256 * j) = pk_fp8x4(o.x, o.y, o.z, o.w);
                if (fout) *(GAS f32x4*)(fout + (size_t)(m + r) * DM + lc + 256 * j) = o; } }
    }
}

__device__ __forceinline__ void prep_phase(Frame& F, const Args& KA, int l, bool dummy = false) {
    const int gw = F.vcu * NWAVES + F.wave, NGW = F.G * NWAVES;
    bf16_t* P = (bf16_t*)(F.ws + WS_PROJ); bf16_t* KC = (bf16_t*)(F.ws + WS_KC);
    const float* cs = (const float*)(F.ws + WS_ROPE);
    const float* gq = GIN(9) + l * 192; const float* gkv = GIN(10) + l * 256; const float* gaq = GIN(13) + l * 64; const float* gak = GIN(14) + l * 64;
    const int lane = F.lane;
    const float g_q0 = gq[lane], g_q1 = gq[lane + 64], g_q2 = gq[lane + 128];
    const float g_kv0 = gkv[lane], g_kv1 = gkv[lane + 64], g_kv2 = gkv[lane + 128], g_kv3 = gkv[lane + 192];
    const float g_aq = gaq[lane], g_ak = gak[lane];
    const int rpw = (((MTOK + NGW - 1) / NGW) + 3) & ~3;
    int m0 = gw * rpw, m1 = m0 + rpw; m1 = m1 > MTOK ? MTOK : m1;
    const int f15 = lane & 15;
    for (int mg = m0; mg < m1; mg += 4) {
        float cq[4][3], ckv[4][4], kr1[4], kr2[4], ax[4][6];
#pragma unroll
        for (int r = 0; r < 4; ++r) { const bf16_t* row = P + (size_t)(mg + r) * LDP;
#pragma unroll
            for (int k = 0; k < 3; ++k) cq[r][k] = bf2f(row[PC_CQ + 64 * k + lane]);
#pragma unroll
            for (int k = 0; k < 4; ++k) ckv[r][k] = bf2f(row[PC_CKV + 64 * k + lane]);
            kr1[r] = bf2f(row[PC_KR + f15]); kr2[r] = bf2f(row[PC_KR + 16 + f15]);
#pragma unroll
            for (int hh = 0; hh < 6; ++hh) ax[r][hh] = bf2f(row[(hh < 4 ? PC_AXQ + 64 * hh : PC_AXK + 64 * (hh - 4)) + lane]); }
        float ss[4][8];
#pragma unroll
        for (int r = 0; r < 4; ++r) { ss[r][0] = cq[r][0] * cq[r][0] + cq[r][1] * cq[r][1] + cq[r][2] * cq[r][2];
            ss[r][1] = ckv[r][0] * ckv[r][0] + ckv[r][1] * ckv[r][1] + ckv[r][2] * ckv[r][2] + ckv[r][3] * ckv[r][3];
#pragma unroll
            for (int hh = 0; hh < 6; ++hh) ss[r][2 + hh] = ax[r][hh] * ax[r][hh]; }
#define PREP_BFLY(M) _Pragma("unroll") for (int r = 0; r < 4; ++r) _Pragma("unroll") for (int q = 0; q < 8; ++q) ss[r][q] += xshfl<M>(ss[r][q]);
        PREP_BFLY(1) PREP_BFLY(2) PREP_BFLY(4) PREP_BFLY(8) PREP_BFLY(16) PREP_BFLY(32)
#undef PREP_BFLY
#pragma unroll
        for (int r = 0; r < 4; ++r) { const int m = mg + r; bf16_t* row = dummy ? (bf16_t*)(F.ws + WS_END2) + (size_t)(m & 255) * LDP : P + (size_t)m * LDP;
            const int pos = m & (SEQ - 1), gr = pos >> 6, gc = pos & 63;
            { const float rstd = rsqrtf(ss[r][0] * (1.0f / 192.0f) + EPS);
              row[PC_CQ + lane] = f2bf(cq[r][0] * rstd * g_q0); row[PC_CQ + 64 + lane] = f2bf(cq[r][1] * rstd * g_q1); row[PC_CQ + 128 + lane] = f2bf(cq[r][2] * rstd * g_q2); }
            { const float rstd = rsqrtf(ss[r][1] * (1.0f / 256.0f) + EPS);
              row[PC_CKV + lane] = f2bf(ckv[r][0] * rstd * g_kv0); row[PC_CKV + 64 + lane] = f2bf(ckv[r][1] * rstd * g_kv1); row[PC_CKV + 128 + lane] = f2bf(ckv[r][2] * rstd * g_kv2); row[PC_CKV + 192 + lane] = f2bf(ckv[r][3] * rstd * g_kv3); }
            if (lane < 16) { const int f = lane; const float x1 = kr1[r], x2 = kr2[r];
                const float c = cs[pos * 16 + f], s = cs[SEQ * 16 + pos * 16 + f];
                const unsigned short o1 = f2bf(x1 * c - x2 * s), o2 = f2bf(x1 * s + x2 * c);
                const int p1 = 8 * (f >> 2) + (f & 3), p2 = p1 + 4;
                bf16_t* kr = (dummy ? (bf16_t*)(F.ws + WS_END2) + (size_t)(m & 255) * LDP : KC + (size_t)m * 384) + 64;
#pragma unroll
                for (int h = 0; h < 4; ++h) { kr[96 * h + p1] = o1; kr[96 * h + p2] = o2; } }
            { const int idx = (lane < 32) ? gr : gc;
              const float c = cs[idx * 16 + f15], s = cs[SEQ * 16 + idx * 16 + f15];
#pragma unroll
              for (int hh = 0; hh < 6; ++hh) {
                  bf16_t* p = row + (hh < 4 ? PC_AXQ + 64 * hh : PC_AXK + 64 * (hh - 4)) + lane;
                  const float rstd = rsqrtf(ss[r][2 + hh] * (1.0f / 64.0f) + EPS);
                  const float y = ax[r][hh] * rstd * (hh < 4 ? g_aq * (0.125f * LOG2E) : g_ak);
                  const float pr = xshfl<16>(y);
                  const float o = (lane & 16) ? (pr * s + y * c) : (y * c - pr * s);
                  *p = f2bf(o);
              } }
        }
    }
}
__device__ __forceinline__ void attn_phase(Frame& F, const Args& KA, int l) {
    bf16_t* P = (bf16_t*)(F.ws + WS_PROJ); bf16_t* QC = (bf16_t*)(F.ws + WS_QC); bf16_t* KC = (bf16_t*)(F.ws + WS_KC); bf16_t* VC = (bf16_t*)(F.ws + WS_VC);
    unsigned char* Y8 = F.ws + WS_Y8;
    constexpr int NU = NB * 4 * (SEQ / 256);
#ifndef REP_C
#define REP_C 1
#endif
#ifndef C_UNIT2
#define C_UNIT2 1
#endif
    if (C_UNIT2) {
        for (int L = F.vcu; L < NU / 2; L += F.G) { const int bh = L >> 3, qb = L & 7, b = bh >> 2, h = bh & 3; const size_t rb = (size_t)b * SEQ;
            att::attn_unit2<96, true>(QC + rb * 384 + 96 * h, QC + (rb + 2048) * 384 + 96 * h, KC + rb * 384 + 96 * h, VC + rb * 256 + 64 * h,
                                (bf16_t*)(Y8 + rb * 1024 + 512 + 64 * h), (bf16_t*)(Y8 + (rb + 2048) * 1024 + 512 + 64 * h), 384, 384, 256, 1024, qb * 256, F.lds, F.wave * 64 + lane_now()); }
    } else
    for (int rep = 0; rep < REP_C; ++rep)
    for (int L = F.vcu; L < NU; L += F.G) { const int bh = L >> 4, qb = L & 15, b = bh >> 2, h = bh & 3; const size_t rb = (size_t)b * SEQ;
        att::attn_unit<96, 0>(QC + rb * 384 + 96 * h, KC + rb * 384 + 96 * h, VC + rb * 256 + 64 * h, P + rb * LDP + PC_YC + 64 * h, 384, 384, 256, LDP,
                              qb * 256, 0.10206207261596575f * LOG2E, 0.f, 0.f, nullptr, F.lds, F.wave * 64 + lane_now()); }
#ifndef REP_D
#define REP_D 1
#endif
#ifndef REP_B
#define REP_B 1
#endif
#ifndef REP_A
#define REP_A 1
#endif
    bf16_t* DUMMY = (bf16_t*)(F.ws + WS_END);
    for (int L = F.vcu; L < NU / 2; L += F.G) { const int bk = L >> 4, qb = L & 15, b = bk >> 1, kv = bk & 1; bf16_t* Pb = P + (size_t)b * SEQ * LDP;
        att::attn_unit2<64, true>(Pb + PC_AXQ + 128 * kv, Pb + PC_AXQ + 128 * kv + 64, Pb + PC_AXK + 64 * kv, Pb + PC_AXV + 64 * kv, (bf16_t*)(Y8 + (size_t)b * SEQ * 1024 + 768 + 128 * kv), (bf16_t*)(Y8 + (size_t)b * SEQ * 1024 + 768 + 128 * kv + 64),
                            LDP, LDP, LDP, 1024, qb * 256, F.lds, F.wave * 64 + lane_now()); }
    for (int rep = 0; rep < REP_B; ++rep)
    for (int L = F.vcu; L < NU; L += F.G) { const int bh = L >> 4, qb = L & 15, b = bh >> 2, h = bh & 3; bf16_t* Pb = P + (size_t)b * SEQ * LDP; const bool dm = rep < REP_B - 1;
        const float slope = exp2f(-2.0f * (float)(h + 1)); const float sink = GIN(8)[l * 4 + h];
        att::attn_unit<64, 1, 0, true>(Pb + PC_WQ + 64 * h, Pb + PC_WK + 64 * (h >> 1), Pb + PC_WV + 64 * (h >> 1), (bf16_t*)(Y8 + (size_t)b * SEQ * 1024 + 256 + 64 * h), LDP, LDP, LDP, 1024,
                              qb * 256, 0.125f * LOG2E, slope * LOG2E, sink * LOG2E, nullptr, F.lds, F.wave * 64 + lane_now()); }
    for (int rep = 0; rep < REP_A; ++rep)
    for (int L = F.vcu; L < NU; L += F.G) { const int bh = L >> 4, qb = L & 15, b = bh >> 2, h = bh & 3; bf16_t* Pb = P + (size_t)b * SEQ * LDP; const bool dm = rep < REP_A - 1;
        att::attn_unit<64, 2, 0, true>(Pb + PC_NAQ + 64 * h, Pb + PC_NAK + 64 * h, Pb + PC_NAV + 64 * h, (bf16_t*)(Y8 + (size_t)b * SEQ * 1024 + 64 * h), LDP, LDP, LDP, 1024,
                              qb * 256, 0.125f * LOG2E, 0.f, 0.f, GIN(7) + (size_t)(l * 4 + h) * (15 * 31), F.lds, F.wave * 64 + lane_now()); }
}

#ifndef REP_BAR
#define REP_BAR 1
#endif
#ifndef REP_G2
#define REP_G2 1
#endif
#ifndef REP_G3
#define REP_G3 1
#endif
#ifndef REP_G5
#define REP_G5 1
#endif
#ifndef REP_G6
#define REP_G6 1
#endif
#ifndef REP_AT
#define REP_AT 1
#endif
#ifndef REP_TH
#define REP_TH 1
#endif
#ifndef FILL_G1
#define FILL_G1 0
#endif
#ifndef FILL_GR
#define FILL_GR 0
#endif
#ifndef FILL_G5
#define FILL_G5 9216
#endif
#ifndef FILL_G6
#define FILL_G6 0
#endif
constexpr int FILL_A = FILL_G1, FILL_B = FILL_A + FILL_GR, FILL_C = FILL_B + FILL_G5, FILL_END = FILL_C + FILL_G6;
#define FILLER(lo, hi, skip) do { if ((hi) > (lo) && l + 1 < DEPTH && (int)blockIdx.x >= (skip) && F.G > (skip)) { __syncthreads(); \
        convert_weights(F, KA, l + 1, F.ws + (((l + 1) & 1) ? WS_W2 : WS_W), (lo), (hi), ((int)blockIdx.x - (skip)) * NWAVES + F.wave, (F.G - (skip)) * NWAVES, false); } } while (0)
constexpr int FILL_SKIP = 64;
constexpr int PH_PER_LAYER = 10, N_PHASES = 1 + DEPTH * PH_PER_LAYER + 1;

__global__ void __launch_bounds__(NWAVES * 64, 2) mk_fwd(Args KA) {
    extern __shared__ __attribute__((aligned(16))) unsigned char lds_raw[];
    { const int t0 = threadIdx.x; for (int u = t0; u < (LDS_BYTES - RING_BYTES) / 4; u += NWAVES * 64) ((LAS unsigned*)((LAS unsigned char*)lds_raw + RING_BYTES))[u] = 0u; }
    __syncthreads();
    const int wave0 = __builtin_amdgcn_readfirstlane((int)threadIdx.x >> 6);
    XcdBarrier bar = xcd_barrier_post((unsigned*)(KA.ws + WS_CTL) + CW_BAR, (volatile LAS unsigned*)((LAS unsigned char*)lds_raw + LC_BARW));
#define FRAME() Frame F; { int t_ = wave0 * 64 + lane_now(); asm volatile("" : "+v"(t_)); unsigned char* w_ = KA.ws; float* o_ = KA.out; asm volatile("" : "+s"(w_), "+s"(o_)); \
        F.lds = (LAS unsigned char*)lds_raw; F.tid = t_; F.lane = t_ & 63; F.wave = __builtin_amdgcn_readfirstlane(t_ >> 6); F.G = gridDim.x; \
        { const int bx = blockIdx.x; F.vcu = (F.G % 8 == 0) ? (bx % 8) * (F.G / 8) + bx / 8 : bx; } F.ws = (unsigned char*)(GAS unsigned char*)w_; F.out = (float*)(GAS float*)o_; F.ctl = (unsigned*)(F.ws + WS_CTL); } \
        unsigned char* wb = F.ws + ((l & 1) ? WS_W2 : WS_W); bf16_t* HB = (bf16_t*)(F.ws + WS_HB); bf16_t* P = (bf16_t*)(F.ws + WS_PROJ); float* mod = (float*)(F.ws + WS_MOD); bf16_t* XB = (bf16_t*)(F.ws + WS_XB); (void)XB; \
        const float* modl = mod + (size_t)l * NB * 6144; const float* x_in = GIN(0); (void)wb; (void)HB; (void)P; (void)modl; (void)x_in
    const int lo = KA.ph_lo, hi = KA.ph_hi;
#ifndef PHMASK
#define PHMASK 0xFFFF
#endif
#define EN(j) ((PHMASK >> (j)) & 1)
#define IN(k) (lo <= (k) && (k) < hi)
#define SEAM(k) do { if (IN(k) && IN((k) + 1)) { XcdBarrier b_ = bar; asm volatile("" : "+s"(b_.bar)); for (int r_ = 0; r_ < REP_BAR; ++r_) xcd_barrier(b_, wave0 == 0 && lane_now() == 0); } } while (0)

    if (EN(11) && IN(0)) { const int l = 0; FRAME(); p0_phase(F, KA); SEAM(0); }

    for (int l = 0; l < DEPTH; ++l) {
        const int pb = 1 + PH_PER_LAYER * l;
        if (EN(0) && IN(pb + 0)) { FRAME();
            for (int rep = 0; rep < REP_TH; ++rep) convert_weights(F, KA, l, wb, (l == 0 || F.G <= 128) ? 0 : FILL_END, 1 << 30, F.vcu * NWAVES + F.wave, F.G * NWAVES, true);
            if (l > 0) load_moe_tables(F, l - 1);
#ifndef REP_T1
#define REP_T1 1
#endif
            norm_phase(F, x_in, l == 0 ? nullptr : XB, XB, l > 0, modl - (size_t)NB * 6144 + 5120, GIN(4) + l * DM, modl, modl + 1024, HB, nullptr, nullptr, F.ws + WS_HB8);
            SEAM(pb + 0);
        }
        if (EN(1) && IN(pb + 1)) { FRAME();
            pg8::Gemm g{HB, (const bf16_t*)(wb + W_IN), nullptr}; pg8::StaticOrder S; S.init(MTOK, 2304, F.G, (int)blockIdx.x);
            pg8::EpiProj E{P, (LAS float*)(F.lds + LC_XCH), (float*)(F.ws + WS_SSQ), (const float*)(F.ws + WS_ROPE), (bf16_t*)(F.ws + WS_KC), GIN(13) + l * 64, GIN(14) + l * 64, 0};
            pg8::Gemm g8{(const bf16_t*)(F.ws + WS_HB8), (const bf16_t*)(wb + W_G8), nullptr}; pg8::StaticOrder S8; S8.init(MTOK, 4096, F.G, (int)blockIdx.x, 1);
            pg8::EpiProj E8 = E; E8.pn0 = 9;
#ifndef REP_G1
#define REP_G1 1
#endif
            for (int rep = 0; rep < REP_G1; ++rep) {
                pg8::gemm_phase<pg8::EpiProj, pg8::StaticOrder, false, true, DM, DM, DM, 0>(F.lds, g, S, E, F.tid);
                pg8::gemm_phase<pg8::EpiProj, pg8::StaticOrder, false, true, DM / 2, DM / 2, DM / 2, 0, true>(F.lds, g8, S8, E8, F.tid);
            }
            FILLER(0, FILL_A, 128);
            SEAM(pb + 1);
        }
        if (EN(2) && IN(pb + 2)) { FRAME();
            { pg8::Gemm g{P + PC_CQ, (const bf16_t*)(wb + W_UQ), nullptr}; pg8::StaticOrder S; S.init(MTOK, 512, F.G, (int)blockIdx.x);
              pg8::EpiQup E{(bf16_t*)(F.ws + WS_QC), (const float*)(F.ws + WS_ROPE), (const float*)(F.ws + WS_SSQ)};
              for (int rep = 0; rep < REP_G2; ++rep) pg8::gemm_phase<pg8::EpiQup, pg8::StaticOrder, false, true, LDP, 256, 256, 0>(F.lds, g, S, E, F.tid); }
            { pg8::Gemm g{P + PC_CKV, (const bf16_t*)(wb + W_UKV), nullptr}; pg8::StaticOrder S; S.init(MTOK, 512, F.G, (int)blockIdx.x);
              pg8::EpiKVup E{(bf16_t*)(F.ws + WS_KC), (bf16_t*)(F.ws + WS_VC), (const float*)(F.ws + WS_SSQ)};
              for (int rep = 0; rep < REP_G2; ++rep) pg8::gemm_phase<pg8::EpiKVup, pg8::StaticOrder, false, true, LDP, 256, 256, 0>(F.lds, g, S, E, F.tid); }
            SEAM(pb + 2);
        }
        if (EN(3) && IN(pb + 3)) { FRAME(); for (int rep = 0; rep < REP_AT; ++rep) { attn_phase(F, KA, l); __syncthreads(); } SEAM(pb + 3); }
        if (EN(4) && IN(pb + 4)) { FRAME();
            for (int rep = 0; rep < REP_G3; ++rep) { pg8::merge_phase3(F.lds, P, F.ws + WS_Y8, wb + W_BR, HB, F.G, F.vcu, F.tid); __syncthreads(); }
            SEAM(pb + 4);
        }
        if (EN(5) && IN(pb + 5)) { FRAME();
            pg8::Gemm g{HB, (const bf16_t*)(wb + W_OUT), nullptr}; pg8::StaticOrder S; S.init(MTOK, DM, F.G, (int)blockIdx.x);
            pg8::EpiResid E{l == 0 ? x_in : nullptr, XB, modl + 2048};
            pg8::gemm_phase<pg8::EpiResid, pg8::StaticOrder, false, true, DM, DM, DM, 0>(F.lds, g, S, E, F.tid);
            SEAM(pb + 5);
        }
        if (EN(6) && IN(pb + 6)) { FRAME(); norm_phase(F, nullptr, XB, nullptr, false, nullptr, GIN(5) + l * DM, modl + 3072, modl + 4096, HB, nullptr); SEAM(pb + 6); }
        if (EN(7) && IN(pb + 7)) { FRAME();
            pg8::Gemm g{HB, (const bf16_t*)(wb + W_RT), nullptr}; pg8::StaticOrder S; S.init(MTOK, 256, F.G, (int)blockIdx.x);
            pg8::EpiRoute E{GIN(18) + l * 4, GIN(20) + l * 32, F.ctl + CW_ECNT + 64 * l, (int*)(F.ws + WS_LIST), (int*)(F.ws + WS_TOKES), (float*)(F.ws + WS_TOKW)};
            pg8::gemm_phase<pg8::EpiRoute, pg8::StaticOrder, false, false, DM, DM, DM, 0>(F.lds, g, S, E, F.tid);
            FILLER(FILL_A, FILL_B, 128);
            SEAM(pb + 7);
        }
        if (EN(8) && IN(pb + 8)) { FRAME();
            load_moe_tables(F, l);
            pg8::Gemm g{HB, (const bf16_t*)(wb + W_E13), (const int*)(F.ws + WS_LIST)};
            pg8::MoeOrder S{F.G, (int)blockIdx.x, 1, (const LAS int*)(F.lds + LC_TEND), (const LAS int*)(F.lds + LC_CNT)};
            pg8::EpiExp1 E{(bf16_t*)(F.ws + WS_HS)};
            for (int rep = 0; rep < REP_G5; ++rep) pg8::gemm_phase<pg8::EpiExp1, pg8::MoeOrder, true, true, DM, DM, DM, 512>(F.lds, g, S, E, F.tid);
            FILLER(FILL_B, FILL_C, 64);
            SEAM(pb + 8);
        }
        if (EN(9) && IN(pb + 9)) { FRAME();
            load_moe_tables(F, l);
            pg8::Gemm g{(const bf16_t*)(F.ws + WS_HS), (const bf16_t*)(wb + W_E2), nullptr};
            pg8::MoeOrder S{F.G, (int)blockIdx.x, 2, (const LAS int*)(F.lds + LC_TEND), (const LAS int*)(F.lds + LC_CNT)};
            pg8::EpiStore E{(bf16_t*)(F.ws + WS_YS), DM};
            for (int rep = 0; rep < REP_G6; ++rep) pg8::gemm_phase<pg8::EpiStore, pg8::MoeOrder, false, true, 256, 256, 256, DM>(F.lds, g, S, E, F.tid);
            FILLER(FILL_C, FILL_END, 64);
            SEAM(pb + 9);
        }
    }
    if (EN(12) && IN(N_PHASES - 1)) { const int l = DEPTH - 1; FRAME();
        load_moe_tables(F, DEPTH - 1);
        norm_phase(F, nullptr, XB, nullptr, true, modl + 5120, GIN(24), nullptr, nullptr, nullptr, F.out);
    }
#undef IN
#undef SEAM
}

#ifndef MK_LAUNCH_PER_PHASE
#define MK_LAUNCH_PER_PHASE 0
#endif
extern "C" void kernel_launch(void* const* d_in, const int* in_sizes, int n_in, void* d_out, int out_size, void* d_ws, size_t ws_size, hipStream_t stream) {
    static int grid = 0;
    if (grid == 0) {
        int dev = 0, cus = 0;
        if (n_in != 25 || ws_size < WS_END4 || hipGetDevice(&dev) != hipSuccess || hipDeviceGetAttribute(&cus, hipDeviceAttributeMultiprocessorCount, dev) != hipSuccess) { grid = -1; return; }
        if (hipFuncSetAttribute((const void*)mk_fwd, hipFuncAttributeMaxDynamicSharedMemorySize, LDS_BYTES) != hipSuccess) { grid = -1; return; }
        grid = cus;
    }
    if (grid < 0) return;
    (void)hipMemsetAsync((char*)d_ws + WS_CTL, 0, CTL_ZERO_BYTES, stream);
    Args a{};
    for (int i = 0; i < 25; ++i) a.in[i] = (const float*)d_in[i];
    a.out = (float*)d_out; a.ws = (unsigned char*)d_ws;
#if MK_LAUNCH_PER_PHASE
#ifndef PH_MAX
#define PH_MAX N_PHASES
#endif
    for (int p = 0; p < PH_MAX; ++p) { a.ph_lo = p; a.ph_hi = p + 1; hipLaunchKernelGGL(mk_fwd, dim3(grid), dim3(NWAVES * 64), LDS_BYTES, stream, a); }
#else
    a.ph_lo = 0; a.ph_hi = N_PHASES;
    hipLaunchKernelGGL(mk_fwd, dim3(grid), dim3(NWAVES * 64), LDS_BYTES, stream, a);
#endif
}
```

```cpp
#include <hip/hip_runtime.h>
#include <hip/hip_bf16.h>
#include <cstdio>
#include <cstdint>

#define GAS __attribute__((address_space(1)))
#define LAS __attribute__((address_space(3)))
typedef unsigned short bf16_t;
typedef short bf16x8 __attribute__((ext_vector_type(8)));
typedef short s16x4 __attribute__((ext_vector_type(4)));
typedef float f32x2 __attribute__((ext_vector_type(2)));
typedef float f32x4 __attribute__((ext_vector_type(4)));
typedef float f32x16 __attribute__((ext_vector_type(16)));
typedef unsigned u32x2 __attribute__((ext_vector_type(2)));
typedef unsigned u32x4 __attribute__((ext_vector_type(4)));
typedef __bf16 bf16x2_t __attribute__((ext_vector_type(2)));

constexpr int NB = 8, SEQ = 4096, DM = 1024, DEPTH = 4, MTOK = NB * SEQ;
constexpr int NPROJ = 6400;
constexpr int LDP = 2304;
constexpr size_t GATE_BASE = (size_t)NB * SEQ * LDP * 2;
__device__ __forceinline__ size_t gate_off(int pm, int g, int wid, int ai, int lane) { return GATE_BASE + ((((size_t)(pm * 16 + g) * 8 + wid) * 2 + ai) * 64 + lane) * 64; }
constexpr int PC_NAQ = 0, PC_NAK = 256, PC_NAV = 512, PC_WQ = 768, PC_WK = 1024, PC_WV = 1152, PC_AXQ = 1280, PC_AXK = 1536, PC_AXV = 1664,
              PC_CQ = 1792, PC_CKV = 1984, PC_KR = 2240, PC_GATE = 2304, PC_YC = 1792;
constexpr int NEXP = 32, LISTCAP = 32768, SORTROWS = 2 * MTOK + NEXP * 256;
constexpr float LOG2E = 1.4426950408889634f;
constexpr float EPS = 1e-6f;

__device__ __forceinline__ unsigned cvt_pk_bf16(float lo, float hi) { f32x2 v = {lo, hi}; bf16x2_t b = __builtin_convertvector(v, bf16x2_t); return __builtin_bit_cast(unsigned, b); }
__device__ __forceinline__ float bf2f(unsigned short b) { return __uint_as_float(((unsigned)b) << 16); }
__device__ __forceinline__ float bflo(unsigned w) { return __uint_as_float(w << 16); }
__device__ __forceinline__ float bfhi(unsigned w) { return __uint_as_float(w & 0xffff0000u); }
__device__ __forceinline__ unsigned short f2bf(float f) { return (unsigned short)(cvt_pk_bf16(f, 0.f) & 0xffffu); }
__device__ __forceinline__ int lane_now() { int l; asm volatile("v_mbcnt_lo_u32_b32 %0, -1, 0\n\tv_mbcnt_hi_u32_b32 %0, -1, %0" : "=v"(l)); return l; }
template <int MASK> __device__ __forceinline__ float xshfl(float v) {
    if constexpr (MASK == 32) { auto rr = __builtin_amdgcn_permlane32_swap(__float_as_uint(v), __float_as_uint(v), false, false); return __uint_as_float((lane_now() & 32) ? rr[0] : rr[1]); }
    else return __uint_as_float((unsigned)__builtin_amdgcn_ds_swizzle((int)__float_as_uint(v), (MASK << 10) | 0x1f));
}
__device__ __forceinline__ unsigned pk_fp8x4(float a, float b, float c, float d) { unsigned w = 0u; w = __builtin_amdgcn_cvt_pk_fp8_f32(a, b, w, false); w = __builtin_amdgcn_cvt_pk_fp8_f32(c, d, w, true); return w; }
__device__ __forceinline__ float fast_sigmoid(float x) { return __builtin_amdgcn_rcpf(1.0f + __builtin_amdgcn_exp2f(-x * LOG2E)); }

namespace pg8 {
constexpr int BM = 256, BK = 64, HALF = 128, HTB = HALF * BK * 2, STAGE_BYTES = 8 * HTB, NXCD = 8, WGM = 8;

__host__ __device__ __forceinline__ int lds_byte(int r, int c) { const int st = (r >> 4) * 2 + (c >> 5), rr = r & 15, cc = c & 31, ob = rr * 64 + cc * 2; return st * 1024 + (ob ^ (((ob >> 9) & 1) << 5)); }
__host__ __device__ __forceinline__ void stage_rc(int b, int& R, int& C) { const int st = b / 1024, sb = b % 1024, swz = sb ^ (((sb >> 9) & 1) << 5); R = (st >> 1) * 16 + swz / 64; C = (st & 1) * 32 + (swz % 64) / 2; }
__host__ __device__ __forceinline__ int perm32(int rho) { const int n = rho >> 4, i = rho & 15; return 8 * (i >> 2) + 4 * n + (i & 3); }

typedef int i32x4 __attribute__((ext_vector_type(4)));
typedef int i32x8 __attribute__((ext_vector_type(8)));
struct Unit { int pm, pn, e, acol, lbase, nv; };
struct Gemm { const bf16_t* A; const bf16_t* Bt; const int* list; };

struct StaticOrder {
    int nM, nN, nwg, G, c, skew;
    __device__ __forceinline__ void init(int M, int N, int G_, int c_, int skew_ = 0) { nM = M / BM; nN = N / BM; nwg = nM * nN; G = G_; c = c_; skew = (skew_ && nwg % G_ == 0 && G_ % 16 == 0 && nwg >= 2 * G_) ? 1 : 0; }
    __device__ __forceinline__ bool next(int i, Unit& u) const {
        long L = (long)i * G + c;
        if (skew) { const int R = nwg / G; if (i >= R - 1) { const int k = i - (R - 1); if (c < G / 2 || k >= 2) return false; L = (long)(R - 1) * G + k * (G / 2) + (c - G / 2); } }
        if (L >= nwg) return false;
        int wgid = (int)L; { const int q = nwg / NXCD, r = nwg % NXCD, xcd = wgid % NXCD, off = wgid / NXCD; wgid = (xcd < r ? xcd * (q + 1) : r * (q + 1) + (xcd - r) * q) + off; }
        const int nig = WGM * nN, gid = wgid / nig, fm = gid * WGM, gsz = (nM - fm) < WGM ? (nM - fm) : WGM;
        u.pm = fm + ((wgid % nig) % gsz); u.pn = (wgid % nig) / gsz; u.e = 0; u.acol = 0; u.lbase = 0; u.nv = 256; return true;
    }
};

template <bool GATHER, int LDA>
__device__ __forceinline__ void a_offsets(const Gemm& g, const Unit& u, const int (&Rr)[2], const unsigned (&Cb)[2], unsigned (&vo)[2][2]) {
#pragma unroll
    for (int h = 0; h < 2; ++h)
#pragma unroll
        for (int i = 0; i < 2; ++i) {
            if constexpr (GATHER) {
                int idx = h * HALF + Rr[i]; idx = idx < u.nv ? idx : (u.nv - 1);
                const int row = g.list[u.lbase + idx];
                vo[h][i] = (unsigned)row * (unsigned)(LDA * 2) + Cb[i];
            } else {
                vo[h][i] = (unsigned)(h * HALF + Rr[i]) * (unsigned)(LDA * 2) + Cb[i];
            }
        }
}

template <class Epi, class Sched, bool GATHER, bool ALIGN_EPI, int LDA, int LDB, int KK, int NBE, bool F8 = false, bool NARROW = false>
__device__ __forceinline__ void gemm_phase(LAS unsigned char* lds, const Gemm g, const Sched& S, const Epi& E, int tid) {
    asm volatile("" : "+v"(tid));
    const int wid = __builtin_amdgcn_readfirstlane(tid >> 6), lane = tid & 63, wr = wid >> 2, wc = wid & 3, fr = lane & 15, fq = lane >> 4;
    constexpr int nt = KK / BK;
    int Rr[2]; unsigned Cb[2]; unsigned voffB[2];
#pragma unroll
    for (int i = 0; i < 2; ++i) { int R, C; stage_rc(tid * 16 + i * 8192, R, C); const int Rb = Epi::PERM ? ((R & ~31) + perm32(R & 31)) : R;
        Rr[i] = R; Cb[i] = (unsigned)C * 2u; voffB[i] = (unsigned)(Rb * LDB + C) * 2u; }
    const size_t kstep = (size_t)(BK * 2);
    constexpr size_t hstepB = (size_t)HALF * LDB * 2, hstepA = (size_t)HALF * LDA * 2;
    const unsigned ldsw = (unsigned)wid * 1024u;
    const int aoff = lds_byte(wr * 64 + fr, fq * 8), boff = lds_byte(wc * 32 + fr, fq * 8);
#define PG8_SA(b, h) (((b) * 2 + (h)) * HTB)
#define PG8_SB(b, h) ((4 + (b) * 2 + (h)) * HTB)
#define PG8_STAGE(bufoff, gbase, voff) do { _Pragma("unroll") for (int _i = 0; _i < 2; ++_i) \
        __builtin_amdgcn_global_load_lds((const unsigned*)((const char*)(gbase) + (voff)[_i]), (LAS unsigned*)(lds + (bufoff) + ldsw + _i * 8192), 16, 0, 0); } while (0)
#define PG8_LDA(dst, b, h) do { _Pragma("unroll") for (int m = 0; m < 4; ++m) { if constexpr (F8) { dst##8[m].lo = *(const LAS i32x4*)(lds + PG8_SA(b, h) + aoff + m * 2048); dst##8[m].hi = *(const LAS i32x4*)(lds + PG8_SA(b, h) + aoff + m * 2048 + 1024); } \
        else { _Pragma("unroll") for (int k = 0; k < 2; ++k) dst[m][k] = *(const LAS bf16x8*)(lds + PG8_SA(b, h) + aoff + m * 2048 + k * 1024); } } } while (0)
#define PG8_LDB(dst, b, h) do { _Pragma("unroll") for (int n = 0; n < 2; ++n) { if constexpr (F8) { dst##8[n].lo = *(const LAS i32x4*)(lds + PG8_SB(b, h) + boff + n * 2048); dst##8[n].hi = *(const LAS i32x4*)(lds + PG8_SB(b, h) + boff + n * 2048 + 1024); } \
        else { _Pragma("unroll") for (int k = 0; k < 2; ++k) dst[n][k] = *(const LAS bf16x8*)(lds + PG8_SB(b, h) + boff + n * 2048 + k * 1024); } } } while (0)
#define PG8_MMA(ai, bj, At, Bt) do { __builtin_amdgcn_s_setprio(1); _Pragma("unroll") for (int m = 0; m < 4; ++m) _Pragma("unroll") for (int n = 0; n < 2; ++n) { \
        if constexpr (F8) { asm volatile("v_mfma_scale_f32_16x16x128_f8f6f4 %0, %1, %2, %0, %3, %3 op_sel_hi:[0,0,0]" : "+v"(acc[ai][bj][m][n]) : "v"(Bt##8[n]), "v"(At##8[m]), "v"(sc127)); }   \
        else { _Pragma("unroll") for (int k = 0; k < 2; ++k) acc[ai][bj][m][n] = __builtin_amdgcn_mfma_f32_16x16x32_bf16(Bt[n][k], At[m][k], acc[ai][bj][m][n], 0, 0, 0); } } \
        __builtin_amdgcn_s_setprio(0); } while (0)
#define PG8_WAIT_V(n) asm volatile("s_waitcnt vmcnt(" #n ")" ::: "memory")
#define PG8_WAIT_L(n) asm volatile("s_waitcnt lgkmcnt(" #n ")" ::: "memory")
#define PG8_BAR __builtin_amdgcn_s_barrier()
#define PG8_SCHED __builtin_amdgcn_sched_barrier(0)
#define PG8_STAGE_A(bufoff, gbase, vo, h) do { if constexpr (GATHER) { PG8_STAGE(bufoff, gbase, (vo)[h]); } else { PG8_STAGE(bufoff, (gbase) + (h) * hstepA, (vo)[0]); } } while (0)
#define PG8_ABASE(u) (GATHER ? (size_t)0 : ((size_t)(u).pm * BM * LDA + (size_t)(u).acol) * 2)
#define PG8_BBASE(u) (((size_t)(u).e * NBE + (size_t)(u).pn * BM) * LDB * 2)
    Unit cur, nxt; int ui = 0;
    if (!S.next(0, cur)) return;
    f32x4 acc[2][2][4][2];
#pragma unroll
    for (int a = 0; a < 2; ++a)
#pragma unroll
        for (int b = 0; b < 2; ++b)
#pragma unroll
            for (int m = 0; m < 4; ++m)
#pragma unroll
                for (int n = 0; n < 2; ++n) acc[a][b][m][n] = (f32x4){0.f, 0.f, 0.f, 0.f};
    bf16x8 At[4][2], B0[2][2], B1[2][2];
    i32x8 At8[4], B08[2], B18[2];
    int sc127 = 127; asm volatile("" : "+v"(sc127)); (void)sc127;
    (void)At; (void)B0; (void)B1; (void)At8; (void)B08; (void)B18;
    unsigned voA[2][2];
    a_offsets<GATHER, LDA>(g, cur, Rr, Cb, voA);
    if constexpr (GATHER) { asm volatile("s_waitcnt vmcnt(0)" ::: "memory"); }
    const char* Ab = (const char*)g.A; const char* Bb = (const char*)g.Bt; asm volatile("" : "+s"(Ab), "+s"(Bb)); Ab = (const char*)(const GAS char*)Ab; Bb = (const char*)(const GAS char*)Bb;
    const char* cA = Ab + PG8_ABASE(cur); const char* cB = Bb + PG8_BBASE(cur);
    PG8_STAGE(PG8_SB(0, 0), cB, voffB); PG8_STAGE(PG8_SB(0, 1), cB + hstepB, voffB); PG8_STAGE_A(PG8_SA(0, 0), cA, voA, 0); PG8_STAGE_A(PG8_SA(0, 1), cA, voA, 1);
    if (wr == 1) PG8_BAR;
    PG8_WAIT_V(2); PG8_BAR;
    PG8_STAGE(PG8_SB(1, 0), cB + kstep, voffB); PG8_STAGE_A(PG8_SA(1, 0), cA + kstep, voA, 0); PG8_STAGE(PG8_SB(1, 1), cB + hstepB + kstep, voffB);
    PG8_WAIT_V(6); PG8_BAR;
    for (;;) {
        const bool has_next = S.next(ui + 1, nxt);
        const char* nA = has_next ? Ab + PG8_ABASE(nxt) : cA; const char* nB = has_next ? Bb + PG8_BBASE(nxt) : cB;
#pragma unroll 1
        for (int t = 0; t < nt; t += 2) {
            const bool last = (t == nt - 2);
            const char* a1 = cA + (size_t)(t + 1) * kstep;
            const char* a2 = last ? nA : cA + (size_t)(t + 2) * kstep; const char* b2 = last ? nB : cB + (size_t)(t + 2) * kstep;
            const char* a3 = a2 + kstep; const char* b3 = b2 + kstep;
            PG8_LDB(B0, 0, 0); if constexpr (!NARROW) { PG8_LDB(B1, 0, 1); } PG8_SCHED; PG8_LDA(At, 0, 0); PG8_STAGE_A(PG8_SA(1, 1), a1, voA, 1);
            if constexpr (GATHER) { if (last && has_next) { a_offsets<GATHER, LDA>(g, nxt, Rr, Cb, voA); asm volatile("s_waitcnt vmcnt(0)" ::: "memory"); } }
            PG8_WAIT_V(8); PG8_WAIT_L(0); PG8_BAR; if (!NARROW || wc < 2) { PG8_MMA(0, 0, At, B0); } if constexpr (!NARROW) { PG8_MMA(0, 1, At, B1); } PG8_BAR; PG8_SCHED;
            PG8_LDA(At, 0, 1); PG8_STAGE(PG8_SB(0, 0), b2, voffB); PG8_STAGE(PG8_SB(0, 1), b2 + hstepB, voffB); PG8_STAGE_A(PG8_SA(0, 0), a2, voA, 0);
            PG8_WAIT_V(8); PG8_WAIT_L(0); PG8_BAR; if (!NARROW || wc < 2) { PG8_MMA(1, 0, At, B0); } if constexpr (!NARROW) { PG8_MMA(1, 1, At, B1); } PG8_BAR; PG8_SCHED;
            PG8_LDB(B0, 1, 0); if constexpr (!NARROW) { PG8_LDB(B1, 1, 1); } PG8_SCHED; PG8_LDA(At, 1, 0); PG8_STAGE_A(PG8_SA(0, 1), a2, voA, 1);
            PG8_WAIT_V(8); PG8_WAIT_L(0); PG8_BAR; if (!NARROW || wc < 2) { PG8_MMA(0, 0, At, B0); } if constexpr (!NARROW) { PG8_MMA(0, 1, At, B1); } PG8_BAR; PG8_SCHED;
            PG8_LDA(At, 1, 1); PG8_STAGE(PG8_SB(1, 0), b3, voffB); PG8_STAGE(PG8_SB(1, 1), b3 + hstepB, voffB); PG8_STAGE_A(PG8_SA(1, 0), a3, voA, 0);
            PG8_WAIT_V(8); PG8_WAIT_L(0); PG8_BAR; if (!NARROW || wc < 2) { PG8_MMA(1, 0, At, B0); } if constexpr (!NARROW) { PG8_MMA(1, 1, At, B1); } PG8_BAR; PG8_SCHED;
        }
        if constexpr (F8) { asm volatile("s_nop 15\n\ts_nop 15\n\ts_nop 15" ::: "memory"); }
        if constexpr (ALIGN_EPI) { if (wr == 0) PG8_BAR; }
        if constexpr (!Epi::AFTER_DRAIN) { E(acc, cur, wr, wc, fr, fq); }
        if (!has_next) break;
#pragma unroll
        for (int a = 0; a < 2; ++a)
#pragma unroll
            for (int b = 0; b < 2; ++b)
#pragma unroll
                for (int m = 0; m < 4; ++m)
#pragma unroll
                    for (int n = 0; n < 2; ++n) acc[a][b][m][n] = (f32x4){0.f, 0.f, 0.f, 0.f};
        cur = nxt; cA = nA; cB = nB; ++ui;
        if constexpr (ALIGN_EPI) { if (wr == 1) PG8_BAR; }
    }
    PG8_WAIT_V(0);
    if constexpr (!ALIGN_EPI) { if (wr == 0) PG8_BAR; }
    PG8_BAR;
    if constexpr (Epi::AFTER_DRAIN) { E.fused(acc, cur, wr, wc, fr, fq, lds, wid, lane); }
#undef PG8_SA
#undef PG8_SB
#undef PG8_STAGE
#undef PG8_LDA
#undef PG8_LDB
#undef PG8_MMA
#undef PG8_WAIT_V
#undef PG8_WAIT_L
#undef PG8_BAR
#undef PG8_SCHED
#undef PG8_STAGE_A
#undef PG8_ABASE
#undef PG8_BBASE
}
}
namespace pg8 {
typedef f32x4 AccT[2][2][4][2];

__device__ __forceinline__ u32x4 pack8(const f32x4 v0, const f32x4 v1) {
    u32x4 w; w.x = cvt_pk_bf16(v0[0], v0[1]); w.y = cvt_pk_bf16(v0[2], v0[3]); w.z = cvt_pk_bf16(v1[0], v1[1]); w.w = cvt_pk_bf16(v1[2], v1[3]); return w;
}
__device__ __forceinline__ void unpack8(const u32x4 w, f32x4& v0, f32x4& v1) {
    v0 = (f32x4){bflo(w.x), bfhi(w.x), bflo(w.y), bfhi(w.y)}; v1 = (f32x4){bflo(w.z), bfhi(w.z), bflo(w.w), bfhi(w.w)};
}

constexpr float MERGE_WSCALE = 16.0f;
constexpr float GATE_WSCALE = 64.0f, GATE_WINV = 1.0f / 64.0f;
struct EpiProj {
    static constexpr bool PERM = true, AFTER_DRAIN = false;
    bf16_t* O; LAS float* xch; float* ssq; const float* cs; bf16_t* KC; const float* gaq; const float* gak; int pn0;
    __device__ __forceinline__ void operator()(const AccT& acc, const Unit& u_, int wr, int wc, int fr, int fq) const {
        Unit u = u_; u.pn += pn0;
        const bool gate = u.pn >= 9;
        const float qs = (u.pn == 0 || u.pn == 3) ? 0.125f * LOG2E : 1.0f;
        const int row0 = u.pm * BM + wr * 64 + fr, col0 = u.pn * BM + wc * 32 + 8 * fq;
        if (gate) {
            int lx = fq * 16 + fr; asm volatile("" : "+v"(lx));
            unsigned char* gt = (unsigned char*)O + gate_off(u.pm, u.pn - 9, wr * 4 + wc, 0, lx);
#pragma unroll
            for (int ai = 0; ai < 2; ++ai)
#pragma unroll
                for (int m = 0; m < 4; ++m) { u32x4 w4;
#pragma unroll
                    for (int bj = 0; bj < 2; ++bj) { const f32x4 v0 = acc[ai][bj][m][0], v1 = acc[ai][bj][m][1]; unsigned q[8];
#pragma unroll
                        for (int j = 0; j < 4; ++j) {
                            q[j] = (unsigned)fmaxf(__builtin_amdgcn_rcpf(1.0f + __builtin_amdgcn_exp2f(v0[j] * GATE_WINV)) * 255.0f + 0.5f, 1.0f); q[4 + j] = (unsigned)fmaxf(__builtin_amdgcn_rcpf(1.0f + __builtin_amdgcn_exp2f(v1[j] * GATE_WINV)) * 255.0f + 0.5f, 1.0f); }
                        const unsigned lo = q[0] | (q[1] << 8) | (q[2] << 16) | (q[3] << 24), hi = q[4] | (q[5] << 8) | (q[6] << 16) | (q[7] << 24);
                        if (bj == 0) { w4.x = lo; w4.y = hi; } else { w4.z = lo; w4.w = hi; } }
                    *(GAS u32x4*)(gt + ai * 4096 + m * 16) = w4; }
        } else if (u.pn == 5 || u.pn == 6) {
            const bool isq = u.pn == 5;
            int frx = fr; asm volatile("" : "+v"(frx));
#pragma unroll
            for (int ai = 0; ai < 2; ++ai)
#pragma unroll
                for (int m = 0; m < 4; ++m)
#pragma unroll
                    for (int bj = 0; bj < 2; ++bj) { const f32x4 v0 = acc[ai][bj][m][0], v1 = acc[ai][bj][m][1];
                        float p = (v0[0] * v0[0] + v0[1] * v0[1]) + (v0[2] * v0[2] + v0[3] * v0[3]) + (v1[0] * v1[0] + v1[1] * v1[1]) + (v1[2] * v1[2] + v1[3] * v1[3]);
                        p += xshfl<16>(p); p += xshfl<32>(p);
                        if (fq == 0 && (isq || bj == 0)) xch[(ai * HALF + wr * 64 + m * 16 + frx) * 8 + 4 * bj + wc] = p; }
            asm volatile("s_waitcnt lgkmcnt(0)\n\ts_barrier" ::: "memory");
            const int hf = wc & 1;
            f32x4 g0, g1;
            { const float* G = (isq ? gaq : gak) + 32 * hf + 4 * fq; g0 = *(const GAS f32x4*)G; g1 = *(const GAS f32x4*)(G + 16); }
#pragma unroll
            for (int ai = 0; ai < 2; ++ai) {
                f32x4 c4[4], s4[4];
#pragma unroll
                for (int m = 0; m < 4; ++m) { const int pos = (u.pm * BM + ai * HALF + wr * 64 + m * 16 + frx) & (SEQ - 1); const int idx = hf ? (pos & 63) : (pos >> 6);
                    c4[m] = *(const GAS f32x4*)(cs + idx * 16 + 4 * fq); s4[m] = *(const GAS f32x4*)(cs + SEQ * 16 + idx * 16 + 4 * fq); }
#pragma unroll
                for (int m = 0; m < 4; ++m) { const int rl = ai * HALF + wr * 64 + m * 16 + frx, row = u.pm * BM + rl;
                    bf16_t* rowp = O + (size_t)row * LDP + col0;
#pragma unroll
                    for (int bj = 0; bj < 2; ++bj) { f32x4 v0 = acc[ai][bj][m][0], v1 = acc[ai][bj][m][1];
                        if (isq || bj == 0) {
                            const f32x2 pr_ = *(const LAS f32x2*)(xch + rl * 8 + ((4 * bj + wc) & ~1)); const float tot = pr_.x + pr_.y;
                            const float rstd = rsqrtf(tot * (1.0f / 64.0f) + EPS) * (isq ? 0.125f * LOG2E : 1.0f);
                            v0 = v0 * rstd * g0; v1 = v1 * rstd * g1;
                            const f32x4 o0 = v0 * c4[m] - v1 * s4[m], o1 = v0 * s4[m] + v1 * c4[m]; v0 = o0; v1 = o1; }
                        *(GAS u32x4*)(rowp + bj * HALF) = pack8(v0, v1); } }
                asm volatile("" ::: "memory"); }
        } else if (u.pn == 7 || u.pn == 8) {
#pragma unroll
            for (int ai = 0; ai < 2; ++ai)
#pragma unroll
                for (int m = 0; m < 4; ++m) { const int row = row0 + ai * HALF + m * 16; bf16_t* rowp = O + (size_t)row * LDP + col0;
#pragma unroll
                    for (int bj = 0; bj < 2; ++bj) { const f32x4 v0 = acc[ai][bj][m][0], v1 = acc[ai][bj][m][1];
                        *(GAS u32x4*)(rowp + bj * HALF) = pack8(v0, v1);
                        const int lc = 128 * bj + 32 * wc;
                        const int grp = lc >> 5;
                        const int slot = (u.pn == 7) ? (grp < 6 ? grp : 8 + (grp - 6)) : (grp < 6 ? 10 + grp : -1);
                        if (slot >= 0) {
                            float p = (v0[0] * v0[0] + v0[1] * v0[1]) + (v0[2] * v0[2] + v0[3] * v0[3]) + (v1[0] * v1[0] + v1[1] * v1[1]) + (v1[2] * v1[2] + v1[3] * v1[3]);
                            p += xshfl<16>(p); p += xshfl<32>(p);
                            if (fq == 0) ssq[(size_t)row * 16 + slot] = p;
                        } else if (lc == 192) {
                            const int pos = row & (SEQ - 1);
                            const f32x4 c4 = *(const GAS f32x4*)(cs + pos * 16 + 4 * fq), s4 = *(const GAS f32x4*)(cs + SEQ * 16 + pos * 16 + 4 * fq);
                            const u32x4 w = pack8(v0 * c4 - v1 * s4, v0 * s4 + v1 * c4);
                            bf16_t* kr = KC + (size_t)row * 384 + 64 + 8 * fq;
#pragma unroll
                            for (int h = 0; h < 4; ++h) *(GAS u32x4*)(kr + 96 * h) = w;
                        } } }
        } else {
#pragma unroll
            for (int ai = 0; ai < 2; ++ai)
#pragma unroll
                for (int m = 0; m < 4; ++m) { bf16_t* rowp = O + (size_t)(row0 + ai * HALF + m * 16) * LDP + col0;
#pragma unroll
                    for (int bj = 0; bj < 2; ++bj) *(GAS u32x4*)(rowp + bj * HALF) = pack8(acc[ai][bj][m][0] * qs, acc[ai][bj][m][1] * qs); }
        }
    }
};

struct EpiNone {
    static constexpr bool PERM = true, AFTER_DRAIN = false;
    float* sink;
    __device__ __forceinline__ void operator()(const AccT& acc, const Unit& u, int wr, int wc, int fr, int fq) const {
        float s = 0.f;
#pragma unroll
        for (int ai = 0; ai < 2; ++ai)
#pragma unroll
            for (int bj = 0; bj < 2; ++bj)
#pragma unroll
                for (int m = 0; m < 4; ++m) s += acc[ai][bj][m][0][0] + acc[ai][bj][m][1][3];
        if (s == 1.2345e30f) sink[0] = s;
    }
};

struct EpiQup {
    static constexpr bool PERM = true, AFTER_DRAIN = false;
    bf16_t* QC; const float* cs; const float* ssq;
    __device__ __forceinline__ void operator()(const AccT& acc, const Unit& u, int wr, int wc, int fr, int fq) const {
        int frx = fr; asm volatile("" : "+v"(frx));
        const int row0 = u.pm * BM + wr * 64 + frx;
        float rs[2][4];
        { f32x4 sa_[2][4]; f32x2 sb_[2][4];
#pragma unroll
          for (int ai = 0; ai < 2; ++ai)
#pragma unroll
              for (int m = 0; m < 4; ++m) { const float* sp = ssq + (size_t)(row0 + ai * HALF + m * 16) * 16; sa_[ai][m] = *(const GAS f32x4*)sp; sb_[ai][m] = *(const GAS f32x2*)(sp + 4); }
#pragma unroll
          for (int ai = 0; ai < 2; ++ai)
#pragma unroll
              for (int m = 0; m < 4; ++m) rs[ai][m] = rsqrtf((((sa_[ai][m][0] + sa_[ai][m][1]) + (sa_[ai][m][2] + sa_[ai][m][3])) + (sb_[ai][m][0] + sb_[ai][m][1])) * (1.0f / 192.0f) + EPS) * (0.10206207261596575f * LOG2E); }
#pragma unroll
        for (int bj = 0; bj < 2; ++bj) {
            const int gi = 8 * u.pn + 4 * bj + wc;
            if (gi >= 12) continue;
            const bool rope = (gi % 3) == 2;
            const int col = 32 * gi + 8 * fq;
#pragma unroll
            for (int ai = 0; ai < 2; ++ai) {
                f32x4 c4[4], s4[4];
                if (rope) {
#pragma unroll
                    for (int m = 0; m < 4; ++m) { const int pos = (row0 + ai * HALF + m * 16) & (SEQ - 1); c4[m] = *(const GAS f32x4*)(cs + pos * 16 + 4 * fq); s4[m] = *(const GAS f32x4*)(cs + SEQ * 16 + pos * 16 + 4 * fq); }
                }
#pragma unroll
                for (int m = 0; m < 4; ++m) { const int row = row0 + ai * HALF + m * 16; const float rs_ = rs[ai][m];
                    f32x4 v0 = acc[ai][bj][m][0] * rs_, v1 = acc[ai][bj][m][1] * rs_;
                    if (rope) { const f32x4 o1 = v0 * c4[m] - v1 * s4[m], o2 = v0 * s4[m] + v1 * c4[m]; v0 = o1; v1 = o2; }
                    *(GAS u32x4*)(QC + (size_t)row * 384 + col) = pack8(v0, v1); }
                asm volatile("" ::: "memory"); }
        }
    }
};

struct EpiKVup {
    static constexpr bool PERM = true, AFTER_DRAIN = false;
    bf16_t* KC; bf16_t* VC; const float* ssq;
    __device__ __forceinline__ void operator()(const AccT& acc, const Unit& u, int wr, int wc, int fr, int fq) const {
        int frx = fr; asm volatile("" : "+v"(frx));
        const int row0 = u.pm * BM + wr * 64 + frx;
        float rs[2][4];
        { f32x4 sa_[2][4], sb_[2][4];
#pragma unroll
          for (int ai = 0; ai < 2; ++ai)
#pragma unroll
              for (int m = 0; m < 4; ++m) { const float* sp = ssq + (size_t)(row0 + ai * HALF + m * 16) * 16 + 8; sa_[ai][m] = *(const GAS f32x4*)sp; sb_[ai][m] = *(const GAS f32x4*)(sp + 4); }
#pragma unroll
          for (int ai = 0; ai < 2; ++ai)
#pragma unroll
              for (int m = 0; m < 4; ++m) rs[ai][m] = rsqrtf((((sa_[ai][m][0] + sa_[ai][m][1]) + (sa_[ai][m][2] + sa_[ai][m][3])) + ((sb_[ai][m][0] + sb_[ai][m][1]) + (sb_[ai][m][2] + sb_[ai][m][3]))) * (1.0f / 256.0f) + EPS); }
#pragma unroll
        for (int bj = 0; bj < 2; ++bj) {
            const int col = 128 * bj + 32 * wc + 8 * fq;
            bf16_t* base = (u.pn == 0) ? KC : VC; const int ld = (u.pn == 0) ? 384 : 256; const int coff = (u.pn == 0) ? (96 * (col >> 6) + (col & 63)) : col;
#pragma unroll
            for (int ai = 0; ai < 2; ++ai)
#pragma unroll
                for (int m = 0; m < 4; ++m) { const int row = row0 + ai * HALF + m * 16; const float rs_ = rs[ai][m];
                    *(GAS u32x4*)(base + (size_t)row * ld + coff) = pack8(acc[ai][bj][m][0] * rs_, acc[ai][bj][m][1] * rs_); }
        }
    }
};

struct EpiMerge {
    static constexpr bool PERM = true, AFTER_DRAIN = false;
    const bf16_t* P; bf16_t* HB;
    __device__ __forceinline__ void operator()(const AccT& acc, const Unit& u, int wr, int wc, int fr, int fq) const {
        const int row0 = u.pm * BM + wr * 64 + fr, col0 = u.pn * BM + wc * 32 + 8 * fq, n = u.e;
#pragma unroll
        for (int ai = 0; ai < 2; ++ai) {
            u32x2 gw[4][2]; u32x4 ow[4][2];
#pragma unroll
            for (int m = 0; m < 4; ++m)
#pragma unroll
                for (int bj = 0; bj < 2; ++bj) { const int row = row0 + ai * HALF + m * 16, col = col0 + bj * HALF;
                    gw[m][bj] = *(const GAS u32x2*)((const unsigned char*)(P + (size_t)row * LDP + PC_GATE) + 1024 * n + col);
                    if (n > 0) ow[m][bj] = *(const GAS u32x4*)(HB + (size_t)row * DM + col); else ow[m][bj] = (u32x4){0u, 0u, 0u, 0u}; }
#pragma unroll
            for (int m = 0; m < 4; ++m)
#pragma unroll
                for (int bj = 0; bj < 2; ++bj) { const int row = row0 + ai * HALF + m * 16, col = col0 + bj * HALF;
                    const unsigned ga = gw[m][bj].x, gb = gw[m][bj].y; constexpr float K = 1.0f / 255.0f;
                    const f32x4 g0 = (f32x4){(float)(ga & 0xffu), (float)((ga >> 8) & 0xffu), (float)((ga >> 16) & 0xffu), (float)(ga >> 24)} * K;
                    const f32x4 g1 = (f32x4){(float)(gb & 0xffu), (float)((gb >> 8) & 0xffu), (float)((gb >> 16) & 0xffu), (float)(gb >> 24)} * K;
                    f32x4 o0, o1; unpack8(ow[m][bj], o0, o1);
                    const f32x4 v0 = g0 * acc[ai][bj][m][0] + o0, v1 = g1 * acc[ai][bj][m][1] + o1;
                    *(GAS u32x4*)(HB + (size_t)row * DM + col) = pack8(v0, v1); }
            asm volatile("" ::: "memory");
        }
    }
};

struct EpiOut {
    static constexpr bool PERM = false, AFTER_DRAIN = false;
    const float* base; float* out; const float* gvec;
    __device__ __forceinline__ void operator()(const AccT& acc, const Unit& u, int wr, int wc, int fr, int fq) const {
        const int b = u.pm >> 4;
        const int row0 = u.pm * BM + wr * 64 + fr, col0 = u.pn * BM + wc * 32 + 4 * fq;
#pragma unroll
        for (int bj = 0; bj < 2; ++bj)
#pragma unroll
            for (int n = 0; n < 2; ++n) {
                const int col = col0 + bj * HALF + n * 16; const f32x4 gv = *(const GAS f32x4*)(gvec + b * 6144 + col);
                f32x4 bs[2][4];
#pragma unroll
                for (int ai = 0; ai < 2; ++ai)
#pragma unroll
                    for (int m = 0; m < 4; ++m) bs[ai][m] = *(const GAS f32x4*)(base + (size_t)(row0 + ai * HALF + m * 16) * DM + col);
#pragma unroll
                for (int ai = 0; ai < 2; ++ai)
#pragma unroll
                    for (int m = 0; m < 4; ++m) *(GAS f32x4*)(out + (size_t)(row0 + ai * HALF + m * 16) * DM + col) = bs[ai][m] + gv * acc[ai][bj][m][n];
                asm volatile("" ::: "memory");
            }
    }
};

struct EpiResid {
    static constexpr bool PERM = true, AFTER_DRAIN = false;
    const float* xf; bf16_t* XBo; const float* gvec;
    __device__ __forceinline__ void operator()(const AccT& acc, const Unit& u, int wr, int wc, int fr, int fq) const {
        const int b = u.pm >> 4;
        const int row0 = u.pm * BM + wr * 64 + fr, col0 = u.pn * BM + wc * 32 + 8 * fq;
#pragma unroll
        for (int bj = 0; bj < 2; ++bj) { const int col = col0 + bj * HALF;
            const f32x4 g0 = *(const GAS f32x4*)(gvec + b * 6144 + col), g1 = *(const GAS f32x4*)(gvec + b * 6144 + col + 4);
#pragma unroll
            for (int ai = 0; ai < 2; ++ai) {
                f32x4 x0[4], x1[4];
                if (xf) {
#pragma unroll
                    for (int m = 0; m < 4; ++m) { const size_t off = (size_t)(row0 + ai * HALF + m * 16) * DM + col; x0[m] = *(const GAS f32x4*)(xf + off); x1[m] = *(const GAS f32x4*)(xf + off + 4); }
                } else {
                    u32x4 xw[4];
#pragma unroll
                    for (int m = 0; m < 4; ++m) xw[m] = *(const GAS u32x4*)(XBo + (size_t)(row0 + ai * HALF + m * 16) * DM + col);
#pragma unroll
                    for (int m = 0; m < 4; ++m) unpack8(xw[m], x0[m], x1[m]);
                }
#pragma unroll
                for (int m = 0; m < 4; ++m) *(GAS u32x4*)(XBo + (size_t)(row0 + ai * HALF + m * 16) * DM + col) = pack8(x0[m] + acc[ai][bj][m][0] * g0, x1[m] + acc[ai][bj][m][1] * g1);
                asm volatile("" ::: "memory"); } }
    }
};

struct EpiRoute {
    static constexpr bool PERM = true, AFTER_DRAIN = true;
    const float* bg; const float* br; unsigned* ecnt; int* list; int* tok_es; float* tok_w;
    __device__ __forceinline__ void fused(const AccT& acc, const Unit& u, int wr, int wc, int fr, int fq, LAS unsigned char* lds, int wid, int lane) const {
        LAS float* LG = (LAS float*)lds;
        LAS unsigned* lcnt = (LAS unsigned*)(lds + 256 * 40 * 4);
        LAS unsigned* lbase = lcnt + 32;
        int tid = wid * 64 + lane; asm volatile("" : "+v"(tid));
        if (wc < 2) {
#pragma unroll
            for (int ai = 0; ai < 2; ++ai)
#pragma unroll
                for (int m = 0; m < 4; ++m) { const int rl = ai * HALF + wr * 64 + m * 16 + fr; const f32x4 v0 = acc[ai][0][m][0], v1 = acc[ai][0][m][1];
                    if (wc == 0) { *(LAS f32x4*)(LG + rl * 40 + 8 * fq) = v0; *(LAS f32x4*)(LG + rl * 40 + 8 * fq + 4) = v1; }
                    else if (fq == 0) { *(LAS f32x4*)(LG + rl * 40 + 32) = v0; } }
        }
        if (tid < 32) lcnt[tid] = 0u;
        __syncthreads();
        int e1 = 0, e2 = 0; unsigned r1 = 0, r2 = 0; float w1 = 0.f, w2 = 0.f;
        if (tid < 256) {
            const LAS float* lg = LG + tid * 40;
            float g[4];
#pragma unroll
            for (int j = 0; j < 4; ++j) g[j] = lg[j] + bg[j];
            int gs = 0; float gm = g[0];
#pragma unroll
            for (int j = 1; j < 4; ++j) if (g[j] > gm) { gm = g[j]; gs = j; }
            float gsum = 0.f;
#pragma unroll
            for (int j = 0; j < 4; ++j) gsum += __expf(g[j] - gm);
            const float gw = 1.0f / gsum;
            float el[8];
#pragma unroll
            for (int j = 0; j < 8; ++j) el[j] = lg[4 + 8 * gs + j] + br[8 * gs + j];
            int i1 = 0; float m1 = el[0];
#pragma unroll
            for (int j = 1; j < 8; ++j) if (el[j] > m1) { m1 = el[j]; i1 = j; }
            int i2 = -1; float m2 = 0.f;
#pragma unroll
            for (int j = 0; j < 8; ++j) if (j != i1 && (i2 < 0 || el[j] > m2)) { m2 = el[j]; i2 = j; }
            const float t = __expf(m2 - m1);
            w1 = gw / (1.0f + t); w2 = gw * t / (1.0f + t);
            e1 = 8 * gs + i1; e2 = 8 * gs + i2;
            r1 = atomicAdd((unsigned*)(lcnt + e1), 1u); r2 = atomicAdd((unsigned*)(lcnt + e2), 1u);
        }
        __syncthreads();
        if (tid < 32) lbase[tid] = __hip_atomic_fetch_add(ecnt + tid, lcnt[tid], __ATOMIC_RELAXED, __HIP_MEMORY_SCOPE_AGENT);
        __syncthreads();
        if (tid < 256) {
            const int token = u.pm * BM + tid;
            const int s1 = (int)(lbase[e1] + r1), s2 = (int)(lbase[e2] + r2);
            list[e1 * LISTCAP + s1] = token; list[e2 * LISTCAP + s2] = token;
            tok_es[2 * token] = (e1 << 16) | s1; tok_es[2 * token + 1] = (e2 << 16) | s2;
            tok_w[2 * token] = w1; tok_w[2 * token + 1] = w2;
        }
    }
};

struct EpiExp1 {
    static constexpr bool PERM = true, AFTER_DRAIN = false;
    bf16_t* HS;
    __device__ __forceinline__ void operator()(const AccT& acc, const Unit& u, int wr, int wc, int fr, int fq) const {
        const int row0 = u.pm * BM + wr * 64 + fr;
#pragma unroll
        for (int ai = 0; ai < 2; ++ai)
#pragma unroll
            for (int m = 0; m < 4; ++m) { bf16_t* rowp = HS + (size_t)(row0 + ai * HALF + m * 16) * 256;
#pragma unroll
                for (int bj = 0; bj < 2; ++bj) { const f32x4 a = acc[ai][bj][m][0], b = acc[ai][bj][m][1]; float h[4];
#pragma unroll
                    for (int j = 0; j < 4; ++j) h[j] = a[j] * fast_sigmoid(a[j]) * b[j];
                    u32x2 w; w.x = cvt_pk_bf16(h[0], h[1]); w.y = cvt_pk_bf16(h[2], h[3]);
                    *(GAS u32x2*)(rowp + u.pn * 128 + 64 * bj + 16 * wc + 4 * fq) = w; } }
    }
};

struct EpiStore {
    static constexpr bool PERM = true, AFTER_DRAIN = false;
    bf16_t* O; int ldc;
    __device__ __forceinline__ void operator()(const AccT& acc, const Unit& u, int wr, int wc, int fr, int fq) const {
        const int row0 = u.pm * BM + wr * 64 + fr, col0 = u.pn * BM + wc * 32 + 8 * fq;
#pragma unroll
        for (int ai = 0; ai < 2; ++ai)
#pragma unroll
            for (int m = 0; m < 4; ++m) { bf16_t* rowp = O + (size_t)(row0 + ai * HALF + m * 16) * ldc + col0;
#pragma unroll
                for (int bj = 0; bj < 2; ++bj) *(GAS u32x4*)(rowp + bj * HALF) = pack8(acc[ai][bj][m][0], acc[ai][bj][m][1]); }
    }
};

struct MergeOrder {
    int G, vc;
    __device__ bool next(int i, Unit& u) const {
        const int tile = vc + G * (i >> 2); if (tile >= (MTOK / BM) * (DM / BM)) return false;
        u.pm = tile >> 2; u.pn = tile & 3; u.e = i & 3; u.lbase = 0; u.nv = 256;
        u.acol = (u.e == 0) ? PC_NAQ : (u.e == 1) ? PC_WQ : (u.e == 2) ? PC_YC : PC_AXQ;
        return true;
    }
};

struct MoeOrder {
    int G, c, sh; const LAS int* tend; const LAS int* cnt;
    __device__ bool next(int i, Unit& u) const {
        const int L = i * G + c, tau = L >> sh;
        const int total = __builtin_amdgcn_readfirstlane(tend[NEXP - 1]);
        if (tau >= total) return false;
        int e = 0;
        while (e < NEXP - 1 && __builtin_amdgcn_readfirstlane(tend[e]) <= tau) ++e;
        const int ts = e ? __builtin_amdgcn_readfirstlane(tend[e - 1]) : 0, lt = tau - ts;
        int nv = __builtin_amdgcn_readfirstlane(cnt[e]) - 256 * lt; nv = nv > 256 ? 256 : nv;
        u.pm = tau; u.pn = L & ((1 << sh) - 1); u.e = e; u.acol = 0; u.lbase = e * LISTCAP + 256 * lt; u.nv = nv;
        return true;
    }
};
}
namespace pg8 {
struct MUnit { int pm, pn; };
__device__ __forceinline__ void merge_phase(LAS unsigned char* lds, const bf16_t* Pp, const bf16_t* Wbt, bf16_t* HBo, int G, int vc, int tid) {
    asm volatile("" : "+v"(tid));
    const int wid = __builtin_amdgcn_readfirstlane(tid >> 6), lane = tid & 63, wr = wid >> 2, wc = wid & 3, fr = lane & 15, fq = lane >> 4;
    constexpr int nt = 16, NU = (MTOK / 128) * (DM / 256);
    unsigned voffA[2], voffB[2];
#pragma unroll
    for (int i = 0; i < 2; ++i) { int R, C; stage_rc(tid * 16 + i * 8192, R, C); const int Rb = (R & ~31) + perm32(R & 31);
        voffA[i] = (unsigned)(R * LDP + C) * 2u; voffB[i] = (unsigned)(Rb * 256 + C) * 2u; }
    const unsigned ldsw = (unsigned)wid * 1024u;
    const int aoff = lds_byte(wr * 64 + fr, fq * 8), boff = lds_byte(wc * 32 + fr, fq * 8);
#define MG_SA(b) (((b) * 2) * HTB)
#define MG_SB(b, h) ((4 + (b) * 2 + (h)) * HTB)
#define MG_STAGE(bufoff, gbase, voff) do { _Pragma("unroll") for (int _i = 0; _i < 2; ++_i) \
        __builtin_amdgcn_global_load_lds((const unsigned*)((const char*)(gbase) + (voff)[_i]), (LAS unsigned*)(lds + (bufoff) + ldsw + _i * 8192), 16, 0, 0); } while (0)
#define MG_LDA(dst, b) do { _Pragma("unroll") for (int m = 0; m < 4; ++m) _Pragma("unroll") for (int k = 0; k < 2; ++k) dst[m][k] = *(const LAS bf16x8*)(lds + MG_SA(b) + aoff + m * 2048 + k * 1024); } while (0)
#define MG_LDB(dst, b, h) do { _Pragma("unroll") for (int n = 0; n < 2; ++n) _Pragma("unroll") for (int k = 0; k < 2; ++k) dst[n][k] = *(const LAS bf16x8*)(lds + MG_SB(b, h) + boff + n * 2048 + k * 1024); } while (0)
#define MG_MMA(bj, At, Bt) do { __builtin_amdgcn_s_setprio(1); _Pragma("unroll") for (int m = 0; m < 4; ++m) _Pragma("unroll") for (int n = 0; n < 2; ++n) _Pragma("unroll") for (int k = 0; k < 2; ++k) \
        acc[bj][m][n] = __builtin_amdgcn_mfma_f32_16x16x32_bf16(Bt[n][k], At[m][k], acc[bj][m][n], 0, 0, 0); __builtin_amdgcn_s_setprio(0); } while (0)
#define MG_WAIT_V(n) asm volatile("s_waitcnt vmcnt(" #n ")" ::: "memory")
#define MG_WAIT_L(n) asm volatile("s_waitcnt lgkmcnt(" #n ")" ::: "memory")
#define MG_BAR __builtin_amdgcn_s_barrier()
#define MG_SCHED __builtin_amdgcn_sched_barrier(0)
    const char* Ab = (const char*)Pp; const char* Bb = (const char*)Wbt; asm volatile("" : "+s"(Ab), "+s"(Bb)); Ab = (const char*)(const GAS char*)Ab; Bb = (const char*)(const GAS char*)Bb;
#define MG_ACOL(n) ((n) == 0 ? PC_NAQ : (n) == 1 ? PC_WQ : (n) == 2 ? PC_YC : PC_AXQ)
#define MG_A(u, kt) (Ab + ((size_t)(u).pm * 128 * LDP + MG_ACOL((kt) >> 2) + ((kt) & 3) * 64) * 2)
#define MG_B(u, kt) (Bb + ((size_t)(((kt) >> 2) * DM + (u).pn * 256) * 256 + ((kt) & 3) * 64) * 2)
    constexpr size_t hstepB = (size_t)HALF * 256 * 2, kstep = 128;
    MUnit cur, nxt; int ui = 0;
    { const int idx = vc; if (idx >= NU) return; cur.pm = idx >> 2; cur.pn = idx & 3; }
    f32x4 acc[2][4][2], sum[2][4][2];
#pragma unroll
    for (int b = 0; b < 2; ++b)
#pragma unroll
        for (int m = 0; m < 4; ++m)
#pragma unroll
            for (int n = 0; n < 2; ++n) { acc[b][m][n] = (f32x4){0.f, 0.f, 0.f, 0.f}; sum[b][m][n] = (f32x4){0.f, 0.f, 0.f, 0.f}; }
    bf16x8 At[4][2], B0[2][2], B1[2][2];
    u32x2 gw[4][2];
#pragma unroll
    for (int m = 0; m < 4; ++m) { gw[m][0] = (u32x2){0u, 0u}; gw[m][1] = (u32x2){0u, 0u}; }
    { const char* b0_ = MG_B(cur, 0); MG_STAGE(MG_SB(0, 0), b0_, voffB); MG_STAGE(MG_SB(0, 1), b0_ + hstepB, voffB); MG_STAGE(MG_SA(0), MG_A(cur, 0), voffA); }
    if (wr == 1) MG_BAR;
    MG_WAIT_V(0); MG_BAR;
    { const char* b1_ = MG_B(cur, 1); MG_STAGE(MG_SB(1, 0), b1_, voffB); MG_STAGE(MG_SA(1), MG_A(cur, 1), voffA); MG_STAGE(MG_SB(1, 1), b1_ + hstepB, voffB); }
    MG_WAIT_V(6); MG_BAR;
    for (;;) {
        bool has_next; { const int idx = vc + G * (ui + 1); has_next = idx < NU; nxt.pm = idx >> 2; nxt.pn = idx & 3; }
#pragma unroll 1
        for (int t = 0; t < nt; t += 2) {
            const bool last = (t == nt - 2);
            const char* a2 = last ? (has_next ? MG_A(nxt, 0) : MG_A(cur, 0)) : MG_A(cur, t + 2);
            const char* b2 = last ? (has_next ? MG_B(nxt, 0) : MG_B(cur, 0)) : MG_B(cur, t + 2);
            const char* a3 = a2 + kstep; const char* b3 = b2 + kstep;
            if ((t & 3) == 0) {
                const int n = t >> 2; int lx = lane; asm volatile("" : "+v"(lx));
                const unsigned char* gp = (const unsigned char*)Pp + gate_off(cur.pm >> 1, 4 * n + cur.pn, wid, cur.pm & 1, lx);
#pragma unroll
                for (int m = 0; m < 4; ++m) { const u32x4 w4 = *(const GAS u32x4*)(gp + m * 16); gw[m][0] = (u32x2){w4.x, w4.y}; gw[m][1] = (u32x2){w4.z, w4.w}; }
            }
            MG_LDB(B0, 0, 0); MG_LDB(B1, 0, 1); MG_SCHED; MG_LDA(At, 0);
            MG_WAIT_L(0); MG_BAR; MG_MMA(0, At, B0); MG_MMA(1, At, B1); MG_BAR; MG_SCHED;
            MG_STAGE(MG_SB(0, 0), b2, voffB); MG_STAGE(MG_SB(0, 1), b2 + hstepB, voffB); MG_STAGE(MG_SA(0), a2, voffA);
            if ((t & 3) == 0) MG_WAIT_V(10); else MG_WAIT_V(6);
            MG_WAIT_L(0); MG_BAR; MG_BAR; MG_SCHED;
            MG_LDB(B0, 1, 0); MG_LDB(B1, 1, 1); MG_SCHED; MG_LDA(At, 1);
            MG_WAIT_L(0); MG_BAR; MG_MMA(0, At, B0); MG_MMA(1, At, B1); MG_BAR; MG_SCHED;
            if ((t & 3) == 2) {
#pragma unroll
                for (int m = 0; m < 4; ++m)
#pragma unroll
                    for (int bj = 0; bj < 2; ++bj) { const unsigned ga = gw[m][bj].x, gb = gw[m][bj].y; constexpr float Kq = 1.0f / 255.0f;
                        const f32x4 g0 = (f32x4){(float)(ga & 0xffu), (float)((ga >> 8) & 0xffu), (float)((ga >> 16) & 0xffu), (float)(ga >> 24)} * Kq;
                        const f32x4 g1 = (f32x4){(float)(gb & 0xffu), (float)((gb >> 8) & 0xffu), (float)((gb >> 16) & 0xffu), (float)(gb >> 24)} * Kq;
                        sum[bj][m][0] += g0 * acc[bj][m][0]; sum[bj][m][1] += g1 * acc[bj][m][1];
                        acc[bj][m][0] = (f32x4){0.f, 0.f, 0.f, 0.f}; acc[bj][m][1] = (f32x4){0.f, 0.f, 0.f, 0.f}; }
                asm volatile("" ::: "memory");
            }
            MG_STAGE(MG_SB(1, 0), b3, voffB); MG_STAGE(MG_SB(1, 1), b3 + hstepB, voffB); MG_STAGE(MG_SA(1), a3, voffA);
            MG_WAIT_V(6); MG_WAIT_L(0); MG_BAR; MG_BAR; MG_SCHED;
        }
        if (wr == 0) MG_BAR;
        { const int row0 = cur.pm * 128 + wr * 64 + fr, col0 = cur.pn * 256 + wc * 32 + 8 * fq;
#pragma unroll
          for (int m = 0; m < 4; ++m)
#pragma unroll
              for (int bj = 0; bj < 2; ++bj) { *(GAS u32x4*)(HBo + (size_t)(row0 + m * 16) * DM + col0 + bj * HALF) = pack8(sum[bj][m][0], sum[bj][m][1]);
                  sum[bj][m][0] = (f32x4){0.f, 0.f, 0.f, 0.f}; sum[bj][m][1] = (f32x4){0.f, 0.f, 0.f, 0.f}; } }
        if (!has_next) break;
        cur = nxt; ++ui;
        if (wr == 1) MG_BAR;
    }
    MG_WAIT_V(0);
    MG_BAR;
#undef MG_SA
#undef MG_SB
#undef MG_STAGE
#undef MG_LDA
#undef MG_LDB
#undef MG_MMA
#undef MG_WAIT_V
#undef MG_WAIT_L
#undef MG_BAR
#undef MG_SCHED
#undef MG_ACOL
#undef MG_A
#undef MG_B
}
}

namespace pg8 {
__device__ __forceinline__ f32x4 gate_q4(unsigned w) {
    f32x4 q = (f32x4){(float)(w & 0xffu), (float)((w >> 8) & 0xffu), (float)((w >> 16) & 0xffu), (float)(w >> 24)};
    return q;
}
__device__ __forceinline__ f32x4 rcp4(f32x4 v) { return (f32x4){__builtin_amdgcn_rcpf(v[0]), __builtin_amdgcn_rcpf(v[1]), __builtin_amdgcn_rcpf(v[2]), __builtin_amdgcn_rcpf(v[3])}; }
__device__ __forceinline__ void merge_phase2(LAS unsigned char* lds, const bf16_t* Pp, const bf16_t* Wbt, bf16_t* HBo, int G, int vc, int tid) {
    asm volatile("" : "+v"(tid));
    const int wid = __builtin_amdgcn_readfirstlane(tid >> 6), lane = tid & 63, wr = wid >> 2, wc = wid & 3, fr = lane & 15, fq = lane >> 4;
    constexpr int nt = 16, NU = (MTOK / 256) * (DM / 256);
    unsigned voffA[2], voffB[2];
#pragma unroll
    for (int i = 0; i < 2; ++i) { int R, C; stage_rc(tid * 16 + i * 8192, R, C); const int Rb = (R & ~31) + perm32(R & 31);
        voffA[i] = (unsigned)(R * LDP + C) * 2u; voffB[i] = (unsigned)(Rb * 256 + C) * 2u; }
    const unsigned ldsw = (unsigned)wid * 1024u;
    const int aoff = lds_byte(wr * 64 + fr, fq * 8), boff = lds_byte(wc * 32 + fr, fq * 8);
#define M2_SA(b, h) (((b) * 2 + (h)) * HTB)
#define M2_SB(b, h) ((4 + (b) * 2 + (h)) * HTB)
#define M2_STAGE(bufoff, gbase, voff) do { _Pragma("unroll") for (int _i = 0; _i < 2; ++_i) \
        __builtin_amdgcn_global_load_lds((const unsigned*)((const char*)(gbase) + (voff)[_i]), (LAS unsigned*)(lds + (bufoff) + ldsw + _i * 8192), 16, 0, 0); } while (0)
#define M2_LDA(dst, b, h) do { _Pragma("unroll") for (int m = 0; m < 4; ++m) _Pragma("unroll") for (int k = 0; k < 2; ++k) dst[m][k] = *(const LAS bf16x8*)(lds + M2_SA(b, h) + aoff + m * 2048 + k * 1024); } while (0)
#define M2_LDB(dst, b, h) do { _Pragma("unroll") for (int n = 0; n < 2; ++n) _Pragma("unroll") for (int k = 0; k < 2; ++k) dst[n][k] = *(const LAS bf16x8*)(lds + M2_SB(b, h) + boff + n * 2048 + k * 1024); } while (0)
#define M2_MMA(ai, bj, At, Bt) do { __builtin_amdgcn_s_setprio(1); _Pragma("unroll") for (int m = 0; m < 4; ++m) _Pragma("unroll") for (int n = 0; n < 2; ++n) _Pragma("unroll") for (int k = 0; k < 2; ++k) \
        acc[ai][bj][m][n] = __builtin_amdgcn_mfma_f32_16x16x32_bf16(Bt[n][k], At[m][k], acc[ai][bj][m][n], 0, 0, 0); __builtin_amdgcn_s_setprio(0); } while (0)
#define M2_WAIT_V(n) asm volatile("s_waitcnt vmcnt(" #n ")" ::: "memory")
#define M2_WAIT_L(n) asm volatile("s_waitcnt lgkmcnt(" #n ")" ::: "memory")
#define M2_BAR __builtin_amdgcn_s_barrier()
#define M2_SCHED __builtin_amdgcn_sched_barrier(0)
    const char* Ab = (const char*)Pp; const char* Bb = (const char*)Wbt; asm volatile("" : "+s"(Ab), "+s"(Bb)); Ab = (const char*)(const GAS char*)Ab; Bb = (const char*)(const GAS char*)Bb;
#define M2_ACOL(n) ((n) == 0 ? PC_NAQ : (n) == 1 ? PC_WQ : (n) == 2 ? PC_YC : PC_AXQ)
#define M2_A(u, kt) (Ab + ((size_t)(u).pm * 256 * LDP + M2_ACOL((kt) >> 2) + ((kt) & 3) * 64) * 2)
#define M2_B(u, kt) (Bb + ((size_t)(((kt) >> 2) * DM + (u).pn * 256) * 256 + ((kt) & 3) * 64) * 2)
    constexpr size_t hstepB = (size_t)HALF * 256 * 2, hstepA = (size_t)HALF * LDP * 2, kstep = 128;
    MUnit cur, nxt; int ui = 0;
    { const int idx = vc; if (idx >= NU) return; cur.pm = idx >> 2; cur.pn = idx & 3; }
    f32x4 acc[2][2][4][2];
#pragma unroll
    for (int a = 0; a < 2; ++a)
#pragma unroll
        for (int b = 0; b < 2; ++b)
#pragma unroll
            for (int m = 0; m < 4; ++m)
#pragma unroll
                for (int n = 0; n < 2; ++n) acc[a][b][m][n] = (f32x4){0.f, 0.f, 0.f, 0.f};
    bf16x8 At[4][2], B0[2][2], B1[2][2];
    u32x2 ga[4][2], gb[4][2];
#pragma unroll
    for (int m = 0; m < 4; ++m) { ga[m][0] = (u32x2){0u, 0u}; ga[m][1] = ga[m][0]; gb[m][0] = ga[m][0]; gb[m][1] = ga[m][0]; }
#define M2_GLOAD(ai, n) do { int lx = lane; asm volatile("" : "+v"(lx)); const unsigned char* gp = (const unsigned char*)Pp + gate_off(cur.pm, 4 * (n) + cur.pn, wid, (ai), lx); \
        _Pragma("unroll") for (int m = 0; m < 4; ++m) { const u32x4 wa = *(const GAS u32x4*)(gp + m * 16), wb_ = *(const GAS u32x4*)(gp + 4 * 65536 + m * 16); \
            ga[m][0] = (u32x2){wa.x, wa.y}; ga[m][1] = (u32x2){wa.z, wa.w}; gb[m][0] = (u32x2){wb_.x, wb_.y}; gb[m][1] = (u32x2){wb_.z, wb_.w}; } } while (0)
#define M2_GSCALE(ai) do { _Pragma("unroll") for (int m = 0; m < 4; ++m) _Pragma("unroll") for (int bj = 0; bj < 2; ++bj) { \
            acc[ai][bj][m][0] = acc[ai][bj][m][0] * (gate_q4(ga[m][bj].x) * rcp4(gate_q4(gb[m][bj].x))); \
            acc[ai][bj][m][1] = acc[ai][bj][m][1] * (gate_q4(ga[m][bj].y) * rcp4(gate_q4(gb[m][bj].y))); } } while (0)
    { const char* cA = M2_A(cur, 0); const char* cB = M2_B(cur, 0);
      M2_STAGE(M2_SB(0, 0), cB, voffB); M2_STAGE(M2_SB(0, 1), cB + hstepB, voffB); M2_STAGE(M2_SA(0, 0), cA, voffA); M2_STAGE(M2_SA(0, 1), cA + hstepA, voffA);
      if (wr == 1) M2_BAR;
      M2_WAIT_V(2); M2_BAR;
      M2_STAGE(M2_SB(1, 0), cB + kstep, voffB); M2_STAGE(M2_SA(1, 0), cA + kstep, voffA); M2_STAGE(M2_SB(1, 1), cB + hstepB + kstep, voffB);
      M2_WAIT_V(6); M2_BAR; }
    for (;;) {
        bool has_next; { const int idx = vc + G * (ui + 1); has_next = idx < NU; nxt.pm = idx >> 2; nxt.pn = idx & 3; }
#pragma unroll 1
        for (int t = 0; t < nt; t += 2) {
            const bool last = (t == nt - 2);
            const bool bnd = ((t & 3) == 2) && !last;
            const bool pend = ((t & 3) == 0) && t != 0;
            const char* a1 = M2_A(cur, t) + kstep;
            const char* a2 = last ? (has_next ? M2_A(nxt, 0) : M2_A(cur, 0)) : M2_A(cur, t + 2);
            const char* b2 = last ? (has_next ? M2_B(nxt, 0) : M2_B(cur, 0)) : M2_B(cur, t + 2);
            const char* a3 = a2 + kstep; const char* b3 = b2 + kstep;
            M2_LDB(B0, 0, 0); M2_LDB(B1, 0, 1); M2_SCHED; M2_LDA(At, 0, 0); M2_STAGE(M2_SA(1, 1), a1 + hstepA, voffA);
            if (pend) M2_WAIT_V(16); else M2_WAIT_V(8);
            M2_WAIT_L(0); M2_BAR; M2_MMA(0, 0, At, B0); M2_MMA(0, 1, At, B1); M2_BAR; M2_SCHED;
            if (pend) { M2_WAIT_V(2); M2_GSCALE(1); M2_SCHED; }
            M2_LDA(At, 0, 1); M2_STAGE(M2_SB(0, 0), b2, voffB); M2_STAGE(M2_SB(0, 1), b2 + hstepB, voffB); M2_STAGE(M2_SA(0, 0), a2, voffA);
            M2_WAIT_V(8); M2_WAIT_L(0); M2_BAR; M2_MMA(1, 0, At, B0); M2_MMA(1, 1, At, B1); M2_BAR; M2_SCHED;
            if (bnd) { M2_GLOAD(0, t >> 2); }
            M2_LDB(B0, 1, 0); M2_LDB(B1, 1, 1); M2_SCHED; M2_LDA(At, 1, 0); M2_STAGE(M2_SA(0, 1), a2 + hstepA, voffA);
            if (bnd) M2_WAIT_V(16); else M2_WAIT_V(8);
            M2_WAIT_L(0); M2_BAR; M2_MMA(0, 0, At, B0); M2_MMA(0, 1, At, B1); M2_BAR; M2_SCHED;
            M2_LDA(At, 1, 1); M2_STAGE(M2_SB(1, 0), b3, voffB); M2_STAGE(M2_SB(1, 1), b3 + hstepB, voffB); M2_STAGE(M2_SA(1, 0), a3, voffA);
            M2_WAIT_V(8); M2_WAIT_L(0); M2_BAR; M2_MMA(1, 0, At, B0); M2_MMA(1, 1, At, B1); if (bnd) { M2_SCHED; M2_GSCALE(0); } M2_BAR;
            if (bnd) { M2_GLOAD(1, t >> 2); }
            M2_SCHED;
        }
        if (wr == 0) M2_BAR;
        { int frx = fr; asm volatile("" : "+v"(frx)); const int row0 = cur.pm * 256 + wr * 64 + frx, col0 = cur.pn * 256 + wc * 32 + 8 * fq;
#pragma unroll
          for (int ai = 0; ai < 2; ++ai) {
              u32x2 g3[4][2];
              { const unsigned char* gp = (const unsigned char*)Pp + gate_off(cur.pm, 12 + cur.pn, wid, ai, frx + 16 * fq);
#pragma unroll
                for (int m = 0; m < 4; ++m) { const u32x4 w4 = *(const GAS u32x4*)(gp + m * 16); g3[m][0] = (u32x2){w4.x, w4.y}; g3[m][1] = (u32x2){w4.z, w4.w}; } }
#pragma unroll
              for (int m = 0; m < 4; ++m)
#pragma unroll
                  for (int bj = 0; bj < 2; ++bj) { constexpr float Kq = 1.0f / 255.0f;
                      *(GAS u32x4*)(HBo + (size_t)(row0 + ai * HALF + m * 16) * DM + col0 + bj * HALF) = pack8(acc[ai][bj][m][0] * (gate_q4(g3[m][bj].x) * Kq), acc[ai][bj][m][1] * (gate_q4(g3[m][bj].y) * Kq));
                      acc[ai][bj][m][0] = (f32x4){0.f, 0.f, 0.f, 0.f}; acc[ai][bj][m][1] = (f32x4){0.f, 0.f, 0.f, 0.f}; }
              asm volatile("" ::: "memory"); } }
        if (!has_next) break;
        cur = nxt; ++ui;
        if (wr == 1) M2_BAR;
    }
    M2_WAIT_V(0);
    M2_BAR;
#undef M2_SA
#undef M2_SB
#undef M2_STAGE
#undef M2_LDA
#undef M2_LDB
#undef M2_MMA
#undef M2_WAIT_V
#undef M2_WAIT_L
#undef M2_BAR
#undef M2_SCHED
#undef M2_GLOAD
#undef M2_GSCALE
#undef M2_ACOL
#undef M2_A
#undef M2_B
}
__device__ __forceinline__ void merge_phase3(LAS unsigned char* lds, const bf16_t* Pp, const unsigned char* Y8, const unsigned char* Wb8, bf16_t* HBo, int G, int vc, int tid) {
    asm volatile("" : "+v"(tid));
    const int wid = __builtin_amdgcn_readfirstlane(tid >> 6), lane = tid & 63, wr = wid >> 2, wc = wid & 3, fr = lane & 15, fq = lane >> 4;
    constexpr int nt = 8, NU = (MTOK / 256) * (DM / 256);
    unsigned voffA[2], voffB[2];
#pragma unroll
    for (int i = 0; i < 2; ++i) { int R, C; stage_rc(tid * 16 + i * 8192, R, C); const int Rb = (R & ~31) + perm32(R & 31);
        voffA[i] = (unsigned)(R * 1024 + C * 2); voffB[i] = (unsigned)(Rb * 256 + C * 2); }
    const unsigned ldsw = (unsigned)wid * 1024u;
    const int aoff = lds_byte(wr * 64 + fr, fq * 8), boff = lds_byte(wc * 32 + fr, fq * 8);
#define M2_SA(b, h) (((b) * 2 + (h)) * HTB)
#define M2_SB(b, h) ((4 + (b) * 2 + (h)) * HTB)
#define M2_STAGE(bufoff, gbase, voff) do { _Pragma("unroll") for (int _i = 0; _i < 2; ++_i) \
        __builtin_amdgcn_global_load_lds((const unsigned*)((const char*)(gbase) + (voff)[_i]), (LAS unsigned*)(lds + (bufoff) + ldsw + _i * 8192), 16, 0, 0); } while (0)
#define M2_LDA(dst, b, h) do { _Pragma("unroll") for (int m = 0; m < 4; ++m) { dst[m].lo = *(const LAS i32x4*)(lds + M2_SA(b, h) + aoff + m * 2048); dst[m].hi = *(const LAS i32x4*)(lds + M2_SA(b, h) + aoff + m * 2048 + 1024); } } while (0)
#define M2_LDB(dst, b, h) do { _Pragma("unroll") for (int n = 0; n < 2; ++n) { dst[n].lo = *(const LAS i32x4*)(lds + M2_SB(b, h) + boff + n * 2048); dst[n].hi = *(const LAS i32x4*)(lds + M2_SB(b, h) + boff + n * 2048 + 1024); } } while (0)
#define M2_MMA(ai, bj, At, Bt) do { __builtin_amdgcn_s_setprio(1); _Pragma("unroll") for (int m = 0; m < 4; ++m) _Pragma("unroll") for (int n = 0; n < 2; ++n) \
        asm volatile("v_mfma_scale_f32_16x16x128_f8f6f4 %0, %1, %2, %0, %3, %3 op_sel_hi:[0,0,0]" : "+v"(acc[ai][bj][m][n]) : "v"(Bt[n]), "v"(At[m]), "v"(sc127)); __builtin_amdgcn_s_setprio(0); } while (0)
#define M2_WAIT_V(n) asm volatile("s_waitcnt vmcnt(" #n ")" ::: "memory")
#define M2_WAIT_L(n) asm volatile("s_waitcnt lgkmcnt(" #n ")" ::: "memory")
#define M2_BAR __builtin_amdgcn_s_barrier()
#define M2_SCHED __builtin_amdgcn_sched_barrier(0)
    const char* Ab = (const char*)Y8; const char* Bb = (const char*)Wb8; asm volatile("" : "+s"(Ab), "+s"(Bb)); Ab = (const char*)(const GAS char*)Ab; Bb = (const char*)(const GAS char*)Bb;
#define M2_A(u, kt) (Ab + ((size_t)(u).pm * 256 * 1024 + ((kt) >> 1) * 256 + ((kt) & 1) * 128))
#define M2_B(u, kt) (Bb + ((size_t)(((kt) >> 1) * DM + (u).pn * 256) * 256 + ((kt) & 1) * 128))
    constexpr size_t hstepB = (size_t)HALF * 256, hstepA = (size_t)HALF * 1024, kstep = 128;
    MUnit cur, nxt; int ui = 0;
    { const int idx = vc; if (idx >= NU) return; cur.pm = idx >> 2; cur.pn = idx & 3; }
    f32x4 acc[2][2][4][2];
    i32x8 At[4], B0[2], B1[2];
    int sc127 = 127; asm volatile("" : "+v"(sc127));
    u32x4 ga4[4], gb4[4];
#define M2_GLOAD(ai, n) do { const int lx = lane_now(); const unsigned char* gp = (const unsigned char*)Pp + gate_off(cur.pm, 4 * (n) + cur.pn, wid, (ai), lx); \
        _Pragma("unroll") for (int m = 0; m < 4; ++m) { ga4[m] = *(const GAS u32x4*)(gp + m * 16); gb4[m] = *(const GAS u32x4*)(gp + 4 * 65536 + m * 16); } } while (0)
#define M2_GSCALE(ai) do { _Pragma("unroll") for (int m = 0; m < 4; ++m) { \
            acc[ai][0][m][0] = acc[ai][0][m][0] * (gate_q4(ga4[m].x) * rcp4(gate_q4(gb4[m].x))); acc[ai][0][m][1] = acc[ai][0][m][1] * (gate_q4(ga4[m].y) * rcp4(gate_q4(gb4[m].y))); \
            acc[ai][1][m][0] = acc[ai][1][m][0] * (gate_q4(ga4[m].z) * rcp4(gate_q4(gb4[m].z))); acc[ai][1][m][1] = acc[ai][1][m][1] * (gate_q4(ga4[m].w) * rcp4(gate_q4(gb4[m].w))); } } while (0)
    { const char* cA = M2_A(cur, 0); const char* cB = M2_B(cur, 0);
      M2_STAGE(M2_SB(0, 0), cB, voffB); M2_SCHED; M2_STAGE(M2_SB(0, 1), cB + hstepB, voffB); M2_SCHED; M2_STAGE(M2_SA(0, 0), cA, voffA); M2_SCHED; M2_STAGE(M2_SA(0, 1), cA + hstepA, voffA); M2_SCHED;
      if (wr == 1) M2_BAR;
      M2_WAIT_V(2); M2_BAR;
      M2_STAGE(M2_SB(1, 0), cB + kstep, voffB); M2_SCHED; M2_STAGE(M2_SA(1, 0), cA + kstep, voffA); M2_SCHED; M2_STAGE(M2_SB(1, 1), cB + hstepB + kstep, voffB); M2_SCHED;
      M2_WAIT_V(6); M2_BAR; }
    M2_SCHED;
#pragma unroll
    for (int a = 0; a < 2; ++a)
#pragma unroll
        for (int b = 0; b < 2; ++b)
#pragma unroll
            for (int m = 0; m < 4; ++m)
#pragma unroll
                for (int n = 0; n < 2; ++n) acc[a][b][m][n] = (f32x4){0.f, 0.f, 0.f, 0.f};
    for (;;) {
        asm volatile("" : "+s"(Ab), "+s"(Bb));
        bool has_next; { const int idx = vc + G * (ui + 1); has_next = idx < NU; nxt.pm = idx >> 2; nxt.pn = idx & 3; }
#pragma unroll 1
        for (int t = 0; t < nt; t += 2) {
            const bool last = (t == nt - 2);
            asm volatile("" : "+v"(voffA[0]), "+v"(voffA[1]), "+v"(voffB[0]), "+v"(voffB[1]));
            const bool bnd = !last;
            const bool pend = t != 0;
            const char* a1 = M2_A(cur, t) + kstep;
            const char* a2 = last ? (has_next ? M2_A(nxt, 0) : M2_A(cur, 0)) : M2_A(cur, t + 2);
            const char* b2 = last ? (has_next ? M2_B(nxt, 0) : M2_B(cur, 0)) : M2_B(cur, t + 2);
            const char* a3 = a2 + kstep; const char* b3 = b2 + kstep;
            M2_LDB(B0, 0, 0); M2_LDB(B1, 0, 1); M2_SCHED; M2_LDA(At, 0, 0); M2_STAGE(M2_SA(1, 1), a1 + hstepA, voffA);
            if (pend) M2_WAIT_V(16); else M2_WAIT_V(8);
            M2_WAIT_L(0); M2_BAR; M2_MMA(0, 0, At, B0); M2_MMA(0, 1, At, B1); M2_BAR; M2_SCHED;
            if (pend) { M2_WAIT_V(2); M2_GSCALE(1); M2_SCHED; }
            M2_LDA(At, 0, 1); M2_STAGE(M2_SB(0, 0), b2, voffB); M2_STAGE(M2_SB(0, 1), b2 + hstepB, voffB); M2_STAGE(M2_SA(0, 0), a2, voffA);
            M2_WAIT_V(8); M2_WAIT_L(0); M2_BAR; M2_MMA(1, 0, At, B0); M2_MMA(1, 1, At, B1); M2_BAR; M2_SCHED;
            if (bnd) { M2_GLOAD(0, t >> 1); }
            M2_LDB(B0, 1, 0); M2_LDB(B1, 1, 1); M2_SCHED; M2_LDA(At, 1, 0); M2_STAGE(M2_SA(0, 1), a2 + hstepA, voffA);
            if (bnd) M2_WAIT_V(16); else M2_WAIT_V(8);
            M2_WAIT_L(0); M2_BAR; M2_MMA(0, 0, At, B0); M2_MMA(0, 1, At, B1); M2_BAR; M2_SCHED;
            M2_LDA(At, 1, 1); M2_STAGE(M2_SB(1, 0), b3, voffB); M2_STAGE(M2_SB(1, 1), b3 + hstepB, voffB); M2_STAGE(M2_SA(1, 0), a3, voffA);
            M2_WAIT_V(8); M2_WAIT_L(0); M2_BAR; M2_MMA(1, 0, At, B0); M2_MMA(1, 1, At, B1); if (bnd) { M2_SCHED; M2_GSCALE(0); } M2_BAR;
            if (bnd) { M2_GLOAD(1, t >> 1); }
            M2_SCHED;
        }
        asm volatile("s_nop 15\n\ts_nop 15\n\ts_nop 15" ::: "memory");
        if (wr == 0) M2_BAR;
        { const int lnx = lane_now(), frx = lnx & 15, fqx = lnx >> 4; const int row0 = cur.pm * 256 + wr * 64 + frx, col0 = cur.pn * 256 + wc * 32 + 8 * fqx;
#pragma unroll
          for (int ai = 0; ai < 2; ++ai) {
              u32x2 g3[4][2];
              { const unsigned char* gp = (const unsigned char*)Pp + gate_off(cur.pm, 12 + cur.pn, wid, ai, lnx);
#pragma unroll
                for (int m = 0; m < 4; ++m) { const u32x4 w4 = *(const GAS u32x4*)(gp + m * 16); g3[m][0] = (u32x2){w4.x, w4.y}; g3[m][1] = (u32x2){w4.z, w4.w}; } }
#pragma unroll
              for (int m = 0; m < 4; ++m)
#pragma unroll
                  for (int bj = 0; bj < 2; ++bj) { constexpr float Kq = 1.0f / (255.0f * 256.0f);
                      *(GAS u32x4*)(HBo + (size_t)(row0 + ai * HALF + m * 16) * DM + col0 + bj * HALF) = pack8(acc[ai][bj][m][0] * (gate_q4(g3[m][bj].x) * Kq), acc[ai][bj][m][1] * (gate_q4(g3[m][bj].y) * Kq));
                      acc[ai][bj][m][0] = (f32x4){0.f, 0.f, 0.f, 0.f}; acc[ai][bj][m][1] = (f32x4){0.f, 0.f, 0.f, 0.f}; }
              asm volatile("" ::: "memory"); } }
        if (!has_next) break;
        cur = nxt; ++ui;
        if (wr == 1) M2_BAR;
    }
    M2_WAIT_V(0);
    M2_BAR;
#undef M2_SA
#undef M2_SB
#undef M2_STAGE
#undef M2_LDA
#undef M2_LDB
#undef M2_MMA
#undef M2_WAIT_V
#undef M2_WAIT_L
#undef M2_BAR
#undef M2_SCHED
#undef M2_GLOAD
#undef M2_GSCALE
#undef M2_A
#undef M2_B
}
}
namespace att {
constexpr int STG = 20480, VOFF = 12288;
constexpr int LDS_WSF = 3 * STG;
constexpr int LDS_OST = LDS_WSF + 8 * 512;
constexpr int LDS_BIAS = LDS_OST + 8 * 4096;
constexpr int LDS_BYTES = LDS_BIAS + 2048;
typedef short v4i16_t __attribute__((ext_vector_type(4)));

__device__ __forceinline__ int crow(int r, int hi) { return (r & 3) + 8 * (r >> 2) + 4 * hi; }
__device__ __forceinline__ s16x4 vtr(const LAS unsigned char* p) { return __builtin_bit_cast(s16x4, __builtin_amdgcn_ds_read_tr16_b64_v4i16((LAS v4i16_t*)p)); }
__device__ __forceinline__ void glds16(const void* gsrc, unsigned lds_dst) { unsigned keep;
    asm volatile("s_mov_b32 %0, m0\n\ts_mov_b32 m0, %2\n\ts_nop 0\n\tglobal_load_lds_dwordx4 %1, off\n\ts_mov_b32 m0, %0" : "=&s"(keep) : "v"(gsrc), "s"(lds_dst) : "memory"); }
__device__ __forceinline__ int clampi(int v, int lo, int hi) { return v < lo ? lo : (v > hi ? hi : v); }

__device__ __forceinline__ u32x2 bf8_to_fp8x8(const u32x4 v) { u32x2 w;
    w.x = pk_fp8x4(bflo(v.x) * 16.0f, bfhi(v.x) * 16.0f, bflo(v.y) * 16.0f, bfhi(v.y) * 16.0f); w.y = pk_fp8x4(bflo(v.z) * 16.0f, bfhi(v.z) * 16.0f, bflo(v.w) * 16.0f, bfhi(v.w) * 16.0f); return w; }
template <int DQ, int MODE, int VAR = 0, bool O8 = false>
__device__ __forceinline__ void attn_unit(const bf16_t* Qp, const bf16_t* Kp, const bf16_t* Vp, bf16_t* Op, int ldq, int ldk, int ldv, int ldo,
                                          int q0, float sc2, float par0, float par1, const float* biasp, LAS unsigned char* lds, int tid) {
    asm volatile("" : "+v"(tid));
    const int lane = tid & 63, r32 = lane & 31, hi = lane >> 5; const int wid = __builtin_amdgcn_readfirstlane(tid >> 6);
    constexpr int ND = DQ / 16;
    int t0 = 0, t1 = SEQ / 64 - 1;
    const int wq0 = q0 + wid * 32;
    int wt0 = 0, wt1 = SEQ / 64 - 1;
    if (MODE == 1) { t0 = (q0 >> 6) - 2; t0 = t0 < 0 ? 0 : t0; t1 = (q0 >> 6) + 5; t1 = t1 > 63 ? 63 : t1;
        int klo = wq0 - 128; klo = klo < 0 ? 0 : klo; int khi = wq0 + 31 + 128; khi = khi > SEQ - 1 ? SEQ - 1 : khi; wt0 = klo >> 6; wt1 = khi >> 6; }
    if (MODE == 2) { const int R0 = q0 >> 6; t0 = clampi(R0 - 4, 0, 56); t1 = clampi(R0 + 3 - 4, 0, 56) + 7; const int R = wq0 >> 6; wt0 = clampi(R - 4, 0, 56); wt1 = wt0 + 7; }
    LAS float* wsf = (LAS float*)(lds + LDS_WSF) + wid * 128;
    LAS float* bt = (LAS float*)(lds + LDS_BIAS);
    bf16x8 qr[ND];
    { const bf16_t* Qw = Qp + (size_t)(wq0 + r32) * ldq + hi * 8;
#pragma unroll
      for (int d0 = 0; d0 < ND; ++d0) qr[d0] = *(const GAS bf16x8*)(Qw + d0 * 16); }
    const bf16_t* ksrc = Kp + (size_t)lane * ldk + wid * 8;
    const bf16_t* ksrc2 = Kp + (size_t)lane * ldk + (8 + (wid & 3)) * 8;
    const bf16_t* vsrc = Vp + (size_t)(16 * (wid & 3) + (lane >> 2)) * ldv + (wid >> 2) * 32 + (lane & 3) * 8;
    const int kdst = wid * 1024 + lane * 16, kdst2 = (8 + (wid & 3)) * 1024 + lane * 16, vdst = VOFF + wid * 1024 + lane * 16;
    u32x4 kreg, kreg2, vreg; kreg2 = (u32x4){0u, 0u, 0u, 0u};
    u32x4 kregB, kreg2B, vregB; kreg2B = (u32x4){0u, 0u, 0u, 0u};
#define ATT_LOAD(t) do { if (VAR == 5) break; const size_t ro_ = (size_t)(t) * 64; kreg = *(const GAS u32x4*)(ksrc + ro_ * ldk); if (DQ == 96) kreg2 = *(const GAS u32x4*)(ksrc2 + ro_ * ldk); vreg = *(const GAS u32x4*)(vsrc + ro_ * ldv); } while (0)
#define ATT_STORE(s) do { if (VAR == 5) break; LAS unsigned char* sb_ = lds + (s) * STG; *(LAS u32x4*)(sb_ + kdst) = kreg; if (DQ == 96) *(LAS u32x4*)(sb_ + kdst2) = kreg2; *(LAS u32x4*)(sb_ + vdst) = vreg; } while (0)
#define ATT_LOADB(t) do { if (VAR == 5) break; const size_t ro_ = (size_t)(t) * 64; kregB = *(const GAS u32x4*)(ksrc + ro_ * ldk); if (DQ == 96) kreg2B = *(const GAS u32x4*)(ksrc2 + ro_ * ldk); vregB = *(const GAS u32x4*)(vsrc + ro_ * ldv); } while (0)
#define ATT_STOREB(s) do { if (VAR == 5) break; LAS unsigned char* sb_ = lds + (s) * STG; *(LAS u32x4*)(sb_ + kdst) = kregB; if (DQ == 96) *(LAS u32x4*)(sb_ + kdst2) = kreg2B; *(LAS u32x4*)(sb_ + vdst) = vregB; } while (0)
    ATT_LOAD(t0);
    if (MODE == 2) { for (int i = tid; i < 15 * 31; i += 512) bt[i] = biasp[i] * LOG2E; }
    ATT_STORE(0);
    if (t0 + 1 <= t1) { ATT_LOAD(t0 + 1); ATT_STORE(1); }
    constexpr float THR = 8.0f;
    float m2 = (MODE == 1) ? par1 : 0.0f;
    bool first = (MODE != 1);
    float lsum = (MODE == 1 && hi == 0) ? 1.0f : 0.0f;
    f32x16 o[2];
#pragma unroll
    for (int r = 0; r < 16; ++r) { o[0][r] = 0.f; o[1][r] = 0.f; }
    const int tq = wq0 + r32;
    const int na_ncs = 4 * hi - clampi((tq & 63) - 8, 0, 48), na_l = 4 * hi - (tq & 63) + 15; (void)na_ncs; (void)na_l;
    f32x16 p0, p1, n0, n1;
#pragma unroll
    for (int r = 0; r < 16; ++r) { p0[r] = 0.f; p1[r] = 0.f; n0[r] = 0.f; n1[r] = 0.f; }
#define ATT_QK(D0, D1, stg_) do { const LAS unsigned char* kb_ = lds + (stg_) * STG + hi * 1024 + r32 * 16; const float ni_ = -m2; \
        _Pragma("unroll") for (int r = 0; r < 16; ++r) { D0[r] = ni_; D1[r] = ni_; } \
        _Pragma("unroll") for (int d0 = 0; d0 < ND; ++d0) { \
            const bf16x8 b0_ = *(const LAS bf16x8*)(kb_ + d0 * 2048), b1_ = *(const LAS bf16x8*)(kb_ + d0 * 2048 + 512); \
            D0 = __builtin_amdgcn_mfma_f32_32x32x16_bf16(b0_, qr[d0], D0, 0, 0, 0); \
            D1 = __builtin_amdgcn_mfma_f32_32x32x16_bf16(b1_, qr[d0], D1, 0, 0, 0); } } while (0)
#define ATT_KPRE(stg_) do { if (VAR == 3 || (VAR == 6 && kfinit)) break; kfinit = true; const LAS unsigned char* kb_ = lds + (stg_) * STG + hi * 1024 + r32 * 16; \
        _Pragma("unroll") for (int d0 = 0; d0 < ND; ++d0) { kf[2 * d0] = *(const LAS bf16x8*)(kb_ + d0 * 2048); kf[2 * d0 + 1] = *(const LAS bf16x8*)(kb_ + d0 * 2048 + 512); } } while (0)
#define ATT_QKF(D0, D1) do { const float ni_ = -m2; \
        _Pragma("unroll") for (int r = 0; r < 16; ++r) { D0[r] = ni_; D1[r] = ni_; } \
        if (VAR == 3) break; \
        _Pragma("unroll") for (int d0 = 0; d0 < ND; ++d0) { \
            D0 = __builtin_amdgcn_mfma_f32_32x32x16_bf16(kf[2 * d0], qr[d0], D0, 0, 0, 0); \
            D1 = __builtin_amdgcn_mfma_f32_32x32x16_bf16(kf[2 * d0 + 1], qr[d0], D1, 0, 0, 0); } } while (0)
    __syncthreads();
    constexpr bool PIPE = true;
    int sc_ = 0, sn_ = 1, sw_ = 2;
#define ATT_HEAD(t, p0, p1, n0, n1) do { \
            float rm = -INFINITY; \
            int ncs_ = na_ncs, nbb_ = 0; if (MODE == 2) { asm volatile("" : "+v"(ncs_)); nbb_ = ((t) - (tq >> 6) + 7) * 31 + na_l; }        \
            const LAS float* bp_ = bt + nbb_; \
            float relb_ = 0.f; if (MODE == 1) { relb_ = (float)((t) * 64 + 4 * hi - tq); asm volatile("" : "+v"(relb_)); } \
            _Pragma("unroll") for (int r = 0; r < 16; ++r) { \
                const int kk = crow(r, hi); \
                float v0 = p0[r], v1 = p1[r]; \
                if (MODE == 1) {        \
                    const float rf0 = relb_ + (float)((r & 3) + 8 * (r >> 2)), rf1 = rf0 + 32.0f; \
                    v0 = (__builtin_fabsf(rf0) <= 128.0f) ? __builtin_fmaf(-par0, __builtin_fabsf(rf0), v0) : -INFINITY; \
                    v1 = (__builtin_fabsf(rf1) <= 128.0f) ? __builtin_fmaf(-par0, __builtin_fabsf(rf1), v1) : -INFINITY; \
                } \
                if (MODE == 2) {        \
                    const int cr = (r & 3) + 8 * (r >> 2); \
                    const unsigned d0c = (unsigned)(cr + ncs_), d1c = (unsigned)(cr + 32 + ncs_); \
                    v0 = (d0c < 16u) ? v0 + bp_[cr] : -INFINITY; \
                    v1 = (d1c < 16u) ? v1 + bp_[cr + 32] : -INFINITY; \
                } \
                if (MODE != 0) { p0[r] = v0; p1[r] = v1; } \
                rm = fmaxf(fmaxf(rm, v0), v1); \
            } \
            { auto rr = __builtin_amdgcn_permlane32_swap(__float_as_uint(rm), __float_as_uint(rm), false, false); rm = fmaxf(__uint_as_float(rr[0]), __uint_as_float(rr[1])); } \
            if (first) { \
                first = false; m2 = rm; \
                _Pragma("unroll") for (int r = 0; r < 16; ++r) { p0[r] -= rm; p1[r] -= rm; if (PIPE && MODE != 0) { n0[r] -= rm; n1[r] -= rm; } } \
            } else if (__any(rm > THR)) { \
                const float dl = fmaxf(rm, 0.f); m2 += dl; \
                _Pragma("unroll") for (int r = 0; r < 16; ++r) { p0[r] -= dl; p1[r] -= dl; if (PIPE && MODE != 0) { n0[r] -= dl; n1[r] -= dl; } } \
                const float f = __builtin_amdgcn_exp2f(-dl); \
                lsum *= f; \
                if (hi == 0) wsf[r32] = f; \
                asm volatile("s_waitcnt lgkmcnt(0)" ::: "memory"); \
                _Pragma("unroll") for (int g4 = 0; g4 < 4; ++g4) { const f32x4 f4 = *(const LAS f32x4*)(wsf + 8 * g4 + 4 * hi); \
                    _Pragma("unroll") for (int j = 0; j < 4; ++j) { o[0][4 * g4 + j] *= f4[j]; o[1][4 * g4 + j] *= f4[j]; } } \
                asm volatile("s_waitcnt lgkmcnt(0)" ::: "memory"); \
            } } while (0)
#define ATT_EXP_PV(stg_, p0, p1) do { \
            float sumA = 0.f, sumB = 0.f; \
            _Pragma("unroll") for (int r = 0; r < 16; ++r) { if (VAR != 1) { p0[r] = __builtin_amdgcn_exp2f(p0[r]); p1[r] = __builtin_amdgcn_exp2f(p1[r]); } sumA += p0[r]; sumB += p1[r]; } \
            lsum += sumA + sumB; \
            u32x4 pw[4]; \
            _Pragma("unroll") for (int j = 0; j < 4; ++j) { pw[0][j] = cvt_pk_bf16(p0[2 * j], p0[2 * j + 1]); pw[1][j] = cvt_pk_bf16(p0[8 + 2 * j], p0[8 + 2 * j + 1]); \
                                          pw[2][j] = cvt_pk_bf16(p1[2 * j], p1[2 * j + 1]); pw[3][j] = cvt_pk_bf16(p1[8 + 2 * j], p1[8 + 2 * j + 1]); } \
            const LAS unsigned char* vp = lds + (stg_) * STG + VOFF + ((lane >> 4) & 1) * 32 + (lane & 3) * 8 + (4 * hi + ((lane & 15) >> 2)) * 64; \
            if (VAR != 2) _Pragma("unroll") for (int i = 0; i < 8; ++i) { \
                const int iv_ = (VAR == 7) ? 0 : i; \
                const s16x4 lo = vtr(vp + (iv_ >> 2) * 4096 + (iv_ & 3) * 1024), hh = vtr(vp + (iv_ >> 2) * 4096 + (iv_ & 3) * 1024 + 512); \
                const bf16x8 vf = (bf16x8){lo[0], lo[1], lo[2], lo[3], hh[0], hh[1], hh[2], hh[3]}; \
                o[i >> 2] = __builtin_amdgcn_mfma_f32_32x32x16_bf16(__builtin_bit_cast(bf16x8, pw[i & 3]), vf, o[i >> 2], 0, 0, 0); \
            } } while (0)
#define ATT_ROT() do { const int tmp_ = sc_; sc_ = sn_; sn_ = sw_; sw_ = tmp_; } while (0)
    if constexpr (MODE == 0) {
        bf16x8 kf[2 * ND]; bool kfinit = false;
        ATT_KPRE(0); ATT_QKF(p0, p1);
        if (t0 + 2 <= t1) ATT_LOAD(t0 + 2);
        for (int t = t0; t + 1 < t1; t += 2) {
            if (t + 3 <= t1) ATT_LOADB(t + 3);
            ATT_KPRE(sn_);
            __builtin_amdgcn_sched_barrier(0);
            ATT_HEAD(t, p0, p1, n0, n1);
            ATT_QKF(n0, n1);
            ATT_EXP_PV(sc_, p0, p1);
            if (t + 2 <= t1) ATT_STORE(sw_);
            if (VAR != 4) __syncthreads();
            ATT_ROT();
            if (t + 4 <= t1) ATT_LOAD(t + 4);
            ATT_KPRE(sn_);
            __builtin_amdgcn_sched_barrier(0);
            ATT_HEAD(t + 1, n0, n1, p0, p1);
            ATT_QKF(p0, p1);
            ATT_EXP_PV(sc_, n0, n1);
            if (t + 3 <= t1) ATT_STOREB(sw_);
            if (VAR != 4) __syncthreads();
            ATT_ROT();
        }
        {
            ATT_KPRE(sn_);
            __builtin_amdgcn_sched_barrier(0);
            ATT_HEAD(t1 - 1, p0, p1, n0, n1);
            ATT_QKF(n0, n1);
            ATT_EXP_PV(sc_, p0, p1);
            __syncthreads();
            ATT_ROT();
        }
        ATT_HEAD(t1, n0, n1, p0, p1);
        ATT_EXP_PV(sc_, n0, n1);
        __syncthreads();
    } else {
        if (PIPE && t0 >= wt0 && t0 <= wt1) ATT_QK(p0, p1, 0);
        for (int t = t0; t <= t1; ++t) {
            if (t + 2 <= t1) ATT_LOAD(t + 2);
            if (PIPE) { const bool nin = (t + 1 <= t1) && (t + 1 >= wt0) && (t + 1 <= wt1); if (nin) ATT_QK(n0, n1, sn_); }
            else { if (t >= wt0 && t <= wt1) ATT_QK(p0, p1, sc_); }
            if (t >= wt0 && t <= wt1) { ATT_HEAD(t, p0, p1, n0, n1); ATT_EXP_PV(sc_, p0, p1); }
            if (t + 2 <= t1) ATT_STORE(sw_);
            __syncthreads();
            if (PIPE) { p0 = n0; p1 = n1; }
            ATT_ROT();
        }
    }
#undef ATT_HEAD
#undef ATT_EXP_PV
#undef ATT_ROT
#undef ATT_QK
#undef ATT_KPRE
#undef ATT_QKF
#undef ATT_LOAD
#undef ATT_LOADB
#undef ATT_STOREB
#undef ATT_STORE
    { auto rr = __builtin_amdgcn_permlane32_swap(__float_as_uint(lsum), __float_as_uint(lsum), false, false); lsum = __uint_as_float(rr[0]) + __uint_as_float(rr[1]); }
    if (hi == 0) wsf[32 + r32] = lsum;
    asm volatile("s_waitcnt lgkmcnt(0)" ::: "memory");
    float rli[16];
#pragma unroll
    for (int g4 = 0; g4 < 4; ++g4) { const f32x4 l4 = *(const LAS f32x4*)(wsf + 32 + 8 * g4 + 4 * hi);
#pragma unroll
        for (int j = 0; j < 4; ++j) rli[4 * g4 + j] = __builtin_amdgcn_rcpf(l4[j]); }
    LAS bf16_t* stg = (LAS bf16_t*)(lds + LDS_OST) + wid * 2048;
#pragma unroll
    for (int r = 0; r < 16; ++r) { const int orow = crow(r, hi);
#pragma unroll
        for (int d0 = 0; d0 < 2; ++d0) stg[orow * 64 + d0 * 32 + r32] = f2bf(o[d0][r] * rli[r]); }
    asm volatile("s_waitcnt lgkmcnt(0)" ::: "memory");
    bf16_t* Ow = Op + (size_t)wq0 * ldo;
#pragma unroll
    for (int i = 0; i < 4; ++i) { const int row = i * 8 + (lane >> 3), ch = lane & 7; const u32x4 v = *(const LAS u32x4*)(stg + row * 64 + ch * 8);
        if constexpr (O8) { *(GAS u32x2*)((unsigned char*)Op + (size_t)(wq0 + row) * ldo + ch * 8) = bf8_to_fp8x8(v); } else { *(GAS u32x4*)(Ow + (size_t)row * ldo + ch * 8) = v; } }
    asm volatile("s_waitcnt lgkmcnt(0)" ::: "memory");
}

template <int DQ, bool O8 = false>
__device__ __forceinline__ void attn_unit2(const bf16_t* QpA, const bf16_t* QpB, const bf16_t* Kp, const bf16_t* Vp, bf16_t* OpA, bf16_t* OpB, int ldq, int ldk, int ldv, int ldo,
                                           int q0, LAS unsigned char* lds, int tid) {
    asm volatile("" : "+v"(tid));
    const int lane = tid & 63, r32 = lane & 31, hi = lane >> 5; const int wid = __builtin_amdgcn_readfirstlane(tid >> 6);
    constexpr int ND = DQ / 16;
    constexpr int t0 = 0, t1 = SEQ / 64 - 1;
    const int wq0 = q0 + wid * 32;
    LAS float* wsf = (LAS float*)(lds + LDS_WSF) + wid * 128;
    bf16x8 qa[ND], qb[ND];
    { const bf16_t* Qw = QpA + (size_t)(wq0 + r32) * ldq + hi * 8; const bf16_t* Qv = QpB + (size_t)(wq0 + r32) * ldq + hi * 8;
#pragma unroll
      for (int d0 = 0; d0 < ND; ++d0) { qa[d0] = *(const GAS bf16x8*)(Qw + d0 * 16); qb[d0] = *(const GAS bf16x8*)(Qv + d0 * 16); } }
    const bf16_t* ksrc = Kp + (size_t)lane * ldk + wid * 8;
    const int k2off = __builtin_amdgcn_readfirstlane((8 + (wid & 3) - wid) * 8);
    const bf16_t* vsrc = Vp + (size_t)(16 * (wid & 3) + (lane >> 2)) * ldv + (wid >> 2) * 32 + (lane & 3) * 8;
    const int k2d = __builtin_amdgcn_readfirstlane((8 + (wid & 3) - wid) * 1024);
    const unsigned lds0 = (unsigned)(uintptr_t)lds;
#define A2_DMA(t, s) do { const size_t ro_ = (size_t)(t) * 64; const unsigned sb_ = (unsigned)__builtin_amdgcn_readfirstlane((int)(lds0 + (unsigned)((s) * STG + wid * 1024))); \
        glds16(ksrc + ro_ * ldk, sb_); \
        if (DQ == 96) glds16(ksrc + ro_ * ldk + k2off, sb_ + (unsigned)k2d); \
        glds16(vsrc + ro_ * ldv, sb_ + (unsigned)VOFF); } while (0)
    A2_DMA(t0, 0);
    asm volatile("s_waitcnt vmcnt(0)" ::: "memory");
    constexpr float THR = 8.0f;
    float mA = 0.f, mB = 0.f, lA = 0.f, lB = 0.f;
    f32x16 oa[2], ob[2];
#pragma unroll
    for (int r = 0; r < 16; ++r) { oa[0][r] = 0.f; oa[1][r] = 0.f; ob[0][r] = 0.f; ob[1][r] = 0.f; }
    __syncthreads();
#define A2_TILE(t, FIRST) do { \
        const int cur = ((t) - t0) & 1; \
        if ((t) < t1) A2_DMA((t) + 1, cur ^ 1); \
        const LAS unsigned char* Ks = lds + cur * STG; \
        const LAS unsigned char* kb = Ks + hi * 1024 + r32 * 16; \
        f32x16 a0, a1, b0, b1; \
        { const float na = -mA, nb = -mB; \
          _Pragma("unroll") for (int r = 0; r < 16; ++r) { a0[r] = na; a1[r] = na; b0[r] = nb; b1[r] = nb; } } \
        __builtin_amdgcn_s_setprio(1); \
        { bf16x8 k0 = *(const LAS bf16x8*)(kb), k1 = *(const LAS bf16x8*)(kb + 512);        \
          _Pragma("unroll") for (int d0 = 0; d0 < ND; ++d0) { \
            bf16x8 n0 = k0, n1 = k1; \
            if (d0 + 1 < ND) { n0 = *(const LAS bf16x8*)(kb + (d0 + 1) * 2048); n1 = *(const LAS bf16x8*)(kb + (d0 + 1) * 2048 + 512); } \
            a0 = __builtin_amdgcn_mfma_f32_32x32x16_bf16(k0, qa[d0], a0, 0, 0, 0); \
            b0 = __builtin_amdgcn_mfma_f32_32x32x16_bf16(k0, qb[d0], b0, 0, 0, 0); \
            a1 = __builtin_amdgcn_mfma_f32_32x32x16_bf16(k1, qa[d0], a1, 0, 0, 0); \
            b1 = __builtin_amdgcn_mfma_f32_32x32x16_bf16(k1, qb[d0], b1, 0, 0, 0); \
            k0 = n0; k1 = n1; \
            __builtin_amdgcn_sched_barrier(0); } } \
        __builtin_amdgcn_s_setprio(0); \
        float rA = -INFINITY, rB = -INFINITY; \
        _Pragma("unroll") for (int r = 0; r < 16; ++r) { rA = fmaxf(fmaxf(rA, a0[r]), a1[r]); rB = fmaxf(fmaxf(rB, b0[r]), b1[r]); } \
        { auto rr = __builtin_amdgcn_permlane32_swap(__float_as_uint(rA), __float_as_uint(rA), false, false); rA = fmaxf(__uint_as_float(rr[0]), __uint_as_float(rr[1])); } \
        { auto rr = __builtin_amdgcn_permlane32_swap(__float_as_uint(rB), __float_as_uint(rB), false, false); rB = fmaxf(__uint_as_float(rr[0]), __uint_as_float(rr[1])); } \
        if (FIRST) { mA = rA; mB = rB; \
            _Pragma("unroll") for (int r = 0; r < 16; ++r) { a0[r] -= rA; a1[r] -= rA; b0[r] -= rB; b1[r] -= rB; } } \
        float sA = 0.f, sB = 0.f; \
        _Pragma("unroll") for (int r = 0; r < 16; ++r) { a0[r] = __builtin_amdgcn_exp2f(a0[r]); a1[r] = __builtin_amdgcn_exp2f(a1[r]); b0[r] = __builtin_amdgcn_exp2f(b0[r]); b1[r] = __builtin_amdgcn_exp2f(b1[r]); \
            sA += a0[r] + a1[r]; sB += b0[r] + b1[r]; } \
        lA += sA; lB += sB; \
        u32x4 pa[4], pb[4]; \
        _Pragma("unroll") for (int j = 0; j < 4; ++j) { pa[0][j] = cvt_pk_bf16(a0[2 * j], a0[2 * j + 1]); pa[1][j] = cvt_pk_bf16(a0[8 + 2 * j], a0[8 + 2 * j + 1]); \
                                      pa[2][j] = cvt_pk_bf16(a1[2 * j], a1[2 * j + 1]); pa[3][j] = cvt_pk_bf16(a1[8 + 2 * j], a1[8 + 2 * j + 1]); \
                                      pb[0][j] = cvt_pk_bf16(b0[2 * j], b0[2 * j + 1]); pb[1][j] = cvt_pk_bf16(b0[8 + 2 * j], b0[8 + 2 * j + 1]); \
                                      pb[2][j] = cvt_pk_bf16(b1[2 * j], b1[2 * j + 1]); pb[3][j] = cvt_pk_bf16(b1[8 + 2 * j], b1[8 + 2 * j + 1]); } \
        const LAS unsigned char* vp = Ks + VOFF + ((lane >> 4) & 1) * 32 + (lane & 3) * 8 + (4 * hi + ((lane & 15) >> 2)) * 64; \
        __builtin_amdgcn_s_setprio(1); \
        { s16x4 lo = vtr(vp), hh = vtr(vp + 512); \
          __builtin_amdgcn_sched_barrier(0); \
          _Pragma("unroll") for (int i = 0; i < 8; ++i) { \
            s16x4 nlo = lo, nhh = hh; \
            if (i + 1 < 8) { nlo = vtr(vp + ((i + 1) >> 2) * 4096 + ((i + 1) & 3) * 1024); nhh = vtr(vp + ((i + 1) >> 2) * 4096 + ((i + 1) & 3) * 1024 + 512); } \
            const bf16x8 vf = (bf16x8){lo[0], lo[1], lo[2], lo[3], hh[0], hh[1], hh[2], hh[3]}; \
            oa[i >> 2] = __builtin_amdgcn_mfma_f32_32x32x16_bf16(__builtin_bit_cast(bf16x8, pa[i & 3]), vf, oa[i >> 2], 0, 0, 0); \
            ob[i >> 2] = __builtin_amdgcn_mfma_f32_32x32x16_bf16(__builtin_bit_cast(bf16x8, pb[i & 3]), vf, ob[i >> 2], 0, 0, 0); \
            lo = nlo; hh = nhh; \
            __builtin_amdgcn_sched_barrier(0); } } \
        __builtin_amdgcn_s_setprio(0); \
        if (!(FIRST) && __any(rA > THR || rB > THR)) { \
            const float dA = fmaxf(rA, 0.f), dB = fmaxf(rB, 0.f); mA += dA; mB += dB; \
            const float fA = __builtin_amdgcn_exp2f(-dA), fB = __builtin_amdgcn_exp2f(-dB); \
            lA *= fA; lB *= fB; \
            if (hi == 0) { wsf[r32] = fA; wsf[32 + r32] = fB; } \
            asm volatile("s_waitcnt lgkmcnt(0)" ::: "memory"); \
            _Pragma("unroll") for (int g4 = 0; g4 < 4; ++g4) { const f32x4 f4 = *(const LAS f32x4*)(wsf + 8 * g4 + 4 * hi), h4 = *(const LAS f32x4*)(wsf + 32 + 8 * g4 + 4 * hi); \
                _Pragma("unroll") for (int j = 0; j < 4; ++j) { oa[0][4 * g4 + j] *= f4[j]; oa[1][4 * g4 + j] *= f4[j]; ob[0][4 * g4 + j] *= h4[j]; ob[1][4 * g4 + j] *= h4[j]; } } \
            asm volatile("s_waitcnt lgkmcnt(0)" ::: "memory"); \
        } \
        asm volatile("s_waitcnt vmcnt(0)" ::: "memory"); \
        __syncthreads(); } while (0)
    A2_TILE(t0, true);
    for (int t = t0 + 1; t <= t1; ++t) A2_TILE(t, false);
#undef A2_TILE
#undef A2_DMA
    { auto rr = __builtin_amdgcn_permlane32_swap(__float_as_uint(lA), __float_as_uint(lA), false, false); lA = __uint_as_float(rr[0]) + __uint_as_float(rr[1]); }
    { auto rr = __builtin_amdgcn_permlane32_swap(__float_as_uint(lB), __float_as_uint(lB), false, false); lB = __uint_as_float(rr[0]) + __uint_as_float(rr[1]); }
    if (hi == 0) { wsf[64 + r32] = lA; wsf[96 + r32] = lB; }
    asm volatile("s_waitcnt lgkmcnt(0)" ::: "memory");
    LAS bf16_t* stg = (LAS bf16_t*)(lds + LDS_OST) + wid * 2048;
#pragma unroll
    for (int blk = 0; blk < 2; ++blk) {
        float rli[16];
#pragma unroll
        for (int g4 = 0; g4 < 4; ++g4) { const f32x4 l4 = *(const LAS f32x4*)(wsf + 64 + 32 * blk + 8 * g4 + 4 * hi);
#pragma unroll
            for (int j = 0; j < 4; ++j) rli[4 * g4 + j] = __builtin_amdgcn_rcpf(l4[j]); }
#pragma unroll
        for (int r = 0; r < 16; ++r) { const int orow = crow(r, hi);
#pragma unroll
            for (int d0 = 0; d0 < 2; ++d0) stg[orow * 64 + d0 * 32 + r32] = f2bf((blk == 0 ? oa[d0][r] : ob[d0][r]) * rli[r]); }
        asm volatile("s_waitcnt lgkmcnt(0)" ::: "memory");
        bf16_t* Ow = (blk == 0 ? OpA : OpB) + (size_t)wq0 * ldo;
#pragma unroll
        for (int i = 0; i < 4; ++i) { const int row = i * 8 + (lane >> 3), ch = lane & 7; const u32x4 v = *(const LAS u32x4*)(stg + row * 64 + ch * 8);
            if constexpr (O8) { *(GAS u32x2*)((unsigned char*)(blk == 0 ? OpA : OpB) + (size_t)(wq0 + row) * ldo + ch * 8) = bf8_to_fp8x8(v); } else { *(GAS u32x4*)(Ow + (size_t)row * ldo + ch * 8) = v; } }
        asm volatile("s_waitcnt lgkmcnt(0)" ::: "memory");
    }
}
}
constexpr size_t MiB = 1u << 20;
constexpr size_t WS_CTL = 0, CTL_ZERO_BYTES = 1 * MiB;
constexpr size_t WS_MOD = 1 * MiB;
constexpr size_t WS_ROPE = 2 * MiB;

constexpr size_t WS_TOKES = 3 * MiB;
constexpr size_t WS_TOKW = 3 * MiB + 512 * 1024;
constexpr size_t WS_LIST = 4 * MiB;
constexpr size_t WS_W = 8 * MiB;
constexpr size_t W_IN = 0, W_UQ = W_IN + (size_t)NPROJ * 1024 * 2, W_UKV = W_UQ + 512 * 256 * 2, W_BR = W_UKV + 512 * 256 * 2, W_OUT = W_BR + (size_t)4 * 1024 * 256 * 2,
                 W_RT = W_OUT + (size_t)1024 * 1024 * 2, W_E13 = W_RT + 256 * 1024 * 2, W_E2 = W_E13 + (size_t)32 * 512 * 1024 * 2, W_END = W_E2 + (size_t)32 * 1024 * 256 * 2;
static_assert(W_END <= 66 * MiB, "weights region");
constexpr size_t WS_HB = 74 * MiB;
constexpr size_t WS_QC = 138 * MiB, WS_KC = 162 * MiB, WS_VC = 186 * MiB;
constexpr size_t WS_PROJ = 202 * MiB;
constexpr size_t WS_HS = WS_PROJ, WS_YS = WS_PROJ + 40 * MiB;
constexpr size_t WS_END = WS_PROJ + (size_t)MTOK * (LDP * 2 + 4096);
constexpr size_t WS_XB = WS_END, WS_SSQ = WS_END + (size_t)MTOK * DM * 2, WS_END2 = WS_SSQ + (size_t)MTOK * 16 * 4;
static_assert((size_t)SORTROWS * 256 * 2 <= 40 * MiB && WS_YS + (size_t)SORTROWS * 1024 * 2 <= WS_END, "moe overlay");
constexpr size_t WS_W2 = WS_END2;
constexpr size_t WS_END3 = WS_W2 + 66 * MiB;
constexpr size_t WS_HB8 = WS_END3, WS_Y8 = WS_HB8 + (size_t)MTOK * DM, WS_END4 = WS_Y8 + (size_t)MTOK * DM;
constexpr size_t W_G8 = W_IN + (size_t)2304 * 1024 * 2;
constexpr int CW_BAR = 4096;
constexpr int CW_ECNT = 16384;
constexpr int RING_BYTES = 131072;
constexpr int LC_TEND = RING_BYTES, LC_CNT = RING_BYTES + 128, LC_BARW = RING_BYTES + 256, LC_XCH = RING_BYTES + 1024;
constexpr int LDS_BYTES = 147456;
constexpr int NWAVES = 8;

#define RLX_AGENT __ATOMIC_RELAXED, __HIP_MEMORY_SCOPE_AGENT

#define XB_TMO      128
#define XB_XCNT(j)  (256  + 64 * (j))
#define XB_XSUB(j)  (1280 + 64 * (j))
#define XB_XGEN(j)  (2304 + 64 * (j))
#define XB_TOP      3328
#define XB_TOPGEN   3392
#define XCD_BAR_WORDS 3456
#define XB_SPIN_CAP (1u << 18)
__device__ __forceinline__ unsigned xb_ld(unsigned* p)              { return __hip_atomic_load(p, __ATOMIC_RELAXED, __HIP_MEMORY_SCOPE_AGENT); }
__device__ __forceinline__ unsigned xb_add(unsigned* p, unsigned v) { return __hip_atomic_fetch_add(p, v, __ATOMIC_RELAXED, __HIP_MEMORY_SCOPE_AGENT); }
__device__ __forceinline__ unsigned xb_xcc_id() { return (unsigned)__builtin_amdgcn_s_getreg((3 << 11) | 20) & 0xFu; }
#define XB_SPIN(cond, bar) do { unsigned _sp = 0; while (cond) { __builtin_amdgcn_s_sleep(1); \
    if ((++_sp & 255u) == 0u) { if (xb_ld(&(bar)[XB_TMO])) break; if (_sp > XB_SPIN_CAP) { atomicAdd(&(bar)[XB_TMO], 1u); break; } } } } while (0)
struct XcdBarrier { unsigned* bar; unsigned x; volatile LAS unsigned* st; };
__device__ __forceinline__ XcdBarrier xcd_barrier_post(unsigned* bar, volatile LAS unsigned* st) {
    XcdBarrier b; b.bar = bar; b.x = xb_xcc_id(); b.st = st;
    if (threadIdx.x == 0) (void)xb_add(&bar[XB_XCNT(b.x)], 1u);
    return b;
}
__device__ __forceinline__ void xcd_barrier_complete(unsigned* bar, unsigned x, unsigned& nloc, unsigned& nx) {
    const unsigned G = gridDim.x * gridDim.y * gridDim.z;
    unsigned sum, cnt, mine, sp = 0u;
    for (;;) {
        sum = 0u; cnt = 0u; mine = 0u;
#pragma unroll
        for (unsigned j = 0; j < 16; ++j) { const unsigned c = xb_ld(&bar[XB_XCNT(j)]); sum += c; cnt += (c > 0u) ? 1u : 0u; mine = (j == x) ? c : mine; }
        if (sum == G) break;
        __builtin_amdgcn_s_sleep(1);
        if ((++sp & 255u) == 0u) { if (xb_ld(&bar[XB_TMO])) break; if (sp > XB_SPIN_CAP) { atomicAdd(&bar[XB_TMO], 1u); break; } }
    }
    nloc = mine > 0u ? mine : 1u; nx = cnt > 0u ? cnt : 1u;
}
__device__ __forceinline__ void xcd_barrier(const XcdBarrier& b, const bool leader) {
    asm volatile("s_waitcnt vmcnt(0)" ::: "memory");
    __syncthreads();
    if (leader) {
        unsigned* bar = b.bar;
        __builtin_amdgcn_s_waitcnt(0);
        unsigned nloc = b.st[0], nx = b.st[1];
        if (nloc == 0u) { xcd_barrier_complete(bar, b.x, nloc, nx); b.st[0] = nloc; b.st[1] = nx; }
        const unsigned old = xb_add(&bar[XB_XSUB(b.x)], 1u);
        const unsigned gen = old / nloc;
        if (old + 1u == (gen + 1u) * nloc) {
            __builtin_amdgcn_fence(__ATOMIC_RELEASE, "agent");
            asm volatile("s_waitcnt vmcnt(0)" ::: "memory");
            const unsigned og = xb_add(&bar[XB_TOP], 1u);
            const unsigned tg = og / nx;
            if (og + 1u == (tg + 1u) * nx) xb_add(&bar[XB_TOPGEN], 1u);
            else XB_SPIN(xb_ld(&bar[XB_TOPGEN]) == tg, bar);
            __builtin_amdgcn_fence(__ATOMIC_ACQUIRE, "agent");
            xb_add(&bar[XB_XGEN(b.x)], 1u);
            asm volatile("s_waitcnt vmcnt(0)" ::: "memory");
        } else {
            XB_SPIN(xb_ld(&bar[XB_XGEN(b.x)]) == gen, bar);
            __builtin_amdgcn_fence(__ATOMIC_ACQUIRE, "agent");
            asm volatile("s_waitcnt vmcnt(0)" ::: "memory");
        }
    }
    __syncthreads();
}

struct Frame {
    LAS unsigned char* lds;
    unsigned* ctl;
    int tid, lane, wave, vcu, G;
    float* out; unsigned char* ws;
};
struct Args { const float* in[25]; float* out; unsigned char* ws; int ph_lo, ph_hi; };
#define GIN(i) ((const float*)(const GAS float*)KA.in[i])
__device__ __forceinline__ float wave_sum(float v) {
    v += xshfl<1>(v); v += xshfl<2>(v); v += xshfl<4>(v); v += xshfl<8>(v); v += xshfl<16>(v); v += xshfl<32>(v);
    return v;
}
#define LDS_WAIT() asm volatile("s_waitcnt lgkmcnt(0)" ::: "memory")

__device__ __forceinline__ void p0_phase(Frame& F, const Args& KA) {
    LAS float* cact = (LAS float*)F.lds;
    LAS float* part = (LAS float*)(F.lds + 32768);
    const float* c = GIN(1); const float* w_ada = GIN(2); const float* b_ada = GIN(3);
    float* mod = (float*)(F.ws + WS_MOD);
    for (int i = F.tid; i < NB * DM; i += NWAVES * 64) { const float v = c[i]; cact[i] = v / (1.0f + __expf(-v)); }
    __syncthreads();
    for (int cb = blockIdx.x; cb < DEPTH * 96; cb += F.G) {
        const int l = cb / 96, n0 = (cb % 96) * 64;
        const float* w = w_ada + ((size_t)l * DM + F.wave * 128) * 6144 + n0 + F.lane;
        float acc[NB];
#pragma unroll
        for (int b = 0; b < NB; ++b) acc[b] = 0.f;
#pragma unroll 8
        for (int k = 0; k < 128; ++k) { const float wv = w[(size_t)k * 6144];
#pragma unroll
            for (int b = 0; b < NB; ++b) acc[b] += cact[b * DM + F.wave * 128 + k] * wv; }
#pragma unroll
        for (int b = 0; b < NB; ++b) part[(F.wave * NB + b) * 64 + F.lane] = acc[b];
        __syncthreads();
        { const int b = F.tid >> 6; float s = b_ada[l * 6144 + n0 + F.lane];
#pragma unroll
          for (int w8 = 0; w8 < NWAVES; ++w8) s += part[(w8 * NB + b) * 64 + F.lane];
          mod[((size_t)l * NB + b) * 6144 + n0 + F.lane] = s; }
        __syncthreads();
    }
    float* cs = (float*)(F.ws + WS_ROPE);
    for (int id = blockIdx.x * (NWAVES * 64) + F.tid; id < SEQ * 16; id += F.G * NWAVES * 64) {
        const int pos = id >> 4, f = id & 15;
        const float inv = powf(10000.0f, -(float)(2 * f) / 32.0f);
        const float ang = (float)pos * inv;
        cs[id] = cosf(ang); cs[SEQ * 16 + id] = sinf(ang);
    }
}

template <class RowMap>
__device__ __forceinline__ void transpose_item(const float* W, int ldw, int k0, int n0, bf16_t* WT, int ldt, const RowMap& rm, LAS float* scr, int lane, const float* kscale = nullptr, float cscale = 1.0f) {
    { const float* wp = (const float*)(const GAS float*)W + (size_t)(k0 + (lane >> 5)) * ldw + n0 + (lane & 31);
      float wv[32];
#pragma unroll
      for (int i = 0; i < 32; ++i) wv[i] = *(const GAS float*)(wp + (size_t)(2 * i) * ldw);
#pragma unroll
      for (int i = 0; i < 32; ++i) { const int kk = 2 * i + (lane >> 5); float v = wv[i]; if (kscale) v *= kscale[k0 + kk]; scr[kk * 33 + (lane & 31)] = v * cscale; } }
    LDS_WAIT(); asm volatile("" ::: "memory");
    const int c = lane & 7;
#pragma unroll
    for (int j = 0; j < 4; ++j) { const int n = (lane >> 3) + 8 * j; const LAS float* s = scr + (8 * c) * 33 + n;
        u32x4 o; o.x = cvt_pk_bf16(s[0 * 33], s[1 * 33]); o.y = cvt_pk_bf16(s[2 * 33], s[3 * 33]); o.z = cvt_pk_bf16(s[4 * 33], s[5 * 33]); o.w = cvt_pk_bf16(s[6 * 33], s[7 * 33]);
        *(u32x4*)(WT + (size_t)rm(n0 + n) * ldt + k0 + 8 * c) = o; }
    LDS_WAIT(); asm volatile("" ::: "memory");
}
__device__ __forceinline__ void transpose_item_f8(const float* W, int ldw, int k0, int n0, unsigned char* WT, int ldt, int nbase, LAS float* scr, int lane, float cscale) {
    { const float* wp = (const float*)(const GAS float*)W + (size_t)(k0 + (lane >> 5)) * ldw + n0 + (lane & 31);
      float wv[32];
#pragma unroll
      for (int i = 0; i < 32; ++i) wv[i] = *(const GAS float*)(wp + (size_t)(2 * i) * ldw);
#pragma unroll
      for (int i = 0; i < 32; ++i) { const int kk = 2 * i + (lane >> 5); scr[kk * 33 + (lane & 31)] = wv[i] * cscale; } }
    LDS_WAIT(); asm volatile("" ::: "memory");
    const int c = lane & 7;
#pragma unroll
    for (int j = 0; j < 4; ++j) { const int n = (lane >> 3) + 8 * j; const LAS float* s = scr + (8 * c) * 33 + n;
        u32x2 o; o.x = pk_fp8x4(s[0 * 33], s[1 * 33], s[2 * 33], s[3 * 33]); o.y = pk_fp8x4(s[4 * 33], s[5 * 33], s[6 * 33], s[7 * 33]);
        *(u32x2*)(WT + (size_t)(n0 + n - nbase) * ldt + k0 + 8 * c) = o; }
    LDS_WAIT(); asm volatile("" ::: "memory");
}
__device__ __forceinline__ int pairpos(int j) { const int f = j & 15, p = j >> 4; return 8 * (f >> 2) + 4 * p + (f & 3); }
struct MapIn   { __device__ __forceinline__ int operator()(int n) const {
    if (n < 1280) return n;
    if (n < 1728) return n + 512;
    if (n < 1760) return 2240 + pairpos(n - 1728);
    if (n < 2144) { const int d = n - 1760; return 1280 + (d & ~31) + pairpos(d & 31); }
    if (n < 2272) return n - 480;
    return n + 32; } };
struct MapId   { __device__ __forceinline__ int operator()(int n) const { return n; } };
struct MapUkv  { __device__ __forceinline__ int operator()(int n) const { const int h = n >> 7, j = n & 127; return j < 64 ? 64 * h + j : 256 + 64 * h + (j - 64); } };
struct MapE13  { int add; __device__ __forceinline__ int operator()(int n) const { return 8 * (n >> 2) + (n & 3) + add; } };

__device__ __forceinline__ void convert_weights(Frame& F, const Args& KA, int l, unsigned char* wb, int it_lo, int it_hi, int gw, int NGW, bool smalls) {
    LAS float* scr = (LAS float*)(F.lds + F.wave * 16384);
    const float* w_in = GIN(6) + (size_t)l * DM * 6368;
    const float* w_ukv = GIN(12) + (size_t)l * 256 * 512;
    const float* w_br = GIN(15) + (size_t)l * 4 * 256 * DM;
    const float* w_out = GIN(16) + (size_t)l * DM * DM;
    const float* w_e1 = GIN(21) + (size_t)l * NEXP * DM * 256;
    const float* w_e3 = GIN(22) + (size_t)l * NEXP * DM * 256;
    const float* w_e2 = GIN(23) + (size_t)l * NEXP * 256 * DM;
    constexpr int I_IN = 16 * 199, I_BR = 4 * 4 * 32, I_OUT = 16 * 32, I_UKV = 4 * 16, I_E1 = NEXP * 16 * 8, I_E2 = NEXP * 4 * 32;
    constexpr int NITEMS = I_IN + I_BR + I_OUT + I_UKV + 2 * I_E1 + I_E2;
    if (it_hi > NITEMS) it_hi = NITEMS;
    for (int it = it_lo + gw; it < it_hi; it += NGW) {
        int r = it;
        if (r < I_IN) { const int kb = r / 199, nb = r % 199;
            if (nb >= 71) transpose_item_f8(w_in, 6368, 64 * kb, 32 * nb, wb + W_G8, DM, 2272, scr, F.lane, -LOG2E * pg8::GATE_WSCALE);
            else transpose_item(w_in, 6368, 64 * kb, 32 * nb, (bf16_t*)(wb + W_IN), DM, MapIn{}, scr, F.lane); continue; } r -= I_IN;
        if (r < I_BR) { const int n = r >> 7, q = r & 127, kb = q >> 5, nb = q & 31; transpose_item_f8(w_br + (size_t)n * 256 * DM, DM, 64 * kb, 32 * nb, wb + W_BR + (size_t)n * DM * 256, 256, 0, scr, F.lane, pg8::MERGE_WSCALE); continue; } r -= I_BR;
        if (r < I_OUT) { const int kb = r >> 5, nb = r & 31; transpose_item(w_out, DM, 64 * kb, 32 * nb, (bf16_t*)(wb + W_OUT), DM, MapId{}, scr, F.lane); continue; } r -= I_OUT;
        if (r < I_UKV) { const int kb = r >> 4, nb = r & 15; transpose_item(w_ukv, 512, 64 * kb, 32 * nb, (bf16_t*)(wb + W_UKV), 256, MapUkv{}, scr, F.lane, GIN(10) + l * 256); continue; } r -= I_UKV;
        if (r < I_E1) { const int e = r >> 7, q = r & 127, kb = q >> 3, nb = q & 7; transpose_item(w_e1 + (size_t)e * DM * 256, 256, 64 * kb, 32 * nb, (bf16_t*)(wb + W_E13) + (size_t)e * 512 * DM, DM, MapE13{0}, scr, F.lane); continue; } r -= I_E1;
        if (r < I_E1) { const int e = r >> 7, q = r & 127, kb = q >> 3, nb = q & 7; transpose_item(w_e3 + (size_t)e * DM * 256, 256, 64 * kb, 32 * nb, (bf16_t*)(wb + W_E13) + (size_t)e * 512 * DM, DM, MapE13{4}, scr, F.lane); continue; } r -= I_E1;
        { const int e = r >> 7, q = r & 127, kb = q >> 5, nb = q & 31; transpose_item(w_e2 + (size_t)e * 256 * DM, DM, 64 * kb, 32 * nb, (bf16_t*)(wb + W_E2) + (size_t)e * DM * 256, 256, MapId{}, scr, F.lane); }
    }
    if (!smalls) return;
    const float* w_uq = GIN(11) + (size_t)l * 192 * 384;
    const float* w_g = GIN(17) + (size_t)l * DM * 4;
    const float* w_r = GIN(19) + (size_t)l * DM * 32;
    bf16_t* uq = (bf16_t*)(wb + W_UQ); bf16_t* rt = (bf16_t*)(wb + W_RT); bf16_t* win = (bf16_t*)(wb + W_IN);
    const int gt = blockIdx.x * (NWAVES * 64) + F.tid, NT = F.G * NWAVES * 64;
    for (int i = gt; i < 512 * 256; i += NT) {
        const int r = i >> 8, k = i & 255; float v = 0.f;
        if (r < 384 && k < 192) { const int h = r / 96, j = r % 96; int src;
            if (j < 64) src = 96 * h + j;
            else { const int q = j - 64, fb = q >> 3, p = (q >> 2) & 1, f = 4 * fb + (q & 3); src = 96 * h + 64 + 16 * p + f; }
            v = w_uq[(size_t)k * 384 + src] * GIN(9)[l * 192 + k]; }
        uq[i] = f2bf(v);
    }
    for (int i = gt; i < 256 * DM; i += NT) {
        const int r = i >> 10, k = i & 1023; float v = 0.f;
        if (r < 4) v = w_g[k * 4 + r]; else if (r < 36) v = w_r[k * 32 + (r - 4)];
        rt[i] = f2bf(v);
    }
    for (int i = gt; i < 32 * DM; i += NT) win[(size_t)2272 * DM + i] = 0;
}

__device__ __forceinline__ void load_moe_tables(Frame& F, int l) {
    LAS int* tend = (LAS int*)(F.lds + LC_TEND); LAS int* cnt = (LAS int*)(F.lds + LC_CNT);
    if (F.tid < NEXP) cnt[F.tid] = (int)__hip_atomic_load(F.ctl + CW_ECNT + 64 * l + F.tid, RLX_AGENT);
    __syncthreads();
    if (F.tid == 0) { int acc = 0; for (int e = 0; e < NEXP; ++e) { acc += (cnt[e] + 255) >> 8; tend[e] = acc; } }
    __syncthreads();
}

__device__ __forceinline__ void norm_phase(Frame& F, const float* xsrc, const bf16_t* xbsrc, bf16_t* xdst, bool combine, const float* g2prev, const float* gain, const float* shv, const float* scv,
                                           bf16_t* hout, float* fout, const bf16_t* delta = nullptr, unsigned char* h8out = nullptr) {
    const int gw = F.vcu * NWAVES + F.wave, NGW = F.G * NWAVES;
    const int rpw = (((MTOK + NGW - 1) / NGW) + 3) & ~3;
    int m0 = gw * rpw, m1 = m0 + rpw; m1 = m1 > MTOK ? MTOK : m1;
    const LAS int* tend = (const LAS int*)(F.lds + LC_TEND);
    const int* tok_es = (const int*)(F.ws + WS_TOKES); const float* tok_w = (const float*)(F.ws + WS_TOKW);
    const bf16_t* YS = (const bf16_t*)(F.ws + WS_YS);
    f32x4 A[4], B[4], G2[4]; int bcur = -1;
#pragma unroll
    for (int j = 0; j < 4; ++j) { A[j] = (f32x4){0.f, 0.f, 0.f, 0.f}; B[j] = A[j]; G2[j] = A[j]; }
    const int lc = 4 * F.lane;
    for (int m = m0; m < m1; m += 4) {
        const int b = m >> 12;
        if (b != bcur) { bcur = b;
#pragma unroll
            for (int j = 0; j < 4; ++j) { const int col = lc + 256 * j; const f32x4 gn = *(const f32x4*)(gain + col);
                if (scv) { const f32x4 sc = *(const f32x4*)(scv + b * 6144 + col); A[j] = gn * (sc + 1.0f); B[j] = *(const f32x4*)(shv + b * 6144 + col); } else { A[j] = gn; }
                if (combine) G2[j] = *(const f32x4*)(g2prev + b * 6144 + col); } }
        f32x4 v[4][4];
        if (xbsrc) {
            u32x2 xb[4][4];
#pragma unroll
            for (int r = 0; r < 4; ++r)
#pragma unroll
                for (int j = 0; j < 4; ++j) xb[r][j] = __builtin_nontemporal_load((const GAS u32x2*)(xbsrc + (size_t)(m + r) * DM + lc + 256 * j));
#pragma unroll
            for (int r = 0; r < 4; ++r)
#pragma unroll
                for (int j = 0; j < 4; ++j) { const u32x2 y0 = xb[r][j]; v[r][j] = (f32x4){bflo(y0.x), bfhi(y0.x), bflo(y0.y), bfhi(y0.y)}; }
        } else {
#pragma unroll
            for (int r = 0; r < 4; ++r)
#pragma unroll
                for (int j = 0; j < 4; ++j) v[r][j] = *(const GAS f32x4*)(xsrc + (size_t)(m + r) * DM + lc + 256 * j);
        }
        if (delta) {
            u32x2 dl[4][4];
#pragma unroll
            for (int r = 0; r < 4; ++r)
#pragma unroll
                for (int j = 0; j < 4; ++j) dl[r][j] = *(const GAS u32x2*)(delta + (size_t)(m + r) * DM + lc + 256 * j);
#pragma unroll
            for (int r = 0; r < 4; ++r)
#pragma unroll
                for (int j = 0; j < 4; ++j) { const u32x2 y0 = dl[r][j]; v[r][j] = v[r][j] + (f32x4){bflo(y0.x), bfhi(y0.x), bflo(y0.y), bfhi(y0.y)}; }
            if (xdst) {
#pragma unroll
                for (int r = 0; r < 4; ++r)
#pragma unroll
                    for (int j = 0; j < 4; ++j) { u32x2 w_; w_.x = cvt_pk_bf16(v[r][j].x, v[r][j].y); w_.y = cvt_pk_bf16(v[r][j].z, v[r][j].w); *(GAS u32x2*)(xdst + (size_t)(m + r) * DM + lc + 256 * j) = w_; } }
        }
        if (combine) {
            int es[4][2]; float ww[4][2];
#pragma unroll
            for (int r = 0; r < 4; ++r) { es[r][0] = tok_es[2 * (m + r)]; es[r][1] = tok_es[2 * (m + r) + 1]; ww[r][0] = tok_w[2 * (m + r)]; ww[r][1] = tok_w[2 * (m + r) + 1]; }
            u32x2 y[4][2][4];
#pragma unroll
            for (int r = 0; r < 4; ++r)
#pragma unroll
                for (int k = 0; k < 2; ++k) { const int e = es[r][k] >> 16; const int rr = 256 * (e ? tend[e - 1] : 0) + (es[r][k] & 0xffff);
#pragma unroll
                    for (int j = 0; j < 4; ++j) y[r][k][j] = __builtin_nontemporal_load((const GAS u32x2*)(YS + (size_t)rr * DM + lc + 256 * j)); }
#pragma unroll
            for (int r = 0; r < 4; ++r)
#pragma unroll
                for (int j = 0; j < 4; ++j) { const u32x2 y0 = y[r][0][j], y1 = y[r][1][j];
                    const f32x4 a = (f32x4){bflo(y0.x), bfhi(y0.x), bflo(y0.y), bfhi(y0.y)}, c = (f32x4){bflo(y1.x), bfhi(y1.x), bflo(y1.y), bfhi(y1.y)};
                    v[r][j] = v[r][j] + G2[j] * (a * ww[r][0] + c * ww[r][1]); }
            if (xdst) {
#pragma unroll
                for (int r = 0; r < 4; ++r)
#pragma unroll
                    for (int j = 0; j < 4; ++j) { u32x2 w_; w_.x = cvt_pk_bf16(v[r][j].x, v[r][j].y); w_.y = cvt_pk_bf16(v[r][j].z, v[r][j].w); *(GAS u32x2*)(xdst + (size_t)(m + r) * DM + lc + 256 * j) = w_; } }
        }
        float s[4];
#pragma unroll
        for (int r = 0; r < 4; ++r) { s[r] = 0.f;
#pragma unroll
            for (int j = 0; j < 4; ++j) s[r] += (v[r][j].x * v[r][j].x + v[r][j].y * v[r][j].y) + (v[r][j].z * v[r][j].z + v[r][j].w * v[r][j].w); }
#pragma unroll
        for (int r = 0; r < 4; ++r) s[r] += xshfl<1>(s[r]);
#pragma unroll
        for (int r = 0; r < 4; ++r) s[r] += xshfl<2>(s[r]);
#pragma unroll
        for (int r = 0; r < 4; ++r) s[r] += xshfl<4>(s[r]);
#pragma unroll
        for (int r = 0; r < 4; ++r) s[r] += xshfl<8>(s[r]);
#pragma unroll
        for (int r = 0; r < 4; ++r) s[r] += xshfl<16>(s[r]);
#pragma unroll
        for (int r = 0; r < 4; ++r) s[r] += xshfl<32>(s[r]);
#pragma unroll
        for (int r = 0; r < 4; ++r) { const float rstd = rsqrtf(s[r] * (1.0f / DM) + EPS);
#pragma unroll
            for (int j = 0; j < 4; ++j) { const f32x4 o = v[r][j] * rstd * A[j] + B[j];
                if (hout) { u32x2 w; w.x = cvt_pk_bf16(o.x, o.y); w.y = cvt_pk_bf16(o.z, o.w); *(GAS u32x2*)(hout + (size_t)(m + r) * DM + lc + 256 * j) = w; }
                if (h8out) *(GAS unsigned*)(h8out + (size_t)(m + r) * DM + lc + 256 * j) = pk_fp8x4(o.x, o.y, o.z, o.w);
                if (fout) *(GAS f32x4*)(fout + (size_t)(m + r) * DM + lc + 256 * j) = o; } }
    }
}

__device__ __forceinline__ void prep_phase(Frame& F, const Args& KA, int l, bool dummy = false) {
    const int gw = F.vcu * NWAVES + F.wave, NGW = F.G * NWAVES;
    bf16_t* P = (bf16_t*)(F.ws + WS_PROJ); bf16_t* KC = (bf16_t*)(F.ws + WS_KC);
    const float* cs = (const float*)(F.ws + WS_ROPE);
    const float* gq = GIN(9) + l * 192; const float* gkv = GIN(10) + l * 256; const float* gaq = GIN(13) + l * 64; const float* gak = GIN(14) + l * 64;
    const int lane = F.lane;
    const float g_q0 = gq[lane], g_q1 = gq[lane + 64], g_q2 = gq[lane + 128];
    const float g_kv0 = gkv[lane], g_kv1 = gkv[lane + 64], g_kv2 = gkv[lane + 128], g_kv3 = gkv[lane + 192];
    const float g_aq = gaq[lane], g_ak = gak[lane];
    const int rpw = (((MTOK + NGW - 1) / NGW) + 3) & ~3;
    int m0 = gw * rpw, m1 = m0 + rpw; m1 = m1 > MTOK ? MTOK : m1;
    const int f15 = lane & 15;
    for (int mg = m0; mg < m1; mg += 4) {
        float cq[4][3], ckv[4][4], kr1[4], kr2[4], ax[4][6];
#pragma unroll
        for (int r = 0; r < 4; ++r) { const bf16_t* row = P + (size_t)(mg + r) * LDP;
#pragma unroll
            for (int k = 0; k < 3; ++k) cq[r][k] = bf2f(row[PC_CQ + 64 * k + lane]);
#pragma unroll
            for (int k = 0; k < 4; ++k) ckv[r][k] = bf2f(row[PC_CKV + 64 * k + lane]);
            kr1[r] = bf2f(row[PC_KR + f15]); kr2[r] = bf2f(row[PC_KR + 16 + f15]);
#pragma unroll
            for (int hh = 0; hh < 6; ++hh) ax[r][hh] = bf2f(row[(hh < 4 ? PC_AXQ + 64 * hh : PC_AXK + 64 * (hh - 4)) + lane]); }
        float ss[4][8];
#pragma unroll
        for (int r = 0; r < 4; ++r) { ss[r][0] = cq[r][0] * cq[r][0] + cq[r][1] * cq[r][1] + cq[r][2] * cq[r][2];
            ss[r][1] = ckv[r][0] * ckv[r][0] + ckv[r][1] * ckv[r][1] + ckv[r][2] * ckv[r][2] + ckv[r][3] * ckv[r][3];
#pragma unroll
            for (int hh = 0; hh < 6; ++hh) ss[r][2 + hh] = ax[r][hh] * ax[r][hh]; }
#define PREP_BFLY(M) _Pragma("unroll") for (int r = 0; r < 4; ++r) _Pragma("unroll") for (int q = 0; q < 8; ++q) ss[r][q] += xshfl<M>(ss[r][q]);
        PREP_BFLY(1) PREP_BFLY(2) PREP_BFLY(4) PREP_BFLY(8) PREP_BFLY(16) PREP_BFLY(32)
#undef PREP_BFLY
#pragma unroll
        for (int r = 0; r < 4; ++r) { const int m = mg + r; bf16_t* row = dummy ? (bf16_t*)(F.ws + WS_END2) + (size_t)(m & 255) * LDP : P + (size_t)m * LDP;
            const int pos = m & (SEQ - 1), gr = pos >> 6, gc = pos & 63;
            { const float rstd = rsqrtf(ss[r][0] * (1.0f / 192.0f) + EPS);
              row[PC_CQ + lane] = f2bf(cq[r][0] * rstd * g_q0); row[PC_CQ + 64 + lane] = f2bf(cq[r][1] * rstd * g_q1); row[PC_CQ + 128 + lane] = f2bf(cq[r][2] * rstd * g_q2); }
            { const float rstd = rsqrtf(ss[r][1] * (1.0f / 256.0f) + EPS);
              row[PC_CKV + lane] = f2bf(ckv[r][0] * rstd * g_kv0); row[PC_CKV + 64 + lane] = f2bf(ckv[r][1] * rstd * g_kv1); row[PC_CKV + 128 + lane] = f2bf(ckv[r][2] * rstd * g_kv2); row[PC_CKV + 192 + lane] = f2bf(ckv[r][3] * rstd * g_kv3); }
            if (lane < 16) { const int f = lane; const float x1 = kr1[r], x2 = kr2[r];
                const float c = cs[pos * 16 + f], s = cs[SEQ * 16 + pos * 16 + f];
                const unsigned short o1 = f2bf(x1 * c - x2 * s), o2 = f2bf(x1 * s + x2 * c);
                const int p1 = 8 * (f >> 2) + (f & 3), p2 = p1 + 4;
                bf16_t* kr = (dummy ? (bf16_t*)(F.ws + WS_END2) + (size_t)(m & 255) * LDP : KC + (size_t)m * 384) + 64;
#pragma unroll
                for (int h = 0; h < 4; ++h) { kr[96 * h + p1] = o1; kr[96 * h + p2] = o2; } }
            { const int idx = (lane < 32) ? gr : gc;
              const float c = cs[idx * 16 + f15], s = cs[SEQ * 16 + idx * 16 + f15];
#pragma unroll
              for (int hh = 0; hh < 6; ++hh) {
                  bf16_t* p = row + (hh < 4 ? PC_AXQ + 64 * hh : PC_AXK + 64 * (hh - 4)) + lane;
                  const float rstd = rsqrtf(ss[r][2 + hh] * (1.0f / 64.0f) + EPS);
                  const float y = ax[r][hh] * rstd * (hh < 4 ? g_aq * (0.125f * LOG2E) : g_ak);
                  const float pr = xshfl<16>(y);
                  const float o = (lane & 16) ? (pr * s + y * c) : (y * c - pr * s);
                  *p = f2bf(o);
              } }
        }
    }
}
__device__ __forceinline__ void attn_phase(Frame& F, const Args& KA, int l) {
    bf16_t* P = (bf16_t*)(F.ws + WS_PROJ); bf16_t* QC = (bf16_t*)(F.ws + WS_QC); bf16_t* KC = (bf16_t*)(F.ws + WS_KC); bf16_t* VC = (bf16_t*)(F.ws + WS_VC);
    unsigned char* Y8 = F.ws + WS_Y8;
    constexpr int NU = NB * 4 * (SEQ / 256);
#ifndef REP_C
#define REP_C 1
#endif
#ifndef C_UNIT2
#define C_UNIT2 1
#endif
    if (C_UNIT2) {
        for (int L = F.vcu; L < NU / 2; L += F.G) { const int bh = L >> 3, qb = L & 7, b = bh >> 2, h = bh & 3; const size_t rb = (size_t)b * SEQ;
            att::attn_unit2<96, true>(QC + rb * 384 + 96 * h, QC + (rb + 2048) * 384 + 96 * h, KC + rb * 384 + 96 * h, VC + rb * 256 + 64 * h,
                                (bf16_t*)(Y8 + rb * 1024 + 512 + 64 * h), (bf16_t*)(Y8 + (rb + 2048) * 1024 + 512 + 64 * h), 384, 384, 256, 1024, qb * 256, F.lds, F.wave * 64 + lane_now()); }
    } else
    for (int rep = 0; rep < REP_C; ++rep)
    for (int L = F.vcu; L < NU; L += F.G) { const int bh = L >> 4, qb = L & 15, b = bh >> 2, h = bh & 3; const size_t rb = (size_t)b * SEQ;
        att::attn_unit<96, 0>(QC + rb * 384 + 96 * h, KC + rb * 384 + 96 * h, VC + rb * 256 + 64 * h, P + rb * LDP + PC_YC + 64 * h, 384, 384, 256, LDP,
                              qb * 256, 0.10206207261596575f * LOG2E, 0.f, 0.f, nullptr, F.lds, F.wave * 64 + lane_now()); }
#ifndef REP_D
#define REP_D 1
#endif
#ifndef REP_B
#define REP_B 1
#endif
#ifndef REP_A
#define REP_A 1
#endif
    bf16_t* DUMMY = (bf16_t*)(F.ws + WS_END);
    for (int L = F.vcu; L < NU / 2; L += F.G) { const int bk = L >> 4, qb = L & 15, b = bk >> 1, kv = bk & 1; bf16_t* Pb = P + (size_t)b * SEQ * LDP;
        att::attn_unit2<64, true>(Pb + PC_AXQ + 128 * kv, Pb + PC_AXQ + 128 * kv + 64, Pb + PC_AXK + 64 * kv, Pb + PC_AXV + 64 * kv, (bf16_t*)(Y8 + (size_t)b * SEQ * 1024 + 768 + 128 * kv), (bf16_t*)(Y8 + (size_t)b * SEQ * 1024 + 768 + 128 * kv + 64),
                            LDP, LDP, LDP, 1024, qb * 256, F.lds, F.wave * 64 + lane_now()); }
    for (int rep = 0; rep < REP_B; ++rep)
    for (int L = F.vcu; L < NU; L += F.G) { const int bh = L >> 4, qb = L & 15, b = bh >> 2, h = bh & 3; bf16_t* Pb = P + (size_t)b * SEQ * LDP; const bool dm = rep < REP_B - 1;
        const float slope = exp2f(-2.0f * (float)(h + 1)); const float sink = GIN(8)[l * 4 + h];
        att::attn_unit<64, 1, 0, true>(Pb + PC_WQ + 64 * h, Pb + PC_WK + 64 * (h >> 1), Pb + PC_WV + 64 * (h >> 1), (bf16_t*)(Y8 + (size_t)b * SEQ * 1024 + 256 + 64 * h), LDP, LDP, LDP, 1024,
                              qb * 256, 0.125f * LOG2E, slope * LOG2E, sink * LOG2E, nullptr, F.lds, F.wave * 64 + lane_now()); }
    for (int rep = 0; rep < REP_A; ++rep)
    for (int L = F.vcu; L < NU; L += F.G) { const int bh = L >> 4, qb = L & 15, b = bh >> 2, h = bh & 3; bf16_t* Pb = P + (size_t)b * SEQ * LDP; const bool dm = rep < REP_A - 1;
        att::attn_unit<64, 2, 0, true>(Pb + PC_NAQ + 64 * h, Pb + PC_NAK + 64 * h, Pb + PC_NAV + 64 * h, (bf16_t*)(Y8 + (size_t)b * SEQ * 1024 + 64 * h), LDP, LDP, LDP, 1024,
                              qb * 256, 0.125f * LOG2E, 0.f, 0.f, GIN(7) + (size_t)(l * 4 + h) * (15 * 31), F.lds, F.wave * 64 + lane_now()); }
}

#ifndef REP_BAR
#define REP_BAR 1
#endif
#ifndef REP_G2
#define REP_G2 1
#endif
#ifndef REP_G3
#define REP_G3 1
#endif
#ifndef REP_G5
#define REP_G5 1
#endif
#ifndef REP_G6
#define REP_G6 1
#endif
#ifndef REP_AT
#define REP_AT 1
#endif
#ifndef REP_TH
#define REP_TH 1
#endif
#ifndef FILL_G1
#define FILL_G1 0
#endif
#ifndef FILL_GR
#define FILL_GR 0
#endif
#ifndef FILL_G5
#define FILL_G5 9216
#endif
#ifndef FILL_G6
#define FILL_G6 0
#endif
constexpr int FILL_A = FILL_G1, FILL_B = FILL_A + FILL_GR, FILL_C = FILL_B + FILL_G5, FILL_END = FILL_C + FILL_G6;
#define FILLER(lo, hi, skip) do { if ((hi) > (lo) && l + 1 < DEPTH && (int)blockIdx.x >= (skip) && F.G > (skip)) { __syncthreads(); \
        convert_weights(F, KA, l + 1, F.ws + (((l + 1) & 1) ? WS_W2 : WS_W), (lo), (hi), ((int)blockIdx.x - (skip)) * NWAVES + F.wave, (F.G - (skip)) * NWAVES, false); } } while (0)
constexpr int FILL_SKIP = 64;
constexpr int PH_PER_LAYER = 10, N_PHASES = 1 + DEPTH * PH_PER_LAYER + 1;

__global__ void __launch_bounds__(NWAVES * 64, 2) mk_fwd(Args KA) {
    extern __shared__ __attribute__((aligned(16))) unsigned char lds_raw[];
    { const int t0 = threadIdx.x; for (int u = t0; u < (LDS_BYTES - RING_BYTES) / 4; u += NWAVES * 64) ((LAS unsigned*)((LAS unsigned char*)lds_raw + RING_BYTES))[u] = 0u; }
    __syncthreads();
    const int wave0 = __builtin_amdgcn_readfirstlane((int)threadIdx.x >> 6);
    XcdBarrier bar = xcd_barrier_post((unsigned*)(KA.ws + WS_CTL) + CW_BAR, (volatile LAS unsigned*)((LAS unsigned char*)lds_raw + LC_BARW));
#define FRAME() Frame F; { int t_ = wave0 * 64 + lane_now(); asm volatile("" : "+v"(t_)); unsigned char* w_ = KA.ws; float* o_ = KA.out; asm volatile("" : "+s"(w_), "+s"(o_)); \
        F.lds = (LAS unsigned char*)lds_raw; F.tid = t_; F.lane = t_ & 63; F.wave = __builtin_amdgcn_readfirstlane(t_ >> 6); F.G = gridDim.x; \
        { const int bx = blockIdx.x; F.vcu = (F.G % 8 == 0) ? (bx % 8) * (F.G / 8) + bx / 8 : bx; } F.ws = (unsigned char*)(GAS unsigned char*)w_; F.out = (float*)(GAS float*)o_; F.ctl = (unsigned*)(F.ws + WS_CTL); } \
        unsigned char* wb = F.ws + ((l & 1) ? WS_W2 : WS_W); bf16_t* HB = (bf16_t*)(F.ws + WS_HB); bf16_t* P = (bf16_t*)(F.ws + WS_PROJ); float* mod = (float*)(F.ws + WS_MOD); bf16_t* XB = (bf16_t*)(F.ws + WS_XB); (void)XB; \
        const float* modl = mod + (size_t)l * NB * 6144; const float* x_in = GIN(0); (void)wb; (void)HB; (void)P; (void)modl; (void)x_in
    const int lo = KA.ph_lo, hi = KA.ph_hi;
#ifndef PHMASK
#define PHMASK 0xFFFF
#endif
#define EN(j) ((PHMASK >> (j)) & 1)
#define IN(k) (lo <= (k) && (k) < hi)
#define SEAM(k) do { if (IN(k) && IN((k) + 1)) { XcdBarrier b_ = bar; asm volatile("" : "+s"(b_.bar)); for (int r_ = 0; r_ < REP_BAR; ++r_) xcd_barrier(b_, wave0 == 0 && lane_now() == 0); } } while (0)

    if (EN(11) && IN(0)) { const int l = 0; FRAME(); p0_phase(F, KA); SEAM(0); }

    for (int l = 0; l < DEPTH; ++l) {
        const int pb = 1 + PH_PER_LAYER * l;
        if (EN(0) && IN(pb + 0)) { FRAME();
            for (int rep = 0; rep < REP_TH; ++rep) convert_weights(F, KA, l, wb, (l == 0 || F.G <= 128) ? 0 : FILL_END, 1 << 30, F.vcu * NWAVES + F.wave, F.G * NWAVES, true);
            if (l > 0) load_moe_tables(F, l - 1);
#ifndef REP_T1
#define REP_T1 1
#endif
            norm_phase(F, x_in, l == 0 ? nullptr : XB, XB, l > 0, modl - (size_t)NB * 6144 + 5120, GIN(4) + l * DM, modl, modl + 1024, HB, nullptr, nullptr, F.ws + WS_HB8);
            SEAM(pb + 0);
        }
        if (EN(1) && IN(pb + 1)) { FRAME();
            pg8::Gemm g{HB, (const bf16_t*)(wb + W_IN), nullptr}; pg8::StaticOrder S; S.init(MTOK, 2304, F.G, (int)blockIdx.x);
            pg8::EpiProj E{P, (LAS float*)(F.lds + LC_XCH), (float*)(F.ws + WS_SSQ), (const float*)(F.ws + WS_ROPE), (bf16_t*)(F.ws + WS_KC), GIN(13) + l * 64, GIN(14) + l * 64, 0};
            pg8::Gemm g8{(const bf16_t*)(F.ws + WS_HB8), (const bf16_t*)(wb + W_G8), nullptr}; pg8::StaticOrder S8; S8.init(MTOK, 4096, F.G, (int)blockIdx.x, 1);
            pg8::EpiProj E8 = E; E8.pn0 = 9;
#ifndef REP_G1
#define REP_G1 1
#endif
            for (int rep = 0; rep < REP_G1; ++rep) {
                pg8::gemm_phase<pg8::EpiProj, pg8::StaticOrder, false, true, DM, DM, DM, 0>(F.lds, g, S, E, F.tid);
                pg8::gemm_phase<pg8::EpiProj, pg8::StaticOrder, false, true, DM / 2, DM / 2, DM / 2, 0, true>(F.lds, g8, S8, E8, F.tid);
            }
            FILLER(0, FILL_A, 128);
            SEAM(pb + 1);
        }
        if (EN(2) && IN(pb + 2)) { FRAME();
            { pg8::Gemm g{P + PC_CQ, (const bf16_t*)(wb + W_UQ), nullptr}; pg8::StaticOrder S; S.init(MTOK, 512, F.G, (int)blockIdx.x);
              pg8::EpiQup E{(bf16_t*)(F.ws + WS_QC), (const float*)(F.ws + WS_ROPE), (const float*)(F.ws + WS_SSQ)};
              for (int rep = 0; rep < REP_G2; ++rep) pg8::gemm_phase<pg8::EpiQup, pg8::StaticOrder, false, true, LDP, 256, 256, 0>(F.lds, g, S, E, F.tid); }
            { pg8::Gemm g{P + PC_CKV, (const bf16_t*)(wb + W_UKV), nullptr}; pg8::StaticOrder S; S.init(MTOK, 512, F.G, (int)blockIdx.x);
              pg8::EpiKVup E{(bf16_t*)(F.ws + WS_KC), (bf16_t*)(F.ws + WS_VC), (const float*)(F.ws + WS_SSQ)};
              for (int rep = 0; rep < REP_G2; ++rep) pg8::gemm_phase<pg8::EpiKVup, pg8::StaticOrder, false, true, LDP, 256, 256, 0>(F.lds, g, S, E, F.tid); }
            SEAM(pb + 2);
        }
        if (EN(3) && IN(pb + 3)) { FRAME(); for (int rep = 0; rep < REP_AT; ++rep) { attn_phase(F, KA, l); __syncthreads(); } SEAM(pb + 3); }
        if (EN(4) && IN(pb + 4)) { FRAME();
            for (int rep = 0; rep < REP_G3; ++rep) { pg8::merge_phase3(F.lds, P, F.ws + WS_Y8, wb + W_BR, HB, F.G, F.vcu, F.tid); __syncthreads(); }
            SEAM(pb + 4);
        }
        if (EN(5) && IN(pb + 5)) { FRAME();
            pg8::Gemm g{HB, (const bf16_t*)(wb + W_OUT), nullptr}; pg8::StaticOrder S; S.init(MTOK, DM, F.G, (int)blockIdx.x);
            pg8::EpiResid E{l == 0 ? x_in : nullptr, XB, modl + 2048};
            pg8::gemm_phase<pg8::EpiResid, pg8::StaticOrder, false, true, DM, DM, DM, 0>(F.lds, g, S, E, F.tid);
            SEAM(pb + 5);
        }
        if (EN(6) && IN(pb + 6)) { FRAME(); norm_phase(F, nullptr, XB, nullptr, false, nullptr, GIN(5) + l * DM, modl + 3072, modl + 4096, HB, nullptr); SEAM(pb + 6); }
        if (EN(7) && IN(pb + 7)) { FRAME();
            pg8::Gemm g{HB, (const bf16_t*)(wb + W_RT), nullptr}; pg8::StaticOrder S; S.init(MTOK, 256, F.G, (int)blockIdx.x);
            pg8::EpiRoute E{GIN(18) + l * 4, GIN(20) + l * 32, F.ctl + CW_ECNT + 64 * l, (int*)(F.ws + WS_LIST), (int*)(F.ws + WS_TOKES), (float*)(F.ws + WS_TOKW)};
            pg8::gemm_phase<pg8::EpiRoute, pg8::StaticOrder, false, false, DM, DM, DM, 0, false, true>(F.lds, g, S, E, F.tid);
            FILLER(FILL_A, FILL_B, 128);
            SEAM(pb + 7);
        }
        if (EN(8) && IN(pb + 8)) { FRAME();
            load_moe_tables(F, l);
            pg8::Gemm g{HB, (const bf16_t*)(wb + W_E13), (const int*)(F.ws + WS_LIST)};
            pg8::MoeOrder S{F.G, (int)blockIdx.x, 1, (const LAS int*)(F.lds + LC_TEND), (const LAS int*)(F.lds + LC_CNT)};
            pg8::EpiExp1 E{(bf16_t*)(F.ws + WS_HS)};
            for (int rep = 0; rep < REP_G5; ++rep) pg8::gemm_phase<pg8::EpiExp1, pg8::MoeOrder, true, true, DM, DM, DM, 512>(F.lds, g, S, E, F.tid);
            FILLER(FILL_B, FILL_C, 64);
            SEAM(pb + 8);
        }
        if (EN(9) && IN(pb + 9)) { FRAME();
            load_moe_tables(F, l);
            pg8::Gemm g{(const bf16_t*)(F.ws + WS_HS), (const bf16_t*)(wb + W_E2), nullptr};
            pg8::MoeOrder S{F.G, (int)blockIdx.x, 2, (const LAS int*)(F.lds + LC_TEND), (const LAS int*)(F.lds + LC_CNT)};
            pg8::EpiStore E{(bf16_t*)(F.ws + WS_YS), DM};
            for (int rep = 0; rep < REP_G6; ++rep) pg8::gemm_phase<pg8::EpiStore, pg8::MoeOrder, false, true, 256, 256, 256, DM>(F.lds, g, S, E, F.tid);
            FILLER(FILL_C, FILL_END, 64);
            SEAM(pb + 9);
        }
    }
    if (EN(12) && IN(N_PHASES - 1)) { const int l = DEPTH - 1; FRAME();
        load_moe_tables(F, DEPTH - 1);
        norm_phase(F, nullptr, XB, nullptr, true, modl + 5120, GIN(24), nullptr, nullptr, nullptr, F.out);
    }
#undef IN
#undef SEAM
}

#ifndef MK_LAUNCH_PER_PHASE
#define MK_LAUNCH_PER_PHASE 0
#endif
extern "C" void kernel_launch(void* const* d_in, const int* in_sizes, int n_in, void* d_out, int out_size, void* d_ws, size_t ws_size, hipStream_t stream) {
    static int grid = 0;
    if (grid == 0) {
        int dev = 0, cus = 0;
        if (n_in != 25 || ws_size < WS_END4 || hipGetDevice(&dev) != hipSuccess || hipDeviceGetAttribute(&cus, hipDeviceAttributeMultiprocessorCount, dev) != hipSuccess) { grid = -1; return; }
        if (hipFuncSetAttribute((const void*)mk_fwd, hipFuncAttributeMaxDynamicSharedMemorySize, LDS_BYTES) != hipSuccess) { grid = -1; return; }
        grid = cus;
    }
    if (grid < 0) return;
    (void)hipMemsetAsync((char*)d_ws + WS_CTL, 0, CTL_ZERO_BYTES, stream);
    Args a{};
    for (int i = 0; i < 25; ++i) a.in[i] = (const float*)d_in[i];
    a.out = (float*)d_out; a.ws = (unsigned char*)d_ws;
#if MK_LAUNCH_PER_PHASE
#ifndef PH_MAX
#define PH_MAX N_PHASES
#endif
    for (int p = 0; p < PH_MAX; ++p) { a.ph_lo = p; a.ph_hi = p + 1; hipLaunchKernelGGL(mk_fwd, dim3(grid), dim3(NWAVES * 64), LDS_BYTES, stream, a); }
#else
    a.ph_lo = 0; a.ph_hi = N_PHASES;
    hipLaunchKernelGGL(mk_fwd, dim3(grid), dim3(NWAVES * 64), LDS_BYTES, stream, a);
#endif
}
```

```cpp
#include <hip/hip_runtime.h>
#include <hip/hip_bf16.h>
#include <cstdio>
#include <cstdint>

#define GAS __attribute__((address_space(1)))
#define LAS __attribute__((address_space(3)))
typedef unsigned short bf16_t;
typedef short bf16x8 __attribute__((ext_vector_type(8)));
typedef short s16x4 __attribute__((ext_vector_type(4)));
typedef float f32x2 __attribute__((ext_vector_type(2)));
typedef float f32x4 __attribute__((ext_vector_type(4)));
typedef float f32x16 __attribute__((ext_vector_type(16)));
typedef unsigned u32x2 __attribute__((ext_vector_type(2)));
typedef unsigned u32x4 __attribute__((ext_vector_type(4)));
typedef __bf16 bf16x2_t __attribute__((ext_vector_type(2)));

constexpr int NB = 8, SEQ = 4096, DM = 1024, DEPTH = 4, MTOK = NB * SEQ;
constexpr int NPROJ = 6400;
constexpr int LDP = 2304;
constexpr size_t GATE_BASE = (size_t)NB * SEQ * LDP * 2;
__device__ __forceinline__ size_t gate_off(int pm, int g, int wid, int ai, int lane) { return GATE_BASE + ((((size_t)(pm * 16 + g) * 8 + wid) * 2 + ai) * 64 + lane) * 64; }
constexpr int PC_NAQ = 0, PC_NAK = 256, PC_NAV = 512, PC_WQ = 768, PC_WK = 1024, PC_WV = 1152, PC_AXQ = 1280, PC_AXK = 1536, PC_AXV = 1664,
              PC_CQ = 1792, PC_CKV = 1984, PC_KR = 2240, PC_GATE = 2304, PC_YC = 1792;
constexpr int NEXP = 32, LISTCAP = 32768, SORTROWS = 2 * MTOK + NEXP * 256;
constexpr float LOG2E = 1.4426950408889634f;
constexpr float EPS = 1e-6f;

__device__ __forceinline__ unsigned cvt_pk_bf16(float lo, float hi) { f32x2 v = {lo, hi}; bf16x2_t b = __builtin_convertvector(v, bf16x2_t); return __builtin_bit_cast(unsigned, b); }
__device__ __forceinline__ float bf2f(unsigned short b) { return __uint_as_float(((unsigned)b) << 16); }
__device__ __forceinline__ float bflo(unsigned w) { return __uint_as_float(w << 16); }
__device__ __forceinline__ float bfhi(unsigned w) { return __uint_as_float(w & 0xffff0000u); }
__device__ __forceinline__ unsigned short f2bf(float f) { return (unsigned short)(cvt_pk_bf16(f, 0.f) & 0xffffu); }
__device__ __forceinline__ int lane_now() { int l; asm volatile("v_mbcnt_lo_u32_b32 %0, -1, 0\n\tv_mbcnt_hi_u32_b32 %0, -1, %0" : "=v"(l)); return l; }
template <int MASK> __device__ __forceinline__ float xshfl(float v) {
    if constexpr (MASK == 32) { auto rr = __builtin_amdgcn_permlane32_swap(__float_as_uint(v), __float_as_uint(v), false, false); return __uint_as_float((lane_now() & 32) ? rr[0] : rr[1]); }
    else return __uint_as_float((unsigned)__builtin_amdgcn_ds_swizzle((int)__float_as_uint(v), (MASK << 10) | 0x1f));
}
__device__ __forceinline__ unsigned pk_fp8x4(float a, float b, float c, float d) { unsigned w = 0u; w = __builtin_amdgcn_cvt_pk_fp8_f32(a, b, w, false); w = __builtin_amdgcn_cvt_pk_fp8_f32(c, d, w, true); return w; }
__device__ __forceinline__ float fast_sigmoid(float x) { return __builtin_amdgcn_rcpf(1.0f + __builtin_amdgcn_exp2f(-x * LOG2E)); }

namespace pg8 {
constexpr int BM = 256, BK = 64, HALF = 128, HTB = HALF * BK * 2, STAGE_BYTES = 8 * HTB, NXCD = 8, WGM = 8;

__host__ __device__ __forceinline__ int lds_byte(int r, int c) { const int st = (r >> 4) * 2 + (c >> 5), rr = r & 15, cc = c & 31, ob = rr * 64 + cc * 2; return st * 1024 + (ob ^ (((ob >> 9) & 1) << 5)); }
__host__ __device__ __forceinline__ void stage_rc(int b, int& R, int& C) { const int st = b / 1024, sb = b % 1024, swz = sb ^ (((sb >> 9) & 1) << 5); R = (st >> 1) * 16 + swz / 64; C = (st & 1) * 32 + (swz % 64) / 2; }
__host__ __device__ __forceinline__ int perm32(int rho) { const int n = rho >> 4, i = rho & 15; return 8 * (i >> 2) + 4 * n + (i & 3); }

typedef int i32x4 __attribute__((ext_vector_type(4)));
typedef int i32x8 __attribute__((ext_vector_type(8)));
struct Unit { int pm, pn, e, acol, lbase, nv; };
struct Gemm { const bf16_t* A; const bf16_t* Bt; const int* list; };

struct StaticOrder {
    int nM, nN, nwg, G, c, skew;
    __device__ __forceinline__ void init(int M, int N, int G_, int c_, int skew_ = 0) { nM = M / BM; nN = N / BM; nwg = nM * nN; G = G_; c = c_; skew = (skew_ && nwg % G_ == 0 && G_ % 16 == 0 && nwg >= 2 * G_) ? 1 : 0; }
    __device__ __forceinline__ bool next(int i, Unit& u) const {
        long L = (long)i * G + c;
        if (skew) { const int R = nwg / G; if (i >= R - 1) { const int k = i - (R - 1); if (c < G / 2 || k >= 2) return false; L = (long)(R - 1) * G + k * (G / 2) + (c - G / 2); } }
        if (L >= nwg) return false;
        int wgid = (int)L; { const int q = nwg / NXCD, r = nwg % NXCD, xcd = wgid % NXCD, off = wgid / NXCD; wgid = (xcd < r ? xcd * (q + 1) : r * (q + 1) + (xcd - r) * q) + off; }
        const int nig = WGM * nN, gid = wgid / nig, fm = gid * WGM, gsz = (nM - fm) < WGM ? (nM - fm) : WGM;
        u.pm = fm + ((wgid % nig) % gsz); u.pn = (wgid % nig) / gsz; u.e = 0; u.acol = 0; u.lbase = 0; u.nv = 256; return true;
    }
};

template <bool GATHER, int LDA>
__device__ __forceinline__ void a_offsets(const Gemm& g, const Unit& u, const int (&Rr)[2], const unsigned (&Cb)[2], unsigned (&vo)[2][2]) {
#pragma unroll
    for (int h = 0; h < 2; ++h)
#pragma unroll
        for (int i = 0; i < 2; ++i) {
            if constexpr (GATHER) {
                int idx = h * HALF + Rr[i]; idx = idx < u.nv ? idx : (u.nv - 1);
                const int row = g.list[u.lbase + idx];
                vo[h][i] = (unsigned)row * (unsigned)(LDA * 2) + Cb[i];
            } else {
                vo[h][i] = (unsigned)(h * HALF + Rr[i]) * (unsigned)(LDA * 2) + Cb[i];
            }
        }
}

template <class Epi, class Sched, bool GATHER, bool ALIGN_EPI, int LDA, int LDB, int KK, int NBE, bool F8 = false, bool NARROW = false>
__device__ __forceinline__ void gemm_phase(LAS unsigned char* lds, const Gemm g, const Sched& S, const Epi& E, int tid) {
    asm volatile("" : "+v"(tid));
    const int wid = __builtin_amdgcn_readfirstlane(tid >> 6), lane = tid & 63, wr = wid >> 2, wc = wid & 3, fr = lane & 15, fq = lane >> 4;
    constexpr int nt = KK / BK;
    int Rr[2]; unsigned Cb[2]; unsigned voffB[2];
#pragma unroll
    for (int i = 0; i < 2; ++i) { int R, C; stage_rc(tid * 16 + i * 8192, R, C); const int Rb = Epi::PERM ? ((R & ~31) + perm32(R & 31)) : R;
        Rr[i] = R; Cb[i] = (unsigned)C * 2u; voffB[i] = (unsigned)(Rb * LDB + C) * 2u; }
    const size_t kstep = (size_t)(BK * 2);
    constexpr size_t hstepB = (size_t)HALF * LDB * 2, hstepA = (size_t)HALF * LDA * 2;
    const unsigned ldsw = (unsigned)wid * 1024u;
    const int aoff = lds_byte(wr * 64 + fr, fq * 8), boff = lds_byte(wc * 32 + fr, fq * 8);
#define PG8_SA(b, h) (((b) * 2 + (h)) * HTB)
#define PG8_SB(b, h) ((4 + (b) * 2 + (h)) * HTB)
#define PG8_STAGE(bufoff, gbase, voff) do { _Pragma("unroll") for (int _i = 0; _i < 2; ++_i) \
        __builtin_amdgcn_global_load_lds((const unsigned*)((const char*)(gbase) + (voff)[_i]), (LAS unsigned*)(lds + (bufoff) + ldsw + _i * 8192), 16, 0, 0); } while (0)
#define PG8_LDA(dst, b, h) do { _Pragma("unroll") for (int m = 0; m < 4; ++m) { if constexpr (F8) { dst##8[m].lo = *(const LAS i32x4*)(lds + PG8_SA(b, h) + aoff + m * 2048); dst##8[m].hi = *(const LAS i32x4*)(lds + PG8_SA(b, h) + aoff + m * 2048 + 1024); } \
        else { _Pragma("unroll") for (int k = 0; k < 2; ++k) dst[m][k] = *(const LAS bf16x8*)(lds + PG8_SA(b, h) + aoff + m * 2048 + k * 1024); } } } while (0)
#define PG8_LDB(dst, b, h) do { _Pragma("unroll") for (int n = 0; n < 2; ++n) { if constexpr (F8) { dst##8[n].lo = *(const LAS i32x4*)(lds + PG8_SB(b, h) + boff + n * 2048); dst##8[n].hi = *(const LAS i32x4*)(lds + PG8_SB(b, h) + boff + n * 2048 + 1024); } \
        else { _Pragma("unroll") for (int k = 0; k < 2; ++k) dst[n][k] = *(const LAS bf16x8*)(lds + PG8_SB(b, h) + boff + n * 2048 + k * 1024); } } } while (0)
#define PG8_MMA(ai, bj, At, Bt) do { __builtin_amdgcn_s_setprio(1); _Pragma("unroll") for (int m = 0; m < 4; ++m) _Pragma("unroll") for (int n = 0; n < 2; ++n) { \
        if constexpr (F8) { asm volatile("v_mfma_scale_f32_16x16x128_f8f6f4 %0, %1, %2, %0, %3, %3 op_sel_hi:[0,0,0]" : "+v"(acc[ai][bj][m][n]) : "v"(Bt##8[n]), "v"(At##8[m]), "v"(sc127)); }   \
        else { _Pragma("unroll") for (int k = 0; k < 2; ++k) acc[ai][bj][m][n] = __builtin_amdgcn_mfma_f32_16x16x32_bf16(Bt[n][k], At[m][k], acc[ai][bj][m][n], 0, 0, 0); } } \
        __builtin_amdgcn_s_setprio(0); } while (0)
#define PG8_WAIT_V(n) asm volatile("s_waitcnt vmcnt(" #n ")" ::: "memory")
#define PG8_WAIT_L(n) asm volatile("s_waitcnt lgkmcnt(" #n ")" ::: "memory")
#define PG8_BAR __builtin_amdgcn_s_barrier()
#define PG8_SCHED __builtin_amdgcn_sched_barrier(0)
#define PG8_STAGE_A(bufoff, gbase, vo, h) do { if constexpr (GATHER) { PG8_STAGE(bufoff, gbase, (vo)[h]); } else { PG8_STAGE(bufoff, (gbase) + (h) * hstepA, (vo)[0]); } } while (0)
#define PG8_ABASE(u) (GATHER ? (size_t)0 : ((size_t)(u).pm * BM * LDA + (size_t)(u).acol) * 2)
#define PG8_BBASE(u) (((size_t)(u).e * NBE + (size_t)(u).pn * BM) * LDB * 2)
    Unit cur, nxt; int ui = 0;
    if (!S.next(0, cur)) return;
    f32x4 acc[2][2][4][2];
#pragma unroll
    for (int a = 0; a < 2; ++a)
#pragma unroll
        for (int b = 0; b < 2; ++b)
#pragma unroll
            for (int m = 0; m < 4; ++m)
#pragma unroll
                for (int n = 0; n < 2; ++n) acc[a][b][m][n] = (f32x4){0.f, 0.f, 0.f, 0.f};
    bf16x8 At[4][2], B0[2][2], B1[2][2];
    i32x8 At8[4], B08[2], B18[2];
    int sc127 = 127; asm volatile("" : "+v"(sc127)); (void)sc127;
    (void)At; (void)B0; (void)B1; (void)At8; (void)B08; (void)B18;
    unsigned voA[2][2];
    a_offsets<GATHER, LDA>(g, cur, Rr, Cb, voA);
    if constexpr (GATHER) { asm volatile("s_waitcnt vmcnt(0)" ::: "memory"); }
    const char* Ab = (const char*)g.A; const char* Bb = (const char*)g.Bt; asm volatile("" : "+s"(Ab), "+s"(Bb)); Ab = (const char*)(const GAS char*)Ab; Bb = (const char*)(const GAS char*)Bb;
    const char* cA = Ab + PG8_ABASE(cur); const char* cB = Bb + PG8_BBASE(cur);
    PG8_STAGE(PG8_SB(0, 0), cB, voffB); PG8_STAGE(PG8_SB(0, 1), cB + hstepB, voffB); PG8_STAGE_A(PG8_SA(0, 0), cA, voA, 0); PG8_STAGE_A(PG8_SA(0, 1), cA, voA, 1);
    if (wr == 1) PG8_BAR;
    PG8_WAIT_V(2); PG8_BAR;
    PG8_STAGE(PG8_SB(1, 0), cB + kstep, voffB); PG8_STAGE_A(PG8_SA(1, 0), cA + kstep, voA, 0); PG8_STAGE(PG8_SB(1, 1), cB + hstepB + kstep, voffB);
    PG8_WAIT_V(6); PG8_BAR;
    for (;;) {
        const bool has_next = S.next(ui + 1, nxt);
        const char* nA = has_next ? Ab + PG8_ABASE(nxt) : cA; const char* nB = has_next ? Bb + PG8_BBASE(nxt) : cB;
#pragma unroll 1
        for (int t = 0; t < nt; t += 2) {
            const bool last = (t == nt - 2);
            const char* a1 = cA + (size_t)(t + 1) * kstep;
            const char* a2 = last ? nA : cA + (size_t)(t + 2) * kstep; const char* b2 = last ? nB : cB + (size_t)(t + 2) * kstep;
            const char* a3 = a2 + kstep; const char* b3 = b2 + kstep;
            PG8_LDB(B0, 0, 0); if constexpr (!NARROW) { PG8_LDB(B1, 0, 1); } PG8_SCHED; PG8_LDA(At, 0, 0); PG8_STAGE_A(PG8_SA(1, 1), a1, voA, 1);
            if constexpr (GATHER) { if (last && has_next) { a_offsets<GATHER, LDA>(g, nxt, Rr, Cb, voA); asm volatile("s_waitcnt vmcnt(0)" ::: "memory"); } }
            PG8_WAIT_V(8); PG8_WAIT_L(0); PG8_BAR; if (!NARROW || wc < 2) { PG8_MMA(0, 0, At, B0); } if constexpr (!NARROW) { PG8_MMA(0, 1, At, B1); } PG8_BAR; PG8_SCHED;
            PG8_LDA(At, 0, 1); PG8_STAGE(PG8_SB(0, 0), b2, voffB); PG8_STAGE(PG8_SB(0, 1), b2 + hstepB, voffB); PG8_STAGE_A(PG8_SA(0, 0), a2, voA, 0);
            PG8_WAIT_V(8); PG8_WAIT_L(0); PG8_BAR; if (!NARROW || wc < 2) { PG8_MMA(1, 0, At, B0); } if constexpr (!NARROW) { PG8_MMA(1, 1, At, B1); } PG8_BAR; PG8_SCHED;
            PG8_LDB(B0, 1, 0); if constexpr (!NARROW) { PG8_LDB(B1, 1, 1); } PG8_SCHED; PG8_LDA(At, 1, 0); PG8_STAGE_A(PG8_SA(0, 1), a2, voA, 1);
            PG8_WAIT_V(8); PG8_WAIT_L(0); PG8_BAR; if (!NARROW || wc < 2) { PG8_MMA(0, 0, At, B0); } if constexpr (!NARROW) { PG8_MMA(0, 1, At, B1); } PG8_BAR; PG8_SCHED;
            PG8_LDA(At, 1, 1); PG8_STAGE(PG8_SB(1, 0), b3, voffB); PG8_STAGE(PG8_SB(1, 1), b3 + hstepB, voffB); PG8_STAGE_A(PG8_SA(1, 0), a3, voA, 0);
            PG8_WAIT_V(8); PG8_WAIT_L(0); PG8_BAR; if (!NARROW || wc < 2) { PG8_MMA(1, 0, At, B0); } if constexpr (!NARROW) { PG8_MMA(1, 1, At, B1); } PG8_BAR; PG8_SCHED;
        }
        if constexpr (F8) { asm volatile("s_nop 15\n\ts_nop 15\n\ts_nop 15" ::: "memory"); }
        if constexpr (ALIGN_EPI) { if (wr == 0) PG8_BAR; }
        if constexpr (!Epi::AFTER_DRAIN) { E(acc, cur, wr, wc, fr, fq); }
        if (!has_next) break;
#pragma unroll
        for (int a = 0; a < 2; ++a)
#pragma unroll
            for (int b = 0; b < 2; ++b)
#pragma unroll
                for (int m = 0; m < 4; ++m)
#pragma unroll
                    for (int n = 0; n < 2; ++n) acc[a][b][m][n] = (f32x4){0.f, 0.f, 0.f, 0.f};
        cur = nxt; cA = nA; cB = nB; ++ui;
        if constexpr (ALIGN_EPI) { if (wr == 1) PG8_BAR; }
    }
    PG8_WAIT_V(0);
    if constexpr (!ALIGN_EPI) { if (wr == 0) PG8_BAR; }
    PG8_BAR;
    if constexpr (Epi::AFTER_DRAIN) { E.fused(acc, cur, wr, wc, fr, fq, lds, wid, lane); }
#undef PG8_SA
#undef PG8_SB
#undef PG8_STAGE
#undef PG8_LDA
#undef PG8_LDB
#undef PG8_MMA
#undef PG8_WAIT_V
#undef PG8_WAIT_L
#undef PG8_BAR
#undef PG8_SCHED
#undef PG8_STAGE_A
#undef PG8_ABASE
#undef PG8_BBASE
}
}
namespace pg8 {
typedef f32x4 AccT[2][2][4][2];

__device__ __forceinline__ u32x4 pack8(const f32x4 v0, const f32x4 v1) {
    u32x4 w; w.x = cvt_pk_bf16(v0[0], v0[1]); w.y = cvt_pk_bf16(v0[2], v0[3]); w.z = cvt_pk_bf16(v1[0], v1[1]); w.w = cvt_pk_bf16(v1[2], v1[3]); return w;
}
__device__ __forceinline__ void unpack8(const u32x4 w, f32x4& v0, f32x4& v1) {
    v0 = (f32x4){bflo(w.x), bfhi(w.x), bflo(w.y), bfhi(w.y)}; v1 = (f32x4){bflo(w.z), bfhi(w.z), bflo(w.w), bfhi(w.w)};
}

constexpr float MERGE_WSCALE = 16.0f;
constexpr float GATE_WSCALE = 64.0f, GATE_WINV = 1.0f / 64.0f;
struct EpiProj {
    static constexpr bool PERM = true, AFTER_DRAIN = false;
    bf16_t* O; LAS float* xch; float* ssq; const float* cs; bf16_t* KC; const float* gaq; const float* gak; int pn0;
    __device__ __forceinline__ void operator()(const AccT& acc, const Unit& u_, int wr, int wc, int fr, int fq) const {
        Unit u = u_; u.pn += pn0;
        const bool gate = u.pn >= 9;
        const float qs = (u.pn == 0 || u.pn == 3) ? 0.125f * LOG2E : 1.0f;
        const int row0 = u.pm * BM + wr * 64 + fr, col0 = u.pn * BM + wc * 32 + 8 * fq;
        if (gate) {
            int lx = fq * 16 + fr; asm volatile("" : "+v"(lx));
            unsigned char* gt = (unsigned char*)O + gate_off(u.pm, u.pn - 9, wr * 4 + wc, 0, lx);
#pragma unroll
            for (int ai = 0; ai < 2; ++ai)
#pragma unroll
                for (int m = 0; m < 4; ++m) { u32x4 w4;
#pragma unroll
                    for (int bj = 0; bj < 2; ++bj) { const f32x4 v0 = acc[ai][bj][m][0], v1 = acc[ai][bj][m][1]; unsigned q[8];
#pragma unroll
                        for (int j = 0; j < 4; ++j) {
                            q[j] = (unsigned)fmaxf(__builtin_amdgcn_rcpf(1.0f + __builtin_amdgcn_exp2f(v0[j] * GATE_WINV)) * 255.0f + 0.5f, 1.0f); q[4 + j] = (unsigned)fmaxf(__builtin_amdgcn_rcpf(1.0f + __builtin_amdgcn_exp2f(v1[j] * GATE_WINV)) * 255.0f + 0.5f, 1.0f); }
                        const unsigned lo = q[0] | (q[1] << 8) | (q[2] << 16) | (q[3] << 24), hi = q[4] | (q[5] << 8) | (q[6] << 16) | (q[7] << 24);
                        if (bj == 0) { w4.x = lo; w4.y = hi; } else { w4.z = lo; w4.w = hi; } }
                    *(GAS u32x4*)(gt + ai * 4096 + m * 16) = w4; }
        } else if (u.pn == 5 || u.pn == 6) {
            const bool isq = u.pn == 5;
            int frx = fr; asm volatile("" : "+v"(frx));
#pragma unroll
            for (int ai = 0; ai < 2; ++ai)
#pragma unroll
                for (int m = 0; m < 4; ++m)
#pragma unroll
                    for (int bj = 0; bj < 2; ++bj) { const f32x4 v0 = acc[ai][bj][m][0], v1 = acc[ai][bj][m][1];
                        float p = (v0[0] * v0[0] + v0[1] * v0[1]) + (v0[2] * v0[2] + v0[3] * v0[3]) + (v1[0] * v1[0] + v1[1] * v1[1]) + (v1[2] * v1[2] + v1[3] * v1[3]);
                        p += xshfl<16>(p); p += xshfl<32>(p);
                        if (fq == 0 && (isq || bj == 0)) xch[(ai * HALF + wr * 64 + m * 16 + frx) * 8 + 4 * bj + wc] = p; }
            asm volatile("s_waitcnt lgkmcnt(0)\n\ts_barrier" ::: "memory");
            const int hf = wc & 1;
            f32x4 g0, g1;
            { const float* G = (isq ? gaq : gak) + 32 * hf + 4 * fq; g0 = *(const GAS f32x4*)G; g1 = *(const GAS f32x4*)(G + 16); }
#pragma unroll
            for (int ai = 0; ai < 2; ++ai) {
                f32x4 c4[4], s4[4];
#pragma unroll
                for (int m = 0; m < 4; ++m) { const int pos = (u.pm * BM + ai * HALF + wr * 64 + m * 16 + frx) & (SEQ - 1); const int idx = hf ? (pos & 63) : (pos >> 6);
                    c4[m] = *(const GAS f32x4*)(cs + idx * 16 + 4 * fq); s4[m] = *(const GAS f32x4*)(cs + SEQ * 16 + idx * 16 + 4 * fq); }
#pragma unroll
                for (int m = 0; m < 4; ++m) { const int rl = ai * HALF + wr * 64 + m * 16 + frx, row = u.pm * BM + rl;
                    bf16_t* rowp = O + (size_t)row * LDP + col0;
#pragma unroll
                    for (int bj = 0; bj < 2; ++bj) { f32x4 v0 = acc[ai][bj][m][0], v1 = acc[ai][bj][m][1];
                        if (isq || bj == 0) {
                            const f32x2 pr_ = *(const LAS f32x2*)(xch + rl * 8 + ((4 * bj + wc) & ~1)); const float tot = pr_.x + pr_.y;
                            const float rstd = rsqrtf(tot * (1.0f / 64.0f) + EPS) * (isq ? 0.125f * LOG2E : 1.0f);
                            v0 = v0 * rstd * g0; v1 = v1 * rstd * g1;
                            const f32x4 o0 = v0 * c4[m] - v1 * s4[m], o1 = v0 * s4[m] + v1 * c4[m]; v0 = o0; v1 = o1; }
                        *(GAS u32x4*)(rowp + bj * HALF) = pack8(v0, v1); } }
                asm volatile("" ::: "memory"); }
        } else if (u.pn == 7 || u.pn == 8) {
#pragma unroll
            for (int ai = 0; ai < 2; ++ai)
#pragma unroll
                for (int m = 0; m < 4; ++m) { const int row = row0 + ai * HALF + m * 16; bf16_t* rowp = O + (size_t)row * LDP + col0;
#pragma unroll
                    for (int bj = 0; bj < 2; ++bj) { const f32x4 v0 = acc[ai][bj][m][0], v1 = acc[ai][bj][m][1];
                        *(GAS u32x4*)(rowp + bj * HALF) = pack8(v0, v1);
                        const int lc = 128 * bj + 32 * wc;
                        const int grp = lc >> 5;
                        const int slot = (u.pn == 7) ? (grp < 6 ? grp : 8 + (grp - 6)) : (grp < 6 ? 10 + grp : -1);
                        if (slot >= 0) {
                            float p = (v0[0] * v0[0] + v0[1] * v0[1]) + (v0[2] * v0[2] + v0[3] * v0[3]) + (v1[0] * v1[0] + v1[1] * v1[1]) + (v1[2] * v1[2] + v1[3] * v1[3]);
                            p += xshfl<16>(p); p += xshfl<32>(p);
                            if (fq == 0) ssq[(size_t)row * 16 + slot] = p;
                        } else if (lc == 192) {
                            const int pos = row & (SEQ - 1);
                            const f32x4 c4 = *(const GAS f32x4*)(cs + pos * 16 + 4 * fq), s4 = *(const GAS f32x4*)(cs + SEQ * 16 + pos * 16 + 4 * fq);
                            const u32x4 w = pack8(v0 * c4 - v1 * s4, v0 * s4 + v1 * c4);
                            bf16_t* kr = KC + (size_t)row * 384 + 64 + 8 * fq;
#pragma unroll
                            for (int h = 0; h < 4; ++h) *(GAS u32x4*)(kr + 96 * h) = w;
                        } } }
        } else {
#pragma unroll
            for (int ai = 0; ai < 2; ++ai)
#pragma unroll
                for (int m = 0; m < 4; ++m) { bf16_t* rowp = O + (size_t)(row0 + ai * HALF + m * 16) * LDP + col0;
#pragma unroll
                    for (int bj = 0; bj < 2; ++bj) *(GAS u32x4*)(rowp + bj * HALF) = pack8(acc[ai][bj][m][0] * qs, acc[ai][bj][m][1] * qs); }
        }
    }
};

struct EpiNone {
    static constexpr bool PERM = true, AFTER_DRAIN = false;
    float* sink;
    __device__ __forceinline__ void operator()(const AccT& acc, const Unit& u, int wr, int wc, int fr, int fq) const {
        float s = 0.f;
#pragma unroll
        for (int ai = 0; ai < 2; ++ai)
#pragma unroll
            for (int bj = 0; bj < 2; ++bj)
#pragma unroll
                for (int m = 0; m < 4; ++m) s += acc[ai][bj][m][0][0] + acc[ai][bj][m][1][3];
        if (s == 1.2345e30f) sink[0] = s;
    }
};

struct EpiQup {
    static constexpr bool PERM = true, AFTER_DRAIN = false;
    bf16_t* QC; const float* cs; const float* ssq;
    __device__ __forceinline__ void operator()(const AccT& acc, const Unit& u, int wr, int wc, int fr, int fq) const {
        int frx = fr; asm volatile("" : "+v"(frx));
        const int row0 = u.pm * BM + wr * 64 + frx;
        float rs[2][4];
        { f32x4 sa_[2][4]; f32x2 sb_[2][4];
#pragma unroll
          for (int ai = 0; ai < 2; ++ai)
#pragma unroll
              for (int m = 0; m < 4; ++m) { const float* sp = ssq + (size_t)(row0 + ai * HALF + m * 16) * 16; sa_[ai][m] = *(const GAS f32x4*)sp; sb_[ai][m] = *(const GAS f32x2*)(sp + 4); }
#pragma unroll
          for (int ai = 0; ai < 2; ++ai)
#pragma unroll
              for (int m = 0; m < 4; ++m) rs[ai][m] = rsqrtf((((sa_[ai][m][0] + sa_[ai][m][1]) + (sa_[ai][m][2] + sa_[ai][m][3])) + (sb_[ai][m][0] + sb_[ai][m][1])) * (1.0f / 192.0f) + EPS) * (0.10206207261596575f * LOG2E); }
#pragma unroll
        for (int bj = 0; bj < 2; ++bj) {
            const int gi = 8 * u.pn + 4 * bj + wc;
            if (gi >= 12) continue;
            const bool rope = (gi % 3) == 2;
            const int col = 32 * gi + 8 * fq;
#pragma unroll
            for (int ai = 0; ai < 2; ++ai) {
                f32x4 c4[4], s4[4];
                if (rope) {
#pragma unroll
                    for (int m = 0; m < 4; ++m) { const int pos = (row0 + ai * HALF + m * 16) & (SEQ - 1); c4[m] = *(const GAS f32x4*)(cs + pos * 16 + 4 * fq); s4[m] = *(const GAS f32x4*)(cs + SEQ * 16 + pos * 16 + 4 * fq); }
                }
#pragma unroll
                for (int m = 0; m < 4; ++m) { const int row = row0 + ai * HALF + m * 16; const float rs_ = rs[ai][m];
                    f32x4 v0 = acc[ai][bj][m][0] * rs_, v1 = acc[ai][bj][m][1] * rs_;
                    if (rope) { const f32x4 o1 = v0 * c4[m] - v1 * s4[m], o2 = v0 * s4[m] + v1 * c4[m]; v0 = o1; v1 = o2; }
                    *(GAS u32x4*)(QC + (size_t)row * 384 + col) = pack8(v0, v1); }
                asm volatile("" ::: "memory"); }
        }
    }
};

struct EpiKVup {
    static constexpr bool PERM = true, AFTER_DRAIN = false;
    bf16_t* KC; bf16_t* VC; const float* ssq;
    __device__ __forceinline__ void operator()(const AccT& acc, const Unit& u, int wr, int wc, int fr, int fq) const {
        int frx = fr; asm volatile("" : "+v"(frx));
        const int row0 = u.pm * BM + wr * 64 + frx;
        float rs[2][4];
        { f32x4 sa_[2][4], sb_[2][4];
#pragma unroll
          for (int ai = 0; ai < 2; ++ai)
#pragma unroll
              for (int m = 0; m < 4; ++m) { const float* sp = ssq + (size_t)(row0 + ai * HALF + m * 16) * 16 + 8; sa_[ai][m] = *(const GAS f32x4*)sp; sb_[ai][m] = *(const GAS f32x4*)(sp + 4); }
#pragma unroll
          for (int ai = 0; ai < 2; ++ai)
#pragma unroll
              for (int m = 0; m < 4; ++m) rs[ai][m] = rsqrtf((((sa_[ai][m][0] + sa_[ai][m][1]) + (sa_[ai][m][2] + sa_[ai][m][3])) + ((sb_[ai][m][0] + sb_[ai][m][1]) + (sb_[ai][m][2] + sb_[ai][m][3]))) * (1.0f / 256.0f) + EPS); }
#pragma unroll
        for (int bj = 0; bj < 2; ++bj) {
            const int col = 128 * bj + 32 * wc + 8 * fq;
            bf16_t* base = (u.pn == 0) ? KC : VC; const int ld = (u.pn == 0) ? 384 : 256; const int coff = (u.pn == 0) ? (96 * (col >> 6) + (col & 63)) : col;
#pragma unroll
            for (int ai = 0; ai < 2; ++ai)
#pragma unroll
                for (int m = 0; m < 4; ++m) { const int row = row0 + ai * HALF + m * 16; const float rs_ = rs[ai][m];
                    *(GAS u32x4*)(base + (size_t)row * ld + coff) = pack8(acc[ai][bj][m][0] * rs_, acc[ai][bj][m][1] * rs_); }
        }
    }
};

struct EpiMerge {
    static constexpr bool PERM = true, AFTER_DRAIN = false;
    const bf16_t* P; bf16_t* HB;
    __device__ __forceinline__ void operator()(const AccT& acc, const Unit& u, int wr, int wc, int fr, int fq) const {
        const int row0 = u.pm * BM + wr * 64 + fr, col0 = u.pn * BM + wc * 32 + 8 * fq, n = u.e;
#pragma unroll
        for (int ai = 0; ai < 2; ++ai) {
            u32x2 gw[4][2]; u32x4 ow[4][2];
#pragma unroll
            for (int m = 0; m < 4; ++m)
#pragma unroll
                for (int bj = 0; bj < 2; ++bj) { const int row = row0 + ai * HALF + m * 16, col = col0 + bj * HALF;
                    gw[m][bj] = *(const GAS u32x2*)((const unsigned char*)(P + (size_t)row * LDP + PC_GATE) + 1024 * n + col);
                    if (n > 0) ow[m][bj] = *(const GAS u32x4*)(HB + (size_t)row * DM + col); else ow[m][bj] = (u32x4){0u, 0u, 0u, 0u}; }
#pragma unroll
            for (int m = 0; m < 4; ++m)
#pragma unroll
                for (int bj = 0; bj < 2; ++bj) { const int row = row0 + ai * HALF + m * 16, col = col0 + bj * HALF;
                    const unsigned ga = gw[m][bj].x, gb = gw[m][bj].y; constexpr float K = 1.0f / 255.0f;
                    const f32x4 g0 = (f32x4){(float)(ga & 0xffu), (float)((ga >> 8) & 0xffu), (float)((ga >> 16) & 0xffu), (float)(ga >> 24)} * K;
                    const f32x4 g1 = (f32x4){(float)(gb & 0xffu), (float)((gb >> 8) & 0xffu), (float)((gb >> 16) & 0xffu), (float)(gb >> 24)} * K;
                    f32x4 o0, o1; unpack8(ow[m][bj], o0, o1);
                    const f32x4 v0 = g0 * acc[ai][bj][m][0] + o0, v1 = g1 * acc[ai][bj][m][1] + o1;
                    *(GAS u32x4*)(HB + (size_t)row * DM + col) = pack8(v0, v1); }
            asm volatile("" ::: "memory");
        }
    }
};

struct EpiOut {
    static constexpr bool PERM = false, AFTER_DRAIN = false;
    const float* base; float* out; const float* gvec;
    __device__ __forceinline__ void operator()(const AccT& acc, const Unit& u, int wr, int wc, int fr, int fq) const {
        const int b = u.pm >> 4;
        const int row0 = u.pm * BM + wr * 64 + fr, col0 = u.pn * BM + wc * 32 + 4 * fq;
#pragma unroll
        for (int bj = 0; bj < 2; ++bj)
#pragma unroll
            for (int n = 0; n < 2; ++n) {
                const int col = col0 + bj * HALF + n * 16; const f32x4 gv = *(const GAS f32x4*)(gvec + b * 6144 + col);
                f32x4 bs[2][4];
#pragma unroll
                for (int ai = 0; ai < 2; ++ai)
#pragma unroll
                    for (int m = 0; m < 4; ++m) bs[ai][m] = *(const GAS f32x4*)(base + (size_t)(row0 + ai * HALF + m * 16) * DM + col);
#pragma unroll
                for (int ai = 0; ai < 2; ++ai)
#pragma unroll
                    for (int m = 0; m < 4; ++m) *(GAS f32x4*)(out + (size_t)(row0 + ai * HALF + m * 16) * DM + col) = bs[ai][m] + gv * acc[ai][bj][m][n];
                asm volatile("" ::: "memory");
            }
    }
};

struct EpiResid {
    static constexpr bool PERM = true, AFTER_DRAIN = false;
    const float* xf; bf16_t* XBo; const float* gvec; bf16_t* XBw;
    __device__ __forceinline__ void operator()(const AccT& acc, const Unit& u, int wr, int wc, int fr, int fq) const {
        const int b = u.pm >> 4;
        int frx = fr; asm volatile("" : "+v"(frx));
        const int row0 = u.pm * BM + wr * 64 + frx, col0 = u.pn * BM + wc * 32 + 8 * fq;
        if (!xf) {
            u32x4 xw[2][2][4];
#pragma unroll
            for (int bj = 0; bj < 2; ++bj)
#pragma unroll
                for (int ai = 0; ai < 2; ++ai)
#pragma unroll
                    for (int m = 0; m < 4; ++m) xw[bj][ai][m] = *(const GAS u32x4*)(XBo + (size_t)(row0 + ai * HALF + m * 16) * DM + col0 + bj * HALF);
#pragma unroll
            for (int bj = 0; bj < 2; ++bj) { const int col = col0 + bj * HALF;
                const f32x4 g0 = *(const GAS f32x4*)(gvec + b * 6144 + col), g1 = *(const GAS f32x4*)(gvec + b * 6144 + col + 4);
#pragma unroll
                for (int ai = 0; ai < 2; ++ai)
#pragma unroll
                    for (int m = 0; m < 4; ++m) { f32x4 x0, x1; unpack8(xw[bj][ai][m], x0, x1);
                        *(GAS u32x4*)(XBw + (size_t)(row0 + ai * HALF + m * 16) * DM + col) = pack8(x0 + acc[ai][bj][m][0] * g0, x1 + acc[ai][bj][m][1] * g1); } }
            return;
        }
#pragma unroll
        for (int bj = 0; bj < 2; ++bj) { const int col = col0 + bj * HALF;
            const f32x4 g0 = *(const GAS f32x4*)(gvec + b * 6144 + col), g1 = *(const GAS f32x4*)(gvec + b * 6144 + col + 4);
#pragma unroll
            for (int ai = 0; ai < 2; ++ai) {
                f32x4 x0[4], x1[4];
#pragma unroll
                for (int m = 0; m < 4; ++m) { const size_t off = (size_t)(row0 + ai * HALF + m * 16) * DM + col; x0[m] = *(const GAS f32x4*)(xf + off); x1[m] = *(const GAS f32x4*)(xf + off + 4); }
#pragma unroll
                for (int m = 0; m < 4; ++m) *(GAS u32x4*)(XBw + (size_t)(row0 + ai * HALF + m * 16) * DM + col) = pack8(x0[m] + acc[ai][bj][m][0] * g0, x1[m] + acc[ai][bj][m][1] * g1);
                asm volatile("" ::: "memory"); } }
    }
};

struct EpiRoute {
    static constexpr bool PERM = true, AFTER_DRAIN = true;
    const float* bg; const float* br; unsigned* ecnt; int* list; int* tok_es; float* tok_w;
    __device__ __forceinline__ void fused(const AccT& acc, const Unit& u, int wr, int wc, int fr, int fq, LAS unsigned char* lds, int wid, int lane) const {
        LAS float* LG = (LAS float*)lds;
        LAS unsigned* lcnt = (LAS unsigned*)(lds + 256 * 40 * 4);
        LAS unsigned* lbase = lcnt + 32;
        int tid = wid * 64 + lane; asm volatile("" : "+v"(tid));
        if (wc < 2) {
#pragma unroll
            for (int ai = 0; ai < 2; ++ai)
#pragma unroll
                for (int m = 0; m < 4; ++m) { const int rl = ai * HALF + wr * 64 + m * 16 + fr; const f32x4 v0 = acc[ai][0][m][0], v1 = acc[ai][0][m][1];
                    if (wc == 0) { *(LAS f32x4*)(LG + rl * 40 + 8 * fq) = v0; *(LAS f32x4*)(LG + rl * 40 + 8 * fq + 4) = v1; }
                    else if (fq == 0) { *(LAS f32x4*)(LG + rl * 40 + 32) = v0; } }
        }
        if (tid < 32) lcnt[tid] = 0u;
        __syncthreads();
        int e1 = 0, e2 = 0; unsigned r1 = 0, r2 = 0; float w1 = 0.f, w2 = 0.f;
        if (tid < 256) {
            const LAS float* lg = LG + tid * 40;
            float g[4];
#pragma unroll
            for (int j = 0; j < 4; ++j) g[j] = lg[j] + bg[j];
            int gs = 0; float gm = g[0];
#pragma unroll
            for (int j = 1; j < 4; ++j) if (g[j] > gm) { gm = g[j]; gs = j; }
            float gsum = 0.f;
#pragma unroll
            for (int j = 0; j < 4; ++j) gsum += __expf(g[j] - gm);
            const float gw = 1.0f / gsum;
            float el[8];
#pragma unroll
            for (int j = 0; j < 8; ++j) el[j] = lg[4 + 8 * gs + j] + br[8 * gs + j];
            int i1 = 0; float m1 = el[0];
#pragma unroll
            for (int j = 1; j < 8; ++j) if (el[j] > m1) { m1 = el[j]; i1 = j; }
            int i2 = -1; float m2 = 0.f;
#pragma unroll
            for (int j = 0; j < 8; ++j) if (j != i1 && (i2 < 0 || el[j] > m2)) { m2 = el[j]; i2 = j; }
            const float t = __expf(m2 - m1);
            w1 = gw / (1.0f + t); w2 = gw * t / (1.0f + t);
            e1 = 8 * gs + i1; e2 = 8 * gs + i2;
            r1 = atomicAdd((unsigned*)(lcnt + e1), 1u); r2 = atomicAdd((unsigned*)(lcnt + e2), 1u);
        }
        __syncthreads();
        if (tid < 32) lbase[tid] = __hip_atomic_fetch_add(ecnt + tid, lcnt[tid], __ATOMIC_RELAXED, __HIP_MEMORY_SCOPE_AGENT);
        __syncthreads();
        if (tid < 256) {
            const int token = u.pm * BM + tid;
            const int s1 = (int)(lbase[e1] + r1), s2 = (int)(lbase[e2] + r2);
            list[e1 * LISTCAP + s1] = token; list[e2 * LISTCAP + s2] = token;
            tok_es[2 * token] = (e1 << 16) | s1; tok_es[2 * token + 1] = (e2 << 16) | s2;
            tok_w[2 * token] = w1; tok_w[2 * token + 1] = w2;
        }
    }
};

struct EpiExp1 {
    static constexpr bool PERM = true, AFTER_DRAIN = false;
    bf16_t* HS;
    __device__ __forceinline__ void operator()(const AccT& acc, const Unit& u, int wr, int wc, int fr, int fq) const {
        const int row0 = u.pm * BM + wr * 64 + fr;
#pragma unroll
        for (int ai = 0; ai < 2; ++ai)
#pragma unroll
            for (int m = 0; m < 4; ++m) { bf16_t* rowp = HS + (size_t)(row0 + ai * HALF + m * 16) * 256;
#pragma unroll
                for (int bj = 0; bj < 2; ++bj) { const f32x4 a = acc[ai][bj][m][0], b = acc[ai][bj][m][1]; float h[4];
#pragma unroll
                    for (int j = 0; j < 4; ++j) h[j] = a[j] * fast_sigmoid(a[j]) * b[j];
                    u32x2 w; w.x = cvt_pk_bf16(h[0], h[1]); w.y = cvt_pk_bf16(h[2], h[3]);
                    *(GAS u32x2*)(rowp + u.pn * 128 + 64 * bj + 16 * wc + 4 * fq) = w; } }
    }
};

struct EpiStore {
    static constexpr bool PERM = true, AFTER_DRAIN = false;
    bf16_t* O; int ldc;
    __device__ __forceinline__ void operator()(const AccT& acc, const Unit& u, int wr, int wc, int fr, int fq) const {
        const int row0 = u.pm * BM + wr * 64 + fr, col0 = u.pn * BM + wc * 32 + 8 * fq;
#pragma unroll
        for (int ai = 0; ai < 2; ++ai)
#pragma unroll
            for (int m = 0; m < 4; ++m) { bf16_t* rowp = O + (size_t)(row0 + ai * HALF + m * 16) * ldc + col0;
#pragma unroll
                for (int bj = 0; bj < 2; ++bj) *(GAS u32x4*)(rowp + bj * HALF) = pack8(acc[ai][bj][m][0], acc[ai][bj][m][1]); }
    }
};

struct MergeOrder {
    int G, vc;
    __device__ bool next(int i, Unit& u) const {
        const int tile = vc + G * (i >> 2); if (tile >= (MTOK / BM) * (DM / BM)) return false;
        u.pm = tile >> 2; u.pn = tile & 3; u.e = i & 3; u.lbase = 0; u.nv = 256;
        u.acol = (u.e == 0) ? PC_NAQ : (u.e == 1) ? PC_WQ : (u.e == 2) ? PC_YC : PC_AXQ;
        return true;
    }
};

struct MoeOrder {
    int G, c, sh; const LAS int* tend; const LAS int* cnt;
    __device__ bool next(int i, Unit& u) const {
        const int L = i * G + c, tau = L >> sh;
        const int total = __builtin_amdgcn_readfirstlane(tend[NEXP - 1]);
        if (tau >= total) return false;
        int e = 0;
        while (e < NEXP - 1 && __builtin_amdgcn_readfirstlane(tend[e]) <= tau) ++e;
        const int ts = e ? __builtin_amdgcn_readfirstlane(tend[e - 1]) : 0, lt = tau - ts;
        int nv = __builtin_amdgcn_readfirstlane(cnt[e]) - 256 * lt; nv = nv > 256 ? 256 : nv;
        u.pm = tau; u.pn = L & ((1 << sh) - 1); u.e = e; u.acol = 0; u.lbase = e * LISTCAP + 256 * lt; u.nv = nv;
        return true;
    }
};
}
namespace pg8 {
struct MUnit { int pm, pn; };
__device__ __forceinline__ void merge_phase(LAS unsigned char* lds, const bf16_t* Pp, const bf16_t* Wbt, bf16_t* HBo, int G, int vc, int tid) {
    asm volatile("" : "+v"(tid));
    const int wid = __builtin_amdgcn_readfirstlane(tid >> 6), lane = tid & 63, wr = wid >> 2, wc = wid & 3, fr = lane & 15, fq = lane >> 4;
    constexpr int nt = 16, NU = (MTOK / 128) * (DM / 256);
    unsigned voffA[2], voffB[2];
#pragma unroll
    for (int i = 0; i < 2; ++i) { int R, C; stage_rc(tid * 16 + i * 8192, R, C); const int Rb = (R & ~31) + perm32(R & 31);
        voffA[i] = (unsigned)(R * LDP + C) * 2u; voffB[i] = (unsigned)(Rb * 256 + C) * 2u; }
    const unsigned ldsw = (unsigned)wid * 1024u;
    const int aoff = lds_byte(wr * 64 + fr, fq * 8), boff = lds_byte(wc * 32 + fr, fq * 8);
#define MG_SA(b) (((b) * 2) * HTB)
#define MG_SB(b, h) ((4 + (b) * 2 + (h)) * HTB)
#define MG_STAGE(bufoff, gbase, voff) do { _Pragma("unroll") for (int _i = 0; _i < 2; ++_i) \
        __builtin_amdgcn_global_load_lds((const unsigned*)((const char*)(gbase) + (voff)[_i]), (LAS unsigned*)(lds + (bufoff) + ldsw + _i * 8192), 16, 0, 0); } while (0)
#define MG_LDA(dst, b) do { _Pragma("unroll") for (int m = 0; m < 4; ++m) _Pragma("unroll") for (int k = 0; k < 2; ++k) dst[m][k] = *(const LAS bf16x8*)(lds + MG_SA(b) + aoff + m * 2048 + k * 1024); } while (0)
#define MG_LDB(dst, b, h) do { _Pragma("unroll") for (int n = 0; n < 2; ++n) _Pragma("unroll") for (int k = 0; k < 2; ++k) dst[n][k] = *(const LAS bf16x8*)(lds + MG_SB(b, h) + boff + n * 2048 + k * 1024); } while (0)
#define MG_MMA(bj, At, Bt) do { __builtin_amdgcn_s_setprio(1); _Pragma("unroll") for (int m = 0; m < 4; ++m) _Pragma("unroll") for (int n = 0; n < 2; ++n) _Pragma("unroll") for (int k = 0; k < 2; ++k) \
        acc[bj][m][n] = __builtin_amdgcn_mfma_f32_16x16x32_bf16(Bt[n][k], At[m][k], acc[bj][m][n], 0, 0, 0); __builtin_amdgcn_s_setprio(0); } while (0)
#define MG_WAIT_V(n) asm volatile("s_waitcnt vmcnt(" #n ")" ::: "memory")
#define MG_WAIT_L(n) asm volatile("s_waitcnt lgkmcnt(" #n ")" ::: "memory")
#define MG_BAR __builtin_amdgcn_s_barrier()
#define MG_SCHED __builtin_amdgcn_sched_barrier(0)
    const char* Ab = (const char*)Pp; const char* Bb = (const char*)Wbt; asm volatile("" : "+s"(Ab), "+s"(Bb)); Ab = (const char*)(const GAS char*)Ab; Bb = (const char*)(const GAS char*)Bb;
#define MG_ACOL(n) ((n) == 0 ? PC_NAQ : (n) == 1 ? PC_WQ : (n) == 2 ? PC_YC : PC_AXQ)
#define MG_A(u, kt) (Ab + ((size_t)(u).pm * 128 * LDP + MG_ACOL((kt) >> 2) + ((kt) & 3) * 64) * 2)
#define MG_B(u, kt) (Bb + ((size_t)(((kt) >> 2) * DM + (u).pn * 256) * 256 + ((kt) & 3) * 64) * 2)
    constexpr size_t hstepB = (size_t)HALF * 256 * 2, kstep = 128;
    MUnit cur, nxt; int ui = 0;
    { const int idx = vc; if (idx >= NU) return; cur.pm = idx >> 2; cur.pn = idx & 3; }
    f32x4 acc[2][4][2], sum[2][4][2];
#pragma unroll
    for (int b = 0; b < 2; ++b)
#pragma unroll
        for (int m = 0; m < 4; ++m)
#pragma unroll
            for (int n = 0; n < 2; ++n) { acc[b][m][n] = (f32x4){0.f, 0.f, 0.f, 0.f}; sum[b][m][n] = (f32x4){0.f, 0.f, 0.f, 0.f}; }
    bf16x8 At[4][2], B0[2][2], B1[2][2];
    u32x2 gw[4][2];
#pragma unroll
    for (int m = 0; m < 4; ++m) { gw[m][0] = (u32x2){0u, 0u}; gw[m][1] = (u32x2){0u, 0u}; }
    { const char* b0_ = MG_B(cur, 0); MG_STAGE(MG_SB(0, 0), b0_, voffB); MG_STAGE(MG_SB(0, 1), b0_ + hstepB, voffB); MG_STAGE(MG_SA(0), MG_A(cur, 0), voffA); }
    if (wr == 1) MG_BAR;
    MG_WAIT_V(0); MG_BAR;
    { const char* b1_ = MG_B(cur, 1); MG_STAGE(MG_SB(1, 0), b1_, voffB); MG_STAGE(MG_SA(1), MG_A(cur, 1), voffA); MG_STAGE(MG_SB(1, 1), b1_ + hstepB, voffB); }
    MG_WAIT_V(6); MG_BAR;
    for (;;) {
        bool has_next; { const int idx = vc + G * (ui + 1); has_next = idx < NU; nxt.pm = idx >> 2; nxt.pn = idx & 3; }
#pragma unroll 1
        for (int t = 0; t < nt; t += 2) {
            const bool last = (t == nt - 2);
            const char* a2 = last ? (has_next ? MG_A(nxt, 0) : MG_A(cur, 0)) : MG_A(cur, t + 2);
            const char* b2 = last ? (has_next ? MG_B(nxt, 0) : MG_B(cur, 0)) : MG_B(cur, t + 2);
            const char* a3 = a2 + kstep; const char* b3 = b2 + kstep;
            if ((t & 3) == 0) {
                const int n = t >> 2; int lx = lane; asm volatile("" : "+v"(lx));
                const unsigned char* gp = (const unsigned char*)Pp + gate_off(cur.pm >> 1, 4 * n + cur.pn, wid, cur.pm & 1, lx);
#pragma unroll
                for (int m = 0; m < 4; ++m) { const u32x4 w4 = *(const GAS u32x4*)(gp + m * 16); gw[m][0] = (u32x2){w4.x, w4.y}; gw[m][1] = (u32x2){w4.z, w4.w}; }
            }
            MG_LDB(B0, 0, 0); MG_LDB(B1, 0, 1); MG_SCHED; MG_LDA(At, 0);
            MG_WAIT_L(0); MG_BAR; MG_MMA(0, At, B0); MG_MMA(1, At, B1); MG_BAR; MG_SCHED;
            MG_STAGE(MG_SB(0, 0), b2, voffB); MG_STAGE(MG_SB(0, 1), b2 + hstepB, voffB); MG_STAGE(MG_SA(0), a2, voffA);
            if ((t & 3) == 0) MG_WAIT_V(10); else MG_WAIT_V(6);
            MG_WAIT_L(0); MG_BAR; MG_BAR; MG_SCHED;
            MG_LDB(B0, 1, 0); MG_LDB(B1, 1, 1); MG_SCHED; MG_LDA(At, 1);
            MG_WAIT_L(0); MG_BAR; MG_MMA(0, At, B0); MG_MMA(1, At, B1); MG_BAR; MG_SCHED;
            if ((t & 3) == 2) {
#pragma unroll
                for (int m = 0; m < 4; ++m)
#pragma unroll
                    for (int bj = 0; bj < 2; ++bj) { const unsigned ga = gw[m][bj].x, gb = gw[m][bj].y; constexpr float Kq = 1.0f / 255.0f;
                        const f32x4 g0 = (f32x4){(float)(ga & 0xffu), (float)((ga >> 8) & 0xffu), (float)((ga >> 16) & 0xffu), (float)(ga >> 24)} * Kq;
                        const f32x4 g1 = (f32x4){(float)(gb & 0xffu), (float)((gb >> 8) & 0xffu), (float)((gb >> 16) & 0xffu), (float)(gb >> 24)} * Kq;
                        sum[bj][m][0] += g0 * acc[bj][m][0]; sum[bj][m][1] += g1 * acc[bj][m][1];
                        acc[bj][m][0] = (f32x4){0.f, 0.f, 0.f, 0.f}; acc[bj][m][1] = (f32x4){0.f, 0.f, 0.f, 0.f}; }
                asm volatile("" ::: "memory");
            }
            MG_STAGE(MG_SB(1, 0), b3, voffB); MG_STAGE(MG_SB(1, 1), b3 + hstepB, voffB); MG_STAGE(MG_SA(1), a3, voffA);
            MG_WAIT_V(6); MG_WAIT_L(0); MG_BAR; MG_BAR; MG_SCHED;
        }
        if (wr == 0) MG_BAR;
        { const int row0 = cur.pm * 128 + wr * 64 + fr, col0 = cur.pn * 256 + wc * 32 + 8 * fq;
#pragma unroll
          for (int m = 0; m < 4; ++m)
#pragma unroll
              for (int bj = 0; bj < 2; ++bj) { *(GAS u32x4*)(HBo + (size_t)(row0 + m * 16) * DM + col0 + bj * HALF) = pack8(sum[bj][m][0], sum[bj][m][1]);
                  sum[bj][m][0] = (f32x4){0.f, 0.f, 0.f, 0.f}; sum[bj][m][1] = (f32x4){0.f, 0.f, 0.f, 0.f}; } }
        if (!has_next) break;
        cur = nxt; ++ui;
        if (wr == 1) MG_BAR;
    }
    MG_WAIT_V(0);
    MG_BAR;
#undef MG_SA
#undef MG_SB
#undef MG_STAGE
#undef MG_LDA
#undef MG_LDB
#undef MG_MMA
#undef MG_WAIT_V
#undef MG_WAIT_L
#undef MG_BAR
#undef MG_SCHED
#undef MG_ACOL
#undef MG_A
#undef MG_B
}
}

namespace pg8 {
__device__ __forceinline__ f32x4 gate_q4(unsigned w) {
    f32x4 q = (f32x4){(float)(w & 0xffu), (float)((w >> 8) & 0xffu), (float)((w >> 16) & 0xffu), (float)(w >> 24)};
    return q;
}
__device__ __forceinline__ f32x4 rcp4(f32x4 v) { return (f32x4){__builtin_amdgcn_rcpf(v[0]), __builtin_amdgcn_rcpf(v[1]), __builtin_amdgcn_rcpf(v[2]), __builtin_amdgcn_rcpf(v[3])}; }
__device__ __forceinline__ void merge_phase2(LAS unsigned char* lds, const bf16_t* Pp, const bf16_t* Wbt, bf16_t* HBo, int G, int vc, int tid) {
    asm volatile("" : "+v"(tid));
    const int wid = __builtin_amdgcn_readfirstlane(tid >> 6), lane = tid & 63, wr = wid >> 2, wc = wid & 3, fr = lane & 15, fq = lane >> 4;
    constexpr int nt = 16, NU = (MTOK / 256) * (DM / 256);
    unsigned voffA[2], voffB[2];
#pragma unroll
    for (int i = 0; i < 2; ++i) { int R, C; stage_rc(tid * 16 + i * 8192, R, C); const int Rb = (R & ~31) + perm32(R & 31);
        voffA[i] = (unsigned)(R * LDP + C) * 2u; voffB[i] = (unsigned)(Rb * 256 + C) * 2u; }
    const unsigned ldsw = (unsigned)wid * 1024u;
    const int aoff = lds_byte(wr * 64 + fr, fq * 8), boff = lds_byte(wc * 32 + fr, fq * 8);
#define M2_SA(b, h) (((b) * 2 + (h)) * HTB)
#define M2_SB(b, h) ((4 + (b) * 2 + (h)) * HTB)
#define M2_STAGE(bufoff, gbase, voff) do { _Pragma("unroll") for (int _i = 0; _i < 2; ++_i) \
        __builtin_amdgcn_global_load_lds((const unsigned*)((const char*)(gbase) + (voff)[_i]), (LAS unsigned*)(lds + (bufoff) + ldsw + _i * 8192), 16, 0, 0); } while (0)
#define M2_LDA(dst, b, h) do { _Pragma("unroll") for (int m = 0; m < 4; ++m) _Pragma("unroll") for (int k = 0; k < 2; ++k) dst[m][k] = *(const LAS bf16x8*)(lds + M2_SA(b, h) + aoff + m * 2048 + k * 1024); } while (0)
#define M2_LDB(dst, b, h) do { _Pragma("unroll") for (int n = 0; n < 2; ++n) _Pragma("unroll") for (int k = 0; k < 2; ++k) dst[n][k] = *(const LAS bf16x8*)(lds + M2_SB(b, h) + boff + n * 2048 + k * 1024); } while (0)
#define M2_MMA(ai, bj, At, Bt) do { __builtin_amdgcn_s_setprio(1); _Pragma("unroll") for (int m = 0; m < 4; ++m) _Pragma("unroll") for (int n = 0; n < 2; ++n) _Pragma("unroll") for (int k = 0; k < 2; ++k) \
        acc[ai][bj][m][n] = __builtin_amdgcn_mfma_f32_16x16x32_bf16(Bt[n][k], At[m][k], acc[ai][bj][m][n], 0, 0, 0); __builtin_amdgcn_s_setprio(0); } while (0)
#define M2_WAIT_V(n) asm volatile("s_waitcnt vmcnt(" #n ")" ::: "memory")
#define M2_WAIT_L(n) asm volatile("s_waitcnt lgkmcnt(" #n ")" ::: "memory")
#define M2_BAR __builtin_amdgcn_s_barrier()
#define M2_SCHED __builtin_amdgcn_sched_barrier(0)
    const char* Ab = (const char*)Pp; const char* Bb = (const char*)Wbt; asm volatile("" : "+s"(Ab), "+s"(Bb)); Ab = (const char*)(const GAS char*)Ab; Bb = (const char*)(const GAS char*)Bb;
#define M2_ACOL(n) ((n) == 0 ? PC_NAQ : (n) == 1 ? PC_WQ : (n) == 2 ? PC_YC : PC_AXQ)
#define M2_A(u, kt) (Ab + ((size_t)(u).pm * 256 * LDP + M2_ACOL((kt) >> 2) + ((kt) & 3) * 64) * 2)
#define M2_B(u, kt) (Bb + ((size_t)(((kt) >> 2) * DM + (u).pn * 256) * 256 + ((kt) & 3) * 64) * 2)
    constexpr size_t hstepB = (size_t)HALF * 256 * 2, hstepA = (size_t)HALF * LDP * 2, kstep = 128;
    MUnit cur, nxt; int ui = 0;
    { const int idx = vc; if (idx >= NU) return; cur.pm = idx >> 2; cur.pn = idx & 3; }
    f32x4 acc[2][2][4][2];
#pragma unroll
    for (int a = 0; a < 2; ++a)
#pragma unroll
        for (int b = 0; b < 2; ++b)
#pragma unroll
            for (int m = 0; m < 4; ++m)
#pragma unroll
                for (int n = 0; n < 2; ++n) acc[a][b][m][n] = (f32x4){0.f, 0.f, 0.f, 0.f};
    bf16x8 At[4][2], B0[2][2], B1[2][2];
    u32x2 ga[4][2], gb[4][2];
#pragma unroll
    for (int m = 0; m < 4; ++m) { ga[m][0] = (u32x2){0u, 0u}; ga[m][1] = ga[m][0]; gb[m][0] = ga[m][0]; gb[m][1] = ga[m][0]; }
#define M2_GLOAD(ai, n) do { int lx = lane; asm volatile("" : "+v"(lx)); const unsigned char* gp = (const unsigned char*)Pp + gate_off(cur.pm, 4 * (n) + cur.pn, wid, (ai), lx); \
        _Pragma("unroll") for (int m = 0; m < 4; ++m) { const u32x4 wa = *(const GAS u32x4*)(gp + m * 16), wb_ = *(const GAS u32x4*)(gp + 4 * 65536 + m * 16); \
            ga[m][0] = (u32x2){wa.x, wa.y}; ga[m][1] = (u32x2){wa.z, wa.w}; gb[m][0] = (u32x2){wb_.x, wb_.y}; gb[m][1] = (u32x2){wb_.z, wb_.w}; } } while (0)
#define M2_GSCALE(ai) do { _Pragma("unroll") for (int m = 0; m < 4; ++m) _Pragma("unroll") for (int bj = 0; bj < 2; ++bj) { \
            acc[ai][bj][m][0] = acc[ai][bj][m][0] * (gate_q4(ga[m][bj].x) * rcp4(gate_q4(gb[m][bj].x))); \
            acc[ai][bj][m][1] = acc[ai][bj][m][1] * (gate_q4(ga[m][bj].y) * rcp4(gate_q4(gb[m][bj].y))); } } while (0)
    { const char* cA = M2_A(cur, 0); const char* cB = M2_B(cur, 0);
      M2_STAGE(M2_SB(0, 0), cB, voffB); M2_STAGE(M2_SB(0, 1), cB + hstepB, voffB); M2_STAGE(M2_SA(0, 0), cA, voffA); M2_STAGE(M2_SA(0, 1), cA + hstepA, voffA);
      if (wr == 1) M2_BAR;
      M2_WAIT_V(2); M2_BAR;
      M2_STAGE(M2_SB(1, 0), cB + kstep, voffB); M2_STAGE(M2_SA(1, 0), cA + kstep, voffA); M2_STAGE(M2_SB(1, 1), cB + hstepB + kstep, voffB);
      M2_WAIT_V(6); M2_BAR; }
    for (;;) {
        bool has_next; { const int idx = vc + G * (ui + 1); has_next = idx < NU; nxt.pm = idx >> 2; nxt.pn = idx & 3; }
#pragma unroll 1
        for (int t = 0; t < nt; t += 2) {
            const bool last = (t == nt - 2);
            const bool bnd = ((t & 3) == 2) && !last;
            const bool pend = ((t & 3) == 0) && t != 0;
            const char* a1 = M2_A(cur, t) + kstep;
            const char* a2 = last ? (has_next ? M2_A(nxt, 0) : M2_A(cur, 0)) : M2_A(cur, t + 2);
            const char* b2 = last ? (has_next ? M2_B(nxt, 0) : M2_B(cur, 0)) : M2_B(cur, t + 2);
            const char* a3 = a2 + kstep; const char* b3 = b2 + kstep;
            M2_LDB(B0, 0, 0); M2_LDB(B1, 0, 1); M2_SCHED; M2_LDA(At, 0, 0); M2_STAGE(M2_SA(1, 1), a1 + hstepA, voffA);
            if (pend) M2_WAIT_V(16); else M2_WAIT_V(8);
            M2_WAIT_L(0); M2_BAR; M2_MMA(0, 0, At, B0); M2_MMA(0, 1, At, B1); M2_BAR; M2_SCHED;
            if (pend) { M2_WAIT_V(2); M2_GSCALE(1); M2_SCHED; }
            M2_LDA(At, 0, 1); M2_STAGE(M2_SB(0, 0), b2, voffB); M2_STAGE(M2_SB(0, 1), b2 + hstepB, voffB); M2_STAGE(M2_SA(0, 0), a2, voffA);
            M2_WAIT_V(8); M2_WAIT_L(0); M2_BAR; M2_MMA(1, 0, At, B0); M2_MMA(1, 1, At, B1); M2_BAR; M2_SCHED;
            if (bnd) { M2_GLOAD(0, t >> 2); }
            M2_LDB(B0, 1, 0); M2_LDB(B1, 1, 1); M2_SCHED; M2_LDA(At, 1, 0); M2_STAGE(M2_SA(0, 1), a2 + hstepA, voffA);
            if (bnd) M2_WAIT_V(16); else M2_WAIT_V(8);
            M2_WAIT_L(0); M2_BAR; M2_MMA(0, 0, At, B0); M2_MMA(0, 1, At, B1); M2_BAR; M2_SCHED;
            M2_LDA(At, 1, 1); M2_STAGE(M2_SB(1, 0), b3, voffB); M2_STAGE(M2_SB(1, 1), b3 + hstepB, voffB); M2_STAGE(M2_SA(1, 0), a3, voffA);
            M2_WAIT_V(8); M2_WAIT_L(0); M2_BAR; M2_MMA(1, 0, At, B0); M2_MMA(1, 1, At, B1); if (bnd) { M2_SCHED; M2_GSCALE(0); } M2_BAR;
            if (bnd) { M2_GLOAD(1, t >> 2); }
            M2_SCHED;
        }
        if (wr == 0) M2_BAR;
        { int frx = fr; asm volatile("" : "+v"(frx)); const int row0 = cur.pm * 256 + wr * 64 + frx, col0 = cur.pn * 256 + wc * 32 + 8 * fq;
#pragma unroll
          for (int ai = 0; ai < 2; ++ai) {
              u32x2 g3[4][2];
              { const unsigned char* gp = (const unsigned char*)Pp + gate_off(cur.pm, 12 + cur.pn, wid, ai, frx + 16 * fq);
#pragma unroll
                for (int m = 0; m < 4; ++m) { const u32x4 w4 = *(const GAS u32x4*)(gp + m * 16); g3[m][0] = (u32x2){w4.x, w4.y}; g3[m][1] = (u32x2){w4.z, w4.w}; } }
#pragma unroll
              for (int m = 0; m < 4; ++m)
#pragma unroll
                  for (int bj = 0; bj < 2; ++bj) { constexpr float Kq = 1.0f / 255.0f;
                      *(GAS u32x4*)(HBo + (size_t)(row0 + ai * HALF + m * 16) * DM + col0 + bj * HALF) = pack8(acc[ai][bj][m][0] * (gate_q4(g3[m][bj].x) * Kq), acc[ai][bj][m][1] * (gate_q4(g3[m][bj].y) * Kq));
                      acc[ai][bj][m][0] = (f32x4){0.f, 0.f, 0.f, 0.f}; acc[ai][bj][m][1] = (f32x4){0.f, 0.f, 0.f, 0.f}; }
              asm volatile("" ::: "memory"); } }
        if (!has_next) break;
        cur = nxt; ++ui;
        if (wr == 1) M2_BAR;
    }
    M2_WAIT_V(0);
    M2_BAR;
#undef M2_SA
#undef M2_SB
#undef M2_STAGE
#undef M2_LDA
#undef M2_LDB
#undef M2_MMA
#undef M2_WAIT_V
#undef M2_WAIT_L
#undef M2_BAR
#undef M2_SCHED
#undef M2_GLOAD
#undef M2_GSCALE
#undef M2_ACOL
#undef M2_A
#undef M2_B
}
__device__ __forceinline__ void merge_phase3(LAS unsigned char* lds, const bf16_t* Pp, const unsigned char* Y8, const unsigned char* Wb8, bf16_t* HBo, int G, int vc, int tid) {
    asm volatile("" : "+v"(tid));
    const int wid = __builtin_amdgcn_readfirstlane(tid >> 6), lane = tid & 63, wr = wid >> 2, wc = wid & 3, fr = lane & 15, fq = lane >> 4;
    constexpr int nt = 8, NU = (MTOK / 256) * (DM / 256);
    unsigned voffA[2], voffB[2];
#pragma unroll
    for (int i = 0; i < 2; ++i) { int R, C; stage_rc(tid * 16 + i * 8192, R, C); const int Rb = (R & ~31) + perm32(R & 31);
        voffA[i] = (unsigned)(R * 1024 + C * 2); voffB[i] = (unsigned)(Rb * 256 + C * 2); }
    const unsigned ldsw = (unsigned)wid * 1024u;
    const int aoff = lds_byte(wr * 64 + fr, fq * 8), boff = lds_byte(wc * 32 + fr, fq * 8);
#define M2_SA(b, h) (((b) * 2 + (h)) * HTB)
#define M2_SB(b, h) ((4 + (b) * 2 + (h)) * HTB)
#define M2_STAGE(bufoff, gbase, voff) do { _Pragma("unroll") for (int _i = 0; _i < 2; ++_i) \
        __builtin_amdgcn_global_load_lds((const unsigned*)((const char*)(gbase) + (voff)[_i]), (LAS unsigned*)(lds + (bufoff) + ldsw + _i * 8192), 16, 0, 0); } while (0)
#define M2_LDA(dst, b, h) do { _Pragma("unroll") for (int m = 0; m < 4; ++m) { dst[m].lo = *(const LAS i32x4*)(lds + M2_SA(b, h) + aoff + m * 2048); dst[m].hi = *(const LAS i32x4*)(lds + M2_SA(b, h) + aoff + m * 2048 + 1024); } } while (0)
#define M2_LDB(dst, b, h) do { _Pragma("unroll") for (int n = 0; n < 2; ++n) { dst[n].lo = *(const LAS i32x4*)(lds + M2_SB(b, h) + boff + n * 2048); dst[n].hi = *(const LAS i32x4*)(lds + M2_SB(b, h) + boff + n * 2048 + 1024); } } while (0)
#define M2_MMA(ai, bj, At, Bt) do { __builtin_amdgcn_s_setprio(1); _Pragma("unroll") for (int m = 0; m < 4; ++m) _Pragma("unroll") for (int n = 0; n < 2; ++n) \
        asm volatile("v_mfma_scale_f32_16x16x128_f8f6f4 %0, %1, %2, %0, %3, %3 op_sel_hi:[0,0,0]" : "+v"(acc[ai][bj][m][n]) : "v"(Bt[n]), "v"(At[m]), "v"(sc127)); __builtin_amdgcn_s_setprio(0); } while (0)
#define M2_WAIT_V(n) asm volatile("s_waitcnt vmcnt(" #n ")" ::: "memory")
#define M2_WAIT_L(n) asm volatile("s_waitcnt lgkmcnt(" #n ")" ::: "memory")
#define M2_BAR __builtin_amdgcn_s_barrier()
#define M2_SCHED __builtin_amdgcn_sched_barrier(0)
    const char* Ab = (const char*)Y8; const char* Bb = (const char*)Wb8; asm volatile("" : "+s"(Ab), "+s"(Bb)); Ab = (const char*)(const GAS char*)Ab; Bb = (const char*)(const GAS char*)Bb;
#define M2_A(u, kt) (Ab + ((size_t)(u).pm * 256 * 1024 + ((kt) >> 1) * 256 + ((kt) & 1) * 128))
#define M2_B(u, kt) (Bb + ((size_t)(((kt) >> 1) * DM + (u).pn * 256) * 256 + ((kt) & 1) * 128))
    constexpr size_t hstepB = (size_t)HALF * 256, hstepA = (size_t)HALF * 1024, kstep = 128;
    MUnit cur, nxt; int ui = 0;
    { const int idx = vc; if (idx >= NU) return; cur.pm = idx >> 2; cur.pn = idx & 3; }
    f32x4 acc[2][2][4][2];
    i32x8 At[4], B0[2], B1[2];
    int sc127 = 127; asm volatile("" : "+v"(sc127));
    u32x4 ga4[4], gb4[4];
#define M2_GLOAD(ai, n) do { const int lx = lane_now(); const unsigned char* gp = (const unsigned char*)Pp + gate_off(cur.pm, 4 * (n) + cur.pn, wid, (ai), lx); \
        _Pragma("unroll") for (int m = 0; m < 4; ++m) { ga4[m] = *(const GAS u32x4*)(gp + m * 16); gb4[m] = *(const GAS u32x4*)(gp + 4 * 65536 + m * 16); } } while (0)
#define M2_GSCALE(ai) do { _Pragma("unroll") for (int m = 0; m < 4; ++m) { \
            acc[ai][0][m][0] = acc[ai][0][m][0] * (gate_q4(ga4[m].x) * rcp4(gate_q4(gb4[m].x))); acc[ai][0][m][1] = acc[ai][0][m][1] * (gate_q4(ga4[m].y) * rcp4(gate_q4(gb4[m].y))); \
            acc[ai][1][m][0] = acc[ai][1][m][0] * (gate_q4(ga4[m].z) * rcp4(gate_q4(gb4[m].z))); acc[ai][1][m][1] = acc[ai][1][m][1] * (gate_q4(ga4[m].w) * rcp4(gate_q4(gb4[m].w))); } } while (0)
    { const char* cA = M2_A(cur, 0); const char* cB = M2_B(cur, 0);
      M2_STAGE(M2_SB(0, 0), cB, voffB); M2_SCHED; M2_STAGE(M2_SB(0, 1), cB + hstepB, voffB); M2_SCHED; M2_STAGE(M2_SA(0, 0), cA, voffA); M2_SCHED; M2_STAGE(M2_SA(0, 1), cA + hstepA, voffA); M2_SCHED;
      if (wr == 1) M2_BAR;
      M2_WAIT_V(2); M2_BAR;
      M2_STAGE(M2_SB(1, 0), cB + kstep, voffB); M2_SCHED; M2_STAGE(M2_SA(1, 0), cA + kstep, voffA); M2_SCHED; M2_STAGE(M2_SB(1, 1), cB + hstepB + kstep, voffB); M2_SCHED;
      M2_WAIT_V(6); M2_BAR; }
    M2_SCHED;
#pragma unroll
    for (int a = 0; a < 2; ++a)
#pragma unroll
        for (int b = 0; b < 2; ++b)
#pragma unroll
            for (int m = 0; m < 4; ++m)
#pragma unroll
                for (int n = 0; n < 2; ++n) acc[a][b][m][n] = (f32x4){0.f, 0.f, 0.f, 0.f};
    for (;;) {
        asm volatile("" : "+s"(Ab), "+s"(Bb));
        bool has_next; { const int idx = vc + G * (ui + 1); has_next = idx < NU; nxt.pm = idx >> 2; nxt.pn = idx & 3; }
#pragma unroll 1
        for (int t = 0; t < nt; t += 2) {
            const bool last = (t == nt - 2);
            asm volatile("" : "+v"(voffA[0]), "+v"(voffA[1]), "+v"(voffB[0]), "+v"(voffB[1]));
            const bool bnd = !last;
            const bool pend = t != 0;
            const char* a1 = M2_A(cur, t) + kstep;
            const char* a2 = last ? (has_next ? M2_A(nxt, 0) : M2_A(cur, 0)) : M2_A(cur, t + 2);
            const char* b2 = last ? (has_next ? M2_B(nxt, 0) : M2_B(cur, 0)) : M2_B(cur, t + 2);
            const char* a3 = a2 + kstep; const char* b3 = b2 + kstep;
            M2_LDB(B0, 0, 0); M2_LDB(B1, 0, 1); M2_SCHED; M2_LDA(At, 0, 0); M2_STAGE(M2_SA(1, 1), a1 + hstepA, voffA);
            if (pend) M2_WAIT_V(16); else M2_WAIT_V(8);
            M2_WAIT_L(0); M2_BAR; M2_MMA(0, 0, At, B0); M2_MMA(0, 1, At, B1); M2_BAR; M2_SCHED;
            if (pend) { M2_WAIT_V(2); M2_GSCALE(1); M2_SCHED; }
            M2_LDA(At, 0, 1); M2_STAGE(M2_SB(0, 0), b2, voffB); M2_STAGE(M2_SB(0, 1), b2 + hstepB, voffB); M2_STAGE(M2_SA(0, 0), a2, voffA);
            M2_WAIT_V(8); M2_WAIT_L(0); M2_BAR; M2_MMA(1, 0, At, B0); M2_MMA(1, 1, At, B1); M2_BAR; M2_SCHED;
            if (bnd) { M2_GLOAD(0, t >> 1); }
            M2_LDB(B0, 1, 0); M2_LDB(B1, 1, 1); M2_SCHED; M2_LDA(At, 1, 0); M2_STAGE(M2_SA(0, 1), a2 + hstepA, voffA);
            if (bnd) M2_WAIT_V(16); else M2_WAIT_V(8);
            M2_WAIT_L(0); M2_BAR; M2_MMA(0, 0, At, B0); M2_MMA(0, 1, At, B1); M2_BAR; M2_SCHED;
            M2_LDA(At, 1, 1); M2_STAGE(M2_SB(1, 0), b3, voffB); M2_STAGE(M2_SB(1, 1), b3 + hstepB, voffB); M2_STAGE(M2_SA(1, 0), a3, voffA);
            M2_WAIT_V(8); M2_WAIT_L(0); M2_BAR; M2_MMA(1, 0, At, B0); M2_MMA(1, 1, At, B1); if (bnd) { M2_SCHED; M2_GSCALE(0); } M2_BAR;
            if (bnd) { M2_GLOAD(1, t >> 1); }
            M2_SCHED;
        }
        asm volatile("s_nop 15\n\ts_nop 15\n\ts_nop 15" ::: "memory");
        if (wr == 0) M2_BAR;
        { const int lnx = lane_now(), frx = lnx & 15, fqx = lnx >> 4; const int row0 = cur.pm * 256 + wr * 64 + frx, col0 = cur.pn * 256 + wc * 32 + 8 * fqx;
#pragma unroll
          for (int ai = 0; ai < 2; ++ai) {
              u32x2 g3[4][2];
              { const unsigned char* gp = (const unsigned char*)Pp + gate_off(cur.pm, 12 + cur.pn, wid, ai, lnx);
#pragma unroll
                for (int m = 0; m < 4; ++m) { const u32x4 w4 = *(const GAS u32x4*)(gp + m * 16); g3[m][0] = (u32x2){w4.x, w4.y}; g3[m][1] = (u32x2){w4.z, w4.w}; } }
#pragma unroll
              for (int m = 0; m < 4; ++m)
#pragma unroll
                  for (int bj = 0; bj < 2; ++bj) { constexpr float Kq = 1.0f / (255.0f * 256.0f);
                      *(GAS u32x4*)(HBo + (size_t)(row0 + ai * HALF + m * 16) * DM + col0 + bj * HALF) = pack8(acc[ai][bj][m][0] * (gate_q4(g3[m][bj].x) * Kq), acc[ai][bj][m][1] * (gate_q4(g3[m][bj].y) * Kq));
                      acc[ai][bj][m][0] = (f32x4){0.f, 0.f, 0.f, 0.f}; acc[ai][bj][m][1] = (f32x4){0.f, 0.f, 0.f, 0.f}; }
              asm volatile("" ::: "memory"); } }
        if (!has_next) break;
        cur = nxt; ++ui;
        if (wr == 1) M2_BAR;
    }
    M2_WAIT_V(0);
    M2_BAR;
#undef M2_SA
#undef M2_SB
#undef M2_STAGE
#undef M2_LDA
#undef M2_LDB
#undef M2_MMA
#undef M2_WAIT_V
#undef M2_WAIT_L
#undef M2_BAR
#undef M2_SCHED
#undef M2_GLOAD
#undef M2_GSCALE
#undef M2_A
#undef M2_B
}
}
namespace att {
constexpr int STG = 20480, VOFF = 12288;
constexpr int LDS_WSF = 3 * STG;
constexpr int LDS_OST = LDS_WSF + 8 * 512;
constexpr int LDS_BIAS = LDS_OST + 8 * 4096;
constexpr int LDS_BYTES = LDS_BIAS + 2048;
typedef short v4i16_t __attribute__((ext_vector_type(4)));

__device__ __forceinline__ int crow(int r, int hi) { return (r & 3) + 8 * (r >> 2) + 4 * hi; }
__device__ __forceinline__ s16x4 vtr(const LAS unsigned char* p) { return __builtin_bit_cast(s16x4, __builtin_amdgcn_ds_read_tr16_b64_v4i16((LAS v4i16_t*)p)); }
__device__ __forceinline__ void glds16(const void* gsrc, unsigned lds_dst) { unsigned keep;
    asm volatile("s_mov_b32 %0, m0\n\ts_mov_b32 m0, %2\n\ts_nop 0\n\tglobal_load_lds_dwordx4 %1, off\n\ts_mov_b32 m0, %0" : "=&s"(keep) : "v"(gsrc), "s"(lds_dst) : "memory"); }
__device__ __forceinline__ int clampi(int v, int lo, int hi) { return v < lo ? lo : (v > hi ? hi : v); }

__device__ __forceinline__ u32x2 bf8_to_fp8x8(const u32x4 v) { u32x2 w;
    w.x = pk_fp8x4(bflo(v.x) * 16.0f, bfhi(v.x) * 16.0f, bflo(v.y) * 16.0f, bfhi(v.y) * 16.0f); w.y = pk_fp8x4(bflo(v.z) * 16.0f, bfhi(v.z) * 16.0f, bflo(v.w) * 16.0f, bfhi(v.w) * 16.0f); return w; }
template <int DQ, int MODE, int VAR = 0, bool O8 = false>
__device__ __forceinline__ void attn_unit(const bf16_t* Qp, const bf16_t* Kp, const bf16_t* Vp, bf16_t* Op, int ldq, int ldk, int ldv, int ldo,
                                          int q0, float sc2, float par0, float par1, const float* biasp, LAS unsigned char* lds, int tid) {
    asm volatile("" : "+v"(tid));
    const int lane = tid & 63, r32 = lane & 31, hi = lane >> 5; const int wid = __builtin_amdgcn_readfirstlane(tid >> 6);
    constexpr int ND = DQ / 16;
    int t0 = 0, t1 = SEQ / 64 - 1;
    const int wq0 = q0 + wid * 32;
    int wt0 = 0, wt1 = SEQ / 64 - 1;
    if (MODE == 1) { t0 = (q0 >> 6) - 2; t0 = t0 < 0 ? 0 : t0; t1 = (q0 >> 6) + 5; t1 = t1 > 63 ? 63 : t1;
        int klo = wq0 - 128; klo = klo < 0 ? 0 : klo; int khi = wq0 + 31 + 128; khi = khi > SEQ - 1 ? SEQ - 1 : khi; wt0 = klo >> 6; wt1 = khi >> 6; }
    if (MODE == 2) { const int R0 = q0 >> 6; t0 = clampi(R0 - 4, 0, 56); t1 = clampi(R0 + 3 - 4, 0, 56) + 7; const int R = wq0 >> 6; wt0 = clampi(R - 4, 0, 56); wt1 = wt0 + 7; }
    LAS float* wsf = (LAS float*)(lds + LDS_WSF) + wid * 128;
    LAS float* bt = (LAS float*)(lds + LDS_BIAS);
    bf16x8 qr[ND];
    { const bf16_t* Qw = Qp + (size_t)(wq0 + r32) * ldq + hi * 8;
#pragma unroll
      for (int d0 = 0; d0 < ND; ++d0) qr[d0] = *(const GAS bf16x8*)(Qw + d0 * 16); }
    const bf16_t* ksrc = Kp + (size_t)lane * ldk + wid * 8;
    const bf16_t* ksrc2 = Kp + (size_t)lane * ldk + (8 + (wid & 3)) * 8;
    const bf16_t* vsrc = Vp + (size_t)(16 * (wid & 3) + (lane >> 2)) * ldv + (wid >> 2) * 32 + (lane & 3) * 8;
    const int kdst = wid * 1024 + lane * 16, kdst2 = (8 + (wid & 3)) * 1024 + lane * 16, vdst = VOFF + wid * 1024 + lane * 16;
    u32x4 kreg, kreg2, vreg; kreg2 = (u32x4){0u, 0u, 0u, 0u};
    u32x4 kregB, kreg2B, vregB; kreg2B = (u32x4){0u, 0u, 0u, 0u};
#define ATT_LOAD(t) do { if (VAR == 5) break; const size_t ro_ = (size_t)(t) * 64; kreg = *(const GAS u32x4*)(ksrc + ro_ * ldk); if (DQ == 96) kreg2 = *(const GAS u32x4*)(ksrc2 + ro_ * ldk); vreg = *(const GAS u32x4*)(vsrc + ro_ * ldv); } while (0)
#define ATT_STORE(s) do { if (VAR == 5) break; LAS unsigned char* sb_ = lds + (s) * STG; *(LAS u32x4*)(sb_ + kdst) = kreg; if (DQ == 96) *(LAS u32x4*)(sb_ + kdst2) = kreg2; *(LAS u32x4*)(sb_ + vdst) = vreg; } while (0)
#define ATT_LOADB(t) do { if (VAR == 5) break; const size_t ro_ = (size_t)(t) * 64; kregB = *(const GAS u32x4*)(ksrc + ro_ * ldk); if (DQ == 96) kreg2B = *(const GAS u32x4*)(ksrc2 + ro_ * ldk); vregB = *(const GAS u32x4*)(vsrc + ro_ * ldv); } while (0)
#define ATT_STOREB(s) do { if (VAR == 5) break; LAS unsigned char* sb_ = lds + (s) * STG; *(LAS u32x4*)(sb_ + kdst) = kregB; if (DQ == 96) *(LAS u32x4*)(sb_ + kdst2) = kreg2B; *(LAS u32x4*)(sb_ + vdst) = vregB; } while (0)
    ATT_LOAD(t0);
    if (MODE == 2) { for (int i = tid; i < 15 * 31; i += 512) bt[i] = biasp[i] * LOG2E; }
    ATT_STORE(0);
    if (t0 + 1 <= t1) { ATT_LOAD(t0 + 1); ATT_STORE(1); }
    constexpr float THR = 8.0f;
    float m2 = (MODE == 1) ? par1 : 0.0f;
    bool first = (MODE != 1);
    float lsum = (MODE == 1 && hi == 0) ? 1.0f : 0.0f;
    f32x16 o[2];
#pragma unroll
    for (int r = 0; r < 16; ++r) { o[0][r] = 0.f; o[1][r] = 0.f; }
    const int tq = wq0 + r32;
    const int na_ncs = 4 * hi - clampi((tq & 63) - 8, 0, 48), na_l = 4 * hi - (tq & 63) + 15; (void)na_ncs; (void)na_l;
    f32x16 p0, p1, n0, n1;
#pragma unroll
    for (int r = 0; r < 16; ++r) { p0[r] = 0.f; p1[r] = 0.f; n0[r] = 0.f; n1[r] = 0.f; }
#define ATT_QK(D0, D1, stg_) do { const LAS unsigned char* kb_ = lds + (stg_) * STG + hi * 1024 + r32 * 16; const float ni_ = -m2; \
        bf16x8 kq_[2 * ND];        \
        _Pragma("unroll") for (int d0 = 0; d0 < ND; ++d0) { kq_[2 * d0] = *(const LAS bf16x8*)(kb_ + d0 * 2048); kq_[2 * d0 + 1] = *(const LAS bf16x8*)(kb_ + d0 * 2048 + 512); } \
        _Pragma("unroll") for (int r = 0; r < 16; ++r) { D0[r] = ni_; D1[r] = ni_; } \
        _Pragma("unroll") for (int d0 = 0; d0 < ND; ++d0) { \
            D0 = __builtin_amdgcn_mfma_f32_32x32x16_bf16(kq_[2 * d0], qr[d0], D0, 0, 0, 0); \
            D1 = __builtin_amdgcn_mfma_f32_32x32x16_bf16(kq_[2 * d0 + 1], qr[d0], D1, 0, 0, 0); } } while (0)
#define ATT_KPRE(stg_) do { if (VAR == 3 || (VAR == 6 && kfinit)) break; kfinit = true; const LAS unsigned char* kb_ = lds + (stg_) * STG + hi * 1024 + r32 * 16; \
        _Pragma("unroll") for (int d0 = 0; d0 < ND; ++d0) { kf[2 * d0] = *(const LAS bf16x8*)(kb_ + d0 * 2048); kf[2 * d0 + 1] = *(const LAS bf16x8*)(kb_ + d0 * 2048 + 512); } } while (0)
#define ATT_QKF(D0, D1) do { const float ni_ = -m2; \
        _Pragma("unroll") for (int r = 0; r < 16; ++r) { D0[r] = ni_; D1[r] = ni_; } \
        if (VAR == 3) break; \
        _Pragma("unroll") for (int d0 = 0; d0 < ND; ++d0) { \
            D0 = __builtin_amdgcn_mfma_f32_32x32x16_bf16(kf[2 * d0], qr[d0], D0, 0, 0, 0); \
            D1 = __builtin_amdgcn_mfma_f32_32x32x16_bf16(kf[2 * d0 + 1], qr[d0], D1, 0, 0, 0); } } while (0)
    __syncthreads();
    constexpr bool PIPE = (MODE != 2);
    int sc_ = 0, sn_ = 1, sw_ = 2;
#define ATT_HEAD(t, p0, p1, n0, n1) do { \
            float rm = -INFINITY; \
            int ncs_ = na_ncs, nbb_ = 0; if (MODE == 2) { asm volatile("" : "+v"(ncs_)); nbb_ = ((t) - (tq >> 6) + 7) * 31 + na_l; }        \
            const LAS float* bp_ = bt + nbb_; \
            float bb0_[16], bb1_[16];        \
            if (MODE == 2 && VAR != 8) { _Pragma("unroll") for (int r = 0; r < 16; ++r) { const int cr = (r & 3) + 8 * (r >> 2); bb0_[r] = bp_[cr]; bb1_[r] = bp_[cr + 32]; } \
                __builtin_amdgcn_sched_barrier(0); } \
            float relb_ = 0.f; if (MODE == 1) { relb_ = (float)((t) * 64 + 4 * hi - tq); asm volatile("" : "+v"(relb_)); } \
            _Pragma("unroll") for (int r = 0; r < 16; ++r) { \
                const int kk = crow(r, hi); \
                float v0 = p0[r], v1 = p1[r]; \
                if (MODE == 1) {        \
                    const float rf0 = relb_ + (float)((r & 3) + 8 * (r >> 2)), rf1 = rf0 + 32.0f; \
                    v0 = (__builtin_fabsf(rf0) <= 128.0f) ? __builtin_fmaf(-par0, __builtin_fabsf(rf0), v0) : -INFINITY; \
                    v1 = (__builtin_fabsf(rf1) <= 128.0f) ? __builtin_fmaf(-par0, __builtin_fabsf(rf1), v1) : -INFINITY; \
                } \
                if (MODE == 2 && VAR != 8) {        \
                    const int cr = (r & 3) + 8 * (r >> 2); \
                    const unsigned d0c = (unsigned)(cr + ncs_), d1c = (unsigned)(cr + 32 + ncs_); \
                    v0 = (d0c < 16u) ? v0 + bb0_[r] : -INFINITY; \
                    v1 = (d1c < 16u) ? v1 + bb1_[r] : -INFINITY; \
                } \
                if (MODE != 0) { p0[r] = v0; p1[r] = v1; } \
                rm = fmaxf(fmaxf(rm, v0), v1); \
            } \
            { auto rr = __builtin_amdgcn_permlane32_swap(__float_as_uint(rm), __float_as_uint(rm), false, false); rm = fmaxf(__uint_as_float(rr[0]), __uint_as_float(rr[1])); } \
            if (first) { \
                first = false; m2 = rm; \
                _Pragma("unroll") for (int r = 0; r < 16; ++r) { p0[r] -= rm; p1[r] -= rm; if (PIPE && MODE != 0) { n0[r] -= rm; n1[r] -= rm; } } \
            } else if (__any(rm > THR)) { \
                const float dl = fmaxf(rm, 0.f); m2 += dl; \
                _Pragma("unroll") for (int r = 0; r < 16; ++r) { p0[r] -= dl; p1[r] -= dl; if (PIPE && MODE != 0) { n0[r] -= dl; n1[r] -= dl; } } \
                const float f = __builtin_amdgcn_exp2f(-dl); \
                lsum *= f; \
                if (hi == 0) wsf[r32] = f; \
                asm volatile("s_waitcnt lgkmcnt(0)" ::: "memory"); \
                _Pragma("unroll") for (int g4 = 0; g4 < 4; ++g4) { const f32x4 f4 = *(const LAS f32x4*)(wsf + 8 * g4 + 4 * hi); \
                    _Pragma("unroll") for (int j = 0; j < 4; ++j) { o[0][4 * g4 + j] *= f4[j]; o[1][4 * g4 + j] *= f4[j]; } } \
                asm volatile("s_waitcnt lgkmcnt(0)" ::: "memory"); \
            } } while (0)
#define ATT_EXP_PV(stg_, p0, p1) do { \
            float sumA = 0.f, sumB = 0.f; \
            _Pragma("unroll") for (int r = 0; r < 16; ++r) { if (VAR != 1) { p0[r] = __builtin_amdgcn_exp2f(p0[r]); p1[r] = __builtin_amdgcn_exp2f(p1[r]); } sumA += p0[r]; sumB += p1[r]; } \
            lsum += sumA + sumB; \
            u32x4 pw[4]; \
            _Pragma("unroll") for (int j = 0; j < 4; ++j) { pw[0][j] = cvt_pk_bf16(p0[2 * j], p0[2 * j + 1]); pw[1][j] = cvt_pk_bf16(p0[8 + 2 * j], p0[8 + 2 * j + 1]); \
                                          pw[2][j] = cvt_pk_bf16(p1[2 * j], p1[2 * j + 1]); pw[3][j] = cvt_pk_bf16(p1[8 + 2 * j], p1[8 + 2 * j + 1]); } \
            const LAS unsigned char* vp = lds + (stg_) * STG + VOFF + ((lane >> 4) & 1) * 32 + (lane & 3) * 8 + (4 * hi + ((lane & 15) >> 2)) * 64; \
            { s16x4 lo = vtr(vp), hh = vtr(vp + 512);        \
              __builtin_amdgcn_sched_barrier(0); \
              _Pragma("unroll") for (int i = 0; i < 8; ++i) { \
                s16x4 nlo = lo, nhh = hh; \
                if (i + 1 < 8) { nlo = vtr(vp + ((i + 1) >> 2) * 4096 + ((i + 1) & 3) * 1024); nhh = vtr(vp + ((i + 1) >> 2) * 4096 + ((i + 1) & 3) * 1024 + 512); } \
                const bf16x8 vf = (bf16x8){lo[0], lo[1], lo[2], lo[3], hh[0], hh[1], hh[2], hh[3]}; \
                o[i >> 2] = __builtin_amdgcn_mfma_f32_32x32x16_bf16(__builtin_bit_cast(bf16x8, pw[i & 3]), vf, o[i >> 2], 0, 0, 0); \
                lo = nlo; hh = nhh; \
                __builtin_amdgcn_sched_barrier(0); } } } while (0)
#define ATT_ROT() do { const int tmp_ = sc_; sc_ = sn_; sn_ = sw_; sw_ = tmp_; } while (0)
    if constexpr (MODE == 0) {
        bf16x8 kf[2 * ND]; bool kfinit = false;
        ATT_KPRE(0); ATT_QKF(p0, p1);
        if (t0 + 2 <= t1) ATT_LOAD(t0 + 2);
        for (int t = t0; t + 1 < t1; t += 2) {
            if (t + 3 <= t1) ATT_LOADB(t + 3);
            ATT_KPRE(sn_);
            __builtin_amdgcn_sched_barrier(0);
            ATT_HEAD(t, p0, p1, n0, n1);
            ATT_QKF(n0, n1);
            ATT_EXP_PV(sc_, p0, p1);
            if (t + 2 <= t1) ATT_STORE(sw_);
            if (VAR != 4) __syncthreads();
            ATT_ROT();
            if (t + 4 <= t1) ATT_LOAD(t + 4);
            ATT_KPRE(sn_);
            __builtin_amdgcn_sched_barrier(0);
            ATT_HEAD(t + 1, n0, n1, p0, p1);
            ATT_QKF(p0, p1);
            ATT_EXP_PV(sc_, n0, n1);
            if (t + 3 <= t1) ATT_STOREB(sw_);
            if (VAR != 4) __syncthreads();
            ATT_ROT();
        }
        {
            ATT_KPRE(sn_);
            __builtin_amdgcn_sched_barrier(0);
            ATT_HEAD(t1 - 1, p0, p1, n0, n1);
            ATT_QKF(n0, n1);
            ATT_EXP_PV(sc_, p0, p1);
            __syncthreads();
            ATT_ROT();
        }
        ATT_HEAD(t1, n0, n1, p0, p1);
        ATT_EXP_PV(sc_, n0, n1);
        __syncthreads();
    } else {
        if (PIPE && t0 >= wt0 && t0 <= wt1) ATT_QK(p0, p1, 0);
        if (t0 + 2 <= t1) ATT_LOAD(t0 + 2);
#define ATT_STEP(t, LOADN, STOREC) do { \
            if ((t) + 3 <= t1) LOADN((t) + 3); \
            if (PIPE) { const bool nin = ((t) + 1 <= t1) && ((t) + 1 >= wt0) && ((t) + 1 <= wt1); if (nin) ATT_QK(n0, n1, sn_); } \
            else { if (VAR != 9 && VAR != 3 && (t) >= wt0 && (t) <= wt1) ATT_QK(p0, p1, sc_); } \
            if (VAR != 9 && (t) >= wt0 && (t) <= wt1) { ATT_HEAD(t, p0, p1, n0, n1); ATT_EXP_PV(sc_, p0, p1); } \
            if ((t) + 2 <= t1) STOREC(sw_); \
            __syncthreads(); \
            if (PIPE) { p0 = n0; p1 = n1; } \
            ATT_ROT(); } while (0)
        for (int t = t0; t <= t1; t += 2) {
            ATT_STEP(t, ATT_LOADB, ATT_STORE);
            if (t + 1 <= t1) ATT_STEP(t + 1, ATT_LOAD, ATT_STOREB);
        }
#undef ATT_STEP
    }
#undef ATT_HEAD
#undef ATT_EXP_PV
#undef ATT_ROT
#undef ATT_QK
#undef ATT_KPRE
#undef ATT_QKF
#undef ATT_LOAD
#undef ATT_LOADB
#undef ATT_STOREB
#undef ATT_STORE
    { auto rr = __builtin_amdgcn_permlane32_swap(__float_as_uint(lsum), __float_as_uint(lsum), false, false); lsum = __uint_as_float(rr[0]) + __uint_as_float(rr[1]); }
    if (hi == 0) wsf[32 + r32] = lsum;
    asm volatile("s_waitcnt lgkmcnt(0)" ::: "memory");
    float rli[16];
#pragma unroll
    for (int g4 = 0; g4 < 4; ++g4) { const f32x4 l4 = *(const LAS f32x4*)(wsf + 32 + 8 * g4 + 4 * hi);
#pragma unroll
        for (int j = 0; j < 4; ++j) rli[4 * g4 + j] = __builtin_amdgcn_rcpf(l4[j]); }
    LAS bf16_t* stg = (LAS bf16_t*)(lds + LDS_OST) + wid * 2048;
#pragma unroll
    for (int r = 0; r < 16; ++r) { const int orow = crow(r, hi);
#pragma unroll
        for (int d0 = 0; d0 < 2; ++d0) stg[orow * 64 + d0 * 32 + r32] = f2bf(o[d0][r] * rli[r]); }
    asm volatile("s_waitcnt lgkmcnt(0)" ::: "memory");
    bf16_t* Ow = Op + (size_t)wq0 * ldo;
#pragma unroll
    for (int i = 0; i < 4; ++i) { const int row = i * 8 + (lane >> 3), ch = lane & 7; const u32x4 v = *(const LAS u32x4*)(stg + row * 64 + ch * 8);
        if constexpr (O8) { *(GAS u32x2*)((unsigned char*)Op + (size_t)(wq0 + row) * ldo + ch * 8) = bf8_to_fp8x8(v); } else { *(GAS u32x4*)(Ow + (size_t)row * ldo + ch * 8) = v; } }
    asm volatile("s_waitcnt lgkmcnt(0)" ::: "memory");
}

template <int DQ, bool O8 = false, int WMODE = 0, bool NOMAX = false>
__device__ __forceinline__ void attn_unit2(const bf16_t* QpA, const bf16_t* QpB, const bf16_t* Kp, const bf16_t* Vp, bf16_t* OpA, bf16_t* OpB, int ldq, int ldk, int ldv, int ldo,
                                           int q0, LAS unsigned char* lds, int tid, float slA = 0.f, float slB = 0.f, float skA = 0.f, float skB = 0.f, const float* biasp = nullptr) {
    asm volatile("" : "+v"(tid));
    const int lane = tid & 63, r32 = lane & 31, hi = lane >> 5; const int wid = __builtin_amdgcn_readfirstlane(tid >> 6);
    constexpr int ND = DQ / 16;
    const int wq0 = q0 + wid * (WMODE == 2 ? 64 : 32);
    int t0 = 0, t1 = SEQ / 64 - 1, wt0 = 0, wt1 = SEQ / 64 - 1;
    if constexpr (WMODE == 2) { const int R0 = q0 >> 6; t0 = clampi(R0 - 4, 0, 56); t1 = clampi(R0 + 7 - 4, 0, 56) + 7; wt0 = clampi((wq0 >> 6) - 4, 0, 56); wt1 = wt0 + 7; }
    if constexpr (WMODE == 1) { t0 = (q0 >> 6) - 2; t0 = t0 < 0 ? 0 : t0; t1 = (q0 >> 6) + 5; t1 = t1 > 63 ? 63 : t1;
        int klo = wq0 - 128; klo = klo < 0 ? 0 : klo; int khi = wq0 + 31 + 128; khi = khi > SEQ - 1 ? SEQ - 1 : khi; wt0 = klo >> 6; wt1 = khi >> 6; }
    (void)wt0; (void)wt1;
    LAS float* wsf = (LAS float*)(lds + LDS_WSF) + wid * 128;
    bf16x8 qa[ND], qb[ND];
    { const bf16_t* Qw = QpA + (size_t)(wq0 + r32) * ldq + hi * 8; const bf16_t* Qv = QpB + (size_t)(wq0 + r32) * ldq + hi * 8;
#pragma unroll
      for (int d0 = 0; d0 < ND; ++d0) { qa[d0] = *(const GAS bf16x8*)(Qw + d0 * 16); qb[d0] = *(const GAS bf16x8*)(Qv + d0 * 16); } }
    const bf16_t* ksrc = Kp + (size_t)lane * ldk + wid * 8;
    const int k2off = __builtin_amdgcn_readfirstlane((8 + (wid & 3) - wid) * 8);
    const bf16_t* vsrc = Vp + (size_t)(16 * (wid & 3) + (lane >> 2)) * ldv + (wid >> 2) * 32 + (lane & 3) * 8;
    const int k2d = __builtin_amdgcn_readfirstlane((8 + (wid & 3) - wid) * 1024);
    const unsigned lds0 = (unsigned)(uintptr_t)lds;
#define A2_DMA(t, s) do { const size_t ro_ = (size_t)(t) * 64; const unsigned sb_ = (unsigned)__builtin_amdgcn_readfirstlane((int)(lds0 + (unsigned)((s) * STG + wid * 1024))); \
        glds16(ksrc + ro_ * ldk, sb_); \
        if (DQ == 96) glds16(ksrc + ro_ * ldk + k2off, sb_ + (unsigned)k2d); \
        glds16(vsrc + ro_ * ldv, sb_ + (unsigned)VOFF); } while (0)
    A2_DMA(t0, 0);
    asm volatile("s_waitcnt vmcnt(0)" ::: "memory");
    constexpr float THR = 8.0f;
    float mA = 0.f, mB = 0.f, lA = 0.f, lB = 0.f;
    LAS float* bt = (LAS float*)(lds + LDS_BIAS);
    if constexpr (WMODE == 2) { for (int i = tid; i < 15 * 31; i += 512) bt[i] = biasp[i] * LOG2E; }
    const int nA_ncs = 4 * hi - clampi(r32 - 8, 0, 48), nA_l = 4 * hi - r32 + 15, nB_ncs = 4 * hi - clampi(32 + r32 - 8, 0, 48), nB_l = 4 * hi - (32 + r32) + 15;
    (void)bt; (void)nA_ncs; (void)nA_l; (void)nB_ncs; (void)nB_l;
    if constexpr (WMODE == 1) { mA = skA; mB = skB; lA = (hi == 0) ? 1.0f : 0.0f; lB = lA; }
    f32x16 oa[2], ob[2];
#pragma unroll
    for (int r = 0; r < 16; ++r) { oa[0][r] = 0.f; oa[1][r] = 0.f; ob[0][r] = 0.f; ob[1][r] = 0.f; }
    __syncthreads();
#define A2_TILE(t, FIRST) do { \
        const int cur = ((t) - t0) & 1; \
        if ((t) < t1) A2_DMA((t) + 1, cur ^ 1); \
        if (WMODE == 0 || ((t) >= wt0 && (t) <= wt1)) { \
        const LAS unsigned char* Ks = lds + cur * STG; \
        const LAS unsigned char* kb = Ks + hi * 1024 + r32 * 16; \
        f32x16 a0, a1, b0, b1; \
        { const float na = -mA, nb = -mB; \
          _Pragma("unroll") for (int r = 0; r < 16; ++r) { a0[r] = na; a1[r] = na; b0[r] = nb; b1[r] = nb; } } \
        __builtin_amdgcn_s_setprio(1); \
        { bf16x8 k0 = *(const LAS bf16x8*)(kb), k1 = *(const LAS bf16x8*)(kb + 512);        \
          _Pragma("unroll") for (int d0 = 0; d0 < ND; ++d0) { \
            bf16x8 n0 = k0, n1 = k1; \
            if (d0 + 1 < ND) { n0 = *(const LAS bf16x8*)(kb + (d0 + 1) * 2048); n1 = *(const LAS bf16x8*)(kb + (d0 + 1) * 2048 + 512); } \
            a0 = __builtin_amdgcn_mfma_f32_32x32x16_bf16(k0, qa[d0], a0, 0, 0, 0); \
            b0 = __builtin_amdgcn_mfma_f32_32x32x16_bf16(k0, qb[d0], b0, 0, 0, 0); \
            a1 = __builtin_amdgcn_mfma_f32_32x32x16_bf16(k1, qa[d0], a1, 0, 0, 0); \
            b1 = __builtin_amdgcn_mfma_f32_32x32x16_bf16(k1, qb[d0], b1, 0, 0, 0); \
            k0 = n0; k1 = n1; \
            __builtin_amdgcn_sched_barrier(0); } } \
        __builtin_amdgcn_s_setprio(0); \
        if (WMODE == 1) {        \
            float relb_ = (float)((t) * 64 + 4 * hi - (wq0 + r32)); asm volatile("" : "+v"(relb_)); \
            _Pragma("unroll") for (int r = 0; r < 16; ++r) { const float rf0 = relb_ + (float)((r & 3) + 8 * (r >> 2)), rf1 = rf0 + 32.0f; \
                const bool in0 = __builtin_fabsf(rf0) <= 128.0f, in1 = __builtin_fabsf(rf1) <= 128.0f; \
                a0[r] = in0 ? __builtin_fmaf(-slA, __builtin_fabsf(rf0), a0[r]) : -INFINITY; a1[r] = in1 ? __builtin_fmaf(-slA, __builtin_fabsf(rf1), a1[r]) : -INFINITY; \
                b0[r] = in0 ? __builtin_fmaf(-slB, __builtin_fabsf(rf0), b0[r]) : -INFINITY; b1[r] = in1 ? __builtin_fmaf(-slB, __builtin_fabsf(rf1), b1[r]) : -INFINITY; } } \
        if (WMODE == 2) {        \
            const int dr31_ = ((t) - (wq0 >> 6) + 7) * 31; \
            { int ncs_ = nA_ncs; asm volatile("" : "+v"(ncs_)); const LAS float* bp_ = bt + dr31_ + nA_l; float bb0_[16], bb1_[16]; \
                \
              _Pragma("unroll") for (int r = 0; r < 16; ++r) { const int cr = (r & 3) + 8 * (r >> 2); bb0_[r] = bp_[cr]; bb1_[r] = (r < 4) ? bp_[cr + 32] : 0.f; } \
              __builtin_amdgcn_sched_barrier(0); \
              _Pragma("unroll") for (int r = 0; r < 16; ++r) { const int cr = (r & 3) + 8 * (r >> 2); \
                  a0[r] = ((unsigned)(cr + ncs_) < 16u) ? a0[r] + bb0_[r] : -INFINITY; a1[r] = (r < 4 && (unsigned)(cr + 32 + ncs_) < 16u) ? a1[r] + bb1_[r] : -INFINITY; } } \
            __builtin_amdgcn_sched_barrier(0); \
            { int ncs_ = nB_ncs; asm volatile("" : "+v"(ncs_)); const LAS float* bp_ = bt + dr31_ + nB_l; float bb0_[16], bb1_[16]; \
                \
              _Pragma("unroll") for (int r = 0; r < 16; ++r) { const int cr = (r & 3) + 8 * (r >> 2); bb0_[r] = (r >= 12) ? bp_[cr] : 0.f; bb1_[r] = bp_[cr + 32]; } \
              __builtin_amdgcn_sched_barrier(0); \
              _Pragma("unroll") for (int r = 0; r < 16; ++r) { const int cr = (r & 3) + 8 * (r >> 2); \
                  b0[r] = (r >= 12 && (unsigned)(cr + ncs_) < 16u) ? b0[r] + bb0_[r] : -INFINITY; b1[r] = ((unsigned)(cr + 32 + ncs_) < 16u) ? b1[r] + bb1_[r] : -INFINITY; } } } \
        float rA = -INFINITY, rB = -INFINITY; \
        if (!NOMAX) { \
        _Pragma("unroll") for (int r = 0; r < 16; ++r) { rA = fmaxf(fmaxf(rA, a0[r]), a1[r]); rB = fmaxf(fmaxf(rB, b0[r]), b1[r]); } \
        { auto rr = __builtin_amdgcn_permlane32_swap(__float_as_uint(rA), __float_as_uint(rA), false, false); rA = fmaxf(__uint_as_float(rr[0]), __uint_as_float(rr[1])); } \
        { auto rr = __builtin_amdgcn_permlane32_swap(__float_as_uint(rB), __float_as_uint(rB), false, false); rB = fmaxf(__uint_as_float(rr[0]), __uint_as_float(rr[1])); } \
        if (FIRST) { mA = rA; mB = rB; \
            _Pragma("unroll") for (int r = 0; r < 16; ++r) { a0[r] -= rA; a1[r] -= rA; b0[r] -= rB; b1[r] -= rB; } } } \
        float sA = 0.f, sB = 0.f; \
        _Pragma("unroll") for (int r = 0; r < 16; ++r) { a0[r] = __builtin_amdgcn_exp2f(a0[r]); a1[r] = (WMODE == 2 && r >= 4) ? 0.f : __builtin_amdgcn_exp2f(a1[r]); b0[r] = (WMODE == 2 && r < 12) ? 0.f : __builtin_amdgcn_exp2f(b0[r]); b1[r] = __builtin_amdgcn_exp2f(b1[r]); \
            sA += a0[r] + a1[r]; sB += b0[r] + b1[r]; } \
        lA += sA; lB += sB; \
        u32x4 pa[4], pb[4]; \
        _Pragma("unroll") for (int j = 0; j < 4; ++j) { pa[0][j] = cvt_pk_bf16(a0[2 * j], a0[2 * j + 1]); pa[1][j] = cvt_pk_bf16(a0[8 + 2 * j], a0[8 + 2 * j + 1]); \
                                      pa[2][j] = cvt_pk_bf16(a1[2 * j], a1[2 * j + 1]); pa[3][j] = cvt_pk_bf16(a1[8 + 2 * j], a1[8 + 2 * j + 1]); \
                                      pb[0][j] = cvt_pk_bf16(b0[2 * j], b0[2 * j + 1]); pb[1][j] = cvt_pk_bf16(b0[8 + 2 * j], b0[8 + 2 * j + 1]); \
                                      pb[2][j] = cvt_pk_bf16(b1[2 * j], b1[2 * j + 1]); pb[3][j] = cvt_pk_bf16(b1[8 + 2 * j], b1[8 + 2 * j + 1]); } \
        const LAS unsigned char* vp = Ks + VOFF + ((lane >> 4) & 1) * 32 + (lane & 3) * 8 + (4 * hi + ((lane & 15) >> 2)) * 64; \
        __builtin_amdgcn_s_setprio(1); \
        { s16x4 lo = vtr(vp), hh = vtr(vp + 512); \
          __builtin_amdgcn_sched_barrier(0); \
          _Pragma("unroll") for (int i = 0; i < 8; ++i) { \
            s16x4 nlo = lo, nhh = hh; \
            if (i + 1 < 8) { nlo = vtr(vp + ((i + 1) >> 2) * 4096 + ((i + 1) & 3) * 1024); nhh = vtr(vp + ((i + 1) >> 2) * 4096 + ((i + 1) & 3) * 1024 + 512); } \
            const bf16x8 vf = (bf16x8){lo[0], lo[1], lo[2], lo[3], hh[0], hh[1], hh[2], hh[3]}; \
            if (!(WMODE == 2 && (i & 3) == 3)) oa[i >> 2] = __builtin_amdgcn_mfma_f32_32x32x16_bf16(__builtin_bit_cast(bf16x8, pa[i & 3]), vf, oa[i >> 2], 0, 0, 0);        \
            if (!(WMODE == 2 && (i & 3) == 0)) ob[i >> 2] = __builtin_amdgcn_mfma_f32_32x32x16_bf16(__builtin_bit_cast(bf16x8, pb[i & 3]), vf, ob[i >> 2], 0, 0, 0); \
            lo = nlo; hh = nhh; \
            __builtin_amdgcn_sched_barrier(0); } } \
        __builtin_amdgcn_s_setprio(0); \
        if (!NOMAX && !(FIRST) && __any(rA > THR || rB > THR)) { \
            const float dA = fmaxf(rA, 0.f), dB = fmaxf(rB, 0.f); mA += dA; mB += dB; \
            const float fA = __builtin_amdgcn_exp2f(-dA), fB = __builtin_amdgcn_exp2f(-dB); \
            lA *= fA; lB *= fB; \
            if (hi == 0) { wsf[r32] = fA; wsf[32 + r32] = fB; } \
            asm volatile("s_waitcnt lgkmcnt(0)" ::: "memory"); \
            _Pragma("unroll") for (int g4 = 0; g4 < 4; ++g4) { const f32x4 f4 = *(const LAS f32x4*)(wsf + 8 * g4 + 4 * hi), h4 = *(const LAS f32x4*)(wsf + 32 + 8 * g4 + 4 * hi); \
                _Pragma("unroll") for (int j = 0; j < 4; ++j) { oa[0][4 * g4 + j] *= f4[j]; oa[1][4 * g4 + j] *= f4[j]; ob[0][4 * g4 + j] *= h4[j]; ob[1][4 * g4 + j] *= h4[j]; } } \
            asm volatile("s_waitcnt lgkmcnt(0)" ::: "memory"); \
        } } \
        asm volatile("s_waitcnt vmcnt(0)" ::: "memory"); \
        __syncthreads(); } while (0)
    if constexpr (WMODE == 0) {
        A2_TILE(t0, true);
        for (int t = t0 + 1; t <= t1; ++t) A2_TILE(t, false);
    } else if constexpr (WMODE == 2) {
#pragma unroll 1
        for (int t = t0; t <= t1; ++t) { const bool fw_ = (t == wt0); A2_TILE(t, fw_); }
    } else {
#pragma unroll 1
        for (int t = t0; t <= t1; ++t) A2_TILE(t, false);
    }
#undef A2_TILE
#undef A2_DMA
    { auto rr = __builtin_amdgcn_permlane32_swap(__float_as_uint(lA), __float_as_uint(lA), false, false); lA = __uint_as_float(rr[0]) + __uint_as_float(rr[1]); }
    { auto rr = __builtin_amdgcn_permlane32_swap(__float_as_uint(lB), __float_as_uint(lB), false, false); lB = __uint_as_float(rr[0]) + __uint_as_float(rr[1]); }
    if (hi == 0) { wsf[64 + r32] = lA; wsf[96 + r32] = lB; }
    asm volatile("s_waitcnt lgkmcnt(0)" ::: "memory");
    LAS bf16_t* stg = (LAS bf16_t*)(lds + LDS_OST) + wid * 2048;
#pragma unroll
    for (int blk = 0; blk < 2; ++blk) {
        float rli[16];
#pragma unroll
        for (int g4 = 0; g4 < 4; ++g4) { const f32x4 l4 = *(const LAS f32x4*)(wsf + 64 + 32 * blk + 8 * g4 + 4 * hi);
#pragma unroll
            for (int j = 0; j < 4; ++j) rli[4 * g4 + j] = __builtin_amdgcn_rcpf(l4[j]); }
#pragma unroll
        for (int r = 0; r < 16; ++r) { const int orow = crow(r, hi);
#pragma unroll
            for (int d0 = 0; d0 < 2; ++d0) stg[orow * 64 + d0 * 32 + r32] = f2bf((blk == 0 ? oa[d0][r] : ob[d0][r]) * rli[r]); }
        asm volatile("s_waitcnt lgkmcnt(0)" ::: "memory");
        bf16_t* Ow = (blk == 0 ? OpA : OpB) + (size_t)wq0 * ldo;
#pragma unroll
        for (int i = 0; i < 4; ++i) { const int row = i * 8 + (lane >> 3), ch = lane & 7; const u32x4 v = *(const LAS u32x4*)(stg + row * 64 + ch * 8);
            if constexpr (O8) { *(GAS u32x2*)((unsigned char*)(blk == 0 ? OpA : OpB) + (size_t)(wq0 + row) * ldo + ch * 8) = bf8_to_fp8x8(v); } else { *(GAS u32x4*)(Ow + (size_t)row * ldo + ch * 8) = v; } }
        asm volatile("s_waitcnt lgkmcnt(0)" ::: "memory");
    }
}
}
constexpr size_t MiB = 1u << 20;
constexpr size_t WS_CTL = 0, CTL_ZERO_BYTES = 1 * MiB;
constexpr size_t WS_MOD = 1 * MiB;
constexpr size_t WS_ROPE = 2 * MiB;

constexpr size_t WS_TOKES = 3 * MiB;
constexpr size_t WS_TOKW = 3 * MiB + 512 * 1024;
constexpr size_t WS_LIST = 4 * MiB;
constexpr size_t WS_W = 8 * MiB;
constexpr size_t W_IN = 0, W_UQ = W_IN + (size_t)NPROJ * 1024 * 2, W_UKV = W_UQ + 512 * 256 * 2, W_BR = W_UKV + 512 * 256 * 2, W_OUT = W_BR + (size_t)4 * 1024 * 256 * 2,
                 W_RT = W_OUT + (size_t)1024 * 1024 * 2, W_E13 = W_RT + 256 * 1024 * 2, W_E2 = W_E13 + (size_t)32 * 512 * 1024 * 2, W_END = W_E2 + (size_t)32 * 1024 * 256 * 2;
static_assert(W_END <= 66 * MiB, "weights region");
constexpr size_t WS_HB = 74 * MiB;
constexpr size_t WS_QC = 138 * MiB, WS_KC = 162 * MiB, WS_VC = 186 * MiB;
constexpr size_t WS_PROJ = 202 * MiB;
constexpr size_t WS_HS = WS_PROJ, WS_YS = WS_PROJ + 40 * MiB;
constexpr size_t WS_END = WS_PROJ + (size_t)MTOK * (LDP * 2 + 4096);
constexpr size_t WS_XB = WS_END, WS_SSQ = WS_END + (size_t)MTOK * DM * 2, WS_END2 = WS_SSQ + (size_t)MTOK * 16 * 4;
static_assert((size_t)SORTROWS * 256 * 2 <= 40 * MiB && WS_YS + (size_t)SORTROWS * 1024 * 2 <= WS_END, "moe overlay");
constexpr size_t WS_W2 = WS_END2;
constexpr size_t WS_END3 = WS_W2 + 66 * MiB;
constexpr size_t WS_HB8 = WS_END3, WS_Y8 = WS_HB8 + (size_t)MTOK * DM, WS_END4 = WS_Y8 + (size_t)MTOK * DM;
constexpr size_t W_G8 = W_IN + (size_t)2304 * 1024 * 2;
constexpr int CW_BAR = 4096;
constexpr int CW_ECNT = 16384;
constexpr int RING_BYTES = 131072;
constexpr int LC_TEND = RING_BYTES, LC_CNT = RING_BYTES + 128, LC_BARW = RING_BYTES + 256, LC_XCH = RING_BYTES + 1024;
constexpr int LDS_BYTES = 147456;
constexpr int NWAVES = 8;

#define RLX_AGENT __ATOMIC_RELAXED, __HIP_MEMORY_SCOPE_AGENT

#define XB_TMO      128
#define XB_XCNT(j)  (256  + 64 * (j))
#define XB_XSUB(j)  (1280 + 64 * (j))
#define XB_XGEN(j)  (2304 + 64 * (j))
#define XB_TOP      3328
#define XB_TOPGEN   3392
#define XCD_BAR_WORDS 3456
#define XB_SPIN_CAP (1u << 18)
__device__ __forceinline__ unsigned xb_ld(unsigned* p)              { return __hip_atomic_load(p, __ATOMIC_RELAXED, __HIP_MEMORY_SCOPE_AGENT); }
__device__ __forceinline__ unsigned xb_add(unsigned* p, unsigned v) { return __hip_atomic_fetch_add(p, v, __ATOMIC_RELAXED, __HIP_MEMORY_SCOPE_AGENT); }
__device__ __forceinline__ unsigned xb_xcc_id() { return (unsigned)__builtin_amdgcn_s_getreg((3 << 11) | 20) & 0xFu; }
#define XB_SPIN(cond, bar) do { unsigned _sp = 0; while (cond) { __builtin_amdgcn_s_sleep(1); \
    if ((++_sp & 255u) == 0u) { if (xb_ld(&(bar)[XB_TMO])) break; if (_sp > XB_SPIN_CAP) { atomicAdd(&(bar)[XB_TMO], 1u); break; } } } } while (0)
struct XcdBarrier { unsigned* bar; unsigned x; volatile LAS unsigned* st; };
__device__ __forceinline__ XcdBarrier xcd_barrier_post(unsigned* bar, volatile LAS unsigned* st) {
    XcdBarrier b; b.bar = bar; b.x = xb_xcc_id(); b.st = st;
    if (threadIdx.x == 0) (void)xb_add(&bar[XB_XCNT(b.x)], 1u);
    return b;
}
__device__ __forceinline__ void xcd_barrier_complete(unsigned* bar, unsigned x, unsigned& nloc, unsigned& nx) {
    const unsigned G = gridDim.x * gridDim.y * gridDim.z;
    unsigned sum, cnt, mine, sp = 0u;
    for (;;) {
        sum = 0u; cnt = 0u; mine = 0u;
#pragma unroll
        for (unsigned j = 0; j < 16; ++j) { const unsigned c = xb_ld(&bar[XB_XCNT(j)]); sum += c; cnt += (c > 0u) ? 1u : 0u; mine = (j == x) ? c : mine; }
        if (sum == G) break;
        __builtin_amdgcn_s_sleep(1);
        if ((++sp & 255u) == 0u) { if (xb_ld(&bar[XB_TMO])) break; if (sp > XB_SPIN_CAP) { atomicAdd(&bar[XB_TMO], 1u); break; } }
    }
    nloc = mine > 0u ? mine : 1u; nx = cnt > 0u ? cnt : 1u;
}
__device__ __forceinline__ void xcd_barrier(const XcdBarrier& b, const bool leader) {
    asm volatile("s_waitcnt vmcnt(0)" ::: "memory");
    __syncthreads();
    if (leader) {
        unsigned* bar = b.bar;
        __builtin_amdgcn_s_waitcnt(0);
        unsigned nloc = b.st[0], nx = b.st[1];
        if (nloc == 0u) { xcd_barrier_complete(bar, b.x, nloc, nx); b.st[0] = nloc; b.st[1] = nx; }
        const unsigned old = xb_add(&bar[XB_XSUB(b.x)], 1u);
        const unsigned gen = old / nloc;
        if (old + 1u == (gen + 1u) * nloc) {
            __builtin_amdgcn_fence(__ATOMIC_RELEASE, "agent");
            asm volatile("s_waitcnt vmcnt(0)" ::: "memory");
            const unsigned og = xb_add(&bar[XB_TOP], 1u);
            const unsigned tg = og / nx;
            if (og + 1u == (tg + 1u) * nx) xb_add(&bar[XB_TOPGEN], 1u);
            else XB_SPIN(xb_ld(&bar[XB_TOPGEN]) == tg, bar);
            __builtin_amdgcn_fence(__ATOMIC_ACQUIRE, "agent");
            xb_add(&bar[XB_XGEN(b.x)], 1u);
            asm volatile("s_waitcnt vmcnt(0)" ::: "memory");
        } else {
            XB_SPIN(xb_ld(&bar[XB_XGEN(b.x)]) == gen, bar);
            __builtin_amdgcn_fence(__ATOMIC_ACQUIRE, "agent");
            asm volatile("s_waitcnt vmcnt(0)" ::: "memory");
        }
    }
    __syncthreads();
}

struct Frame {
    LAS unsigned char* lds;
    unsigned* ctl;
    int tid, lane, wave, vcu, G;
    float* out; unsigned char* ws;
};
struct Args { const float* in[25]; float* out; unsigned char* ws; int ph_lo, ph_hi; };
#define GIN(i) ((const float*)(const GAS float*)KA.in[i])
__device__ __forceinline__ float wave_sum(float v) {
    v += xshfl<1>(v); v += xshfl<2>(v); v += xshfl<4>(v); v += xshfl<8>(v); v += xshfl<16>(v); v += xshfl<32>(v);
    return v;
}
#define LDS_WAIT() asm volatile("s_waitcnt lgkmcnt(0)" ::: "memory")

__device__ __forceinline__ void p0_phase(Frame& F, const Args& KA) {
    LAS float* cact = (LAS float*)F.lds;
    LAS float* part = (LAS float*)(F.lds + 32768);
    const float* c = GIN(1); const float* w_ada = GIN(2); const float* b_ada = GIN(3);
    float* mod = (float*)(F.ws + WS_MOD);
    for (int i = F.tid; i < NB * DM; i += NWAVES * 64) { const float v = c[i]; cact[i] = v / (1.0f + __expf(-v)); }
    __syncthreads();
    for (int cb = blockIdx.x; cb < DEPTH * 96; cb += F.G) {
        const int l = cb / 96, n0 = (cb % 96) * 64;
        const float* w = w_ada + ((size_t)l * DM + F.wave * 128) * 6144 + n0 + F.lane;
        float acc[NB];
#pragma unroll
        for (int b = 0; b < NB; ++b) acc[b] = 0.f;
#pragma unroll 8
        for (int k = 0; k < 128; ++k) { const float wv = w[(size_t)k * 6144];
#pragma unroll
            for (int b = 0; b < NB; ++b) acc[b] += cact[b * DM + F.wave * 128 + k] * wv; }
#pragma unroll
        for (int b = 0; b < NB; ++b) part[(F.wave * NB + b) * 64 + F.lane] = acc[b];
        __syncthreads();
        { const int b = F.tid >> 6; float s = b_ada[l * 6144 + n0 + F.lane];
#pragma unroll
          for (int w8 = 0; w8 < NWAVES; ++w8) s += part[(w8 * NB + b) * 64 + F.lane];
          mod[((size_t)l * NB + b) * 6144 + n0 + F.lane] = s; }
        __syncthreads();
    }
    float* cs = (float*)(F.ws + WS_ROPE);
    for (int id = blockIdx.x * (NWAVES * 64) + F.tid; id < SEQ * 16; id += F.G * NWAVES * 64) {
        const int pos = id >> 4, f = id & 15;
        const float inv = powf(10000.0f, -(float)(2 * f) / 32.0f);
        const float ang = (float)pos * inv;
        cs[id] = cosf(ang); cs[SEQ * 16 + id] = sinf(ang);
    }
}

template <class RowMap>
__device__ __forceinline__ void transpose_item(const float* W, int ldw, int k0, int n0, bf16_t* WT, int ldt, const RowMap& rm, LAS float* scr, int lane, const float* kscale = nullptr, float cscale = 1.0f) {
    { const float* wp = (const float*)(const GAS float*)W + (size_t)(k0 + (lane >> 5)) * ldw + n0 + (lane & 31);
      float wv[32];
#pragma unroll
      for (int i = 0; i < 32; ++i) wv[i] = *(const GAS float*)(wp + (size_t)(2 * i) * ldw);
#pragma unroll
      for (int i = 0; i < 32; ++i) { const int kk = 2 * i + (lane >> 5); float v = wv[i]; if (kscale) v *= kscale[k0 + kk]; scr[kk * 33 + (lane & 31)] = v * cscale; } }
    LDS_WAIT(); asm volatile("" ::: "memory");
    const int c = lane & 7;
#pragma unroll
    for (int j = 0; j < 4; ++j) { const int n = (lane >> 3) + 8 * j; const LAS float* s = scr + (8 * c) * 33 + n;
        u32x4 o; o.x = cvt_pk_bf16(s[0 * 33], s[1 * 33]); o.y = cvt_pk_bf16(s[2 * 33], s[3 * 33]); o.z = cvt_pk_bf16(s[4 * 33], s[5 * 33]); o.w = cvt_pk_bf16(s[6 * 33], s[7 * 33]);
        *(u32x4*)(WT + (size_t)rm(n0 + n) * ldt + k0 + 8 * c) = o; }
    LDS_WAIT(); asm volatile("" ::: "memory");
}
__device__ __forceinline__ void transpose_item_f8(const float* W, int ldw, int k0, int n0, unsigned char* WT, int ldt, int nbase, LAS float* scr, int lane, float cscale) {
    { const float* wp = (const float*)(const GAS float*)W + (size_t)(k0 + (lane >> 5)) * ldw + n0 + (lane & 31);
      float wv[32];
#pragma unroll
      for (int i = 0; i < 32; ++i) wv[i] = *(const GAS float*)(wp + (size_t)(2 * i) * ldw);
#pragma unroll
      for (int i = 0; i < 32; ++i) { const int kk = 2 * i + (lane >> 5); scr[kk * 33 + (lane & 31)] = wv[i] * cscale; } }
    LDS_WAIT(); asm volatile("" ::: "memory");
    const int c = lane & 7;
#pragma unroll
    for (int j = 0; j < 4; ++j) { const int n = (lane >> 3) + 8 * j; const LAS float* s = scr + (8 * c) * 33 + n;
        u32x2 o; o.x = pk_fp8x4(s[0 * 33], s[1 * 33], s[2 * 33], s[3 * 33]); o.y = pk_fp8x4(s[4 * 33], s[5 * 33], s[6 * 33], s[7 * 33]);
        *(u32x2*)(WT + (size_t)(n0 + n - nbase) * ldt + k0 + 8 * c) = o; }
    LDS_WAIT(); asm volatile("" ::: "memory");
}
__device__ __forceinline__ int pairpos(int j) { const int f = j & 15, p = j >> 4; return 8 * (f >> 2) + 4 * p + (f & 3); }
struct MapIn   { __device__ __forceinline__ int operator()(int n) const {
    if (n < 1280) return n;
    if (n < 1728) return n + 512;
    if (n < 1760) return 2240 + pairpos(n - 1728);
    if (n < 2144) { const int d = n - 1760; return 1280 + (d & ~31) + pairpos(d & 31); }
    if (n < 2272) return n - 480;
    return n + 32; } };
struct MapId   { __device__ __forceinline__ int operator()(int n) const { return n; } };
struct MapUkv  { __device__ __forceinline__ int operator()(int n) const { const int h = n >> 7, j = n & 127; return j < 64 ? 64 * h + j : 256 + 64 * h + (j - 64); } };
struct MapE13  { int add; __device__ __forceinline__ int operator()(int n) const { return 8 * (n >> 2) + (n & 3) + add; } };

__device__ __forceinline__ void convert_weights(Frame& F, const Args& KA, int l, unsigned char* wb, int it_lo, int it_hi, int gw, int NGW, bool smalls) {
    LAS float* scr = (LAS float*)(F.lds + F.wave * 16384);
    const float* w_in = GIN(6) + (size_t)l * DM * 6368;
    const float* w_ukv = GIN(12) + (size_t)l * 256 * 512;
    const float* w_br = GIN(15) + (size_t)l * 4 * 256 * DM;
    const float* w_out = GIN(16) + (size_t)l * DM * DM;
    const float* w_e1 = GIN(21) + (size_t)l * NEXP * DM * 256;
    const float* w_e3 = GIN(22) + (size_t)l * NEXP * DM * 256;
    const float* w_e2 = GIN(23) + (size_t)l * NEXP * 256 * DM;
    constexpr int I_IN = 16 * 199, I_BR = 4 * 4 * 32, I_OUT = 16 * 32, I_UKV = 4 * 16, I_E1 = NEXP * 16 * 8, I_E2 = NEXP * 4 * 32;
    constexpr int NITEMS = I_IN + I_BR + I_OUT + I_UKV + 2 * I_E1 + I_E2;
    if (it_hi > NITEMS) it_hi = NITEMS;
    for (int it = it_lo + gw; it < it_hi; it += NGW) {
        int r = it;
        if (r < I_IN) { const int kb = r / 199, nb = r % 199;
            if (nb >= 71) transpose_item_f8(w_in, 6368, 64 * kb, 32 * nb, wb + W_G8, DM, 2272, scr, F.lane, -LOG2E * pg8::GATE_WSCALE);
            else transpose_item(w_in, 6368, 64 * kb, 32 * nb, (bf16_t*)(wb + W_IN), DM, MapIn{}, scr, F.lane); continue; } r -= I_IN;
        if (r < I_BR) { const int n = r >> 7, q = r & 127, kb = q >> 5, nb = q & 31; transpose_item_f8(w_br + (size_t)n * 256 * DM, DM, 64 * kb, 32 * nb, wb + W_BR + (size_t)n * DM * 256, 256, 0, scr, F.lane, pg8::MERGE_WSCALE); continue; } r -= I_BR;
        if (r < I_OUT) { const int kb = r >> 5, nb = r & 31; transpose_item(w_out, DM, 64 * kb, 32 * nb, (bf16_t*)(wb + W_OUT), DM, MapId{}, scr, F.lane); continue; } r -= I_OUT;
        if (r < I_UKV) { const int kb = r >> 4, nb = r & 15; transpose_item(w_ukv, 512, 64 * kb, 32 * nb, (bf16_t*)(wb + W_UKV), 256, MapUkv{}, scr, F.lane, GIN(10) + l * 256); continue; } r -= I_UKV;
        if (r < I_E1) { const int e = r >> 7, q = r & 127, kb = q >> 3, nb = q & 7; transpose_item(w_e1 + (size_t)e * DM * 256, 256, 64 * kb, 32 * nb, (bf16_t*)(wb + W_E13) + (size_t)e * 512 * DM, DM, MapE13{0}, scr, F.lane); continue; } r -= I_E1;
        if (r < I_E1) { const int e = r >> 7, q = r & 127, kb = q >> 3, nb = q & 7; transpose_item(w_e3 + (size_t)e * DM * 256, 256, 64 * kb, 32 * nb, (bf16_t*)(wb + W_E13) + (size_t)e * 512 * DM, DM, MapE13{4}, scr, F.lane); continue; } r -= I_E1;
        { const int e = r >> 7, q = r & 127, kb = q >> 5, nb = q & 31; transpose_item(w_e2 + (size_t)e * 256 * DM, DM, 64 * kb, 32 * nb, (bf16_t*)(wb + W_E2) + (size_t)e * DM * 256, 256, MapId{}, scr, F.lane); }
    }
    if (!smalls) return;
    const float* w_uq = GIN(11) + (size_t)l * 192 * 384;
    const float* w_g = GIN(17) + (size_t)l * DM * 4;
    const float* w_r = GIN(19) + (size_t)l * DM * 32;
    bf16_t* uq = (bf16_t*)(wb + W_UQ); bf16_t* rt = (bf16_t*)(wb + W_RT); bf16_t* win = (bf16_t*)(wb + W_IN);
    const int gt = blockIdx.x * (NWAVES * 64) + F.tid, NT = F.G * NWAVES * 64;
    for (int i = gt; i < 512 * 256; i += NT) {
        const int r = i >> 8, k = i & 255; float v = 0.f;
        if (r < 384 && k < 192) { const int h = r / 96, j = r % 96; int src;
            if (j < 64) src = 96 * h + j;
            else { const int q = j - 64, fb = q >> 3, p = (q >> 2) & 1, f = 4 * fb + (q & 3); src = 96 * h + 64 + 16 * p + f; }
            v = w_uq[(size_t)k * 384 + src] * GIN(9)[l * 192 + k]; }
        uq[i] = f2bf(v);
    }
    for (int i = gt; i < 256 * DM; i += NT) {
        const int r = i >> 10, k = i & 1023; float v = 0.f;
        if (r < 4) v = w_g[k * 4 + r]; else if (r < 36) v = w_r[k * 32 + (r - 4)];
        rt[i] = f2bf(v);
    }
    for (int i = gt; i < 32 * DM; i += NT) win[(size_t)2272 * DM + i] = 0;
}

__device__ __forceinline__ void load_moe_tables(Frame& F, int l) {
    LAS int* tend = (LAS int*)(F.lds + LC_TEND); LAS int* cnt = (LAS int*)(F.lds + LC_CNT);
    if (F.tid < NEXP) cnt[F.tid] = (int)__hip_atomic_load(F.ctl + CW_ECNT + 64 * l + F.tid, RLX_AGENT);
    __syncthreads();
    if (F.tid == 0) { int acc = 0; for (int e = 0; e < NEXP; ++e) { acc += (cnt[e] + 255) >> 8; tend[e] = acc; } }
    __syncthreads();
}

__device__ __forceinline__ void norm_phase(Frame& F, const float* xsrc, const bf16_t* xbsrc, bf16_t* xdst, bool combine, const float* g2prev, const float* gain, const float* shv, const float* scv,
                                           bf16_t* hout, float* fout, const bf16_t* delta = nullptr, unsigned char* h8out = nullptr) {
    const int gw = F.vcu * NWAVES + F.wave, NGW = F.G * NWAVES;
    const int rpw = (((MTOK + NGW - 1) / NGW) + 3) & ~3;
    int m0 = gw * rpw, m1 = m0 + rpw; m1 = m1 > MTOK ? MTOK : m1;
    const LAS int* tend = (const LAS int*)(F.lds + LC_TEND);
    const int* tok_es = (const int*)(F.ws + WS_TOKES); const float* tok_w = (const float*)(F.ws + WS_TOKW);
    const bf16_t* YS = (const bf16_t*)(F.ws + WS_YS);
    f32x4 A[4], B[4], G2[4]; int bcur = -1;
#pragma unroll
    for (int j = 0; j < 4; ++j) { A[j] = (f32x4){0.f, 0.f, 0.f, 0.f}; B[j] = A[j]; G2[j] = A[j]; }
    const int lc8 = 8 * F.lane;
#define NP_COL(j) (lc8 + 512 * ((j) >> 1) + 4 * ((j) & 1))
#define NP_UNPACK(W_, LO_, HI_) do { const u32x4 w__ = (W_); LO_ = (f32x4){bflo(w__.x), bfhi(w__.x), bflo(w__.y), bfhi(w__.y)}; HI_ = (f32x4){bflo(w__.z), bfhi(w__.z), bflo(w__.w), bfhi(w__.w)}; } while (0)
#define NP_PACK(LO_, HI_) ((u32x4){cvt_pk_bf16((LO_).x, (LO_).y), cvt_pk_bf16((LO_).z, (LO_).w), cvt_pk_bf16((HI_).x, (HI_).y), cvt_pk_bf16((HI_).z, (HI_).w)})
    u32x4 xb[4][2];
#pragma unroll
    for (int r = 0; r < 4; ++r) { xb[r][0] = (u32x4){0u, 0u, 0u, 0u}; xb[r][1] = xb[r][0]; }
    const bool pf = !combine;
    if (pf && m0 < m1 && xbsrc) {
#pragma unroll
        for (int r = 0; r < 4; ++r)
#pragma unroll
            for (int q = 0; q < 2; ++q) xb[r][q] = __builtin_nontemporal_load((const GAS u32x4*)(xbsrc + (size_t)(m0 + r) * DM + lc8 + 512 * q)); }
    for (int m = m0; m < m1; m += 4) {
        const int b = m >> 12;
        if (b != bcur) { bcur = b;
#pragma unroll
            for (int j = 0; j < 4; ++j) { const int col = NP_COL(j); const f32x4 gn = *(const f32x4*)(gain + col);
                if (scv) { const f32x4 sc = *(const f32x4*)(scv + b * 6144 + col); A[j] = gn * (sc + 1.0f); B[j] = *(const f32x4*)(shv + b * 6144 + col); } else { A[j] = gn; }
                if (combine) G2[j] = *(const f32x4*)(g2prev + b * 6144 + col); } }
        f32x4 v[4][4];
        if (xbsrc) {
            if (!pf) {
#pragma unroll
                for (int r = 0; r < 4; ++r)
#pragma unroll
                    for (int q = 0; q < 2; ++q) xb[r][q] = __builtin_nontemporal_load((const GAS u32x4*)(xbsrc + (size_t)(m + r) * DM + lc8 + 512 * q)); }
#pragma unroll
            for (int r = 0; r < 4; ++r)
#pragma unroll
                for (int q = 0; q < 2; ++q) NP_UNPACK(xb[r][q], v[r][2 * q], v[r][2 * q + 1]);
            if (pf && m + 4 < m1) {
#pragma unroll
                for (int r = 0; r < 4; ++r)
#pragma unroll
                    for (int q = 0; q < 2; ++q) xb[r][q] = __builtin_nontemporal_load((const GAS u32x4*)(xbsrc + (size_t)(m + 4 + r) * DM + lc8 + 512 * q)); }
        } else {
#pragma unroll
            for (int r = 0; r < 4; ++r)
#pragma unroll
                for (int j = 0; j < 4; ++j) v[r][j] = *(const GAS f32x4*)(xsrc + (size_t)(m + r) * DM + NP_COL(j));
        }
        if (delta) {
            u32x4 dl[4][2];
#pragma unroll
            for (int r = 0; r < 4; ++r)
#pragma unroll
                for (int q = 0; q < 2; ++q) dl[r][q] = *(const GAS u32x4*)(delta + (size_t)(m + r) * DM + lc8 + 512 * q);
#pragma unroll
            for (int r = 0; r < 4; ++r)
#pragma unroll
                for (int q = 0; q < 2; ++q) { f32x4 a, c; NP_UNPACK(dl[r][q], a, c); v[r][2 * q] = v[r][2 * q] + a; v[r][2 * q + 1] = v[r][2 * q + 1] + c; }
            if (xdst) {
#pragma unroll
                for (int r = 0; r < 4; ++r)
#pragma unroll
                    for (int q = 0; q < 2; ++q) *(GAS u32x4*)(xdst + (size_t)(m + r) * DM + lc8 + 512 * q) = NP_PACK(v[r][2 * q], v[r][2 * q + 1]); }
        }
        if (combine) {
            int esc[4][2]; float wwc[4][2];
#pragma unroll
            for (int r = 0; r < 4; ++r) { esc[r][0] = tok_es[2 * (m + r)]; esc[r][1] = tok_es[2 * (m + r) + 1]; wwc[r][0] = tok_w[2 * (m + r)]; wwc[r][1] = tok_w[2 * (m + r) + 1]; }
            u32x4 y[4][2][2];
#pragma unroll
            for (int r = 0; r < 4; ++r)
#pragma unroll
                for (int k = 0; k < 2; ++k) { const int e = esc[r][k] >> 16; const int rr = 256 * (e ? tend[e - 1] : 0) + (esc[r][k] & 0xffff);
#pragma unroll
                    for (int q = 0; q < 2; ++q) y[r][k][q] = __builtin_nontemporal_load((const GAS u32x4*)(YS + (size_t)rr * DM + lc8 + 512 * q)); }
#pragma unroll
            for (int r = 0; r < 4; ++r)
#pragma unroll
                for (int q = 0; q < 2; ++q) { f32x4 a0, a1, c0, c1; NP_UNPACK(y[r][0][q], a0, a1); NP_UNPACK(y[r][1][q], c0, c1);
                    v[r][2 * q] = v[r][2 * q] + G2[2 * q] * (a0 * wwc[r][0] + c0 * wwc[r][1]); v[r][2 * q + 1] = v[r][2 * q + 1] + G2[2 * q + 1] * (a1 * wwc[r][0] + c1 * wwc[r][1]); }
            if (xdst) {
#pragma unroll
                for (int r = 0; r < 4; ++r)
#pragma unroll
                    for (int q = 0; q < 2; ++q) *(GAS u32x4*)(xdst + (size_t)(m + r) * DM + lc8 + 512 * q) = NP_PACK(v[r][2 * q], v[r][2 * q + 1]); }
        }
        float s[4];
#pragma unroll
        for (int r = 0; r < 4; ++r) { s[r] = 0.f;
#pragma unroll
            for (int j = 0; j < 4; ++j) s[r] += (v[r][j].x * v[r][j].x + v[r][j].y * v[r][j].y) + (v[r][j].z * v[r][j].z + v[r][j].w * v[r][j].w); }
#pragma unroll
        for (int r = 0; r < 4; ++r) s[r] += xshfl<1>(s[r]);
#pragma unroll
        for (int r = 0; r < 4; ++r) s[r] += xshfl<2>(s[r]);
#pragma unroll
        for (int r = 0; r < 4; ++r) s[r] += xshfl<4>(s[r]);
#pragma unroll
        for (int r = 0; r < 4; ++r) s[r] += xshfl<8>(s[r]);
#pragma unroll
        for (int r = 0; r < 4; ++r) s[r] += xshfl<16>(s[r]);
#pragma unroll
        for (int r = 0; r < 4; ++r) s[r] += xshfl<32>(s[r]);
#pragma unroll
        for (int r = 0; r < 4; ++r) { const float rstd = rsqrtf(s[r] * (1.0f / DM) + EPS);
            f32x4 o[4];
#pragma unroll
            for (int j = 0; j < 4; ++j) o[j] = v[r][j] * rstd * A[j] + B[j];
#pragma unroll
            for (int q = 0; q < 2; ++q) {
                if (hout) *(GAS u32x4*)(hout + (size_t)(m + r) * DM + lc8 + 512 * q) = NP_PACK(o[2 * q], o[2 * q + 1]);
                if (h8out) { u32x2 w8; w8.x = pk_fp8x4(o[2 * q].x, o[2 * q].y, o[2 * q].z, o[2 * q].w); w8.y = pk_fp8x4(o[2 * q + 1].x, o[2 * q + 1].y, o[2 * q + 1].z, o[2 * q + 1].w);
                    *(GAS u32x2*)(h8out + (size_t)(m + r) * DM + lc8 + 512 * q) = w8; }
                if (fout) { *(GAS f32x4*)(fout + (size_t)(m + r) * DM + NP_COL(2 * q)) = o[2 * q]; *(GAS f32x4*)(fout + (size_t)(m + r) * DM + NP_COL(2 * q + 1)) = o[2 * q + 1]; } } }
    }
#undef NP_COL
#undef NP_UNPACK
#undef NP_PACK
}

__device__ __forceinline__ void prep_phase(Frame& F, const Args& KA, int l, bool dummy = false) {
    const int gw = F.vcu * NWAVES + F.wave, NGW = F.G * NWAVES;
    bf16_t* P = (bf16_t*)(F.ws + WS_PROJ); bf16_t* KC = (bf16_t*)(F.ws + WS_KC);
    const float* cs = (const float*)(F.ws + WS_ROPE);
    const float* gq = GIN(9) + l * 192; const float* gkv = GIN(10) + l * 256; const float* gaq = GIN(13) + l * 64; const float* gak = GIN(14) + l * 64;
    const int lane = F.lane;
    const float g_q0 = gq[lane], g_q1 = gq[lane + 64], g_q2 = gq[lane + 128];
    const float g_kv0 = gkv[lane], g_kv1 = gkv[lane + 64], g_kv2 = gkv[lane + 128], g_kv3 = gkv[lane + 192];
    const float g_aq = gaq[lane], g_ak = gak[lane];
    const int rpw = (((MTOK + NGW - 1) / NGW) + 3) & ~3;
    int m0 = gw * rpw, m1 = m0 + rpw; m1 = m1 > MTOK ? MTOK : m1;
    const int f15 = lane & 15;
    for (int mg = m0; mg < m1; mg += 4) {
        float cq[4][3], ckv[4][4], kr1[4], kr2[4], ax[4][6];
#pragma unroll
        for (int r = 0; r < 4; ++r) { const bf16_t* row = P + (size_t)(mg + r) * LDP;
#pragma unroll
            for (int k = 0; k < 3; ++k) cq[r][k] = bf2f(row[PC_CQ + 64 * k + lane]);
#pragma unroll
            for (int k = 0; k < 4; ++k) ckv[r][k] = bf2f(row[PC_CKV + 64 * k + lane]);
            kr1[r] = bf2f(row[PC_KR + f15]); kr2[r] = bf2f(row[PC_KR + 16 + f15]);
#pragma unroll
            for (int hh = 0; hh < 6; ++hh) ax[r][hh] = bf2f(row[(hh < 4 ? PC_AXQ + 64 * hh : PC_AXK + 64 * (hh - 4)) + lane]); }
        float ss[4][8];
#pragma unroll
        for (int r = 0; r < 4; ++r) { ss[r][0] = cq[r][0] * cq[r][0] + cq[r][1] * cq[r][1] + cq[r][2] * cq[r][2];
            ss[r][1] = ckv[r][0] * ckv[r][0] + ckv[r][1] * ckv[r][1] + ckv[r][2] * ckv[r][2] + ckv[r][3] * ckv[r][3];
#pragma unroll
            for (int hh = 0; hh < 6; ++hh) ss[r][2 + hh] = ax[r][hh] * ax[r][hh]; }
#define PREP_BFLY(M) _Pragma("unroll") for (int r = 0; r < 4; ++r) _Pragma("unroll") for (int q = 0; q < 8; ++q) ss[r][q] += xshfl<M>(ss[r][q]);
        PREP_BFLY(1) PREP_BFLY(2) PREP_BFLY(4) PREP_BFLY(8) PREP_BFLY(16) PREP_BFLY(32)
#undef PREP_BFLY
#pragma unroll
        for (int r = 0; r < 4; ++r) { const int m = mg + r; bf16_t* row = dummy ? (bf16_t*)(F.ws + WS_END2) + (size_t)(m & 255) * LDP : P + (size_t)m * LDP;
            const int pos = m & (SEQ - 1), gr = pos >> 6, gc = pos & 63;
            { const float rstd = rsqrtf(ss[r][0] * (1.0f / 192.0f) + EPS);
              row[PC_CQ + lane] = f2bf(cq[r][0] * rstd * g_q0); row[PC_CQ + 64 + lane] = f2bf(cq[r][1] * rstd * g_q1); row[PC_CQ + 128 + lane] = f2bf(cq[r][2] * rstd * g_q2); }
            { const float rstd = rsqrtf(ss[r][1] * (1.0f / 256.0f) + EPS);
              row[PC_CKV + lane] = f2bf(ckv[r][0] * rstd * g_kv0); row[PC_CKV + 64 + lane] = f2bf(ckv[r][1] * rstd * g_kv1); row[PC_CKV + 128 + lane] = f2bf(ckv[r][2] * rstd * g_kv2); row[PC_CKV + 192 + lane] = f2bf(ckv[r][3] * rstd * g_kv3); }
            if (lane < 16) { const int f = lane; const float x1 = kr1[r], x2 = kr2[r];
                const float c = cs[pos * 16 + f], s = cs[SEQ * 16 + pos * 16 + f];
                const unsigned short o1 = f2bf(x1 * c - x2 * s), o2 = f2bf(x1 * s + x2 * c);
                const int p1 = 8 * (f >> 2) + (f & 3), p2 = p1 + 4;
                bf16_t* kr = (dummy ? (bf16_t*)(F.ws + WS_END2) + (size_t)(m & 255) * LDP : KC + (size_t)m * 384) + 64;
#pragma unroll
                for (int h = 0; h < 4; ++h) { kr[96 * h + p1] = o1; kr[96 * h + p2] = o2; } }
            { const int idx = (lane < 32) ? gr : gc;
              const float c = cs[idx * 16 + f15], s = cs[SEQ * 16 + idx * 16 + f15];
#pragma unroll
              for (int hh = 0; hh < 6; ++hh) {
                  bf16_t* p = row + (hh < 4 ? PC_AXQ + 64 * hh : PC_AXK + 64 * (hh - 4)) + lane;
                  const float rstd = rsqrtf(ss[r][2 + hh] * (1.0f / 64.0f) + EPS);
                  const float y = ax[r][hh] * rstd * (hh < 4 ? g_aq * (0.125f * LOG2E) : g_ak);
                  const float pr = xshfl<16>(y);
                  const float o = (lane & 16) ? (pr * s + y * c) : (y * c - pr * s);
                  *p = f2bf(o);
              } }
        }
    }
}
__device__ __forceinline__ void attn_phase(Frame& F, const Args& KA, int l) {
    bf16_t* P = (bf16_t*)(F.ws + WS_PROJ); bf16_t* QC = (bf16_t*)(F.ws + WS_QC); bf16_t* KC = (bf16_t*)(F.ws + WS_KC); bf16_t* VC = (bf16_t*)(F.ws + WS_VC);
    unsigned char* Y8 = F.ws + WS_Y8;
    constexpr int NU = NB * 4 * (SEQ / 256);
#ifndef REP_C
#define REP_C 1
#endif
#ifndef C_UNIT2
#define C_UNIT2 1
#endif
    if (C_UNIT2) {
        for (int L = F.vcu; L < NU / 2; L += F.G) { const int bh = L >> 3, qb = L & 7, b = bh >> 2, h = bh & 3; const size_t rb = (size_t)b * SEQ;
            att::attn_unit2<96, true>(QC + rb * 384 + 96 * h, QC + (rb + 2048) * 384 + 96 * h, KC + rb * 384 + 96 * h, VC + rb * 256 + 64 * h,
                                (bf16_t*)(Y8 + rb * 1024 + 512 + 64 * h), (bf16_t*)(Y8 + (rb + 2048) * 1024 + 512 + 64 * h), 384, 384, 256, 1024, qb * 256, F.lds, F.wave * 64 + lane_now()); }
    } else
    for (int rep = 0; rep < REP_C; ++rep)
    for (int L = F.vcu; L < NU; L += F.G) { const int bh = L >> 4, qb = L & 15, b = bh >> 2, h = bh & 3; const size_t rb = (size_t)b * SEQ;
        att::attn_unit<96, 0>(QC + rb * 384 + 96 * h, KC + rb * 384 + 96 * h, VC + rb * 256 + 64 * h, P + rb * LDP + PC_YC + 64 * h, 384, 384, 256, LDP,
                              qb * 256, 0.10206207261596575f * LOG2E, 0.f, 0.f, nullptr, F.lds, F.wave * 64 + lane_now()); }
#ifndef REP_D
#define REP_D 1
#endif
#ifndef D_NOMAX
#define D_NOMAX 1
#endif
#ifndef REP_B
#define REP_B 1
#endif
#ifndef VAR_A
#define VAR_A 0
#endif
#ifndef REP_A
#define REP_A 1
#endif
    bf16_t* DUMMY = (bf16_t*)(F.ws + WS_END);
    float gqm_ = 0.f, gkm_ = 0.f;
    for (int i = 0; i < 64; ++i) { gqm_ = fmaxf(gqm_, fabsf(GIN(13)[l * 64 + i])); gkm_ = fmaxf(gkm_, fabsf(GIN(14)[l * 64 + i])); }
    const bool d_nomax = D_NOMAX && (11.6f * gqm_ * gkm_ < 60.0f);
    for (int repd = 0; repd < REP_D; ++repd)
    for (int L = F.vcu; L < NU / 2; L += F.G) { const int bk = L >> 4, qb = L & 15, b = bk >> 1, kv = bk & 1; bf16_t* Pb = P + (size_t)b * SEQ * LDP;
        if (d_nomax) att::attn_unit2<64, true, 0, true>(Pb + PC_AXQ + 128 * kv, Pb + PC_AXQ + 128 * kv + 64, Pb + PC_AXK + 64 * kv, Pb + PC_AXV + 64 * kv, (bf16_t*)(Y8 + (size_t)b * SEQ * 1024 + 768 + 128 * kv), (bf16_t*)(Y8 + (size_t)b * SEQ * 1024 + 768 + 128 * kv + 64),
                            LDP, LDP, LDP, 1024, qb * 256, F.lds, F.wave * 64 + lane_now());
        else att::attn_unit2<64, true>(Pb + PC_AXQ + 128 * kv, Pb + PC_AXQ + 128 * kv + 64, Pb + PC_AXK + 64 * kv, Pb + PC_AXV + 64 * kv, (bf16_t*)(Y8 + (size_t)b * SEQ * 1024 + 768 + 128 * kv), (bf16_t*)(Y8 + (size_t)b * SEQ * 1024 + 768 + 128 * kv + 64),
                            LDP, LDP, LDP, 1024, qb * 256, F.lds, F.wave * 64 + lane_now()); }
    for (int L = F.vcu; L < NU / 2; L += F.G) { const int bk = L >> 4, qb = L & 15, b = bk >> 1, kv = bk & 1; bf16_t* Pb = P + (size_t)b * SEQ * LDP; const int hA = 2 * kv, hB = 2 * kv + 1;
        att::attn_unit2<64, true, 1>(Pb + PC_WQ + 64 * hA, Pb + PC_WQ + 64 * hB, Pb + PC_WK + 64 * kv, Pb + PC_WV + 64 * kv, (bf16_t*)(Y8 + (size_t)b * SEQ * 1024 + 256 + 64 * hA), (bf16_t*)(Y8 + (size_t)b * SEQ * 1024 + 256 + 64 * hB),
                            LDP, LDP, LDP, 1024, qb * 256, F.lds, F.wave * 64 + lane_now(), exp2f(-2.0f * (float)(hA + 1)) * LOG2E, exp2f(-2.0f * (float)(hB + 1)) * LOG2E, GIN(8)[l * 4 + hA] * LOG2E, GIN(8)[l * 4 + hB] * LOG2E); }
    for (int repa = 0; repa < REP_A; ++repa)
    for (int L = F.vcu; L < NU / 2; L += F.G) { const int bh = L >> 3, qb = L & 7, b = bh >> 2, h = bh & 3; bf16_t* Pb = P + (size_t)b * SEQ * LDP;
        att::attn_unit2<64, true, 2>(Pb + PC_NAQ + 64 * h, Pb + PC_NAQ + 64 * h + (size_t)32 * LDP, Pb + PC_NAK + 64 * h, Pb + PC_NAV + 64 * h,
                            (bf16_t*)(Y8 + (size_t)b * SEQ * 1024 + 64 * h), (bf16_t*)(Y8 + (size_t)b * SEQ * 1024 + 64 * h + (size_t)32 * 1024),
                            LDP, LDP, LDP, 1024, qb * 512, F.lds, F.wave * 64 + lane_now(), 0.f, 0.f, 0.f, 0.f, GIN(7) + (size_t)(l * 4 + h) * (15 * 31)); }
}

#ifndef REP_BAR
#define REP_BAR 1
#endif
#ifndef REP_G2
#define REP_G2 1
#endif
#ifndef REP_G3
#define REP_G3 1
#endif
#ifndef REP_G5
#define REP_G5 1
#endif
#ifndef REP_G6
#define REP_G6 1
#endif
#ifndef REP_AT
#define REP_AT 1
#endif
#ifndef REP_T1N
#define REP_T1N 1
#endif
#ifndef REP_G4
#define REP_G4 1
#endif
#ifndef REP_TH
#define REP_TH 1
#endif
#ifndef FILL_G1
#define FILL_G1 0
#endif
#ifndef FILL_GR
#define FILL_GR 0
#endif
#ifndef FILL_G5
#define FILL_G5 9216
#endif
#ifndef FILL_G6
#define FILL_G6 0
#endif
constexpr int FILL_A = FILL_G1, FILL_B = FILL_A + FILL_GR, FILL_C = FILL_B + FILL_G5, FILL_END = FILL_C + FILL_G6;
#define FILLER(lo, hi, skip) do { if ((hi) > (lo) && l + 1 < DEPTH && (int)blockIdx.x >= (skip) && F.G > (skip)) { __syncthreads(); \
        convert_weights(F, KA, l + 1, F.ws + (((l + 1) & 1) ? WS_W2 : WS_W), (lo), (hi), ((int)blockIdx.x - (skip)) * NWAVES + F.wave, (F.G - (skip)) * NWAVES, false); } } while (0)
constexpr int FILL_SKIP = 64;
constexpr int PH_PER_LAYER = 10, N_PHASES = 1 + DEPTH * PH_PER_LAYER + 1;

__global__ void __launch_bounds__(NWAVES * 64, 2) mk_fwd(Args KA) {
    extern __shared__ __attribute__((aligned(16))) unsigned char lds_raw[];
    { const int t0 = threadIdx.x; for (int u = t0; u < (LDS_BYTES - RING_BYTES) / 4; u += NWAVES * 64) ((LAS unsigned*)((LAS unsigned char*)lds_raw + RING_BYTES))[u] = 0u; }
    __syncthreads();
    const int wave0 = __builtin_amdgcn_readfirstlane((int)threadIdx.x >> 6);
    XcdBarrier bar = xcd_barrier_post((unsigned*)(KA.ws + WS_CTL) + CW_BAR, (volatile LAS unsigned*)((LAS unsigned char*)lds_raw + LC_BARW));
#define FRAME() Frame F; { int t_ = wave0 * 64 + lane_now(); asm volatile("" : "+v"(t_)); unsigned char* w_ = KA.ws; float* o_ = KA.out; asm volatile("" : "+s"(w_), "+s"(o_)); \
        F.lds = (LAS unsigned char*)lds_raw; F.tid = t_; F.lane = t_ & 63; F.wave = __builtin_amdgcn_readfirstlane(t_ >> 6); F.G = gridDim.x; \
        { const int bx = blockIdx.x; F.vcu = (F.G % 8 == 0) ? (bx % 8) * (F.G / 8) + bx / 8 : bx; } F.ws = (unsigned char*)(GAS unsigned char*)w_; F.out = (float*)(GAS float*)o_; F.ctl = (unsigned*)(F.ws + WS_CTL); } \
        unsigned char* wb = F.ws + ((l & 1) ? WS_W2 : WS_W); bf16_t* HB = (bf16_t*)(F.ws + WS_HB); bf16_t* P = (bf16_t*)(F.ws + WS_PROJ); float* mod = (float*)(F.ws + WS_MOD); bf16_t* XB = (bf16_t*)(F.ws + WS_XB); (void)XB; \
        const float* modl = mod + (size_t)l * NB * 6144; const float* x_in = GIN(0); (void)wb; (void)HB; (void)P; (void)modl; (void)x_in
    const int lo = KA.ph_lo, hi = KA.ph_hi;
#ifndef PHMASK
#define PHMASK 0xFFFF
#endif
#define EN(j) ((PHMASK >> (j)) & 1)
#define IN(k) (lo <= (k) && (k) < hi)
#define SEAM(k) do { if (IN(k) && IN((k) + 1)) { XcdBarrier b_ = bar; asm volatile("" : "+s"(b_.bar)); for (int r_ = 0; r_ < REP_BAR; ++r_) xcd_barrier(b_, wave0 == 0 && lane_now() == 0); } } while (0)

    if (EN(11) && IN(0)) { const int l = 0; FRAME(); p0_phase(F, KA); SEAM(0); }

    for (int l = 0; l < DEPTH; ++l) {
        const int pb = 1 + PH_PER_LAYER * l;
        if (EN(0) && IN(pb + 0)) { FRAME();
            for (int rep = 0; rep < REP_TH; ++rep) convert_weights(F, KA, l, wb, (l == 0 || F.G <= 128) ? 0 : FILL_END, 1 << 30, F.vcu * NWAVES + F.wave, F.G * NWAVES, true);
            if (l > 0) load_moe_tables(F, l - 1);
#ifndef REP_T1
#define REP_T1 1
#endif
            for (int rp1 = 1; rp1 < REP_T1N; ++rp1) norm_phase(F, x_in, l == 0 ? nullptr : XB, (bf16_t*)(F.ws + WS_END4), l > 0, modl - (size_t)NB * 6144 + 5120, GIN(4) + l * DM, modl, modl + 1024, HB, nullptr, nullptr, F.ws + WS_HB8);
            norm_phase(F, x_in, l == 0 ? nullptr : XB, XB, l > 0, modl - (size_t)NB * 6144 + 5120, GIN(4) + l * DM, modl, modl + 1024, HB, nullptr, nullptr, F.ws + WS_HB8);
            SEAM(pb + 0);
        }
        if (EN(1) && IN(pb + 1)) { FRAME();
            pg8::Gemm g{HB, (const bf16_t*)(wb + W_IN), nullptr}; pg8::StaticOrder S; S.init(MTOK, 2304, F.G, (int)blockIdx.x);
            pg8::EpiProj E{P, (LAS float*)(F.lds + LC_XCH), (float*)(F.ws + WS_SSQ), (const float*)(F.ws + WS_ROPE), (bf16_t*)(F.ws + WS_KC), GIN(13) + l * 64, GIN(14) + l * 64, 0};
            pg8::Gemm g8{(const bf16_t*)(F.ws + WS_HB8), (const bf16_t*)(wb + W_G8), nullptr}; pg8::StaticOrder S8; S8.init(MTOK, 4096, F.G, (int)blockIdx.x, 1);
            pg8::EpiProj E8 = E; E8.pn0 = 9;
#ifndef REP_G1
#define REP_G1 1
#endif
            for (int rep = 0; rep < REP_G1; ++rep) {
                pg8::gemm_phase<pg8::EpiProj, pg8::StaticOrder, false, true, DM, DM, DM, 0>(F.lds, g, S, E, F.tid);
                pg8::gemm_phase<pg8::EpiProj, pg8::StaticOrder, false, true, DM / 2, DM / 2, DM / 2, 0, true>(F.lds, g8, S8, E8, F.tid);
            }
            FILLER(0, FILL_A, 128);
            SEAM(pb + 1);
        }
        if (EN(2) && IN(pb + 2)) { FRAME();
            { pg8::Gemm g{P + PC_CQ, (const bf16_t*)(wb + W_UQ), nullptr}; pg8::StaticOrder S; S.init(MTOK, 512, F.G, (int)blockIdx.x);
              pg8::EpiQup E{(bf16_t*)(F.ws + WS_QC), (const float*)(F.ws + WS_ROPE), (const float*)(F.ws + WS_SSQ)};
              for (int rep = 0; rep < REP_G2; ++rep) pg8::gemm_phase<pg8::EpiQup, pg8::StaticOrder, false, true, LDP, 256, 256, 0>(F.lds, g, S, E, F.tid); }
            { pg8::Gemm g{P + PC_CKV, (const bf16_t*)(wb + W_UKV), nullptr}; pg8::StaticOrder S; S.init(MTOK, 512, F.G, (int)blockIdx.x);
              pg8::EpiKVup E{(bf16_t*)(F.ws + WS_KC), (bf16_t*)(F.ws + WS_VC), (const float*)(F.ws + WS_SSQ)};
              for (int rep = 0; rep < REP_G2; ++rep) pg8::gemm_phase<pg8::EpiKVup, pg8::StaticOrder, false, true, LDP, 256, 256, 0>(F.lds, g, S, E, F.tid); }
            SEAM(pb + 2);
        }
        if (EN(3) && IN(pb + 3)) { FRAME(); for (int rep = 0; rep < REP_AT; ++rep) { attn_phase(F, KA, l); __syncthreads(); } SEAM(pb + 3); }
        if (EN(4) && IN(pb + 4)) { FRAME();
            for (int rep = 0; rep < REP_G3; ++rep) { pg8::merge_phase3(F.lds, P, F.ws + WS_Y8, wb + W_BR, HB, F.G, F.vcu, F.tid); __syncthreads(); }
            SEAM(pb + 4);
        }
        if (EN(5) && IN(pb + 5)) { FRAME();
            pg8::Gemm g{HB, (const bf16_t*)(wb + W_OUT), nullptr}; pg8::StaticOrder S; S.init(MTOK, DM, F.G, (int)blockIdx.x);
            pg8::EpiResid E{l == 0 ? x_in : nullptr, XB, modl + 2048, XB};
            { pg8::EpiResid Ep{l == 0 ? x_in : nullptr, XB, modl + 2048, (bf16_t*)(F.ws + WS_END4)}; for (int rp4 = 1; rp4 < REP_G4; ++rp4) pg8::gemm_phase<pg8::EpiResid, pg8::StaticOrder, false, false, DM, DM, DM, 0>(F.lds, g, S, Ep, F.tid); }
            pg8::gemm_phase<pg8::EpiResid, pg8::StaticOrder, false, false, DM, DM, DM, 0>(F.lds, g, S, E, F.tid);
            SEAM(pb + 5);
        }
        if (EN(6) && IN(pb + 6)) { FRAME(); norm_phase(F, nullptr, XB, nullptr, false, nullptr, GIN(5) + l * DM, modl + 3072, modl + 4096, HB, nullptr); SEAM(pb + 6); }
        if (EN(7) && IN(pb + 7)) { FRAME();
            pg8::Gemm g{HB, (const bf16_t*)(wb + W_RT), nullptr}; pg8::StaticOrder S; S.init(MTOK, 256, F.G, (int)blockIdx.x);
            pg8::EpiRoute E{GIN(18) + l * 4, GIN(20) + l * 32, F.ctl + CW_ECNT + 64 * l, (int*)(F.ws + WS_LIST), (int*)(F.ws + WS_TOKES), (float*)(F.ws + WS_TOKW)};
            pg8::gemm_phase<pg8::EpiRoute, pg8::StaticOrder, false, false, DM, DM, DM, 0, false, true>(F.lds, g, S, E, F.tid);
            FILLER(FILL_A, FILL_B, 128);
            SEAM(pb + 7);
        }
        if (EN(8) && IN(pb + 8)) { FRAME();
            load_moe_tables(F, l);
            pg8::Gemm g{HB, (const bf16_t*)(wb + W_E13), (const int*)(F.ws + WS_LIST)};
            pg8::MoeOrder S{F.G, (int)blockIdx.x, 1, (const LAS int*)(F.lds + LC_TEND), (const LAS int*)(F.lds + LC_CNT)};
            pg8::EpiExp1 E{(bf16_t*)(F.ws + WS_HS)};
            for (int rep = 0; rep < REP_G5; ++rep) pg8::gemm_phase<pg8::EpiExp1, pg8::MoeOrder, true, true, DM, DM, DM, 512>(F.lds, g, S, E, F.tid);
            FILLER(FILL_B, FILL_C, 64);
            SEAM(pb + 8);
        }
        if (EN(9) && IN(pb + 9)) { FRAME();
            load_moe_tables(F, l);
            pg8::Gemm g{(const bf16_t*)(F.ws + WS_HS), (const bf16_t*)(wb + W_E2), nullptr};
            pg8::MoeOrder S{F.G, (int)blockIdx.x, 2, (const LAS int*)(F.lds + LC_TEND), (const LAS int*)(F.lds + LC_CNT)};
            pg8::EpiStore E{(bf16_t*)(F.ws + WS_YS), DM};
            for (int rep = 0; rep < REP_G6; ++rep) pg8::gemm_phase<pg8::EpiStore, pg8::MoeOrder, false, true, 256, 256, 256, DM>(F.lds, g, S, E, F.tid);
            FILLER(FILL_C, FILL_END, 64);
            SEAM(pb + 9);
        }
    }
    if (EN(12) && IN(N_PHASES - 1)) { const int l = DEPTH - 1; FRAME();
        load_moe_tables(F, DEPTH - 1);
        norm_phase(F, nullptr, XB, nullptr, true, modl + 5120, GIN(24), nullptr, nullptr, nullptr, F.out);
    }
#undef IN
#undef SEAM
}

#ifndef MK_LAUNCH_PER_PHASE
#define MK_LAUNCH_PER_PHASE 0
#endif
extern "C" void kernel_launch(void* const* d_in, const int* in_sizes, int n_in, void* d_out, int out_size, void* d_ws, size_t ws_size, hipStream_t stream) {
    static int grid = 0;
    if (grid == 0) {
        int dev = 0, cus = 0;
        if (n_in != 25 || ws_size < WS_END4 || hipGetDevice(&dev) != hipSuccess || hipDeviceGetAttribute(&cus, hipDeviceAttributeMultiprocessorCount, dev) != hipSuccess) { grid = -1; return; }
        if (hipFuncSetAttribute((const void*)mk_fwd, hipFuncAttributeMaxDynamicSharedMemorySize, LDS_BYTES) != hipSuccess) { grid = -1; return; }
        grid = cus;
    }
    if (grid < 0) return;
    (void)hipMemsetAsync((char*)d_ws + WS_CTL, 0, CTL_ZERO_BYTES, stream);
    Args a{};
    for (int i = 0; i < 25; ++i) a.in[i] = (const float*)d_in[i];
    a.out = (float*)d_out; a.ws = (unsigned char*)d_ws;
#if MK_LAUNCH_PER_PHASE
#ifndef PH_MAX
#define PH_MAX N_PHASES
#endif
    for (int p = 0; p < PH_MAX; ++p) { a.ph_lo = p; a.ph_hi = p + 1; hipLaunchKernelGGL(mk_fwd, dim3(grid), dim3(NWAVES * 64), LDS_BYTES, stream, a); }
#else
    a.ph_lo = 0; a.ph_hi = N_PHASES;
    hipLaunchKernelGGL(mk_fwd, dim3(grid), dim3(NWAVES * 64), LDS_BYTES, stream, a);
#endif
}
```
